# Optimizing an MI355X kernel written in HIP

```python
import jax
import jax.numpy as jnp
from jax import lax
import numpy as np

D_MODEL = 1024
BATCH = 4
SEQ = 8192
DEPTH = 4

GRID_W = 64
CTX_LEN = 256
N_MIXERS = 4
BLOCK = 128
WINDOW = 128
WIN_HEADS = 16
WIN_KV = 4
WIN_HD = 64
AX_HEADS = 8
AX_KV = 2
AX_HD = 128
ML_HEADS = 4
ML_DK = 128
ML_DV = 256
ML_CHUNK = 128
D_FF = 2816
ROPE_THETA = 10000.0
EPS = 1e-6
NEG = -1e30

kernel_name = 'hybrid_interleaved_diffusion_block'


def rms_norm(x, g):
    xf = x.astype(jnp.float32)
    y = xf * lax.rsqrt(jnp.mean(xf * xf, axis=-1, keepdims=True) + EPS)
    return (y * g.astype(jnp.float32)).astype(x.dtype)


def dwconv3(x, w):
    xp = jnp.pad(x, ((0, 0), (1, 1), (0, 0)))
    return xp[:, :-2] * w[0] + xp[:, 1:-1] * w[1] + xp[:, 2:] * w[2]


def adaln(cvec, w, b):
    m = (jax.nn.silu(cvec) @ w + b)[..., None, :]
    return jnp.split(m, 6, axis=-1)


def modulate(x, shift, scale):
    return x * (1 + scale) + shift


def axial_rope(n_tok, hd):
    rows = n_tok // GRID_W
    row = jnp.repeat(jnp.arange(rows, dtype=jnp.float32), GRID_W)
    col = jnp.tile(jnp.arange(GRID_W, dtype=jnp.float32), rows)
    n_freq = hd // 4
    inv = jnp.power(ROPE_THETA, -jnp.arange(n_freq, dtype=jnp.float32) / n_freq)
    ang = jnp.concatenate([row[:, None] * inv, col[:, None] * inv], axis=-1)
    return jnp.cos(ang), jnp.sin(ang)


def apply_rope(t, cos, sin):
    t1, t2 = jnp.split(t, 2, axis=-1)
    cos = cos.astype(t.dtype)
    sin = sin.astype(t.dtype)
    return jnp.concatenate([t1 * cos - t2 * sin, t2 * cos + t1 * sin], axis=-1)


def split_heads(t, n_heads, hd):
    b, s, _ = t.shape
    return t.reshape(b, s, n_heads, hd).transpose(0, 2, 1, 3)


def merge_heads(o):
    b, _, _, s, _ = o.shape
    return o.transpose(0, 3, 1, 2, 4).reshape(b, s, -1)


def qkv_heads(a, w_qkv, q_norm, k_norm, n_heads, n_kv, hd):
    b, s, _ = a.shape
    q, k, v = jnp.split(a @ w_qkv, [n_heads * hd, (n_heads + n_kv) * hd], axis=-1)
    q = rms_norm(split_heads(q, n_heads, hd), q_norm).reshape(b, n_kv, n_heads // n_kv, s, hd)
    k = rms_norm(split_heads(k, n_kv, hd), k_norm)
    v = split_heads(v, n_kv, hd)
    return q, k, v


def gqa_softmax(q, k, v, mask, sink):
    s = jnp.einsum('bkgqd,bkjd->bkgqj', q, k, preferred_element_type=jnp.float32) * (q.shape[-1] ** -0.5)
    if mask is not None:
        s = jnp.where(mask, s, NEG)
    if sink is None:
        p = jax.nn.softmax(s, axis=-1)
    else:
        sk = sink.astype(jnp.float32)[None, :, :, None, None]
        m = jnp.maximum(s.max(axis=-1, keepdims=True), sk)
        e = jnp.exp(s - m)
        p = e / (e.sum(axis=-1, keepdims=True) + jnp.exp(sk - m))
    return jnp.einsum('bkgqj,bkjd->bkgqd', p.astype(v.dtype), v)


def window_attention_mixer(a_lat, a_ctx, w_qkv, q_norm, k_norm, sink, w_o, ctx_out):
    b, s, _ = a_lat.shape
    nb = s // BLOCK
    g = WIN_HEADS // WIN_KV
    span = BLOCK + 2 * WINDOW
    q, k, v = qkv_heads(a_lat, w_qkv, q_norm, k_norm, WIN_HEADS, WIN_KV, WIN_HD)
    qc, kc, vc = qkv_heads(a_ctx, w_qkv, q_norm, k_norm, WIN_HEADS, WIN_KV, WIN_HD)
    cos, sin = axial_rope(s, WIN_HD)
    q = apply_rope(q, cos, sin)
    k = apply_rope(k, cos, sin)
    sink = sink.reshape(WIN_KV, g)
    kp = jnp.pad(k, ((0, 0), (0, 0), (WINDOW, WINDOW), (0, 0)))
    vp = jnp.pad(v, ((0, 0), (0, 0), (WINDOW, WINDOW), (0, 0)))
    qb = jnp.moveaxis(q.reshape(b, WIN_KV, g, nb, BLOCK, WIN_HD), 3, 0)
    offs = jnp.arange(span) - WINDOW
    ctx_cols = jnp.ones((BLOCK, kc.shape[2]), bool)

    def block(args):
        bi, qblk = args
        start = bi * BLOCK
        kw = jnp.concatenate([lax.dynamic_slice_in_dim(kp, start, span, axis=2), kc], axis=2)
        vw = jnp.concatenate([lax.dynamic_slice_in_dim(vp, start, span, axis=2), vc], axis=2)
        qpos = start + jnp.arange(BLOCK)
        kpos = start + offs
        band = (jnp.abs(qpos[:, None] - kpos[None, :]) <= WINDOW) & (kpos >= 0)[None, :] & (kpos < s)[None, :]
        return gqa_softmax(qblk, kw, vw, jnp.concatenate([band, ctx_cols], axis=1), sink)

    o = lax.map(block, (jnp.arange(nb), qb))
    o = jnp.moveaxis(o, 0, 3).reshape(b, WIN_KV, g, s, WIN_HD)
    y_lat = merge_heads(o) @ w_o
    y_ctx = merge_heads(gqa_softmax(qc, kc, vc, None, sink)) @ w_o if ctx_out else None
    return y_lat, y_ctx


def short_conv_mixer(a, w_in, conv_w, w_out):
    gate_b, gate_c, u = jnp.split(a @ w_in, 3, axis=-1)
    return (gate_b * dwconv3(gate_c * u, conv_w)) @ w_out


def axial_attention_mixer(a_lat, a_ctx, w_qkv, q_norm, k_norm, w_o, ctx_out):
    b, s, _ = a_lat.shape
    nb = s // BLOCK
    g = AX_HEADS // AX_KV
    q, k, v = qkv_heads(a_lat, w_qkv, q_norm, k_norm, AX_HEADS, AX_KV, AX_HD)
    qc, kc, vc = qkv_heads(a_ctx, w_qkv, q_norm, k_norm, AX_HEADS, AX_KV, AX_HD)
    cos, sin = axial_rope(s, AX_HD)
    q = apply_rope(q, cos, sin)
    k = apply_rope(k, cos, sin)
    k_all = jnp.concatenate([k, kc], axis=2)
    v_all = jnp.concatenate([v, vc], axis=2)
    qb = jnp.moveaxis(q.reshape(b, AX_KV, g, nb, BLOCK, AX_HD), 3, 0)

    def block(qblk):
        return gqa_softmax(qblk, k_all, v_all, None, None)

    o = lax.map(block, qb)
    o = jnp.moveaxis(o, 0, 3).reshape(b, AX_KV, g, s, AX_HD)
    y_lat = merge_heads(o) @ w_o
    y_ctx = merge_heads(gqa_softmax(qc, kc, vc, None, None)) @ w_o if ctx_out else None
    return y_lat, y_ctx


def mlstm_chunk_summary(k, v, log_i, log_f):
    cum = jnp.cumsum(log_f, axis=-1)
    a = cum[..., -1:] - cum + log_i
    m = a.max(axis=-1)
    w = jnp.exp(a - m[..., None])
    c_bar = jnp.einsum('...lv,...lk->...vk', v * w[..., None], k)
    n_bar = jnp.einsum('...l,...lk->...k', w, k)
    return c_bar, n_bar, m, cum


def mlstm_final_state(k, v, log_i, log_f):
    c_bar, n_bar, m, _ = mlstm_chunk_summary(k, v, log_i, log_f)
    return (c_bar, n_bar, m)


def mlstm_chunkwise(q, k, v, log_i, log_f, state):
    b, h, s, dk = q.shape
    dv = v.shape[-1]
    nc = s // ML_CHUNK
    qc = q.reshape(b, h, nc, ML_CHUNK, dk)
    kc = k.reshape(b, h, nc, ML_CHUNK, dk)
    vc = v.reshape(b, h, nc, ML_CHUNK, dv)
    lic = log_i.reshape(b, h, nc, ML_CHUNK)
    lfc = log_f.reshape(b, h, nc, ML_CHUNK)
    c_bar, n_bar, m_bar, cum = mlstm_chunk_summary(kc, vc, lic, lfc)

    def step(carry, xs):
        c_prev, n_prev, m_prev = carry
        cb, nb_, mb, gb = xs
        m_new = jnp.maximum(gb + m_prev, mb)
        decay = jnp.exp(gb + m_prev - m_new)
        inj = jnp.exp(mb - m_new)
        c_new = decay[..., None, None] * c_prev + inj[..., None, None] * cb
        n_new = decay[..., None] * n_prev + inj[..., None] * nb_
        return (c_new, n_new, m_new), (c_prev, n_prev, m_prev)

    xs = (jnp.moveaxis(c_bar, 2, 0), jnp.moveaxis(n_bar, 2, 0), jnp.moveaxis(m_bar, 2, 0), jnp.moveaxis(cum[..., -1], 2, 0))
    final, (c_start, n_start, m_start) = lax.scan(step, state, xs)
    c_start = jnp.moveaxis(c_start, 0, 2)
    n_start = jnp.moveaxis(n_start, 0, 2)
    m_start = jnp.moveaxis(m_start, 0, 2)
    tri = jnp.tril(jnp.ones((ML_CHUNK, ML_CHUNK), bool))
    d = jnp.where(tri, cum[..., :, None] - cum[..., None, :] + lic[..., None, :], NEG)
    inter = cum + m_start[..., None]
    m_t = jnp.maximum(inter, d.max(axis=-1))
    w_intra = jnp.exp(d - m_t[..., None])
    w_inter = jnp.exp(inter - m_t)
    qk = jnp.einsum('bhcld,bhcsd->bhcls', qc, kc) * w_intra
    num = jnp.einsum('bhcls,bhcsv->bhclv', qk, vc) + w_inter[..., None] * jnp.einsum('bhcld,bhcvd->bhclv', qc, c_start)
    den = qk.sum(axis=-1) + w_inter * jnp.einsum('bhcld,bhcd->bhcl', qc, n_start)
    out = num / jnp.maximum(jnp.abs(den), jnp.exp(-m_t))[..., None]
    return out.reshape(b, h, s, dv), final


def mlstm_mixer(a_lat, a_ctx, w_in, b_gate, h_norm, w_out, ctx_out):
    qk_w = ML_HEADS * ML_DK
    v_w = ML_HEADS * ML_DV

    def proj(a):
        b, s, _ = a.shape
        q, k, v, o, gates = jnp.split(a @ w_in, [qk_w, 2 * qk_w, 2 * qk_w + v_w, 2 * qk_w + 2 * v_w], axis=-1)
        q = split_heads(q, ML_HEADS, ML_DK).astype(jnp.float32) * (ML_DK ** -0.5)
        k = split_heads(k, ML_HEADS, ML_DK).astype(jnp.float32)
        v = split_heads(v, ML_HEADS, ML_DV).astype(jnp.float32)
        gates = (gates + b_gate).astype(jnp.float32).reshape(b, s, 4, ML_HEADS).transpose(2, 0, 3, 1)
        fwd = (gates[0], jax.nn.log_sigmoid(gates[1]))
        bwd = (gates[2], jax.nn.log_sigmoid(gates[3]))
        return q, k, v, o, fwd, bwd

    def flip(t):
        return jnp.flip(t, axis=2)

    def readout(h_f, h_b, o):
        hs = rms_norm(h_f + flip(h_b), h_norm)
        b, h, s, dv = hs.shape
        hs = hs.transpose(0, 2, 1, 3).reshape(b, s, h * dv).astype(o.dtype)
        return (jax.nn.sigmoid(o) * hs) @ w_out

    qc, kc, vc, oc, gfc, gbc = proj(a_ctx)
    bsz = a_ctx.shape[0]
    zero = (jnp.zeros((bsz, ML_HEADS, ML_DV, ML_DK), jnp.float32),
            jnp.zeros((bsz, ML_HEADS, ML_DK), jnp.float32),
            jnp.full((bsz, ML_HEADS), NEG, jnp.float32))
    if ctx_out:
        hc_f, st_f = mlstm_chunkwise(qc, kc, vc, gfc[0], gfc[1], zero)
        hc_b, st_b = mlstm_chunkwise(flip(qc), flip(kc), flip(vc), flip(gbc[0]), flip(gbc[1]), zero)
        y_ctx = readout(hc_f, hc_b, oc)
    else:
        st_f = mlstm_final_state(kc, vc, gfc[0], gfc[1])
        st_b = mlstm_final_state(flip(kc), flip(vc), flip(gbc[0]), flip(gbc[1]))
        y_ctx = None
    ql, kl, vl, ol, gfl, gbl = proj(a_lat)
    hl_f, _ = mlstm_chunkwise(ql, kl, vl, gfl[0], gfl[1], st_f)
    hl_b, _ = mlstm_chunkwise(flip(ql), flip(kl), flip(vl), flip(gbl[0]), flip(gbl[1]), st_b)
    return readout(hl_f, hl_b, ol), y_ctx


def conv_ffn(a, w_up, conv_w, w_down):
    g, u = jnp.split(dwconv3(a @ w_up, conv_w), 2, axis=-1)
    return (jax.nn.silu(g) * u) @ w_down


def setup_inputs(seed: int = 0) -> dict:
    d = D_MODEL
    n_win, n_sc, n_ax, n_ml = [len(range(kind, DEPTH, N_MIXERS)) for kind in range(N_MIXERS)]
    keys = iter(jax.random.split(jax.random.key(seed), 40))

    def normal(shape, std):
        return std * jax.random.normal(next(keys), shape, jnp.float32)

    def gain(shape):
        return 1.0 + normal(shape, 0.1)

    ml_in = 2 * ML_HEADS * ML_DK + 2 * ML_HEADS * ML_DV + 4 * ML_HEADS
    f_base = jnp.linspace(3.0, 6.0, ML_HEADS, dtype=jnp.float32)
    zeros_h = jnp.zeros((ML_HEADS,), jnp.float32)
    gate_base = jnp.concatenate([zeros_h, f_base, zeros_h, f_base])
    return {
        'x': normal((BATCH, SEQ, d), 1.0),
        'c': normal((BATCH, d), 1.0),
        'ctx': normal((BATCH, CTX_LEN, d), 1.0),
        'c_ctx': normal((d,), 1.0),
        'ada_w': normal((DEPTH, d, 6 * d), 0.5 * d ** -0.5),
        'ada_b': normal((DEPTH, 6 * d), 0.02),
        'norm_mix': gain((DEPTH, d)),
        'norm_ffn': gain((DEPTH, d)),
        'ffn_w_up': normal((DEPTH, d, 2 * D_FF), d ** -0.5),
        'ffn_conv': normal((DEPTH, 3, 2 * D_FF), 3 ** -0.5),
        'ffn_w_down': normal((DEPTH, D_FF, d), D_FF ** -0.5),
        'win_w_qkv': normal((n_win, d, (WIN_HEADS + 2 * WIN_KV) * WIN_HD), d ** -0.5),
        'win_q_norm': gain((n_win, WIN_HD)),
        'win_k_norm': gain((n_win, WIN_HD)),
        'win_sink': normal((n_win, WIN_HEADS), 0.5),
        'win_w_o': normal((n_win, WIN_HEADS * WIN_HD, d), (WIN_HEADS * WIN_HD) ** -0.5),
        'sc_w_in': normal((n_sc, d, 3 * d), d ** -0.5),
        'sc_conv': normal((n_sc, 3, d), 3 ** -0.5),
        'sc_w_out': normal((n_sc, d, d), d ** -0.5),
        'ax_w_qkv': normal((n_ax, d, (AX_HEADS + 2 * AX_KV) * AX_HD), d ** -0.5),
        'ax_q_norm': gain((n_ax, AX_HD)),
        'ax_k_norm': gain((n_ax, AX_HD)),
        'ax_w_o': normal((n_ax, AX_HEADS * AX_HD, d), (AX_HEADS * AX_HD) ** -0.5),
        'ml_w_in': normal((n_ml, d, ml_in), d ** -0.5),
        'ml_b_gate': gate_base + normal((n_ml, 4 * ML_HEADS), 0.1),
        'ml_h_norm': gain((n_ml, ML_DV)),
        'ml_w_out': normal((n_ml, ML_HEADS * ML_DV, d), (ML_HEADS * ML_DV) ** -0.5),
    }


def reference(x, c, ctx, c_ctx, ada_w, ada_b, norm_mix, norm_ffn, ffn_w_up, ffn_conv, ffn_w_down,
              win_w_qkv, win_q_norm, win_k_norm, win_sink, win_w_o,
              sc_w_in, sc_conv, sc_w_out,
              ax_w_qkv, ax_q_norm, ax_k_norm, ax_w_o,
              ml_w_in, ml_b_gate, ml_h_norm, ml_w_out):
    h, hc = x, ctx
    for i in range(DEPTH):
        kind, j = i % N_MIXERS, i // N_MIXERS
        ctx_out = i < DEPTH - 1
        sh1, sc1, g1, sh2, sc2, g2 = adaln(c, ada_w[i], ada_b[i])
        a_lat = modulate(rms_norm(h, norm_mix[i]), sh1, sc1)
        if ctx_out or kind != 1:
            csh1, csc1, cg1, csh2, csc2, cg2 = adaln(c_ctx, ada_w[i], ada_b[i])
            a_ctx = modulate(rms_norm(hc, norm_mix[i]), csh1, csc1)
        if kind == 0:
            y_lat, y_ctx = window_attention_mixer(a_lat, a_ctx, win_w_qkv[j], win_q_norm[j], win_k_norm[j],
                                                  win_sink[j], win_w_o[j], ctx_out)
        elif kind == 1:
            y_lat = short_conv_mixer(a_lat, sc_w_in[j], sc_conv[j], sc_w_out[j])
            y_ctx = short_conv_mixer(a_ctx, sc_w_in[j], sc_conv[j], sc_w_out[j]) if ctx_out else None
        elif kind == 2:
            y_lat, y_ctx = axial_attention_mixer(a_lat, a_ctx, ax_w_qkv[j], ax_q_norm[j], ax_k_norm[j],
                                                 ax_w_o[j], ctx_out)
        else:
            y_lat, y_ctx = mlstm_mixer(a_lat, a_ctx, ml_w_in[j], ml_b_gate[j], ml_h_norm[j], ml_w_out[j], ctx_out)
        h = h + g1 * y_lat
        h = h + g2 * conv_ffn(modulate(rms_norm(h, norm_ffn[i]), sh2, sc2), ffn_w_up[i], ffn_conv[i], ffn_w_down[i])
        if ctx_out:
            hc = hc + cg1 * y_ctx
            hc = hc + cg2 * conv_ffn(modulate(rms_norm(hc, norm_ffn[i]), csh2, csc2),
                                     ffn_w_up[i], ffn_conv[i], ffn_w_down[i])
    return h
```

```cpp
#include <hip/hip_runtime.h>
#include <cstdio>
#include <cstdint>
namespace pg8 {
#define PG8_LAS __attribute__((address_space(3)))
typedef unsigned short bf16_t;
typedef short bf16x8 __attribute__((ext_vector_type(8)));
typedef float f32x4 __attribute__((ext_vector_type(4)));
typedef unsigned u32x4 __attribute__((ext_vector_type(4)));
constexpr int BM = 256, BK = 64, HALF = 128, HTB = HALF * BK * 2  , STAGE_BYTES = 8 * HTB, NXCD = 8, WGM = 8;

__host__ __device__ __forceinline__ int lds_byte(int r, int c) { const int st = (r >> 4) * 2 + (c >> 5), rr = r & 15, cc = c & 31, ob = rr * 64 + cc * 2; return st * 1024 + (ob ^ (((ob >> 9) & 1) << 5)); }
__host__ __device__ __forceinline__ void stage_rc(int b, int& R, int& C) { const int st = b / 1024, sb = b % 1024, swz = sb ^ (((sb >> 9) & 1) << 5); R = (st >> 1) * 16 + swz / 64; C = (st & 1) * 32 + (swz % 64) / 2; }
__host__ __device__ __forceinline__ int perm32(int rho) { const int n = rho >> 4, i = rho & 15; return 8 * (i >> 2) + 4 * n + (i & 3); }

struct Unit { int pm, pn; };
struct Gemm { const bf16_t* A; const bf16_t* Bt; int M, N, K; };

struct StaticOrder {
    int nM, nN, nwg, G, c;
    __host__ __device__ void init(int M, int N, int G_, int c_) { nM = M / BM; nN = N / BM; nwg = nM * nN; G = G_; c = c_; }
    __host__ __device__ bool next(int i, Unit& u) const {
        const long L = (long)i * G + c; if (L >= nwg) return false;
        int wgid = (int)L; { const int q = nwg / NXCD, r = nwg % NXCD, xcd = wgid % NXCD, off = wgid / NXCD; wgid = (xcd < r ? xcd * (q + 1) : r * (q + 1) + (xcd - r) * q) + off; }
        const int nig = WGM * nN, gid = wgid / nig, fm = gid * WGM, gsz = (nM - fm) < WGM ? (nM - fm) : WGM;
        u.pm = fm + ((wgid % nig) % gsz); u.pn = (wgid % nig) / gsz; return true;
    }
    __device__ __forceinline__ void a_ready(const Unit&) const {}
    __device__ __forceinline__ void done(const Unit&) const {}
};

__device__ __forceinline__ unsigned cvt_pk_bf16(float lo, float hi) { unsigned r; asm volatile("v_cvt_pk_bf16_f32 %0, %1, %2" : "=v"(r) : "v"(lo), "v"(hi)); return r; }
typedef float f32x2 __attribute__((ext_vector_type(2)));
struct EpiStoreBf16 {
    static constexpr bool PERM = true, AFTER_DRAIN = false;
    bf16_t* O; int ldc;
    __device__ __forceinline__ void operator()(const f32x4 (&acc)[2][2][4][2], const Unit& u, int wr, int wc, int fr, int fq) const {
        const int row0 = u.pm * BM + wr * 64 + fr, col0 = u.pn * BM + wc * 32 + 8 * fq;
#pragma unroll
        for (int ai = 0; ai < 2; ++ai)
#pragma unroll
            for (int m = 0; m < 4; ++m) { bf16_t* rowp = O + (size_t)(row0 + ai * HALF + m * 16) * ldc + col0;
#pragma unroll
                for (int bj = 0; bj < 2; ++bj) { const f32x4 v0 = acc[ai][bj][m][0], v1 = acc[ai][bj][m][1];
                    u32x4 w; w.x = cvt_pk_bf16(v0[0], v0[1]); w.y = cvt_pk_bf16(v0[2], v0[3]); w.z = cvt_pk_bf16(v1[0], v1[1]); w.w = cvt_pk_bf16(v1[2], v1[3]);
                    *(u32x4*)(rowp + bj * HALF) = w; } }
    }
};
struct EpiResid {
    static constexpr bool PERM = false, AFTER_DRAIN = false;
    const float* base_lat; const float* base_ctx; float* out_lat; float* out_ctx; const float* gate; int tile0;
    __device__ __forceinline__ void operator()(const f32x4 (&acc)[2][2][4][2], const Unit& u, int wr, int wc, int fr, int fq) const {
        const int tile = tile0 + u.pm; const int mb = tile < 128 ? (tile >> 5) : 4;
        const float* bp = tile < 128 ? base_lat + (size_t)tile * (256 * 1024) : base_ctx + (size_t)(tile - 128) * (256 * 1024);
        float* op = tile < 128 ? out_lat + (size_t)tile * (256 * 1024) : out_ctx + (size_t)(tile - 128) * (256 * 1024);
        const int col0 = u.pn * BM + wc * 32 + 4 * fq;
        f32x4 g[2][2];
#pragma unroll
        for (int bj = 0; bj < 2; ++bj)
#pragma unroll
            for (int n = 0; n < 2; ++n) g[bj][n] = *(const f32x4*)(gate + mb * 6144 + col0 + bj * HALF + n * 16);
#pragma unroll
        for (int ai = 0; ai < 2; ++ai)
#pragma unroll
            for (int m = 0; m < 4; ++m) { const size_t off = (size_t)(ai * HALF + wr * 64 + m * 16 + fr) * 1024 + col0;
#pragma unroll
                for (int bj = 0; bj < 2; ++bj)
#pragma unroll
                    for (int n = 0; n < 2; ++n) { const f32x4 bs = *(const f32x4*)(bp + off + bj * HALF + n * 16); *(f32x4*)(op + off + bj * HALF + n * 16) = bs + g[bj][n] * acc[ai][bj][m][n]; }
                asm volatile("" ::: "memory"); }
    }
};
template <class Epi, class Sched, bool ALIGN_EPI = false, bool SP2 = false>
__device__ __forceinline__ void gemm_phase(PG8_LAS unsigned char* lds, const Gemm g, const Sched& S, const Epi& E, const int tid) {
    const int wid = __builtin_amdgcn_readfirstlane(tid >> 6), lane = tid & 63, wr = wid >> 2, wc = wid & 3, fr = lane & 15, fq = lane >> 4;
    const int K = g.K, nt = K / BK;
    unsigned voffA[2], voffB[2];
#pragma unroll
    for (int i = 0; i < 2; ++i) { int R, C; stage_rc(tid * 16 + i * 8192, R, C); const int Rb = Epi::PERM ? ((R & ~31) + perm32(R & 31)) : R;
        voffA[i] = (unsigned)(R * K + C) * 2u; voffB[i] = (unsigned)(Rb * K + C) * 2u; }
    const size_t kstep = (size_t)(BK * 2);
    const size_t hstep = (size_t)HALF * K * 2;
    const size_t tstep = 2 * hstep;
    const unsigned ldsw = (unsigned)wid * 1024u;
    const int aoff = lds_byte(wr * 64 + fr, fq * 8), boff = lds_byte(wc * 32 + fr, fq * 8);
#define PG8_SA(b, h) (((b) * 2 + (h)) * HTB)
#define PG8_SB(b, h) ((4 + (b) * 2 + (h)) * HTB)
#define PG8_STAGE(bufoff, gbase, voff) do { _Pragma("unroll") for (int _i = 0; _i < 2; ++_i) \
        __builtin_amdgcn_global_load_lds((const unsigned*)((const char*)(gbase) + (voff)[_i]), (PG8_LAS unsigned*)(lds + (bufoff) + ldsw + _i * 8192), 16, 0, 0); } while (0)
#define PG8_LDA(dst, b, h) do { _Pragma("unroll") for (int m = 0; m < 4; ++m) _Pragma("unroll") for (int k = 0; k < 2; ++k) dst[m][k] = *(const PG8_LAS bf16x8*)(lds + PG8_SA(b, h) + aoff + m * 2048 + k * 1024); } while (0)
#define PG8_LDB(dst, b, h) do { _Pragma("unroll") for (int n = 0; n < 2; ++n) _Pragma("unroll") for (int k = 0; k < 2; ++k) dst[n][k] = *(const PG8_LAS bf16x8*)(lds + PG8_SB(b, h) + boff + n * 2048 + k * 1024); } while (0)
#define PG8_MMA(ai, bj, At, Bt) do { __builtin_amdgcn_s_setprio(1); _Pragma("unroll") for (int m = 0; m < 4; ++m) _Pragma("unroll") for (int n = 0; n < 2; ++n) _Pragma("unroll") for (int k = 0; k < 2; ++k) \
        acc[ai][bj][m][n] = __builtin_amdgcn_mfma_f32_16x16x32_bf16(Bt[n][k], At[m][k], acc[ai][bj][m][n], 0, 0, 0); __builtin_amdgcn_s_setprio(0); } while (0)
#define PG8_WAIT_V(n) asm volatile("s_waitcnt vmcnt(" #n ")" ::: "memory")
#define PG8_WAIT_L(n) asm volatile("s_waitcnt lgkmcnt(" #n ")" ::: "memory")
#define PG8_BAR __builtin_amdgcn_s_barrier()
#define PG8_SCHED __builtin_amdgcn_sched_barrier(0)
    Unit cur, nxt; int ui = 0;
    if (!S.next(0, cur)) return;
    f32x4 acc[2][2][4][2];
#pragma unroll
    for (int a = 0; a < 2; ++a)
#pragma unroll
        for (int b = 0; b < 2; ++b)
#pragma unroll
            for (int m = 0; m < 4; ++m)
#pragma unroll
                for (int n = 0; n < 2; ++n) acc[a][b][m][n] = (f32x4){0.f, 0.f, 0.f, 0.f};
    bf16x8 At[4][2], B0[2][2], B1[2][2];
    const char* cA = (const char*)g.A + (size_t)cur.pm * tstep; const char* cB = (const char*)g.Bt + (size_t)cur.pn * tstep;
    S.a_ready(cur);
    if constexpr (SP2) {
        PG8_STAGE(PG8_SB(0, 0), cB, voffB); PG8_STAGE(PG8_SB(0, 1), cB + hstep, voffB); PG8_STAGE(PG8_SA(0, 0), cA, voffA); PG8_STAGE(PG8_SA(0, 1), cA + hstep, voffA);
        if (wr == 1) PG8_BAR;
        PG8_WAIT_V(2); PG8_BAR;
        PG8_STAGE(PG8_SB(1, 0), cB + kstep, voffB); PG8_STAGE(PG8_SA(1, 0), cA + kstep, voffA); PG8_STAGE(PG8_SB(1, 1), cB + hstep + kstep, voffB);
        PG8_WAIT_V(6); PG8_BAR;
    } else {
        PG8_STAGE(PG8_SB(0, 0), cB, voffB); PG8_STAGE(PG8_SA(0, 0), cA, voffA); PG8_STAGE(PG8_SB(0, 1), cB + hstep, voffB); PG8_STAGE(PG8_SA(0, 1), cA + hstep, voffA);
        if (wr == 1) PG8_BAR;
        PG8_WAIT_V(4); PG8_BAR;
        PG8_STAGE(PG8_SB(1, 0), cB + kstep, voffB); PG8_STAGE(PG8_SA(1, 0), cA + kstep, voffA); PG8_STAGE(PG8_SB(1, 1), cB + hstep + kstep, voffB);
        PG8_WAIT_V(6); PG8_BAR;
    }
    for (;;) {
        const bool has_next = S.next(ui + 1, nxt);
        const char* nA = has_next ? (const char*)g.A + (size_t)nxt.pm * tstep : cA; const char* nB = has_next ? (const char*)g.Bt + (size_t)nxt.pn * tstep : cB;
        for (int t = 0; t < nt; t += 2) {
            const bool last = (t == nt - 2);
            const char* a1 = cA + (size_t)(t + 1) * kstep;
            const char* a2 = last ? nA : cA + (size_t)(t + 2) * kstep; const char* b2 = last ? nB : cB + (size_t)(t + 2) * kstep;
            const char* a3 = a2 + kstep; const char* b3 = b2 + kstep;
            if (last && has_next) S.a_ready(nxt);
            if constexpr (SP2) {
            PG8_LDB(B0, 0, 0); PG8_LDB(B1, 0, 1); PG8_SCHED; PG8_LDA(At, 0, 0); PG8_STAGE(PG8_SA(1, 1), a1 + hstep, voffA);
            PG8_WAIT_V(8); PG8_WAIT_L(0); PG8_BAR; PG8_MMA(0, 0, At, B0); PG8_MMA(0, 1, At, B1); PG8_BAR; PG8_SCHED;
            PG8_LDA(At, 0, 1); PG8_STAGE(PG8_SB(0, 0), b2, voffB); PG8_STAGE(PG8_SB(0, 1), b2 + hstep, voffB); PG8_STAGE(PG8_SA(0, 0), a2, voffA);
            PG8_WAIT_V(8); PG8_WAIT_L(0); PG8_BAR; PG8_MMA(1, 0, At, B0); PG8_MMA(1, 1, At, B1); PG8_BAR; PG8_SCHED;
            PG8_LDB(B0, 1, 0); PG8_LDB(B1, 1, 1); PG8_SCHED; PG8_LDA(At, 1, 0); PG8_STAGE(PG8_SA(0, 1), a2 + hstep, voffA);
            PG8_WAIT_V(8); PG8_WAIT_L(0); PG8_BAR; PG8_MMA(0, 0, At, B0); PG8_MMA(0, 1, At, B1); PG8_BAR; PG8_SCHED;
            PG8_LDA(At, 1, 1); PG8_STAGE(PG8_SB(1, 0), b3, voffB); PG8_STAGE(PG8_SB(1, 1), b3 + hstep, voffB); PG8_STAGE(PG8_SA(1, 0), a3, voffA);
            PG8_WAIT_V(8); PG8_WAIT_L(0); PG8_BAR; PG8_MMA(1, 0, At, B0); PG8_MMA(1, 1, At, B1); PG8_BAR; PG8_SCHED;
            } else {
            PG8_LDB(B0, 0, 0); PG8_SCHED; PG8_LDA(At, 0, 0); PG8_STAGE(PG8_SA(1, 1), a1 + hstep, voffA);
            PG8_WAIT_L(8); PG8_BAR; PG8_WAIT_L(0); PG8_MMA(0, 0, At, B0); PG8_BAR; PG8_SCHED;
            PG8_LDB(B1, 0, 1); PG8_STAGE(PG8_SB(0, 0), b2, voffB);
            PG8_BAR; PG8_WAIT_L(0); PG8_MMA(0, 1, At, B1); PG8_BAR;
            PG8_LDA(At, 0, 1); PG8_STAGE(PG8_SA(0, 0), a2, voffA);
            PG8_BAR; PG8_WAIT_L(0); PG8_MMA(1, 0, At, B0); PG8_BAR; PG8_SCHED;
            PG8_STAGE(PG8_SB(0, 1), b2 + hstep, voffB);
            PG8_WAIT_V(6); PG8_BAR; PG8_MMA(1, 1, At, B1); PG8_BAR;
            PG8_LDB(B0, 1, 0); PG8_SCHED; PG8_LDA(At, 1, 0); PG8_STAGE(PG8_SA(0, 1), a2 + hstep, voffA);
            PG8_WAIT_L(8); PG8_BAR; PG8_WAIT_L(0); PG8_MMA(0, 0, At, B0); PG8_BAR; PG8_SCHED;
            PG8_LDB(B1, 1, 1); PG8_STAGE(PG8_SB(1, 0), b3, voffB);
            PG8_BAR; PG8_WAIT_L(0); PG8_MMA(0, 1, At, B1); PG8_BAR;
            PG8_LDA(At, 1, 1); PG8_STAGE(PG8_SA(1, 0), a3, voffA);
            PG8_BAR; PG8_WAIT_L(0); PG8_MMA(1, 0, At, B0); PG8_BAR; PG8_SCHED;
            PG8_STAGE(PG8_SB(1, 1), b3 + hstep, voffB);
            PG8_WAIT_V(6); PG8_BAR; PG8_MMA(1, 1, At, B1); PG8_BAR;
            }
        }
        if constexpr (ALIGN_EPI) { if (wr == 0) PG8_BAR; }
        if constexpr (!Epi::AFTER_DRAIN) { E(acc, cur, wr, wc, fr, fq); S.done(cur); }
        if (!has_next) break;
#pragma unroll
        for (int a = 0; a < 2; ++a)
#pragma unroll
            for (int b = 0; b < 2; ++b)
#pragma unroll
                for (int m = 0; m < 4; ++m)
#pragma unroll
                    for (int n = 0; n < 2; ++n) acc[a][b][m][n] = (f32x4){0.f, 0.f, 0.f, 0.f};
        cur = nxt; cA = nA; cB = nB; ++ui;
        if constexpr (ALIGN_EPI) { if (wr == 1) PG8_BAR; }
    }
    PG8_WAIT_V(0);
    if constexpr (!ALIGN_EPI) { if (wr == 0) PG8_BAR; }
    PG8_BAR;
    if constexpr (Epi::AFTER_DRAIN) { E.fused(acc, cur, wr, wc, fr, fq, lds, wid, lane); S.done(cur); }
#undef PG8_SA
#undef PG8_SB
#undef PG8_STAGE
#undef PG8_LDA
#undef PG8_LDB
#undef PG8_MMA
#undef PG8_WAIT_V
#undef PG8_WAIT_L
#undef PG8_BAR
#undef PG8_SCHED
}
}

constexpr int DM = 1024, NB = 4, SEQ = 8192, CTXL = 256, ML = NB * SEQ, MC = NB * CTXL, MT = ML + MC;
constexpr int DFF = 2816, NUP = 2 * DFF;
constexpr float EPS = 1e-6f;
constexpr int NWAVES = 8;
constexpr float LOG2E = 1.4426950408889634f;

constexpr size_t MiB = 1u << 20;
constexpr size_t WS_CTL = 0, CTL_ZERO_BYTES = 64 * 1024;
constexpr int CW_BAR = 1024;
constexpr size_t WS_MOD = 1 * MiB;
constexpr size_t WS_ROPE64 = 1 * MiB + 512 * 1024;
constexpr size_t WS_ROPE128 = WS_ROPE64 + 16384;
constexpr size_t WS_HC = 2 * MiB;
constexpr size_t WS_WT = 6 * MiB;
constexpr size_t SZ_UP = (size_t)NUP * DM * 2, SZ_DOWN = (size_t)DM * DFF * 2, SZ_W1536 = 1536u * 1024 * 2, SZ_W1024 = 1024u * 1024 * 2, SZ_W3072 = 3072u * 1024 * 2;
constexpr size_t SZ_LA = SZ_W1536 + SZ_W1024 + SZ_UP + SZ_DOWN, SZ_LB = SZ_W3072 + SZ_W1024 + SZ_UP + SZ_DOWN;
constexpr size_t WT_L0 = WS_WT, WT_L1 = WT_L0 + SZ_LA, WT_L2 = WT_L1 + SZ_LB, WT_L3 = WT_L2 + SZ_LA, WT_END = WT_L3 + SZ_LB;
static_assert(WT_END <= 98 * MiB, "weights");
constexpr size_t WS_XN = 98 * MiB;
constexpr size_t WS_GATES = 164 * MiB;
constexpr size_t WS_BIG = 168 * MiB;
constexpr size_t WS_END = 512 * MiB;
constexpr size_t BG_RAW = WS_BIG, BG_Q = WS_BIG + 100 * MiB, BG_K = WS_BIG + 166 * MiB, BG_V = WS_BIG + 183 * MiB, BG_O = WS_BIG + 200 * MiB;
constexpr size_t BG_CBAR = WS_BIG + 200 * MiB, BG_NBAR = WS_BIG + 332 * MiB, BG_MSC = WS_BIG + 334 * MiB;
constexpr size_t WS_HF = WS_XN, WS_HB = WS_WT;
static_assert((size_t)ML * 1024 * 2 <= WT_L3 - WS_WT, "HB fits below layer 3's weights");
constexpr size_t BG_U = WS_BIG, BG_ACT = WS_BIG + 190 * MiB;
constexpr int ML_NUID = 32 * 66;

constexpr int RING_BYTES = 131072, LDSCTL_OFF = RING_BYTES, MISC_OFF = LDSCTL_OFF + 320, LDS_BYTES = 147456;
#define GAS __attribute__((address_space(1)))
#define LAS __attribute__((address_space(3)))
typedef unsigned short bf16;
typedef unsigned v4u __attribute__((ext_vector_type(4)));
typedef float f32x4 __attribute__((ext_vector_type(4)));
typedef short bf16x8 __attribute__((ext_vector_type(8)));
typedef GAS unsigned gu32;
typedef GAS unsigned long long gu64;
#define RLX_AGENT __ATOMIC_RELAXED, __HIP_MEMORY_SCOPE_AGENT
#define LDS_WAIT() asm volatile("s_waitcnt lgkmcnt(0)" ::: "memory")
#define VM_WAIT() asm volatile("s_waitcnt vmcnt(0)" ::: "memory")
__device__ __forceinline__ unsigned long long rt() { return __builtin_amdgcn_s_memrealtime(); }
__device__ __forceinline__ unsigned f2bf(float f) { unsigned u = __builtin_bit_cast(unsigned, f); return (u + 0x7fffu + ((u >> 16) & 1u)) >> 16; }
__device__ __forceinline__ unsigned pk2(float lo, float hi) { return f2bf(lo) | (f2bf(hi) << 16); }

#define XB_TMO      128
#define XB_XCNT(j)  (256  + 64 * (j))
#define XB_XSUB(j)  (1280 + 64 * (j))
#define XB_XGEN(j)  (2304 + 64 * (j))
#define XB_TOP      3328
#define XB_TOPGEN   3392
#define XCD_BAR_WORDS 3456
#define XB_SPIN_CAP (1u << 18)

__device__ __forceinline__ unsigned xb_ld(unsigned* p)              { return __hip_atomic_load(p, __ATOMIC_RELAXED, __HIP_MEMORY_SCOPE_AGENT); }
__device__ __forceinline__ unsigned xb_add(unsigned* p, unsigned v) { return __hip_atomic_fetch_add(p, v, __ATOMIC_RELAXED, __HIP_MEMORY_SCOPE_AGENT); }
__device__ __forceinline__ unsigned xb_xcc_id() { return (unsigned)__builtin_amdgcn_s_getreg((3 << 11) | 20) & 0xFu; }
#define XB_SPIN(cond, bar) do { unsigned _sp = 0; while (cond) { __builtin_amdgcn_s_sleep(1); \
    if ((++_sp & 255u) == 0u) { if (xb_ld(&(bar)[XB_TMO])) break; if (_sp > XB_SPIN_CAP) { atomicAdd(&(bar)[XB_TMO], 1u); break; } } } } while (0)

struct XcdBarrier {
    unsigned* bar; unsigned x;
    volatile LAS unsigned* st;
};

__device__ __forceinline__ XcdBarrier xcd_barrier_post(unsigned* bar, volatile LAS unsigned* st) {
    XcdBarrier b; b.bar = bar; b.x = xb_xcc_id(); b.st = st;
    if (threadIdx.x == 0) (void)xb_add(&bar[XB_XCNT(b.x)], 1u);
    return b;
}
__device__ __forceinline__ void xcd_barrier_complete(unsigned* bar, unsigned x, unsigned& nloc, unsigned& nx) {
    const unsigned G = gridDim.x * gridDim.y * gridDim.z;
    unsigned sum, cnt, mine, sp = 0u;
    for (;;) {
        sum = 0u; cnt = 0u; mine = 0u;
#pragma nounroll
        for (unsigned j = 0; j < 16; ++j) { const unsigned c = xb_ld(&bar[XB_XCNT(j)]); sum += c; cnt += (c > 0u) ? 1u : 0u; mine = (j == x) ? c : mine; }
        if (sum == G) break;
        __builtin_amdgcn_s_sleep(1);
        if ((++sp & 255u) == 0u) { if (xb_ld(&bar[XB_TMO])) break; if (sp > XB_SPIN_CAP) { atomicAdd(&bar[XB_TMO], 1u); break; } }
    }
    nloc = mine > 0u ? mine : 1u; nx = cnt > 0u ? cnt : 1u;
}

__device__ __forceinline__ void xcd_barrier(const XcdBarrier& b) {
    asm volatile("s_waitcnt vmcnt(0)" ::: "memory");
    __syncthreads();
    if (threadIdx.x == 0) {
        unsigned* bar = b.bar;
        __builtin_amdgcn_s_waitcnt(0);
        unsigned nloc = b.st[0], nx = b.st[1];
        if (nloc == 0u) { xcd_barrier_complete(bar, b.x, nloc, nx); b.st[0] = nloc; b.st[1] = nx; }
        const unsigned old = xb_add(&bar[XB_XSUB(b.x)], 1u);
        const unsigned gen = old / nloc;
        if (old + 1u == (gen + 1u) * nloc) {
            __builtin_amdgcn_fence(__ATOMIC_RELEASE, "agent");
            asm volatile("s_waitcnt vmcnt(0)" ::: "memory");
            const unsigned og = xb_add(&bar[XB_TOP], 1u);
            const unsigned tg = og / nx;
            if (og + 1u == (tg + 1u) * nx) xb_add(&bar[XB_TOPGEN], 1u);
            else XB_SPIN(xb_ld(&bar[XB_TOPGEN]) == tg, bar);
            __builtin_amdgcn_fence(__ATOMIC_ACQUIRE, "agent");
            xb_add(&bar[XB_XGEN(b.x)], 1u);
            asm volatile("s_waitcnt vmcnt(0)" ::: "memory");
        } else {
            XB_SPIN(xb_ld(&bar[XB_XGEN(b.x)]) == gen, bar);
            __builtin_amdgcn_fence(__ATOMIC_ACQUIRE, "agent");
            asm volatile("s_waitcnt vmcnt(0)" ::: "memory");
        }
    }
    __syncthreads();
}

typedef unsigned u32x2 __attribute__((ext_vector_type(2)));
struct Frame { LAS unsigned char* lds; int tid, lane, wave, G, gw, ngw; };

__device__ __forceinline__ float wave_sum(float v) {
#pragma unroll
    for (int o = 1; o < 64; o <<= 1) v += __shfl_xor(v, o);
    return v;
}
__device__ __forceinline__ float wave_max(float v) {
#pragma unroll
    for (int o = 1; o < 64; o <<= 1) v = fmaxf(v, __shfl_xor(v, o));
    return v;
}
__device__ __forceinline__ float bf2f(unsigned short x) { return __uint_as_float((unsigned)x << 16); }
__device__ __forceinline__ float bflo(unsigned w) { return __uint_as_float(w << 16); }
__device__ __forceinline__ float bfhi(unsigned w) { return __uint_as_float(w & 0xffff0000u); }
__device__ __forceinline__ unsigned cvtpk2(float lo, float hi) { unsigned r; asm volatile("v_cvt_pk_bf16_f32 %0, %1, %2" : "=v"(r) : "v"(lo), "v"(hi)); return r; }
__device__ __forceinline__ unsigned short f2bf16(float f) { return (unsigned short)(cvtpk2(f, 0.f) & 0xffffu); }
__device__ __forceinline__ void unpack8(const v4u w, float (&f)[8]) { f[0] = bflo(w.x); f[1] = bfhi(w.x); f[2] = bflo(w.y); f[3] = bfhi(w.y); f[4] = bflo(w.z); f[5] = bfhi(w.z); f[6] = bflo(w.w); f[7] = bfhi(w.w); }
__device__ __forceinline__ v4u pack8(const float (&f)[8]) { v4u w; w.x = cvtpk2(f[0], f[1]); w.y = cvtpk2(f[2], f[3]); w.z = cvtpk2(f[4], f[5]); w.w = cvtpk2(f[6], f[7]); return w; }
__device__ __forceinline__ float sigmoidf_(float x) { return 1.f / (1.f + expf(-x)); }

__device__ __forceinline__ void p0_transpose_item(const float* W, int K, int pitch, int nblk, bf16* WT, LAS float* scr, int item, int lane) {
    const int kb = item / nblk, nb = item % nblk, k0 = 64 * kb, n0 = 32 * nb;
#pragma unroll 8
    for (int i = 0; i < 32; ++i) { const int kk = 2 * i + (lane >> 5); scr[kk * 33 + (lane & 31)] = W[(size_t)(k0 + kk) * pitch + n0 + (lane & 31)]; }
    LDS_WAIT(); asm volatile("" ::: "memory");
    const int c = lane & 7;
#pragma unroll
    for (int j = 0; j < 4; ++j) { const int n = (lane >> 3) + 8 * j; const LAS float* s = scr + (8 * c) * 33 + n;
        v4u o; o.x = pk2(s[0 * 33], s[1 * 33]); o.y = pk2(s[2 * 33], s[3 * 33]); o.z = pk2(s[4 * 33], s[5 * 33]); o.w = pk2(s[6 * 33], s[7 * 33]);
        *(v4u*)(WT + (size_t)(n0 + n) * K + k0 + 8 * c) = o; }
    LDS_WAIT(); asm volatile("" ::: "memory");
}
__device__ __forceinline__ void transpose_matrix(const Frame& F, const float* W, int K, int pitch, int Nused, bf16* WT, int& rot) {
    const int nblk = Nused / 32, nitems = (K / 64) * nblk;
    LAS float* scr = (LAS float*)(F.lds + F.wave * 16384);
    int first = (F.gw - rot) % F.ngw; if (first < 0) first += F.ngw;
    for (int it = first; it < nitems; it += F.ngw) p0_transpose_item(W, K, pitch, nblk, WT, scr, it, F.lane);
    rot = (rot + nitems) % F.ngw;
}
__device__ __forceinline__ void mod_phase(const Frame& F, const float* c, const float* cctx, const float* ada_w, const float* ada_b, float* MOD) {
    LAS float* sc = (LAS float*)F.lds;
    LAS float* red = (LAS float*)(F.lds + 20480);
    for (int i = F.tid; i < 5 * 1024; i += 512) { const float v = i < 4096 ? c[i] : cctx[i - 4096]; sc[i] = v / (1.f + expf(-v)); }
    __syncthreads();
    const int ks = F.tid >> 5, cn = F.tid & 31;
    for (int item = blockIdx.x; item < 768; item += F.G) {
        const int layer = item / 192, n0 = (item % 192) * 32;
        const float* wp = ada_w + (size_t)layer * 1024 * 6144 + (size_t)(ks * 64) * 6144 + n0 + cn;
        float a0 = 0.f, a1 = 0.f, a2 = 0.f, a3 = 0.f, a4 = 0.f;
#pragma unroll 8
        for (int k = 0; k < 64; ++k) { const float w = wp[(size_t)k * 6144]; const int kk = ks * 64 + k;
            a0 += w * sc[kk]; a1 += w * sc[1024 + kk]; a2 += w * sc[2048 + kk]; a3 += w * sc[3072 + kk]; a4 += w * sc[4096 + kk]; }
        LAS float* rp = red + (ks * 32 + cn) * 5; rp[0] = a0; rp[1] = a1; rp[2] = a2; rp[3] = a3; rp[4] = a4;
        __syncthreads();
        if (F.tid < 160) { const int cn2 = F.tid & 31, b = F.tid >> 5; float s = 0.f;
#pragma unroll
            for (int k2 = 0; k2 < 16; ++k2) s += red[(k2 * 32 + cn2) * 5 + b];
            MOD[(size_t)(layer * 5 + b) * 6144 + n0 + cn2] = s + ada_b[layer * 6144 + n0 + cn2]; }
        __syncthreads();
    }
}
__device__ __forceinline__ void rope_tables(const Frame& F, float* R64, float* R128) {
    for (int i = blockIdx.x * 512 + F.tid; i < 6144; i += F.G * 512) {
        int pos, f, nf; float* dst;
        if (i < 2048) { pos = i >> 4; f = i & 15; nf = 16; dst = R64 + 2 * i; } else { const int j = i - 2048; pos = j >> 5; f = j & 31; nf = 32; dst = R128 + 2 * j; }
        const float inv = powf(10000.f, -(float)f / (float)nf);
        const float ang = (float)pos * inv;
        dst[0] = cosf(ang); dst[1] = sinf(ang);
    }
}

template <bool GATES>
__device__ __forceinline__ void norm_phase(const Frame& F, const float* hlat, const float* hctx, int nrows, const float* gain, const float* mod, int sh_off, int sc_off, bf16* XN,
                                           const float* wg_src, const float* bgate, float* GATESb) {
    LAS float* WgT = (LAS float*)F.lds;
    if (GATES) { for (int i = F.tid; i < 16384; i += 512) { const int k = i >> 4, j = i & 15; WgT[j * 1024 + k] = wg_src[(size_t)k * 3088 + 3072 + j]; } __syncthreads(); }
    const int nitems = nrows / 16;
    for (int it = F.gw; it < nitems; it += F.ngw) {
        const int r0 = it * 16, mb = r0 < ML ? (r0 >> 13) : 4;
        f32x4 A[4], Bv[4];
#pragma unroll
        for (int j = 0; j < 4; ++j) { const int col = 4 * F.lane + 256 * j; const f32x4 g = *(const f32x4*)(gain + col), s = *(const f32x4*)(mod + mb * 6144 + sc_off + col);
            A[j] = g * (1.f + s); Bv[j] = *(const f32x4*)(mod + mb * 6144 + sh_off + col); }
        for (int rr = 0; rr < 16; ++rr) {
            const int r = r0 + rr; const float* src = r < ML ? hlat + (size_t)r * 1024 : hctx + (size_t)(r - ML) * 1024;
            f32x4 v[4]; float ss = 0.f;
#pragma unroll
            for (int j = 0; j < 4; ++j) { v[j] = *(const f32x4*)(src + 4 * F.lane + 256 * j); ss += (v[j].x * v[j].x + v[j].y * v[j].y) + (v[j].z * v[j].z + v[j].w * v[j].w); }
            ss = wave_sum(ss); const float rs = 1.f / sqrtf(ss * (1.f / 1024.f) + EPS);
#pragma unroll
            for (int j = 0; j < 4; ++j) { v[j] = v[j] * rs * A[j] + Bv[j];
                u32x2 w; w.x = cvtpk2(v[j].x, v[j].y); w.y = cvtpk2(v[j].z, v[j].w); *(u32x2*)(XN + (size_t)r * 1024 + 4 * F.lane + 256 * j) = w; }
            if (GATES) {
                float val = 0.f;
#pragma unroll
                for (int jg = 0; jg < 16; ++jg) { float s = 0.f;
#pragma unroll
                    for (int j = 0; j < 4; ++j) { const f32x4 w = *(const LAS f32x4*)(WgT + jg * 1024 + 4 * F.lane + 256 * j); s += (v[j].x * w.x + v[j].y * w.y) + (v[j].z * w.z + v[j].w * w.w); }
                    s = wave_sum(s); val = (F.lane == jg) ? s : val; }
                if (F.lane < 16) { val += bgate[F.lane]; const int kind = F.lane >> 2;
                    if (kind & 1) val = fminf(val, 0.f) - log1pf(expf(-fabsf(val)));
                    GATESb[(size_t)r * 16 + F.lane] = val; }
            }
        }
    }
}
__device__ __forceinline__ void qknorm_rope64(const Frame& F, const bf16* RAW, const float* qn, const float* kn, const float* R64, bf16* Qp, bf16* Kp) {
    const int i = F.lane & 31, half = F.lane >> 5, f = i & 15;
    const float gq1 = qn[i], gq2 = qn[i + 32], gk1 = kn[i], gk2 = kn[i + 32];
    for (int r = F.gw; r < MT; r += F.ngw) {
        const bf16* src = RAW + (size_t)r * 1536;
        float cs = 1.f, sn = 0.f;
        if (r < ML) { const int t = r & (SEQ - 1), pos = i < 16 ? (t >> 6) : (t & 63); cs = R64[(pos * 16 + f) * 2]; sn = R64[(pos * 16 + f) * 2 + 1]; }
#pragma unroll
        for (int jj = 0; jj < 10; ++jj) { const int hh = 2 * jj + half;
            const float x1 = bf2f(src[hh * 64 + i]), x2 = bf2f(src[hh * 64 + 32 + i]);
            float ss = x1 * x1 + x2 * x2;
#pragma unroll
            for (int o = 1; o < 32; o <<= 1) ss += __shfl_xor(ss, o);
            const float rs = 1.f / sqrtf(ss * (1.f / 64.f) + EPS);
            const bool isq = hh < 16;
            const float y1 = x1 * rs * (isq ? gq1 : gk1), y2 = x2 * rs * (isq ? gq2 : gk2);
            const float o1 = y1 * cs - y2 * sn, o2 = y2 * cs + y1 * sn;
            bf16* dst = isq ? Qp + (size_t)r * 1024 + hh * 64 : Kp + (size_t)r * 256 + (hh - 16) * 64;
            dst[i] = f2bf16(o1); dst[i + 32] = f2bf16(o2); }
    }
}
__device__ __forceinline__ void qknorm_rope128(const Frame& F, const bf16* RAW, const float* qn, const float* kn, const float* R128, bf16* Qp, bf16* K2, bf16* V2) {
    const int i = F.lane, f = i & 31;
    const float gq1 = qn[i], gq2 = qn[i + 64], gk1 = kn[i], gk2 = kn[i + 64];
    for (int r = F.gw; r < MT; r += F.ngw) {
        const bf16* src = RAW + (size_t)r * 1536;
        float cs = 1.f, sn = 0.f; size_t kvrow;
        if (r < ML) { const int t = r & (SEQ - 1), pos = i < 32 ? (t >> 6) : (t & 63); cs = R128[(pos * 32 + f) * 2]; sn = R128[(pos * 32 + f) * 2 + 1]; kvrow = (size_t)(r >> 13) * 8448 + t; }
        else { const int rc = r - ML; kvrow = (size_t)(rc >> 8) * 8448 + 8192 + (rc & 255); }
#pragma unroll
        for (int hh = 0; hh < 10; ++hh) {
            const float x1 = bf2f(src[hh * 128 + i]), x2 = bf2f(src[hh * 128 + 64 + i]);
            const float ss = wave_sum(x1 * x1 + x2 * x2);
            const float rs = 1.f / sqrtf(ss * (1.f / 128.f) + EPS);
            const bool isq = hh < 8;
            const float y1 = x1 * rs * (isq ? gq1 : gk1), y2 = x2 * rs * (isq ? gq2 : gk2);
            const float o1 = y1 * cs - y2 * sn, o2 = y2 * cs + y1 * sn;
            bf16* dst = isq ? Qp + (size_t)r * 1024 + hh * 128 : K2 + kvrow * 256 + (hh - 8) * 128;
            dst[i] = f2bf16(o1); dst[i + 64] = f2bf16(o2); }
        *(u32x2*)(V2 + kvrow * 256 + 4 * i) = *(const u32x2*)(src + 1280 + 4 * i);
    }
}
__device__ __forceinline__ void sconv_phase(const Frame& F, const bf16* RAW, const float* cw  , bf16* O) {
    const long total = (long)MT * 128;
    for (long idx = (long)(F.gw >> 3) * 512 + F.tid; idx < total; idx += (long)F.G * 512) {
        const int r = (int)(idx >> 7), c0 = (int)(idx & 127) * 8;
        const int tl = r < ML ? (r & (SEQ - 1)) : ((r - ML) & (CTXL - 1)), len = r < ML ? SEQ : CTXL;
        float z[8];
#pragma unroll
        for (int e = 0; e < 8; ++e) z[e] = 0.f;
#pragma unroll
        for (int j = 0; j < 3; ++j) {
            const int tj = tl + j - 1;
            if (tj >= 0 && tj < len) {
                const bf16* rp = RAW + (size_t)(r + j - 1) * 3072;
                float gc[8], uu[8]; unpack8(*(const v4u*)(rp + 1024 + c0), gc); unpack8(*(const v4u*)(rp + 2048 + c0), uu);
                const f32x4 w0 = *(const f32x4*)(cw + j * 1024 + c0), w1 = *(const f32x4*)(cw + j * 1024 + c0 + 4);
                z[0] += w0.x * (gc[0] * uu[0]); z[1] += w0.y * (gc[1] * uu[1]); z[2] += w0.z * (gc[2] * uu[2]); z[3] += w0.w * (gc[3] * uu[3]);
                z[4] += w1.x * (gc[4] * uu[4]); z[5] += w1.y * (gc[5] * uu[5]); z[6] += w1.z * (gc[6] * uu[6]); z[7] += w1.w * (gc[7] * uu[7]);
            }
        }
        float gb[8]; unpack8(*(const v4u*)(RAW + (size_t)r * 3072 + c0), gb);
#pragma unroll
        for (int e = 0; e < 8; ++e) z[e] *= gb[e];
        *(v4u*)(O + (size_t)r * 1024 + c0) = pack8(z);
    }
}
__device__ __forceinline__ void convact_phase(const Frame& F, const bf16* U, const float* cw  , bf16* ACT, int row0, int nrows) {
    const long total = (long)nrows * 352;
    for (long idx = (long)(F.gw >> 3) * 512 + F.tid; idx < total; idx += (long)F.G * 512) {
        const int rl = (int)(idx / 352), c0 = (int)(idx % 352) * 8, r = row0 + rl;
        const int tl = r < ML ? (r & (SEQ - 1)) : ((r - ML) & (CTXL - 1)), len = r < ML ? SEQ : CTXL;
        float g[8], u[8];
#pragma unroll
        for (int e = 0; e < 8; ++e) { g[e] = 0.f; u[e] = 0.f; }
#pragma unroll
        for (int j = 0; j < 3; ++j) {
            const int tj = tl + j - 1;
            if (tj >= 0 && tj < len) {
                const bf16* rp = U + (size_t)(rl + j - 1) * NUP;
                float a[8], b[8]; unpack8(*(const v4u*)(rp + c0), a); unpack8(*(const v4u*)(rp + DFF + c0), b);
                const f32x4 wg0 = *(const f32x4*)(cw + j * NUP + c0), wg1 = *(const f32x4*)(cw + j * NUP + c0 + 4);
                const f32x4 wu0 = *(const f32x4*)(cw + j * NUP + DFF + c0), wu1 = *(const f32x4*)(cw + j * NUP + DFF + c0 + 4);
                g[0] += wg0.x * a[0]; g[1] += wg0.y * a[1]; g[2] += wg0.z * a[2]; g[3] += wg0.w * a[3]; g[4] += wg1.x * a[4]; g[5] += wg1.y * a[5]; g[6] += wg1.z * a[6]; g[7] += wg1.w * a[7];
                u[0] += wu0.x * b[0]; u[1] += wu0.y * b[1]; u[2] += wu0.z * b[2]; u[3] += wu0.w * b[3]; u[4] += wu1.x * b[4]; u[5] += wu1.y * b[5]; u[6] += wu1.z * b[6]; u[7] += wu1.w * b[7];
            }
        }
        float o[8];
#pragma unroll
        for (int e = 0; e < 8; ++e) o[e] = g[e] / (1.f + expf(-g[e])) * u[e];
        *(v4u*)(ACT + (size_t)rl * DFF + c0) = pack8(o);
    }
}

namespace exd {
typedef unsigned short bf16;
constexpr int   D = 128, NW = 8, QBLK = 32, KVBLK = 64;
constexpr float SCALE = 0.088388347648318440f;
constexpr float THR = 8.f;
constexpr int SDEPTH = 1;
constexpr int LDQ = 1024, LDK = 256, LDO = 1024;
constexpr size_t SHM_V = KVBLK * D * 2, SHM_K = KVBLK * D * 2, SHM_ATTN = 2 * SHM_V + 2 * SHM_K + NW * 64 * 4;
using bf16x8 = __attribute__((ext_vector_type(8))) short;
using s16x4  = __attribute__((ext_vector_type(4))) short;
using f32x16 = __attribute__((ext_vector_type(16))) float;
using f32x8  = __attribute__((ext_vector_type(8))) float;
using u32x4  = __attribute__((ext_vector_type(4))) unsigned;
#define KSWZ(row, colB) ((row) * 256 + ((colB) ^ (((row) & 7) << 4)))
#define SBAR() __builtin_amdgcn_sched_barrier(0)
__device__ __forceinline__ int crow(int r, int hi) { return (r & 3) + 8 * (r >> 2) + 4 * hi; }
__device__ __forceinline__ unsigned cvtpk(float lo, float hi) {
  unsigned r; asm volatile("v_cvt_pk_bf16_f32 %0, %1, %2" : "=v"(r) : "v"(lo), "v"(hi)); return r;
}
template <typename TIn> struct Stage;
template <> struct Stage<bf16>  { using T = bf16x8;
  __device__ static __forceinline__ T ld8(const bf16* p) { return *reinterpret_cast<const bf16x8*>(p); }
  __device__ static __forceinline__ bf16x8 tobf(T x) { return x; } };
template <> struct Stage<float> { using T = f32x8;
  __device__ static __forceinline__ T ld8(const float* p) { return *reinterpret_cast<const f32x8*>(p); }
  __device__ static __forceinline__ bf16x8 tobf(T x) {
    u32x4 w = {cvtpk(x[0], x[1]), cvtpk(x[2], x[3]), cvtpk(x[4], x[5]), cvtpk(x[6], x[7])}; return *reinterpret_cast<bf16x8*>(&w); } };

__device__ __forceinline__ void partialSM(f32x16& p0, f32x16& p1, float& m_reg, float& mn, float& alpha) {
  constexpr float C = SCALE * 1.4426950408889634f;
  float pmax = p0[0]; for (int r = 1; r < 16; ++r) pmax = fmaxf(pmax, p0[r]); for (int r = 0; r < 16; ++r) pmax = fmaxf(pmax, p1[r]);
  { auto rr = __builtin_amdgcn_permlane32_swap(__float_as_uint(pmax), __float_as_uint(pmax), false, false);
    pmax = fmaxf(__uint_as_float(rr[0]), __uint_as_float(rr[1])); }
  if (__builtin_expect(__all(pmax - m_reg <= THR / SCALE), 1)) { mn = m_reg; alpha = 1.f; }
  else { mn = fmaxf(m_reg, pmax); alpha = __builtin_amdgcn_exp2f((m_reg - mn) * C); m_reg = mn; }
  float mnC = -mn * C;
  for (int r = 0; r < 16; ++r) p0[r] = fmaf(p0[r], C, mnC); for (int r = 0; r < 16; ++r) p1[r] = fmaf(p1[r], C, mnC);
  for (int r = 0; r < 16; ++r) p0[r] = __builtin_amdgcn_exp2f(p0[r]);
}
__device__ __forceinline__ void finishSM(f32x16& p0, f32x16& p1, float alpha, float& l_reg, bf16x8& pa0, bf16x8& pa1, bf16x8& pa2, bf16x8& pa3) {
  for (int r = 0; r < 16; ++r) p1[r] = __builtin_amdgcn_exp2f(p1[r]);
  float ps = 0; for (int r = 0; r < 16; ++r) ps += p0[r]; for (int r = 0; r < 16; ++r) ps += p1[r];
  { auto rr = __builtin_amdgcn_permlane32_swap(__float_as_uint(ps), __float_as_uint(ps), false, false);
    ps = __uint_as_float(rr[0]) + __uint_as_float(rr[1]); }
  l_reg = l_reg * alpha + ps;
#define PK4(P, BASE, OUT) do { unsigned a0 = cvtpk(P[BASE + 0], P[BASE + 1]), a1 = cvtpk(P[BASE + 2], P[BASE + 3]);   \
    unsigned b0 = cvtpk(P[BASE + 4], P[BASE + 5]), b1 = cvtpk(P[BASE + 6], P[BASE + 7]);                              \
    auto r0 = __builtin_amdgcn_permlane32_swap(a0, b0, false, false); auto r1 = __builtin_amdgcn_permlane32_swap(a1, b1, false, false); \
    u32x4 w = {r0[0], r1[0], r0[1], r1[1]}; OUT = *reinterpret_cast<bf16x8*>(&w); } while (0)
  PK4(p0, 0, pa0); PK4(p0, 8, pa1); PK4(p1, 0, pa2); PK4(p1, 8, pa3);
#undef PK4
}
__device__ __forceinline__ void qkt(f32x16& p0, f32x16& p1, const bf16* Ks, const bf16x8* qr, int r32, int hi) {
  p0 = f32x16{}; p1 = f32x16{};
  for (int d0 = 0; d0 < 8; ++d0) { int cb = (d0 * 16 + hi * 8) * 2;
    bf16x8 b0 = *reinterpret_cast<const bf16x8*>((const char*)Ks + KSWZ(r32, cb));
    bf16x8 b1 = *reinterpret_cast<const bf16x8*>((const char*)Ks + KSWZ(32 + r32, cb));
    p0 = __builtin_amdgcn_mfma_f32_32x32x16_bf16(b0, qr[d0], p0, 0, 0, 0);
    p1 = __builtin_amdgcn_mfma_f32_32x32x16_bf16(b1, qr[d0], p1, 0, 0, 0); }
}
__device__ __forceinline__ int v_st(int k, int c) { const int kk = (k & ~0xC) | ((k & 4) << 1) | ((k & 8) >> 1); return ((kk >> 3) * 4 + (c >> 5)) * 512 + ((kk & 7) * 32 + (c & 31)) * 2; }
__device__ __forceinline__ int v_rd_base(int lane) { return ((lane & 3) << 3) | (((lane >> 2) & 3) << 6) | (((lane >> 4) & 1) << 5) | (((lane >> 5) & 1) << 8); }
constexpr int v_rd_off(int d0, int ks, int half) { return d0 * 512 + ks * 4096 + half * 2048; }
template <int OFF> __device__ __forceinline__ s16x4 tr_read(int vb) {
  s16x4 r; asm volatile("ds_read_b64_tr_b16 %0, %1 offset:%2" : "=&v"(r) : "v"(vb), "i"(OFF) : "memory"); return r;
}
template <int D0> __device__ __forceinline__ void pv_one(f32x16& od, int vb, bf16x8 pa0, bf16x8 pa1, bf16x8 pa2, bf16x8 pa3) {
  const s16x4 l0 = tr_read<v_rd_off(D0, 0, 0)>(vb), h0 = tr_read<v_rd_off(D0, 0, 1)>(vb), l1 = tr_read<v_rd_off(D0, 1, 0)>(vb), h1 = tr_read<v_rd_off(D0, 1, 1)>(vb);
  const s16x4 l2 = tr_read<v_rd_off(D0, 2, 0)>(vb), h2 = tr_read<v_rd_off(D0, 2, 1)>(vb), l3 = tr_read<v_rd_off(D0, 3, 0)>(vb), h3 = tr_read<v_rd_off(D0, 3, 1)>(vb);
  asm volatile("s_waitcnt lgkmcnt(0)" ::: "memory"); SBAR();
#define PK(L, H) (bf16x8){L[0], L[1], L[2], L[3], H[0], H[1], H[2], H[3]}
  od = __builtin_amdgcn_mfma_f32_32x32x16_bf16(pa0, PK(l0, h0), od, 0, 0, 0);
  od = __builtin_amdgcn_mfma_f32_32x32x16_bf16(pa1, PK(l1, h1), od, 0, 0, 0);
  od = __builtin_amdgcn_mfma_f32_32x32x16_bf16(pa2, PK(l2, h2), od, 0, 0, 0);
  od = __builtin_amdgcn_mfma_f32_32x32x16_bf16(pa3, PK(l3, h3), od, 0, 0, 0);
#undef PK
}
__device__ __forceinline__ void pv_d0(f32x16* o, int vb, bf16x8 pa0, bf16x8 pa1, bf16x8 pa2, bf16x8 pa3) {
  pv_one<0>(o[0], vb, pa0, pa1, pa2, pa3); pv_one<1>(o[1], vb, pa0, pa1, pa2, pa3); pv_one<2>(o[2], vb, pa0, pa1, pa2, pa3); pv_one<3>(o[3], vb, pa0, pa1, pa2, pa3);
}

template <typename TQ>
__device__ __forceinline__ void attn_dense_body(const TQ* __restrict__ Qb, const bf16* __restrict__ Kh, const bf16* __restrict__ Vh,
                                                bf16* __restrict__ Ob, int seq, char* lds, const int tid) {
  using St = Stage<bf16>; using SQ = Stage<TQ>;
  const int wid = tid >> 6, lane = tid & 63, r32 = lane & 31, hi = lane >> 5;
  bf16* V_lds = (bf16*)lds; bf16* K_lds = (bf16*)(lds + 2 * SHM_V);
  float* ws = (float*)(lds + 2 * SHM_V + 2 * SHM_K) + wid * 64; float* li_l = ws; float* al_l = ws + 32;
  float m_reg = -1e30f, l_reg = 0; f32x16 o[4] = {}; bf16x8 qr[8];
  const TQ* Qw = Qb + (long)(wid * QBLK + r32) * LDQ + hi * 8;
#pragma unroll
  for (int d0 = 0; d0 < 8; ++d0) qr[d0] = SQ::tobf(SQ::ld8(Qw + d0 * 16));
  const int sr = tid >> 4, sc = (tid & 15) * 8, vst0 = v_st(sr, sc), vst1 = v_st(32 + sr, sc);
  const int vb0 = (int)(uintptr_t)V_lds + v_rd_base(lane);
  struct { typename St::T vs0, vs1, ks0, ks1; } sr_[SDEPTH];
#define SLOAD(i, k0) do { sr_[i].vs0 = St::ld8(&Vh[(long)((k0) + sr) * LDK + sc]); sr_[i].vs1 = St::ld8(&Vh[(long)((k0) + 32 + sr) * LDK + sc]); \
    sr_[i].ks0 = St::ld8(&Kh[(long)((k0) + sr) * LDK + sc]); sr_[i].ks1 = St::ld8(&Kh[(long)((k0) + 32 + sr) * LDK + sc]); } while (0)
#define SWRITE(b, i) do { *(bf16x8*)((char*)V_lds + (b) * SHM_V + vst0) = St::tobf(sr_[i].vs0);          \
    *(bf16x8*)((char*)V_lds + (b) * SHM_V + vst1) = St::tobf(sr_[i].vs1); int kc = sc * 2;               \
    *(bf16x8*)((char*)K_lds + (b) * SHM_K + KSWZ(sr, kc)) = St::tobf(sr_[i].ks0);                       \
    *(bf16x8*)((char*)K_lds + (b) * SHM_K + KSWZ(32 + sr, kc)) = St::tobf(sr_[i].ks1); } while (0)
#define SWAIT() do { if constexpr (SDEPTH == 2) asm volatile("s_waitcnt vmcnt(4)" ::: "memory"); else asm volatile("s_waitcnt vmcnt(0)" ::: "memory"); } while (0)
#define RESC(a) do { if (__any((a) < 1.f)) { if (hi == 0) al_l[r32] = (a); asm volatile("s_waitcnt lgkmcnt(0)" ::: "memory"); \
    for (int d = 0; d < 4; ++d) for (int r = 0; r < 16; ++r) o[d][r] *= al_l[crow(r, hi)]; } } while (0)
  f32x16 pA0, pA1, pB0, pB1; float mnA, mnB, alA, alB; bf16x8 pa0, pa1, pa2, pa3; const int NT = seq / KVBLK;
  constexpr int SE = 0, SO = SDEPTH - 1;
  SLOAD(SE, 0); asm volatile("s_waitcnt vmcnt(0)" ::: "memory"); SWRITE(0, SE); __syncthreads();
  qkt(pA0, pA1, K_lds, qr, r32, hi); partialSM(pA0, pA1, m_reg, mnA, alA);
  SLOAD(SO, KVBLK); if constexpr (SDEPTH == 2) { if (2 < NT) SLOAD(SE, 2 * KVBLK); }
  SWAIT(); SWRITE(1, SO); __syncthreads();
  for (int j = 1; j + 1 < NT; j += 2) {
    SBAR(); qkt(pB0, pB1, (bf16*)((char*)K_lds + SHM_K), qr, r32, hi);
    finishSM(pA0, pA1, alA, l_reg, pa0, pa1, pa2, pa3); SBAR();
    SLOAD(SO, (j + SDEPTH) * KVBLK); SBAR();
    pv_d0(o, vb0, pa0, pa1, pa2, pa3); partialSM(pB0, pB1, m_reg, mnB, alB);
    __syncthreads(); SWAIT(); SWRITE(0, SE);
    RESC(alB); __syncthreads();
    SBAR(); qkt(pA0, pA1, K_lds, qr, r32, hi);
    finishSM(pB0, pB1, alB, l_reg, pa0, pa1, pa2, pa3); SBAR();
    if (SDEPTH == 1 || j + 3 < NT) SLOAD(SE, (j + 1 + SDEPTH) * KVBLK); SBAR();
    pv_d0(o, vb0 + (int)SHM_V, pa0, pa1, pa2, pa3); partialSM(pA0, pA1, m_reg, mnA, alA);
    __syncthreads(); SWAIT(); SWRITE(1, SO);
    RESC(alA); __syncthreads();
  }
  SBAR(); qkt(pB0, pB1, (bf16*)((char*)K_lds + SHM_K), qr, r32, hi);
  finishSM(pA0, pA1, alA, l_reg, pa0, pa1, pa2, pa3); SBAR();
  pv_d0(o, vb0, pa0, pa1, pa2, pa3); partialSM(pB0, pB1, m_reg, mnB, alB);
  __syncthreads(); RESC(alB);
  finishSM(pB0, pB1, alB, l_reg, pa0, pa1, pa2, pa3); SBAR();
  pv_d0(o, vb0 + (int)SHM_V, pa0, pa1, pa2, pa3);
  if (hi == 0) li_l[r32] = l_reg; asm volatile("s_waitcnt lgkmcnt(0)" ::: "memory");
  float rli[16];
#pragma unroll
  for (int r = 0; r < 16; ++r) rli[r] = __builtin_amdgcn_rcpf(li_l[crow(r, hi)]);
  bf16* Ow = Ob + (long)(wid * QBLK) * LDO;
#pragma unroll
  for (int r = 0; r < 16; ++r) { int orow = crow(r, hi);
    for (int d0 = 0; d0 < 4; ++d0) Ow[(long)orow * LDO + d0 * 32 + r32] = (bf16)(cvtpk(o[d0][r] * rli[r], 0.f) & 0xffffu); }
#undef SLOAD
#undef SWRITE
#undef SWAIT
#undef RESC
}
#undef KSWZ
#undef SBAR
}

namespace att {
typedef short bf16x8 __attribute__((ext_vector_type(8)));
typedef short s16x4 __attribute__((ext_vector_type(4)));
typedef float f32x16 __attribute__((ext_vector_type(16)));
typedef unsigned u32x4 __attribute__((ext_vector_type(4)));
#define SBAR() __builtin_amdgcn_sched_barrier(0)
__device__ __forceinline__ int crow(int r, int hi) { return (r & 3) + 8 * (r >> 2) + 4 * hi; }
__device__ __forceinline__ unsigned cvtpk(float lo, float hi) { unsigned r; asm volatile("v_cvt_pk_bf16_f32 %0, %1, %2" : "=v"(r) : "v"(lo), "v"(hi)); return r; }
__device__ __forceinline__ int lds_addr(const LAS void* p) { return (int)(unsigned)(unsigned long long)p; }
template <int D> __device__ __forceinline__ int kswz(int row, int colB) { return row * (2 * D) + (colB ^ ((row & 7) << 4)); }
__device__ __forceinline__ void partialSM(f32x16& p0, f32x16& p1, float& m_reg, float& mn, float& alpha, const float C, const float THRS) {
  float pmax = p0[0];
#pragma unroll
  for (int r = 1; r < 16; ++r) pmax = fmaxf(pmax, p0[r]);
#pragma unroll
  for (int r = 0; r < 16; ++r) pmax = fmaxf(pmax, p1[r]);
  { auto rr = __builtin_amdgcn_permlane32_swap(__float_as_uint(pmax), __float_as_uint(pmax), false, false);
    pmax = fmaxf(__uint_as_float(rr[0]), __uint_as_float(rr[1])); }
  if (__builtin_expect(__all(pmax - m_reg <= THRS), 1)) { mn = m_reg; alpha = 1.f; }
  else { mn = fmaxf(m_reg, pmax); alpha = __builtin_amdgcn_exp2f((m_reg - mn) * C); m_reg = mn; }
  const float mnC = -mn * C;
#pragma unroll
  for (int r = 0; r < 16; ++r) p0[r] = fmaf(p0[r], C, mnC);
#pragma unroll
  for (int r = 0; r < 16; ++r) p1[r] = fmaf(p1[r], C, mnC);
#pragma unroll
  for (int r = 0; r < 16; ++r) p0[r] = __builtin_amdgcn_exp2f(p0[r]);
}
__device__ __forceinline__ void pack_p(const f32x16& p0, const f32x16& p1, bf16x8& pa0, bf16x8& pa1, bf16x8& pa2, bf16x8& pa3) {
#define PK4(P, BASE, OUT) do { unsigned a0 = cvtpk(P[BASE + 0], P[BASE + 1]), a1 = cvtpk(P[BASE + 2], P[BASE + 3]);   \
    unsigned b0 = cvtpk(P[BASE + 4], P[BASE + 5]), b1 = cvtpk(P[BASE + 6], P[BASE + 7]);                              \
    auto r0 = __builtin_amdgcn_permlane32_swap(a0, b0, false, false); auto r1 = __builtin_amdgcn_permlane32_swap(a1, b1, false, false); \
    u32x4 w = {r0[0], r1[0], r0[1], r1[1]}; OUT = *reinterpret_cast<bf16x8*>(&w); } while (0)
  PK4(p0, 0, pa0); PK4(p0, 8, pa1); PK4(p1, 0, pa2); PK4(p1, 8, pa3);
#undef PK4
}
__device__ __forceinline__ float row_sum(const f32x16& p0, const f32x16& p1) {
  float ps = 0.f;
#pragma unroll
  for (int r = 0; r < 16; ++r) ps += p0[r];
#pragma unroll
  for (int r = 0; r < 16; ++r) ps += p1[r];
  auto rr = __builtin_amdgcn_permlane32_swap(__float_as_uint(ps), __float_as_uint(ps), false, false);
  return __uint_as_float(rr[0]) + __uint_as_float(rr[1]);
}
__device__ __forceinline__ void finishSM(f32x16& p0, f32x16& p1, float alpha, float& l_reg, bf16x8& pa0, bf16x8& pa1, bf16x8& pa2, bf16x8& pa3) {
#pragma unroll
  for (int r = 0; r < 16; ++r) p1[r] = __builtin_amdgcn_exp2f(p1[r]);
  const float ps = row_sum(p0, p1);
  l_reg = l_reg * alpha + ps;
  pack_p(p0, p1, pa0, pa1, pa2, pa3);
}
template <int D> __device__ __forceinline__ void qkt(f32x16& p0, f32x16& p1, const LAS char* Ks, const bf16x8* qr, int r32, int hi) {
  p0 = f32x16{}; p1 = f32x16{};
#pragma unroll
  for (int d0 = 0; d0 < D / 16; ++d0) { const int cb = (d0 * 16 + hi * 8) * 2;
    const bf16x8 b0 = *(const LAS bf16x8*)(Ks + kswz<D>(r32, cb));
    const bf16x8 b1 = *(const LAS bf16x8*)(Ks + kswz<D>(32 + r32, cb));
    p0 = __builtin_amdgcn_mfma_f32_32x32x16_bf16(b0, qr[d0], p0, 0, 0, 0);
    p1 = __builtin_amdgcn_mfma_f32_32x32x16_bf16(b1, qr[d0], p1, 0, 0, 0); }
}
template <int D> __device__ __forceinline__ int v_st(int k, int c) { const int kk = (k & ~0xC) | ((k & 4) << 1) | ((k & 8) >> 1); return ((kk >> 3) * (D / 32) + (c >> 5)) * 512 + ((kk & 7) * 32 + (c & 31)) * 2; }
__device__ __forceinline__ int v_rd_base(int lane) { return ((lane & 3) << 3) | (((lane >> 2) & 3) << 6) | (((lane >> 4) & 1) << 5) | (((lane >> 5) & 1) << 8); }
template <int D> constexpr int v_rd_off(int d0, int ks, int half) { return d0 * 512 + ks * (D / 32) * 1024 + half * (D / 32) * 512; }
template <int OFF> __device__ __forceinline__ s16x4 tr_read(int vb) {
  s16x4 r; asm volatile("ds_read_b64_tr_b16 %0, %1 offset:%2" : "=&v"(r) : "v"(vb), "i"(OFF) : "memory"); return r;
}
template <int D, int D0> __device__ __forceinline__ void pv_one(f32x16& od, int vb, bf16x8 pa0, bf16x8 pa1, bf16x8 pa2, bf16x8 pa3) {
  const s16x4 l0 = tr_read<v_rd_off<D>(D0, 0, 0)>(vb), h0 = tr_read<v_rd_off<D>(D0, 0, 1)>(vb), l1 = tr_read<v_rd_off<D>(D0, 1, 0)>(vb), h1 = tr_read<v_rd_off<D>(D0, 1, 1)>(vb);
  const s16x4 l2 = tr_read<v_rd_off<D>(D0, 2, 0)>(vb), h2 = tr_read<v_rd_off<D>(D0, 2, 1)>(vb), l3 = tr_read<v_rd_off<D>(D0, 3, 0)>(vb), h3 = tr_read<v_rd_off<D>(D0, 3, 1)>(vb);
  asm volatile("s_waitcnt lgkmcnt(0)" ::: "memory"); SBAR();
#define PK(L, H) (bf16x8){L[0], L[1], L[2], L[3], H[0], H[1], H[2], H[3]}
  od = __builtin_amdgcn_mfma_f32_32x32x16_bf16(pa0, PK(l0, h0), od, 0, 0, 0);
  od = __builtin_amdgcn_mfma_f32_32x32x16_bf16(pa1, PK(l1, h1), od, 0, 0, 0);
  od = __builtin_amdgcn_mfma_f32_32x32x16_bf16(pa2, PK(l2, h2), od, 0, 0, 0);
  od = __builtin_amdgcn_mfma_f32_32x32x16_bf16(pa3, PK(l3, h3), od, 0, 0, 0);
#undef PK
}
}

__device__ __forceinline__ void win_attn_unit(const Frame& F, bool ctxq, int b, int h, int qb, const bf16* Qp, const bf16* Kp, const bf16* RAW, bf16* O, float sink, LAS char* lds) {
  using namespace att;
  constexpr float SCALE = 0.125f, C = SCALE * LOG2E, THRS = 8.f / SCALE;
  const int tid = F.tid, wid = F.wave, lane = F.lane, r32 = lane & 31, hi = lane >> 5;
  LAS char* Kl = lds; LAS char* Vl = lds + 16384; LAS float* li_l = (LAS float*)(lds + 32768) + wid * 64; LAS float* al_l = li_l + 32;
  const int g = h >> 2;
  const int q0 = ctxq ? 0 : qb * 256;
  const long qrow_w = (ctxq ? (long)ML + b * CTXL : (long)b * SEQ + q0) + wid * 32;
  bf16x8 qr[4];
#pragma unroll
  for (int d0 = 0; d0 < 4; ++d0) qr[d0] = *(const bf16x8*)(Qp + (qrow_w + r32) * 1024 + h * 64 + d0 * 16 + hi * 8);
  int jlo = 0, jhi = 0;
  if (!ctxq) { jlo = (q0 == 0) ? 2 : 0; jhi = (SEQ - (q0 - 128)) / 64; if (jhi > 8) jhi = 8; }
  const int NT = 4 + (jhi - jlo);
  const int srow = tid >> 3, sch = tid & 7;
  const int vb0 = lds_addr(Vl) + v_rd_base(lane);
  float m_reg = -1e30f, l_reg = 0.f; f32x16 o[2]; o[0] = f32x16{}; o[1] = f32x16{};
  v4u kreg, vreg;
#define TROW(i) ((i) < 4 ? (long)ML + b * CTXL + 64 * (i) : (long)b * SEQ + q0 - 128 + 64 * (jlo + (i) - 4))
#define WLOAD(i) do { const long tr_ = TROW(i) + srow; kreg = *(const v4u*)(Kp + tr_ * 256 + g * 64 + sch * 8); vreg = *(const v4u*)(RAW + tr_ * 1536 + 1280 + g * 64 + sch * 8); } while (0)
  WLOAD(0);
  for (int i = 0; i < NT; ++i) {
    const int buf = i & 1;
    *(LAS v4u*)(Kl + buf * 8192 + kswz<64>(srow, sch * 16)) = kreg;
    *(LAS v4u*)(Vl + buf * 8192 + v_st<64>(srow, sch * 8)) = vreg;
    __syncthreads();
    if (i + 1 < NT) WLOAD(i + 1);
    bool need = true; int T = 0;
    if (i >= 4) { T = q0 - 128 + 64 * (jlo + i - 4); const int qw0 = q0 + wid * 32; need = (T + 63 >= qw0 - 128) && (T <= qw0 + 31 + 128); }
    if (need) {
      f32x16 p0, p1; qkt<64>(p0, p1, Kl + buf * 8192, qr, r32, hi);
      if (i >= 4) { const int dq = q0 + wid * 32 + r32 - T;
#pragma unroll
        for (int r = 0; r < 16; ++r) { const int d0_ = dq - crow(r, hi), d1_ = d0_ - 32;
          if (d0_ > 128 || d0_ < -128) p0[r] = -1e30f;
          if (d1_ > 128 || d1_ < -128) p1[r] = -1e30f; } }
      float mn, alpha; partialSM(p0, p1, m_reg, mn, alpha, C, THRS);
      if (__any(alpha < 1.f)) { if (hi == 0) al_l[r32] = alpha; asm volatile("s_waitcnt lgkmcnt(0)" ::: "memory");
#pragma unroll
        for (int d = 0; d < 2; ++d)
#pragma unroll
          for (int r = 0; r < 16; ++r) o[d][r] *= al_l[crow(r, hi)]; }
      bf16x8 pa0, pa1, pa2, pa3; finishSM(p0, p1, alpha, l_reg, pa0, pa1, pa2, pa3); SBAR();
      pv_one<64, 0>(o[0], vb0 + buf * 8192, pa0, pa1, pa2, pa3); pv_one<64, 1>(o[1], vb0 + buf * 8192, pa0, pa1, pa2, pa3);
    }
  }
#undef TROW
#undef WLOAD
  l_reg += __builtin_amdgcn_exp2f(sink * LOG2E - m_reg * C);
  if (hi == 0) li_l[r32] = l_reg; asm volatile("s_waitcnt lgkmcnt(0)" ::: "memory");
  float rli[16];
#pragma unroll
  for (int r = 0; r < 16; ++r) rli[r] = __builtin_amdgcn_rcpf(li_l[crow(r, hi)]);
  bf16* Ow = O + qrow_w * 1024 + h * 64;
#pragma unroll
  for (int r = 0; r < 16; ++r) { const int orow = crow(r, hi);
#pragma unroll
    for (int d0 = 0; d0 < 2; ++d0) Ow[(long)orow * 1024 + d0 * 32 + r32] = f2bf16(o[d0][r] * rli[r]); }
  __syncthreads();
}


__device__ __forceinline__ void ml_decode(int uid, int& b, int& h, int& dir, int& c, long& base, int& sgn) {
  c = uid % 66; const int sid = uid / 66; dir = sid & 1; h = (sid >> 1) & 3; b = sid >> 3;
  if (dir == 0) { base = c < 2 ? (long)ML + b * CTXL + 128 * c : (long)b * SEQ + 128 * (c - 2); sgn = 1; }
  else { base = c < 2 ? (long)ML + b * CTXL + 255 - 128 * c : (long)b * SEQ + 8191 - 128 * (c - 2); sgn = -1; }
}
__device__ __forceinline__ float wave_incl_scan_add(float v, int lane) {
#pragma unroll
  for (int o = 1; o < 64; o <<= 1) { const float t = __shfl_up(v, o); if (lane >= o) v += t; }
  return v;
}
__device__ __forceinline__ float wave_incl_scan_max(float v, int lane) {
#pragma unroll
  for (int o = 1; o < 64; o <<= 1) { const float t = __shfl_up(v, o); if (lane >= o) v = fmaxf(v, t); }
  return v;
}
__device__ __forceinline__ void ml1_unit(const Frame& F, int uid, const bf16* RAW, const float* GATESb, bf16* CBAR, float* NBAR, float* MSC, LAS char* lds) {
  using namespace att;
  constexpr int TP = 136;
  LAS bf16* kT = (LAS bf16*)lds; LAS bf16* vT = (LAS bf16*)(lds + 128 * TP * 2); LAS float* wS = (LAS float*)(lds + 384 * TP * 2);
  int b, h, dir, c, sgn; long base; ml_decode(uid, b, h, dir, c, base, sgn);
  const int tid = F.tid, wid = F.wave, lane = F.lane, r32 = lane & 31, hi = lane >> 5;
  if (wid == 0) {
    const long ra = base + sgn * lane, rb = base + sgn * (lane + 64);
    const float lia = GATESb[ra * 16 + dir * 8 + h], lfa = GATESb[ra * 16 + dir * 8 + 4 + h], lib = GATESb[rb * 16 + dir * 8 + h], lfb = GATESb[rb * 16 + dir * 8 + 4 + h];
    const float ca = wave_incl_scan_add(lfa, lane); const float tot = __shfl(ca, 63);
    const float cb = wave_incl_scan_add(lfb, lane) + tot; const float g = __shfl(cb, 63);
    const float ua = lia - ca, ub = lib - cb; const float um = wave_max(fmaxf(ua, ub));
    wS[lane] = expf(ua - um); wS[lane + 64] = expf(ub - um);
    if (lane == 0) { MSC[(size_t)uid * 4 + 0] = g; MSC[(size_t)uid * 4 + 1] = g + um; }
  }
  __syncthreads();
#pragma unroll
  for (int ii = 0; ii < 4; ++ii) { const int q = tid + 512 * ii, l = q >> 4, cc = (q & 15) * 8;
    const v4u w = *(const v4u*)(RAW + (size_t)(base + sgn * l) * 3072 + 512 + 128 * h + cc);
    const unsigned ww[4] = {w.x, w.y, w.z, w.w};
#pragma unroll
    for (int e = 0; e < 4; ++e) { kT[(cc + 2 * e) * TP + l] = (bf16)(ww[e] & 0xffffu); kT[(cc + 2 * e + 1) * TP + l] = (bf16)(ww[e] >> 16); } }
#pragma unroll
  for (int ii = 0; ii < 8; ++ii) { const int q = tid + 512 * ii, l = q >> 5, cc = (q & 31) * 8;
    float f[8]; unpack8(*(const v4u*)(RAW + (size_t)(base + sgn * l) * 3072 + 1024 + 256 * h + cc), f);
    const float wl = wS[l];
#pragma unroll
    for (int e = 0; e < 8; ++e) vT[(cc + e) * TP + l] = f2bf16(f[e] * wl); }
  __syncthreads();
  f32x16 acc[4]; acc[0] = f32x16{}; acc[1] = f32x16{}; acc[2] = f32x16{}; acc[3] = f32x16{};
#pragma unroll
  for (int ks = 0; ks < 8; ++ks) {
    const bf16x8 a = *(const LAS bf16x8*)(vT + (32 * wid + r32) * TP + 16 * ks + 8 * hi);
#pragma unroll
    for (int nb = 0; nb < 4; ++nb) { const bf16x8 bb = *(const LAS bf16x8*)(kT + (32 * nb + r32) * TP + 16 * ks + 8 * hi);
      acc[nb] = __builtin_amdgcn_mfma_f32_32x32x16_bf16(a, bb, acc[nb], 0, 0, 0); }
  }
  bf16* cbp = CBAR + (size_t)uid * 32768;
#pragma unroll
  for (int nb = 0; nb < 4; ++nb)
#pragma unroll
    for (int r = 0; r < 16; ++r) cbp[(32 * wid + crow(r, hi)) * 128 + 32 * nb + r32] = f2bf16(acc[nb][r]);
  if (tid < 128) { float s = 0.f;
    for (int l8 = 0; l8 < 16; ++l8) { float f[8]; unpack8(*(const LAS v4u*)(kT + tid * TP + 8 * l8), f);
#pragma unroll
      for (int e = 0; e < 8; ++e) s += f[e] * wS[8 * l8 + e]; }
    NBAR[(size_t)uid * 128 + tid] = s; }
  __syncthreads();
}
__device__ __forceinline__ void ml2_scan(const Frame& F, int s, bf16* CBAR, float* NBAR, float* MSC) {
  const int sid = s >> 3, slice = s & 7, uid0 = sid * 66;
  const size_t e0 = (size_t)(slice * 32 + (F.tid >> 4)) * 128 + (F.tid & 15) * 8;
  const bool nthr = (slice == 0) && (F.tid < 128);
  float Cs[8]; float m = -1e30f, nst = 0.f;
#pragma unroll
  for (int e = 0; e < 8; ++e) Cs[e] = 0.f;
  for (int grp = 0; grp < 3; ++grp) {
    v4u cb[22];
#pragma unroll
    for (int i = 0; i < 22; ++i) cb[i] = *(const v4u*)(CBAR + (size_t)(uid0 + grp * 22 + i) * 32768 + e0);
#pragma unroll
    for (int i = 0; i < 22; ++i) {
      const int uid = uid0 + grp * 22 + i;
      const float g = MSC[(size_t)uid * 4 + 0], mb = MSC[(size_t)uid * 4 + 1];
      *(v4u*)(CBAR + (size_t)uid * 32768 + e0) = pack8(Cs);
      if (slice == 0 && F.tid == 0) MSC[(size_t)uid * 4 + 2] = m;
      float nb = 0.f; if (nthr) { nb = NBAR[(size_t)uid * 128 + F.tid]; NBAR[(size_t)uid * 128 + F.tid] = nst; }
      const float m_new = fmaxf(g + m, mb), decay = expf(g + m - m_new), inj = expf(mb - m_new);
      float f[8]; unpack8(cb[i], f);
#pragma unroll
      for (int e = 0; e < 8; ++e) Cs[e] = decay * Cs[e] + inj * f[e];
      nst = decay * nst + inj * nb; m = m_new;
    }
  }
}
__device__ __forceinline__ void ml3_unit(const Frame& F, int uid, int dvh, const bf16* RAW, const float* GATESb, const bf16* CBAR, const float* NBAR, const float* MSC, bf16* HX, LAS char* lds) {
  using namespace att;
  constexpr float SCQ = 0.08838834764831845f;
  LAS char* Kl = lds; LAS char* Vl = lds + 32768; LAS char* Cl = lds + 65536;
  LAS float* uS = (LAS float*)(lds + 98304); LAS float* MS_ = uS + 128; LAS float* wiS = uS + 256; LAS float* emS = uS + 384; LAS float* nS = uS + 512;
  int b, h, dir, c, sgn; long base; ml_decode(uid, b, h, dir, c, base, sgn);
  const int tid = F.tid, wid = F.wave, lane = F.lane, r32 = lane & 31, hi = lane >> 5;
  LAS float* wsf = (LAS float*)(lds + 98304 + 2560) + wid * 64;
  if (wid == 0) {
    const long ra = base + sgn * lane, rb = base + sgn * (lane + 64);
    const float lia = GATESb[ra * 16 + dir * 8 + h], lfa = GATESb[ra * 16 + dir * 8 + 4 + h], lib = GATESb[rb * 16 + dir * 8 + h], lfb = GATESb[rb * 16 + dir * 8 + 4 + h];
    const float ca = wave_incl_scan_add(lfa, lane); const float tot = __shfl(ca, 63);
    const float cb = wave_incl_scan_add(lfb, lane) + tot;
    const float ua = lia - ca, ub = lib - cb;
    const float pa = wave_incl_scan_max(ua, lane); const float pma = __shfl(pa, 63);
    const float pb = fmaxf(wave_incl_scan_max(ub, lane), pma);
    const float ms = MSC[(size_t)uid * 4 + 2];
    const float Ma = fmaxf(ms, pa), Mb = fmaxf(ms, pb);
    uS[lane] = ua; uS[lane + 64] = ub; MS_[lane] = Ma; MS_[lane + 64] = Mb;
    wiS[lane] = expf(ms - Ma); wiS[lane + 64] = expf(ms - Mb);
    emS[lane] = expf(-(ca + Ma)); emS[lane + 64] = expf(-(cb + Mb));
  } else if (wid == 2 || wid == 3) { nS[tid - 128] = NBAR[(size_t)uid * 128 + tid - 128]; }
#pragma unroll
  for (int ii = 0; ii < 4; ++ii) { const int q = tid + 512 * ii, l = q >> 4, cc = (q & 15) * 8; const size_t rr = (size_t)(base + sgn * l) * 3072;
    *(LAS v4u*)(Kl + kswz<128>(l, cc * 2)) = *(const v4u*)(RAW + rr + 512 + 128 * h + cc);
    *(LAS v4u*)(Vl + (l >> 6) * 16384 + v_st<128>(l & 63, cc)) = *(const v4u*)(RAW + rr + 1024 + 256 * h + 128 * dvh + cc);
    *(LAS v4u*)(Cl + kswz<128>(l, cc * 2)) = *(const v4u*)(CBAR + (size_t)uid * 32768 + (size_t)(128 * dvh + l) * 128 + cc); }
  __syncthreads();
  const int rblk = wid & 3, dq = wid >> 2, lq = 32 * rblk + r32;
  bf16x8 qr[8];
  { const bf16* qp = RAW + (size_t)(base + sgn * lq) * 3072 + 128 * h + hi * 8;
#pragma unroll
    for (int d0 = 0; d0 < 8; ++d0) qr[d0] = *(const bf16x8*)(qp + d0 * 16); }
  float qn = 0.f;
#pragma unroll
  for (int d0 = 0; d0 < 8; ++d0)
#pragma unroll
    for (int e = 0; e < 8; ++e) qn += bf2f((unsigned short)qr[d0][e]) * nS[d0 * 16 + hi * 8 + e];
  qn += __shfl_xor(qn, 32);
  f32x16 o[2]; o[0] = f32x16{}; o[1] = f32x16{};
#pragma unroll
  for (int d0 = 0; d0 < 8; ++d0)
#pragma unroll
    for (int j = 0; j < 2; ++j) { const bf16x8 cf = *(const LAS bf16x8*)(Cl + kswz<128>(64 * dq + 32 * j + r32, (d0 * 16 + hi * 8) * 2));
      o[j] = __builtin_amdgcn_mfma_f32_32x32x16_bf16(qr[d0], cf, o[j], 0, 0, 0); }
#pragma unroll
  for (int r = 0; r < 16; ++r) { const float wi = wiS[32 * rblk + crow(r, hi)]; o[0][r] *= wi; o[1][r] *= wi; }
  float den = 0.f; const float Mq = MS_[lq];
  const int vb0 = lds_addr(Vl) + v_rd_base(lane);
#pragma nounroll
  for (int kt = 0; kt < 2; ++kt) {
    if (64 * kt <= 32 * rblk + 31) {
      f32x16 p0, p1; qkt<128>(p0, p1, Kl + kt * 16384, qr, r32, hi);
      const LAS float* up = uS + 64 * kt + 4 * hi; const int dql = lq - 64 * kt - 4 * hi;
#pragma unroll
      for (int r = 0; r < 16; ++r) { const int cr = (r & 3) + 8 * (r >> 2);
        const float u0 = up[cr], u1 = up[cr + 32];
        const float a0 = (cr <= dql) ? (u0 - Mq) * LOG2E : -1e30f, a1 = (cr + 32 <= dql) ? (u1 - Mq) * LOG2E : -1e30f;
        p0[r] *= __builtin_amdgcn_exp2f(a0); p1[r] *= __builtin_amdgcn_exp2f(a1); }
      asm volatile("" : "+v"(p0), "+v"(p1));
      den += row_sum(p0, p1);
      bf16x8 pa0, pa1, pa2, pa3; pack_p(p0, p1, pa0, pa1, pa2, pa3); SBAR();
      if (dq == 0) { pv_one<128, 0>(o[0], vb0 + kt * 16384, pa0, pa1, pa2, pa3); pv_one<128, 1>(o[1], vb0 + kt * 16384, pa0, pa1, pa2, pa3); }
      else { pv_one<128, 2>(o[0], vb0 + kt * 16384, pa0, pa1, pa2, pa3); pv_one<128, 3>(o[1], vb0 + kt * 16384, pa0, pa1, pa2, pa3); }
    }
  }
  const float dtot = den + wiS[lq] * qn;
  const float fac = SCQ / fmaxf(SCQ * fabsf(dtot), emS[lq]);
  if (hi == 0) wsf[r32] = fac; asm volatile("s_waitcnt lgkmcnt(0)" ::: "memory");
#pragma unroll
  for (int r = 0; r < 16; ++r) { const int lo_ = 32 * rblk + crow(r, hi); const float fr_ = wsf[crow(r, hi)];
    bf16* op = HX + (size_t)(base + sgn * lo_) * 1024 + 256 * h + 128 * dvh + 64 * dq + r32;
    op[0] = f2bf16(o[0][r] * fr_); op[32] = f2bf16(o[1][r] * fr_); }
  __syncthreads();
}
__device__ __forceinline__ void mln_phase(const Frame& F, bf16* HF, const bf16* HB, const bf16* RAW, const float* hnorm) {
  const f32x4 hn = *(const f32x4*)(hnorm + 4 * F.lane);
  for (int r = F.gw; r < ML; r += F.ngw) {
#pragma unroll
    for (int j = 0; j < 4; ++j) { const size_t off = (size_t)r * 1024 + 256 * j + 4 * F.lane;
      const u32x2 a = *(const u32x2*)(HF + off), bb = *(const u32x2*)(HB + off), og = *(const u32x2*)(RAW + (size_t)r * 3072 + 2048 + 256 * j + 4 * F.lane);
      const float s0 = bflo(a.x) + bflo(bb.x), s1 = bfhi(a.x) + bfhi(bb.x), s2 = bflo(a.y) + bflo(bb.y), s3 = bfhi(a.y) + bfhi(bb.y);
      const float ss = wave_sum((s0 * s0 + s1 * s1) + (s2 * s2 + s3 * s3));
      const float rs = 1.f / sqrtf(ss * (1.f / 256.f) + EPS);
      u32x2 w; w.x = cvtpk2(sigmoidf_(bflo(og.x)) * s0 * rs * hn.x, sigmoidf_(bfhi(og.x)) * s1 * rs * hn.y);
      w.y = cvtpk2(sigmoidf_(bflo(og.y)) * s2 * rs * hn.z, sigmoidf_(bfhi(og.y)) * s3 * rs * hn.w);
      *(u32x2*)(HF + off) = w; }
  }
}

struct Args { const float* in[27]; float* out; unsigned char* ws; };
enum { I_X = 0, I_C, I_CTX, I_CCTX, I_ADAW, I_ADAB, I_NMIX, I_NFFN, I_WUP, I_FCONV, I_WDOWN, I_WINQKV, I_WINQN, I_WINKN, I_WINSINK, I_WINWO,
       I_SCWIN, I_SCCONV, I_SCWOUT, I_AXQKV, I_AXQN, I_AXKN, I_AXWO, I_MLWIN, I_MLBG, I_MLHN, I_MLWOUT };
typedef const __attribute__((address_space(4))) Args* ArgsP;

typedef pg8::StaticOrder SOrd;
#define GEMM_BF16(Aptr, Bptr, Mrows, Ncols, Kdim, Optr, ldc_) do { pg8::Gemm g_{(const pg8::bf16_t*)(Aptr), (const pg8::bf16_t*)(Bptr), (Mrows), (Ncols), (Kdim)}; SOrd S_; S_.init((Mrows), (Ncols), F.G, bid); \
    pg8::EpiStoreBf16 E_{(pg8::bf16_t*)(Optr), (ldc_)}; pg8::gemm_phase<pg8::EpiStoreBf16, SOrd, true, true>(F.lds, g_, S_, E_, F.tid); } while (0)
#define GEMM_RESID(Aptr, Bptr, Mrows, Kdim, blat, bctx, olat, octx, gatep, tile0_) do { pg8::Gemm g_{(const pg8::bf16_t*)(Aptr), (const pg8::bf16_t*)(Bptr), (Mrows), 1024, (Kdim)}; SOrd S_; S_.init((Mrows), 1024, F.G, bid); \
    pg8::EpiResid E_{(blat), (bctx), (olat), (octx), (gatep), (tile0_)}; pg8::gemm_phase<pg8::EpiResid, SOrd, true, true>(F.lds, g_, S_, E_, F.tid); } while (0)
#define PHASE() do { asm volatile("" : "+v"(F.tid)); F.lane = F.tid & 63; F.wave = __builtin_amdgcn_readfirstlane(F.tid >> 6); asm volatile("" : "+s"(bid), "+s"(F.G)); \
    F.gw = bid * NWAVES + F.wave; F.ngw = F.G * NWAVES; asm volatile("" : "+s"(ap)); ws = ap->ws; } while (0)
#define AIN(k) (ap->in[k])

__global__ void __launch_bounds__(NWAVES * 64, 2) hybrid_fwd(Args args_unused) {
    extern __shared__ __attribute__((aligned(16))) unsigned char lds_raw[];
    ArgsP ap = (ArgsP)__builtin_amdgcn_kernarg_segment_ptr();
    Frame F;
    F.lds = (LAS unsigned char*)lds_raw;
    F.tid = threadIdx.x; F.lane = F.tid & 63; F.wave = __builtin_amdgcn_readfirstlane(F.tid >> 6);
    int bid = blockIdx.x;
    F.G = gridDim.x; F.gw = bid * NWAVES + F.wave; F.ngw = F.G * NWAVES;
    unsigned char* ws = ap->ws;
    for (int u = F.tid; u < (LDS_BYTES - LDSCTL_OFF) / 4; u += NWAVES * 64) ((LAS unsigned*)(F.lds + LDSCTL_OFF))[u] = 0u;
    __syncthreads();
    XcdBarrier bar = xcd_barrier_post((unsigned*)((gu32*)(ws + WS_CTL) + CW_BAR), (volatile LAS unsigned*)(F.lds + MISC_OFF) + 8);
#define GRID_BAR() xcd_barrier(bar)
    LAS char* ldsc = (LAS char*)F.lds;

    {
        PHASE();
        mod_phase(F, AIN(I_C), AIN(I_CCTX), AIN(I_ADAW), AIN(I_ADAB), (float*)(ws + WS_MOD));
        rope_tables(F, (float*)(ws + WS_ROPE64), (float*)(ws + WS_ROPE128));
        int rot = 0;
#pragma nounroll
        for (int l = 0; l < 4; ++l) {
            const size_t lb = l == 0 ? WT_L0 : l == 1 ? WT_L1 : l == 2 ? WT_L2 : WT_L3;
            const size_t szin = (l == 0 || l == 2) ? SZ_W1536 : SZ_W3072;
            const float* win = l == 0 ? AIN(I_WINQKV) : l == 1 ? AIN(I_SCWIN) : l == 2 ? AIN(I_AXQKV) : AIN(I_MLWIN);
            const float* wout = l == 0 ? AIN(I_WINWO) : l == 1 ? AIN(I_SCWOUT) : l == 2 ? AIN(I_AXWO) : AIN(I_MLWOUT);
            const int nin = (l == 0 || l == 2) ? 1536 : 3072, pin = l == 3 ? 3088 : nin;
            transpose_matrix(F, win, 1024, pin, nin, (bf16*)(ws + lb), rot);
            transpose_matrix(F, wout, 1024, 1024, 1024, (bf16*)(ws + lb + szin), rot);
            transpose_matrix(F, AIN(I_WUP) + (size_t)l * 1024 * NUP, 1024, NUP, NUP, (bf16*)(ws + lb + szin + SZ_W1024), rot);
            transpose_matrix(F, AIN(I_WDOWN) + (size_t)l * DFF * 1024, DFF, 1024, 1024, (bf16*)(ws + lb + szin + SZ_W1024 + SZ_UP), rot);
        }
    }
    GRID_BAR();

#pragma nounroll
    for (int layer = 0; layer < 4; ++layer) {
        asm volatile("" : "+s"(layer));
#define LB() (layer == 0 ? WT_L0 : layer == 1 ? WT_L1 : layer == 2 ? WT_L2 : WT_L3)
#define SZIN() ((layer == 0 || layer == 2) ? SZ_W1536 : SZ_W3072)
#define MODP() ((const float*)(ws + WS_MOD) + (size_t)layer * 5 * 6144)
#define HLAT() (layer == 0 ? AIN(I_X) : (const float*)ap->out)
#define HCTX() (layer == 0 ? AIN(I_CTX) : (const float*)(ws + WS_HC))
#define ROWS_OUT() (layer == 3 ? ML : MT)

        PHASE();
        if (layer == 3) norm_phase<true>(F, HLAT(), HCTX(), MT, AIN(I_NMIX) + layer * 1024, MODP(), 0, 1024, (bf16*)(ws + WS_XN), AIN(I_MLWIN), AIN(I_MLBG), (float*)(ws + WS_GATES));
        else norm_phase<false>(F, HLAT(), HCTX(), MT, AIN(I_NMIX) + layer * 1024, MODP(), 0, 1024, (bf16*)(ws + WS_XN), nullptr, nullptr, nullptr);
        GRID_BAR();
        PHASE();
        { const int nin = (layer == 0 || layer == 2) ? 1536 : 3072;
          GEMM_BF16(ws + WS_XN, ws + LB(), MT, nin, 1024, ws + BG_RAW, nin); }
        GRID_BAR();
        if (layer == 0) {
            PHASE();
            qknorm_rope64(F, (const bf16*)(ws + BG_RAW), AIN(I_WINQN), AIN(I_WINKN), (const float*)(ws + WS_ROPE64), (bf16*)(ws + BG_Q), (bf16*)(ws + BG_K));
            GRID_BAR();
            PHASE();
            for (int u = bid; u < 2048 + 64; u += F.G) {
                const bf16* Qp = (const bf16*)(ws + BG_Q); const bf16* Kp = (const bf16*)(ws + BG_K); const bf16* RAW = (const bf16*)(ws + BG_RAW); bf16* Ob = (bf16*)(ws + BG_O);
                if (u < 2048) { const int qb = u & 31, h = (u >> 5) & 15, b = u >> 9; win_attn_unit(F, false, b, h, qb, Qp, Kp, RAW, Ob, AIN(I_WINSINK)[h], ldsc); }
                else { const int v = u - 2048, h = v & 15, b = v >> 4; win_attn_unit(F, true, b, h, 0, Qp, Kp, RAW, Ob, AIN(I_WINSINK)[h], ldsc); }
            }
        } else if (layer == 1) {
            PHASE();
            sconv_phase(F, (const bf16*)(ws + BG_RAW), AIN(I_SCCONV), (bf16*)(ws + BG_O));
        } else if (layer == 2) {
            PHASE();
            qknorm_rope128(F, (const bf16*)(ws + BG_RAW), AIN(I_AXQN), AIN(I_AXKN), (const float*)(ws + WS_ROPE128), (bf16*)(ws + BG_Q), (bf16*)(ws + BG_K), (bf16*)(ws + BG_V));
            GRID_BAR();
            PHASE();
            for (int u = bid; u < 1024 + 32; u += F.G) {
                const exd::bf16* Qp = (const exd::bf16*)(ws + BG_Q); const exd::bf16* K2 = (const exd::bf16*)(ws + BG_K); const exd::bf16* V2 = (const exd::bf16*)(ws + BG_V); exd::bf16* Ob = (exd::bf16*)(ws + BG_O);
                if (u < 1024) { const int qb = u & 31, h = (u >> 5) & 7, b = u >> 8; const size_t qrow = (size_t)b * SEQ + qb * 256;
                    exd::attn_dense_body<exd::bf16>(Qp + qrow * 1024 + h * 128, K2 + (size_t)b * 8448 * 256 + (h >> 2) * 128, V2 + (size_t)b * 8448 * 256 + (h >> 2) * 128, Ob + qrow * 1024 + h * 128, 8448, (char*)lds_raw, F.tid); }
                else { const int v = u - 1024, h = v & 7, b = v >> 3; const size_t qrow = (size_t)ML + b * CTXL; const size_t kvo = ((size_t)b * 8448 + 8192) * 256 + (h >> 2) * 128;
                    exd::attn_dense_body<exd::bf16>(Qp + qrow * 1024 + h * 128, K2 + kvo, V2 + kvo, Ob + qrow * 1024 + h * 128, 256, (char*)lds_raw, F.tid); }
                __syncthreads();
            }
        } else {
            PHASE();
            for (int u = bid; u < ML_NUID; u += F.G) ml1_unit(F, u, (const bf16*)(ws + BG_RAW), (const float*)(ws + WS_GATES), (bf16*)(ws + BG_CBAR), (float*)(ws + BG_NBAR), (float*)(ws + BG_MSC), ldsc);
            GRID_BAR();
            PHASE();
            for (int s = bid; s < 256; s += F.G) ml2_scan(F, s, (bf16*)(ws + BG_CBAR), (float*)(ws + BG_NBAR), (float*)(ws + BG_MSC));
            GRID_BAR();
            PHASE();
            for (int u = bid; u < 4096; u += F.G) { const int dvh = u & 1, cc = (u >> 1) & 63, sid = u >> 7;
                ml3_unit(F, sid * 66 + cc + 2, dvh, (const bf16*)(ws + BG_RAW), (const float*)(ws + WS_GATES), (const bf16*)(ws + BG_CBAR), (const float*)(ws + BG_NBAR), (const float*)(ws + BG_MSC),
                         (sid & 1) ? (bf16*)(ws + WS_HB) : (bf16*)(ws + WS_HF), ldsc); }
            GRID_BAR();
            PHASE();
            mln_phase(F, (bf16*)(ws + WS_HF), (const bf16*)(ws + WS_HB), (const bf16*)(ws + BG_RAW), AIN(I_MLHN));
        }
        GRID_BAR();
        PHASE();
        GEMM_RESID(layer == 3 ? ws + WS_HF : ws + BG_O, ws + LB() + SZIN(), ROWS_OUT(), 1024, HLAT(), HCTX(), ap->out, (float*)(ws + WS_HC), MODP() + 2048, 0);
        GRID_BAR();
        PHASE();
        norm_phase<false>(F, (const float*)ap->out, (const float*)(ws + WS_HC), ROWS_OUT(), AIN(I_NFFN) + layer * 1024, MODP(), 3072, 4096, (bf16*)(ws + WS_XN), nullptr, nullptr, nullptr);
        GRID_BAR();
#pragma nounroll
        for (int half = 0; half < 2; ++half) {
            asm volatile("" : "+s"(half));
            PHASE();
            { const int r0 = half * 16384, nr = (half == 0 ? 16384 : ROWS_OUT() - 16384);
              GEMM_BF16(ws + WS_XN + (size_t)r0 * 2048, ws + LB() + SZIN() + SZ_W1024, nr, NUP, 1024, ws + BG_U, NUP); }
            GRID_BAR();
            PHASE();
            { const int r0 = half * 16384, nr = (half == 0 ? 16384 : ROWS_OUT() - 16384);
              convact_phase(F, (const bf16*)(ws + BG_U), AIN(I_FCONV) + (size_t)layer * 3 * NUP, (bf16*)(ws + BG_ACT), r0, nr); }
            GRID_BAR();
            PHASE();
            { const int r0 = half * 16384, nr = (half == 0 ? 16384 : ROWS_OUT() - 16384);
              GEMM_RESID(ws + BG_ACT, ws + LB() + SZIN() + SZ_W1024 + SZ_UP, nr, DFF, (const float*)ap->out, (const float*)(ws + WS_HC), ap->out, (float*)(ws + WS_HC), MODP() + 5120, r0 / 256); }
            GRID_BAR();
        }
    }
}

extern "C" void kernel_launch(void* const* d_in, const int* in_sizes, int n_in, void* d_out, int out_size, void* d_ws, size_t ws_size, hipStream_t stream) {
    static int grid = 0;
    if (grid == 0) {
        if (n_in != 27 || out_size != ML * DM || ws_size < WS_END) { fprintf(stderr, "kernel_launch: unexpected shapes: n_in %d out %d ws %zu (need %zu)\n", n_in, out_size, ws_size, (size_t)WS_END); grid = -1; return; }
        int dev = 0, cus = 0;
        if (hipGetDevice(&dev) != hipSuccess || hipDeviceGetAttribute(&cus, hipDeviceAttributeMultiprocessorCount, dev) != hipSuccess) { grid = -1; return; }
        if (hipFuncSetAttribute((const void*)hybrid_fwd, hipFuncAttributeMaxDynamicSharedMemorySize, LDS_BYTES) != hipSuccess) { fprintf(stderr, "kernel_launch: hipFuncSetAttribute failed\n"); grid = -1; return; }
        int per_cu = 0;
        if (hipOccupancyMaxActiveBlocksPerMultiprocessor(&per_cu, (const void*)hybrid_fwd, NWAVES * 64, LDS_BYTES) != hipSuccess || per_cu < 1) { fprintf(stderr, "kernel_launch: occupancy query reports %d\n", per_cu); }
        (void)hipGetLastError();
        grid = cus;
    }
    if (grid < 0) return;
    if (hipMemsetAsync((char*)d_ws + WS_CTL, 0, CTL_ZERO_BYTES, stream) != hipSuccess) return;
    Args a{};
    for (int i = 0; i < 27; ++i) a.in[i] = (const float*)d_in[i];
    a.out = (float*)d_out; a.ws = (unsigned char*)d_ws;
    hipLaunchKernelGGL(hybrid_fwd, dim3(grid), dim3(NWAVES * 64), LDS_BYTES, stream, a);
}
```

```cpp
#include <hip/hip_runtime.h>
#include <cstdio>
#include <cstdint>
namespace pg8 {
#define PG8_LAS __attribute__((address_space(3)))
typedef unsigned short bf16_t;
typedef short bf16x8 __attribute__((ext_vector_type(8)));
typedef float f32x4 __attribute__((ext_vector_type(4)));
typedef unsigned u32x4 __attribute__((ext_vector_type(4)));
constexpr int BM = 256, BK = 64, HALF = 128, HTB = HALF * BK * 2  , STAGE_BYTES = 8 * HTB, NXCD = 8, WGM = 8;

__host__ __device__ __forceinline__ int lds_byte(int r, int c) { const int st = (r >> 4) * 2 + (c >> 5), rr = r & 15, cc = c & 31, ob = rr * 64 + cc * 2; return st * 1024 + (ob ^ (((ob >> 9) & 1) << 5)); }
__host__ __device__ __forceinline__ void stage_rc(int b, int& R, int& C) { const int st = b / 1024, sb = b % 1024, swz = sb ^ (((sb >> 9) & 1) << 5); R = (st >> 1) * 16 + swz / 64; C = (st & 1) * 32 + (swz % 64) / 2; }
__host__ __device__ __forceinline__ int perm32(int rho) { const int n = rho >> 4, i = rho & 15; return 8 * (i >> 2) + 4 * n + (i & 3); }

struct Unit { int pm, pn, ko, nt; };
struct Gemm { const bf16_t* A; const bf16_t* Bt; int M, N, K; };

struct StaticOrder {
    int nM, nN, nwg, G, c;
    __host__ __device__ __forceinline__ void init(int M, int N, int G_, int c_) { nM = M / BM; nN = N / BM; nwg = nM * nN; G = G_; c = c_; }
    __host__ __device__ __forceinline__ bool next(int i, Unit& u) const {
        const long L = (long)i * G + c; if (L >= nwg) return false;
        int wgid = (int)L; { const int q = nwg / NXCD, r = nwg % NXCD, xcd = wgid % NXCD, off = wgid / NXCD; wgid = (xcd < r ? xcd * (q + 1) : r * (q + 1) + (xcd - r) * q) + off; }
        const int nig = WGM * nN, gid = wgid / nig, fm = gid * WGM, gsz = (nM - fm) < WGM ? (nM - fm) : WGM;
        u.pm = fm + ((wgid % nig) % gsz); u.pn = (wgid % nig) / gsz; u.ko = 0; u.nt = 0; return true;
    }
    __device__ __forceinline__ void a_ready(const Unit&) const {}
    __device__ __forceinline__ void done(const Unit&) const {}
};

__device__ __forceinline__ unsigned cvt_pk_bf16(float lo, float hi) { typedef float f32x2cv_ __attribute__((ext_vector_type(2))); typedef __bf16 bf16x2cv_ __attribute__((ext_vector_type(2))); const f32x2cv_ v_ = {lo, hi}; const bf16x2cv_ b_ = __builtin_convertvector(v_, bf16x2cv_); return __builtin_bit_cast(unsigned, b_); }
typedef float f32x2 __attribute__((ext_vector_type(2)));
struct EpiStoreBf16 {
    static constexpr bool PERM = true, AFTER_DRAIN = false;
    bf16_t* O; int ldc;
    __device__ __forceinline__ void operator()(const f32x4 (&acc)[2][2][4][2], const Unit& u, int wr, int wc, int fr, int fq) const {
        const int row0 = u.pm * BM + wr * 64 + fr, col0 = u.pn * BM + wc * 32 + 8 * fq;
#pragma unroll
        for (int ai = 0; ai < 2; ++ai)
#pragma unroll
            for (int m = 0; m < 4; ++m) { bf16_t* rowp = O + (size_t)(row0 + ai * HALF + m * 16) * ldc + col0;
#pragma unroll
                for (int bj = 0; bj < 2; ++bj) { const f32x4 v0 = acc[ai][bj][m][0], v1 = acc[ai][bj][m][1];
                    u32x4 w; w.x = cvt_pk_bf16(v0[0], v0[1]); w.y = cvt_pk_bf16(v0[2], v0[3]); w.z = cvt_pk_bf16(v1[0], v1[1]); w.w = cvt_pk_bf16(v1[2], v1[3]);
                    *(u32x4*)(rowp + bj * HALF) = w; } }
    }
};
struct CtxSplitOrder {
    StaticOrder lat; int nlat, nsub, G, c;
    __device__ __forceinline__ void init(int K, bool with_ctx, int G_, int c_) { lat.init(128 * BM, 1024, G_, c_); nlat = 128 * 4; nsub = with_ctx ? 16 * (K / 256) : 0; G = G_; c = c_; }
    __device__ __forceinline__ bool next(int i, Unit& u) const {
        const int L = i * G + c;
        if (L < nlat) return lat.next(i, u);
        const int s = L - nlat; if (s >= nsub) return false;
        u.pm = 128 + (s & 3); u.pn = (s >> 2) & 3; u.ko = (s >> 4) * 256; u.nt = 4; return true;
    }
    __device__ __forceinline__ void a_ready(const Unit&) const {}
    __device__ __forceinline__ void done(const Unit&) const {}
};
struct EpiResid {
    static constexpr bool PERM = true, AFTER_DRAIN = false;
    const void* base_lat; const float* base_ctx; void* out_lat; float* out_ctx; const float* gate; int tile0; bool bin, bout;
    template <bool BIN, bool BOUT>
    __device__ __forceinline__ void body(const f32x4 (&acc)[2][2][4][2], const void* bp_, void* op_, const float* gp, int wr, int fr) const {
        f32x4 g[2][2];
#pragma unroll
        for (int bj = 0; bj < 2; ++bj)
#pragma unroll
            for (int n = 0; n < 2; ++n) g[bj][n] = *(const f32x4*)(gp + bj * HALF + n * 4);
        if constexpr (BIN) {
            u32x4 rb[8][2];
#define RB_LOAD(it_) do { _Pragma("unroll") for (int bj = 0; bj < 2; ++bj) rb[it_][bj] = *(const u32x4*)((const bf16_t*)bp_ + (size_t)(((it_) >> 2) * HALF + wr * 64 + ((it_) & 3) * 16 + fr) * 1024 + bj * HALF); } while (0)
            RB_LOAD(0); RB_LOAD(1); RB_LOAD(2); RB_LOAD(3); RB_LOAD(4);
#pragma unroll
            for (int it = 0; it < 8; ++it) { const int ai = it >> 2, m = it & 3; const size_t off = (size_t)(ai * HALF + wr * 64 + m * 16 + fr) * 1024;
#pragma unroll
                for (int bj = 0; bj < 2; ++bj) { const size_t o = off + bj * HALF; const u32x4 w = rb[it][bj];
                    const f32x4 b0 = (f32x4){__uint_as_float(w.x << 16), __uint_as_float(w.x & 0xffff0000u), __uint_as_float(w.y << 16), __uint_as_float(w.y & 0xffff0000u)};
                    const f32x4 b1 = (f32x4){__uint_as_float(w.z << 16), __uint_as_float(w.z & 0xffff0000u), __uint_as_float(w.w << 16), __uint_as_float(w.w & 0xffff0000u)};
                    const f32x4 r0 = b0 + g[bj][0] * acc[ai][bj][m][0], r1 = b1 + g[bj][1] * acc[ai][bj][m][1];
                    if (BOUT) { u32x4 w2; w2.x = cvt_pk_bf16(r0[0], r0[1]); w2.y = cvt_pk_bf16(r0[2], r0[3]); w2.z = cvt_pk_bf16(r1[0], r1[1]); w2.w = cvt_pk_bf16(r1[2], r1[3]); *(u32x4*)((bf16_t*)op_ + o) = w2; }
                    else { *(f32x4*)((float*)op_ + o) = r0; *(f32x4*)((float*)op_ + o + 4) = r1; } }
                if (it + 5 < 8) RB_LOAD(it + 5);
                __builtin_amdgcn_sched_barrier(0); }
#undef RB_LOAD
        } else {
#pragma unroll
            for (int ai = 0; ai < 2; ++ai)
#pragma unroll
                for (int m = 0; m < 4; ++m) { const size_t off = (size_t)(ai * HALF + wr * 64 + m * 16 + fr) * 1024;
#pragma unroll
                    for (int bj = 0; bj < 2; ++bj) { const size_t o = off + bj * HALF;
                        const f32x4 b0 = *(const f32x4*)((const float*)bp_ + o), b1 = *(const f32x4*)((const float*)bp_ + o + 4);
                        const f32x4 r0 = b0 + g[bj][0] * acc[ai][bj][m][0], r1 = b1 + g[bj][1] * acc[ai][bj][m][1];
                        if (BOUT) { u32x4 w2; w2.x = cvt_pk_bf16(r0[0], r0[1]); w2.y = cvt_pk_bf16(r0[2], r0[3]); w2.z = cvt_pk_bf16(r1[0], r1[1]); w2.w = cvt_pk_bf16(r1[2], r1[3]); *(u32x4*)((bf16_t*)op_ + o) = w2; }
                        else { *(f32x4*)((float*)op_ + o) = r0; *(f32x4*)((float*)op_ + o + 4) = r1; } }
                    asm volatile("" ::: "memory"); }
        }
    }
    __device__ __forceinline__ void operator()(const f32x4 (&acc)[2][2][4][2], const Unit& u, int wr, int wc, int fr, int fq) const {
        asm volatile("" : "+v"(fr), "+v"(fq));
        const int tile = tile0 + u.pm; const bool lat = tile < 128; const int mb = lat ? (tile >> 5) : 4;
        const int col0 = u.pn * BM + wc * 32 + 8 * fq;
        const size_t toff = (lat ? (size_t)tile : (size_t)(tile - 128)) * (256 * 1024) + col0;
        const float* gp = gate + mb * 6144 + col0;
        if (!lat) {
            f32x4 g[2][2];
#pragma unroll
            for (int bj = 0; bj < 2; ++bj)
#pragma unroll
                for (int n = 0; n < 2; ++n) g[bj][n] = *(const f32x4*)(gp + bj * HALF + n * 4);
            float* op = out_ctx + (size_t)(u.ko >> 8) * (1024 * 1024) + toff;
#pragma unroll
            for (int ai = 0; ai < 2; ++ai)
#pragma unroll
                for (int m = 0; m < 4; ++m) { const size_t off = (size_t)(ai * HALF + wr * 64 + m * 16 + fr) * 1024;
#pragma unroll
                    for (int bj = 0; bj < 2; ++bj)
#pragma unroll
                        for (int n = 0; n < 2; ++n) *(f32x4*)(op + off + bj * HALF + n * 4) = g[bj][n] * acc[ai][bj][m][n]; }
        }
        else if (bin && bout) body<true, true>(acc, (const bf16_t*)base_lat + toff, (bf16_t*)out_lat + toff, gp, wr, fr);
        else if (bout) body<false, true>(acc, (const float*)base_lat + toff, (bf16_t*)out_lat + toff, gp, wr, fr);
        else body<true, false>(acc, (const bf16_t*)base_lat + toff, (float*)out_lat + toff, gp, wr, fr);
    }
};
struct EpiConvAct {
    static constexpr bool PERM = true, AFTER_DRAIN = false;
    bf16_t* ACT; float* HALO; const float* cw; PG8_LAS float* XB;
    __device__ __forceinline__ void operator()(const f32x4 (&acc)[2][2][4][2], const Unit& u, int wr, int wc, int fr, int fq) const {
        { int l_; asm volatile("v_mbcnt_lo_u32_b32 %0, -1, 0\n\tv_mbcnt_hi_u32_b32 %0, -1, %0" : "=v"(l_)); fr = l_ & 15; fq = l_ >> 4; }
        const int lane = fq * 16 + fr, cloc = wc * 32 + 8 * fq;
        const int chan = u.pn * 128 + cloc;
#pragma unroll
        for (int ai = 0; ai < 2; ++ai) { const int k = 2 * ai + wr;
            if (fr == 0 || fr == 15) { const int slot = 2 * k + (fr == 15 ? 1 : 0), m = fr == 15 ? 3 : 0;
#pragma unroll
                for (int bj = 0; bj < 2; ++bj)
#pragma unroll
                    for (int n = 0; n < 2; ++n) *(PG8_LAS f32x4*)(XB + slot * 256 + bj * 128 + cloc + 4 * n) = (m == 0) ? acc[ai][bj][0][n] : acc[ai][bj][3][n]; } }
        if ((wr == 0 && fr < 2) || (wr == 1 && fr >= 14)) { const int hr = wr == 0 ? fr : fr - 12; float* hp = HALO + ((size_t)u.pm * 4 + hr) * 5632 + chan;
#pragma unroll
            for (int bj = 0; bj < 2; ++bj)
#pragma unroll
                for (int n = 0; n < 2; ++n) *(f32x4*)(hp + bj * 2816 + 4 * n) = (wr == 0) ? acc[0][bj][0][n] : acc[1][bj][3][n]; }
        asm volatile("s_waitcnt lgkmcnt(0)" ::: "memory"); __builtin_amdgcn_s_barrier(); asm volatile("" ::: "memory");
        const int ldn = ((lane & 48) | ((fr + 15) & 15)) << 2, lup = ((lane & 48) | ((fr + 1) & 15)) << 2;
        f32x4 w[2][3][2];
#pragma unroll
        for (int n = 0; n < 2; ++n)
#pragma unroll
            for (int t = 0; t < 3; ++t)
#pragma unroll
                for (int bj = 0; bj < 2; ++bj) w[n][t][bj] = *(const f32x4*)(cw + t * 5632 + bj * 2816 + chan + 4 * n) * (bj == 0 ? -1.4426950408889634f : -0.6931471805599453f);
#pragma unroll
        for (int ai = 0; ai < 2; ++ai) { const int k = 2 * ai + wr;
#pragma unroll
            for (int m = 0; m < 4; ++m) {
                u32x4 o;
#pragma unroll
                for (int n = 0; n < 2; ++n) {
                    f32x4 y[2];
#pragma unroll
                    for (int bj = 0; bj < 2; ++bj) {
                        const f32x4 x = acc[ai][bj][m][n];
                        f32x4 tdn = x, tup = x;
                        if (m > 0) { const f32x4 xm = acc[ai][bj][m > 0 ? m - 1 : 0][n]; if (fr == 15) tdn = xm; }
                        if (m < 3) { const f32x4 xp = acc[ai][bj][m < 3 ? m + 1 : 3][n]; if (fr == 0) tup = xp; }
                        f32x4 prev, next;
#pragma unroll
                        for (int e = 0; e < 4; ++e) { prev[e] = __int_as_float(__builtin_amdgcn_ds_bpermute(ldn, __float_as_int(tdn[e]))); next[e] = __int_as_float(__builtin_amdgcn_ds_bpermute(lup, __float_as_int(tup[e]))); }
                        if (m == 0) { f32x4 xb = (f32x4){0.f, 0.f, 0.f, 0.f}; if (k > 0) xb = *(const PG8_LAS f32x4*)(XB + (2 * k - 1) * 256 + bj * 128 + cloc + 4 * n); if (fr == 0) prev = xb; }
                        if (m == 3) { f32x4 xb = (f32x4){0.f, 0.f, 0.f, 0.f}; if (k < 3) xb = *(const PG8_LAS f32x4*)(XB + (2 * k + 2) * 256 + bj * 128 + cloc + 4 * n); if (fr == 15) next = xb; }
                        y[bj] = w[n][0][bj] * prev + w[n][1][bj] * x + w[n][2][bj] * next;
                    }
                    float a[4];
#pragma unroll
                    for (int e = 0; e < 4; ++e) a[e] = y[0][e] * __builtin_amdgcn_rcpf(1.f + __builtin_amdgcn_exp2f(y[0][e])) * y[1][e];
                    if (n == 0) { o.x = cvt_pk_bf16(a[0], a[1]); o.y = cvt_pk_bf16(a[2], a[3]); } else { o.z = cvt_pk_bf16(a[0], a[1]); o.w = cvt_pk_bf16(a[2], a[3]); }
                }
                *(u32x4*)(ACT + (size_t)(u.pm * BM + ai * HALF + wr * 64 + m * 16 + fr) * 2816 + chan) = o;
                __builtin_amdgcn_sched_barrier(0);
            }
        }
    }
};
template <class Epi, class Sched, bool ALIGN_EPI = false, bool SP2 = false>
__device__ __forceinline__ void gemm_phase(PG8_LAS unsigned char* lds, const Gemm g, const Sched& S, const Epi& E, const int tid) {
    const int wid = __builtin_amdgcn_readfirstlane(tid >> 6), lane = tid & 63, wr = wid >> 2, wc = wid & 3, fr = lane & 15, fq = lane >> 4;
    const int K = g.K;
    unsigned voffA[2], voffB[2];
#pragma unroll
    for (int i = 0; i < 2; ++i) { int R, C; stage_rc(tid * 16 + i * 8192, R, C); const int Rb = Epi::PERM ? ((R & ~31) + perm32(R & 31)) : R;
        voffA[i] = (unsigned)(R * K + C) * 2u; voffB[i] = (unsigned)(Rb * K + C) * 2u; }
    const size_t kstep = (size_t)(BK * 2);
    const size_t hstep = (size_t)HALF * K * 2;
    const size_t tstep = 2 * hstep;
    const unsigned ldsw = (unsigned)wid * 1024u;
    const int aoff = lds_byte(wr * 64 + fr, fq * 8), boff = lds_byte(wc * 32 + fr, fq * 8);
#define PG8_SA(b, h) (((b) * 2 + (h)) * HTB)
#define PG8_SB(b, h) ((4 + (b) * 2 + (h)) * HTB)
#define PG8_STAGE(bufoff, gbase, voff) do { _Pragma("unroll") for (int _i = 0; _i < 2; ++_i) \
        __builtin_amdgcn_global_load_lds((const unsigned*)((const char*)(gbase) + (voff)[_i]), (PG8_LAS unsigned*)(lds + (bufoff) + ldsw + _i * 8192), 16, 0, 0); } while (0)
#define PG8_LDA(dst, b, h) do { _Pragma("unroll") for (int m = 0; m < 4; ++m) _Pragma("unroll") for (int k = 0; k < 2; ++k) dst[m][k] = *(const PG8_LAS bf16x8*)(lds + PG8_SA(b, h) + aoff + m * 2048 + k * 1024); } while (0)
#define PG8_LDB(dst, b, h) do { _Pragma("unroll") for (int n = 0; n < 2; ++n) _Pragma("unroll") for (int k = 0; k < 2; ++k) dst[n][k] = *(const PG8_LAS bf16x8*)(lds + PG8_SB(b, h) + boff + n * 2048 + k * 1024); } while (0)
#define PG8_MMA(ai, bj, At, Bt) do { __builtin_amdgcn_s_setprio(1); _Pragma("unroll") for (int m = 0; m < 4; ++m) _Pragma("unroll") for (int n = 0; n < 2; ++n) _Pragma("unroll") for (int k = 0; k < 2; ++k) \
        acc[ai][bj][m][n] = __builtin_amdgcn_mfma_f32_16x16x32_bf16(Bt[n][k], At[m][k], acc[ai][bj][m][n], 0, 0, 0); __builtin_amdgcn_s_setprio(0); } while (0)
#define PG8_WAIT_V(n) asm volatile("s_waitcnt vmcnt(" #n ")" ::: "memory")
#define PG8_WAIT_L(n) asm volatile("s_waitcnt lgkmcnt(" #n ")" ::: "memory")
#define PG8_BAR __builtin_amdgcn_s_barrier()
#define PG8_SCHED __builtin_amdgcn_sched_barrier(0)
    Unit cur, nxt; int ui = 0;
    if (!S.next(0, cur)) return;
    f32x4 acc[2][2][4][2];
#pragma unroll
    for (int a = 0; a < 2; ++a)
#pragma unroll
        for (int b = 0; b < 2; ++b)
#pragma unroll
            for (int m = 0; m < 4; ++m)
#pragma unroll
                for (int n = 0; n < 2; ++n) acc[a][b][m][n] = (f32x4){0.f, 0.f, 0.f, 0.f};
    bf16x8 At[4][2], B0[2][2], B1[2][2];
    const char* cA = (const char*)g.A + (size_t)cur.pm * tstep + (size_t)cur.ko * 2; const char* cB = (const char*)g.Bt + (size_t)cur.pn * tstep + (size_t)cur.ko * 2;
    S.a_ready(cur);
    if constexpr (SP2) {
        PG8_STAGE(PG8_SB(0, 0), cB, voffB); PG8_STAGE(PG8_SB(0, 1), cB + hstep, voffB); PG8_STAGE(PG8_SA(0, 0), cA, voffA); PG8_STAGE(PG8_SA(0, 1), cA + hstep, voffA);
        if (wr == 1) PG8_BAR;
        PG8_WAIT_V(2); PG8_BAR;
        PG8_STAGE(PG8_SB(1, 0), cB + kstep, voffB); PG8_STAGE(PG8_SA(1, 0), cA + kstep, voffA); PG8_STAGE(PG8_SB(1, 1), cB + hstep + kstep, voffB);
        PG8_WAIT_V(6); PG8_BAR;
    } else {
        PG8_STAGE(PG8_SB(0, 0), cB, voffB); PG8_STAGE(PG8_SA(0, 0), cA, voffA); PG8_STAGE(PG8_SB(0, 1), cB + hstep, voffB); PG8_STAGE(PG8_SA(0, 1), cA + hstep, voffA);
        if (wr == 1) PG8_BAR;
        PG8_WAIT_V(4); PG8_BAR;
        PG8_STAGE(PG8_SB(1, 0), cB + kstep, voffB); PG8_STAGE(PG8_SA(1, 0), cA + kstep, voffA); PG8_STAGE(PG8_SB(1, 1), cB + hstep + kstep, voffB);
        PG8_WAIT_V(6); PG8_BAR;
    }
    for (;;) {
        const bool has_next = S.next(ui + 1, nxt);
        const char* nA = has_next ? (const char*)g.A + (size_t)nxt.pm * tstep + (size_t)nxt.ko * 2 : cA; const char* nB = has_next ? (const char*)g.Bt + (size_t)nxt.pn * tstep + (size_t)nxt.ko * 2 : cB;
        const int nt = cur.nt ? cur.nt : K / BK;
        for (int t = 0; t < nt; t += 2) {
            const bool last = (t == nt - 2);
            const char* a1 = cA + (size_t)(t + 1) * kstep;
            const char* a2 = last ? nA : cA + (size_t)(t + 2) * kstep; const char* b2 = last ? nB : cB + (size_t)(t + 2) * kstep;
            const char* a3 = a2 + kstep; const char* b3 = b2 + kstep;
            if (last && has_next) S.a_ready(nxt);
            if constexpr (SP2) {
            PG8_LDB(B0, 0, 0); PG8_LDB(B1, 0, 1); PG8_SCHED; PG8_LDA(At, 0, 0); PG8_STAGE(PG8_SA(1, 1), a1 + hstep, voffA);
            PG8_WAIT_V(8); PG8_WAIT_L(0); PG8_BAR; PG8_MMA(0, 0, At, B0); PG8_MMA(0, 1, At, B1); PG8_BAR; PG8_SCHED;
            PG8_LDA(At, 0, 1); PG8_STAGE(PG8_SB(0, 0), b2, voffB); PG8_STAGE(PG8_SB(0, 1), b2 + hstep, voffB); PG8_STAGE(PG8_SA(0, 0), a2, voffA);
            PG8_WAIT_V(8); PG8_WAIT_L(0); PG8_BAR; PG8_MMA(1, 0, At, B0); PG8_MMA(1, 1, At, B1); PG8_BAR; PG8_SCHED;
            PG8_LDB(B0, 1, 0); PG8_LDB(B1, 1, 1); PG8_SCHED; PG8_LDA(At, 1, 0); PG8_STAGE(PG8_SA(0, 1), a2 + hstep, voffA);
            PG8_WAIT_V(8); PG8_WAIT_L(0); PG8_BAR; PG8_MMA(0, 0, At, B0); PG8_MMA(0, 1, At, B1); PG8_BAR; PG8_SCHED;
            PG8_LDA(At, 1, 1); PG8_STAGE(PG8_SB(1, 0), b3, voffB); PG8_STAGE(PG8_SB(1, 1), b3 + hstep, voffB); PG8_STAGE(PG8_SA(1, 0), a3, voffA);
            PG8_WAIT_V(8); PG8_WAIT_L(0); PG8_BAR; PG8_MMA(1, 0, At, B0); PG8_MMA(1, 1, At, B1); PG8_BAR; PG8_SCHED;
            } else {
            PG8_LDB(B0, 0, 0); PG8_SCHED; PG8_LDA(At, 0, 0); PG8_STAGE(PG8_SA(1, 1), a1 + hstep, voffA);
            PG8_WAIT_L(8); PG8_BAR; PG8_WAIT_L(0); PG8_MMA(0, 0, At, B0); PG8_BAR; PG8_SCHED;
            PG8_LDB(B1, 0, 1); PG8_STAGE(PG8_SB(0, 0), b2, voffB);
            PG8_BAR; PG8_WAIT_L(0); PG8_MMA(0, 1, At, B1); PG8_BAR;
            PG8_LDA(At, 0, 1); PG8_STAGE(PG8_SA(0, 0), a2, voffA);
            PG8_BAR; PG8_WAIT_L(0); PG8_MMA(1, 0, At, B0); PG8_BAR; PG8_SCHED;
            PG8_STAGE(PG8_SB(0, 1), b2 + hstep, voffB);
            PG8_WAIT_V(6); PG8_BAR; PG8_MMA(1, 1, At, B1); PG8_BAR;
            PG8_LDB(B0, 1, 0); PG8_SCHED; PG8_LDA(At, 1, 0); PG8_STAGE(PG8_SA(0, 1), a2 + hstep, voffA);
            PG8_WAIT_L(8); PG8_BAR; PG8_WAIT_L(0); PG8_MMA(0, 0, At, B0); PG8_BAR; PG8_SCHED;
            PG8_LDB(B1, 1, 1); PG8_STAGE(PG8_SB(1, 0), b3, voffB);
            PG8_BAR; PG8_WAIT_L(0); PG8_MMA(0, 1, At, B1); PG8_BAR;
            PG8_LDA(At, 1, 1); PG8_STAGE(PG8_SA(1, 0), a3, voffA);
            PG8_BAR; PG8_WAIT_L(0); PG8_MMA(1, 0, At, B0); PG8_BAR; PG8_SCHED;
            PG8_STAGE(PG8_SB(1, 1), b3 + hstep, voffB);
            PG8_WAIT_V(6); PG8_BAR; PG8_MMA(1, 1, At, B1); PG8_BAR;
            }
        }
        if constexpr (ALIGN_EPI) { if (wr == 0) PG8_BAR; }
        if constexpr (!Epi::AFTER_DRAIN) { E(acc, cur, wr, wc, fr, fq); S.done(cur); }
        if (!has_next) break;
#pragma unroll
        for (int a = 0; a < 2; ++a)
#pragma unroll
            for (int b = 0; b < 2; ++b)
#pragma unroll
                for (int m = 0; m < 4; ++m)
#pragma unroll
                    for (int n = 0; n < 2; ++n) acc[a][b][m][n] = (f32x4){0.f, 0.f, 0.f, 0.f};
        cur = nxt; cA = nA; cB = nB; ++ui;
        if constexpr (ALIGN_EPI) { if (wr == 1) PG8_BAR; }
    }
    PG8_WAIT_V(0);
    if constexpr (!ALIGN_EPI) { if (wr == 0) PG8_BAR; }
    PG8_BAR;
    if constexpr (Epi::AFTER_DRAIN) { E.fused(acc, cur, wr, wc, fr, fq, lds, wid, lane); S.done(cur); }
#undef PG8_SA
#undef PG8_SB
#undef PG8_STAGE
#undef PG8_LDA
#undef PG8_LDB
#undef PG8_MMA
#undef PG8_WAIT_V
#undef PG8_WAIT_L
#undef PG8_BAR
#undef PG8_SCHED
}
}

constexpr int DM = 1024, NB = 4, SEQ = 8192, CTXL = 256, ML = NB * SEQ, MC = NB * CTXL, MT = ML + MC;
constexpr int DFF = 2816, NUP = 2 * DFF;
constexpr float EPS = 1e-6f;
constexpr int NWAVES = 8;
constexpr float LOG2E = 1.4426950408889634f;

constexpr size_t MiB = 1u << 20;
constexpr size_t WS_CTL = 0, CTL_ZERO_BYTES = 64 * 1024;
constexpr int CW_BAR = 1024;
constexpr size_t WS_MOD = 1 * MiB;
constexpr size_t WS_ROPE64 = 1 * MiB + 512 * 1024;
constexpr size_t WS_ROPE128 = WS_ROPE64 + 16384;
constexpr size_t WS_HC = 2 * MiB;
constexpr size_t WS_WT = 6 * MiB;
constexpr size_t SZ_UP = (size_t)NUP * DM * 2, SZ_DOWN = (size_t)DM * DFF * 2, SZ_W1536 = 1536u * 1024 * 2, SZ_W1024 = 1024u * 1024 * 2, SZ_W3072 = 3072u * 1024 * 2;
constexpr size_t SZ_LA = SZ_W1536 + SZ_W1024 + SZ_UP + SZ_DOWN, SZ_LB = SZ_W3072 + SZ_W1024 + SZ_UP + SZ_DOWN;
constexpr size_t WT_L0 = WS_WT, WT_L1 = WT_L0 + SZ_LA, WT_L2 = WT_L1 + SZ_LB, WT_L3 = WT_L2 + SZ_LA, WT_END = WT_L3 + SZ_LB;
static_assert(WT_END <= 98 * MiB, "weights");
constexpr size_t WS_XN = 98 * MiB;
constexpr size_t WS_GATES = 164 * MiB;
constexpr size_t WS_BIG = 168 * MiB;
constexpr size_t WS_END = 512 * MiB;
constexpr size_t BG_RAW = WS_BIG, BG_Q = WS_BIG + 100 * MiB, BG_K = WS_BIG + 166 * MiB, BG_V = WS_BIG + 183 * MiB, BG_O = WS_BIG + 200 * MiB;
constexpr size_t BG_CBAR = WS_BIG + 200 * MiB, BG_NBAR = WS_BIG + 332 * MiB, BG_MSC = WS_BIG + 334 * MiB;
constexpr size_t WS_HF = WS_XN, WS_HB = WS_WT;
static_assert((size_t)ML * 1024 * 2 <= WT_L3 - WS_WT, "HB fits below layer 3's weights");
constexpr size_t BG_ACT = WS_BIG, BG_HALO = WS_BIG + 184 * MiB;
constexpr size_t BG_SLAB = WS_BIG + 270 * MiB;
constexpr int XB_OFF = 135168;
constexpr int ML_NUID = 32 * 66;

constexpr int RING_BYTES = 131072, LDSCTL_OFF = RING_BYTES, MISC_OFF = LDSCTL_OFF + 320, LDS_BYTES = 147456;
#define GAS __attribute__((address_space(1)))
#define LAS __attribute__((address_space(3)))
typedef unsigned short bf16;
typedef unsigned v4u __attribute__((ext_vector_type(4)));
typedef float f32x4 __attribute__((ext_vector_type(4)));
typedef short bf16x8 __attribute__((ext_vector_type(8)));
typedef GAS unsigned gu32;
typedef GAS unsigned long long gu64;
#define RLX_AGENT __ATOMIC_RELAXED, __HIP_MEMORY_SCOPE_AGENT
#define LDS_WAIT() asm volatile("s_waitcnt lgkmcnt(0)" ::: "memory")
#define VM_WAIT() asm volatile("s_waitcnt vmcnt(0)" ::: "memory")
__device__ __forceinline__ unsigned long long rt() { return __builtin_amdgcn_s_memrealtime(); }
__device__ __forceinline__ unsigned f2bf(float f) { unsigned u = __builtin_bit_cast(unsigned, f); return (u + 0x7fffu + ((u >> 16) & 1u)) >> 16; }
__device__ __forceinline__ unsigned pk2(float lo, float hi) { return f2bf(lo) | (f2bf(hi) << 16); }

#define XB_TMO      128
#define XB_XCNT(j)  (256  + 64 * (j))
#define XB_XSUB(j)  (1280 + 64 * (j))
#define XB_XGEN(j)  (2304 + 64 * (j))
#define XB_TOP      3328
#define XB_TOPGEN   3392
#define XCD_BAR_WORDS 3456
#define XB_SPIN_CAP (1u << 18)

__device__ __forceinline__ unsigned xb_ld(unsigned* p)              { return __hip_atomic_load(p, __ATOMIC_RELAXED, __HIP_MEMORY_SCOPE_AGENT); }
__device__ __forceinline__ unsigned xb_add(unsigned* p, unsigned v) { return __hip_atomic_fetch_add(p, v, __ATOMIC_RELAXED, __HIP_MEMORY_SCOPE_AGENT); }
__device__ __forceinline__ unsigned xb_xcc_id() { return (unsigned)__builtin_amdgcn_s_getreg((3 << 11) | 20) & 0xFu; }
#define XB_SPIN(cond, bar) do { unsigned _sp = 0; while (cond) { __builtin_amdgcn_s_sleep(1); \
    if ((++_sp & 255u) == 0u) { if (xb_ld(&(bar)[XB_TMO])) break; if (_sp > XB_SPIN_CAP) { atomicAdd(&(bar)[XB_TMO], 1u); break; } } } } while (0)

struct XcdBarrier {
    unsigned* bar; unsigned x;
    volatile LAS unsigned* st;
};

__device__ __forceinline__ int xb_lane() { int l_; asm volatile("v_mbcnt_lo_u32_b32 %0, -1, 0\n\tv_mbcnt_hi_u32_b32 %0, -1, %0" : "=v"(l_)); return l_; }
__device__ __forceinline__ XcdBarrier xcd_barrier_post(unsigned* bar, volatile LAS unsigned* st, int wave) {
    XcdBarrier b; b.bar = bar; b.x = xb_xcc_id(); b.st = st;
    if (wave == 0 && xb_lane() == 0) (void)xb_add(&bar[XB_XCNT(b.x)], 1u);
    return b;
}
__device__ __forceinline__ void xcd_barrier_complete(unsigned* bar, unsigned x, unsigned& nloc, unsigned& nx) {
    const unsigned G = gridDim.x * gridDim.y * gridDim.z;
    unsigned sum, cnt, mine, sp = 0u;
    for (;;) {
        sum = 0u; cnt = 0u; mine = 0u;
#pragma nounroll
        for (unsigned j = 0; j < 16; ++j) { const unsigned c = xb_ld(&bar[XB_XCNT(j)]); sum += c; cnt += (c > 0u) ? 1u : 0u; mine = (j == x) ? c : mine; }
        if (sum == G) break;
        __builtin_amdgcn_s_sleep(1);
        if ((++sp & 255u) == 0u) { if (xb_ld(&bar[XB_TMO])) break; if (sp > XB_SPIN_CAP) { atomicAdd(&bar[XB_TMO], 1u); break; } }
    }
    nloc = mine > 0u ? mine : 1u; nx = cnt > 0u ? cnt : 1u;
}

__device__ __forceinline__ void xcd_barrier(const XcdBarrier& b, int wave  ) {
    asm volatile("s_waitcnt vmcnt(0)" ::: "memory");
    __syncthreads();
    if (wave == 0 && xb_lane() == 0) {
        unsigned* bar = b.bar;
        __builtin_amdgcn_s_waitcnt(0);
        unsigned nloc = b.st[0], nx = b.st[1];
        if (nloc == 0u) { xcd_barrier_complete(bar, b.x, nloc, nx); b.st[0] = nloc; b.st[1] = nx; }
        const unsigned old = xb_add(&bar[XB_XSUB(b.x)], 1u);
        const unsigned gen = old / nloc;
        if (old + 1u == (gen + 1u) * nloc) {
            __builtin_amdgcn_fence(__ATOMIC_RELEASE, "agent");
            asm volatile("s_waitcnt vmcnt(0)" ::: "memory");
            const unsigned og = xb_add(&bar[XB_TOP], 1u);
            const unsigned tg = og / nx;
            if (og + 1u == (tg + 1u) * nx) xb_add(&bar[XB_TOPGEN], 1u);
            else XB_SPIN(xb_ld(&bar[XB_TOPGEN]) == tg, bar);
            __builtin_amdgcn_fence(__ATOMIC_ACQUIRE, "agent");
            xb_add(&bar[XB_XGEN(b.x)], 1u);
            asm volatile("s_waitcnt vmcnt(0)" ::: "memory");
        } else {
            XB_SPIN(xb_ld(&bar[XB_XGEN(b.x)]) == gen, bar);
            __builtin_amdgcn_fence(__ATOMIC_ACQUIRE, "agent");
            asm volatile("s_waitcnt vmcnt(0)" ::: "memory");
        }
    }
    __syncthreads();
}

typedef unsigned u32x2 __attribute__((ext_vector_type(2)));
struct Frame { LAS unsigned char* lds; int tid, lane, wave, G, gw, ngw; };

__device__ __forceinline__ float bperm(float v, int srclane) { return __int_as_float(__builtin_amdgcn_ds_bpermute(srclane << 2, __float_as_int(v))); }
#define DPP_ADD(v, ctrl) ((v) + __int_as_float(__builtin_amdgcn_update_dpp(0, __float_as_int(v), (ctrl), 0xf, 0xf, true)))
__device__ __forceinline__ float row_sum16(float v) {
    v = DPP_ADD(v, 0xB1); v = DPP_ADD(v, 0x4E); v = DPP_ADD(v, 0x141); v = DPP_ADD(v, 0x140); return v;
}
__device__ __forceinline__ float wave_sum(float v, int lane) {
    v = row_sum16(v);
    const float a = __int_as_float(__builtin_amdgcn_readlane(__float_as_int(v), 0)), b = __int_as_float(__builtin_amdgcn_readlane(__float_as_int(v), 16));
    const float c = __int_as_float(__builtin_amdgcn_readlane(__float_as_int(v), 32)), d = __int_as_float(__builtin_amdgcn_readlane(__float_as_int(v), 48));
    return (a + b) + (c + d);
}
__device__ __forceinline__ float wave_max(float v, int lane) {
#pragma unroll
    for (int o = 1; o < 64; o <<= 1) v = fmaxf(v, bperm(v, lane ^ o));
    return v;
}
__device__ __forceinline__ float bf2f(unsigned short x) { return __uint_as_float((unsigned)x << 16); }
__device__ __forceinline__ float bflo(unsigned w) { return __uint_as_float(w << 16); }
__device__ __forceinline__ float bfhi(unsigned w) { return __uint_as_float(w & 0xffff0000u); }
__device__ __forceinline__ unsigned cvtpk2(float lo, float hi) { unsigned r; asm volatile("v_cvt_pk_bf16_f32 %0, %1, %2" : "=v"(r) : "v"(lo), "v"(hi)); return r; }
__device__ __forceinline__ unsigned short f2bf16_mfma(float f) { const __bf16 b = (__bf16)f; return __builtin_bit_cast(unsigned short, b); }
__device__ __forceinline__ unsigned short f2bf16(float f) { return (unsigned short)(cvtpk2(f, 0.f) & 0xffffu); }
__device__ __forceinline__ void unpack8(const v4u w, float (&f)[8]) { f[0] = bflo(w.x); f[1] = bfhi(w.x); f[2] = bflo(w.y); f[3] = bfhi(w.y); f[4] = bflo(w.z); f[5] = bfhi(w.z); f[6] = bflo(w.w); f[7] = bfhi(w.w); }
__device__ __forceinline__ v4u pack8(const float (&f)[8]) { v4u w; w.x = cvtpk2(f[0], f[1]); w.y = cvtpk2(f[2], f[3]); w.z = cvtpk2(f[4], f[5]); w.w = cvtpk2(f[6], f[7]); return w; }
__device__ __forceinline__ float sigmoidf_(float x) { return __builtin_amdgcn_rcpf(1.f + __builtin_amdgcn_exp2f(-1.4426950408889634f * x)); }

__device__ __forceinline__ void p0_transpose_item(const float* W, int K, int pitch, int nblk, bf16* WT, LAS float* scr, int item, int lane, bool upperm) {
    const int kb = item / nblk, nb = item % nblk, k0 = 64 * kb, n0 = 32 * nb;
    int d0 = n0; if (upperm) { const int c = n0 < DFF ? n0 : n0 - DFF; d0 = 256 * (c >> 7) + (c & 127) + (n0 < DFF ? 0 : 128); }
    float wv[32];
#pragma unroll
    for (int i = 0; i < 32; ++i) { const int kk = 2 * i + (lane >> 5); wv[i] = W[(size_t)(k0 + kk) * pitch + n0 + (lane & 31)]; }
#pragma unroll
    for (int i = 0; i < 32; ++i) { const int kk = 2 * i + (lane >> 5); scr[kk * 33 + (lane & 31)] = wv[i]; }
    LDS_WAIT(); asm volatile("" ::: "memory");
    const int c = lane & 7;
#pragma unroll
    for (int j = 0; j < 4; ++j) { const int n = (lane >> 3) + 8 * j; const LAS float* s = scr + (8 * c) * 33 + n;
        v4u o; o.x = pk2(s[0 * 33], s[1 * 33]); o.y = pk2(s[2 * 33], s[3 * 33]); o.z = pk2(s[4 * 33], s[5 * 33]); o.w = pk2(s[6 * 33], s[7 * 33]);
        *(v4u*)(WT + (size_t)(d0 + n) * K + k0 + 8 * c) = o; }
    LDS_WAIT(); asm volatile("" ::: "memory");
}
__device__ __forceinline__ void transpose_matrix(const Frame& F, const float* W, int K, int pitch, int Nused, bf16* WT, int& rot, bool upperm = false) {
    const int nblk = Nused / 32, nitems = (K / 64) * nblk;
    LAS float* scr = (LAS float*)(F.lds + F.wave * 16384);
    int first = (F.gw - rot) % F.ngw; if (first < 0) first += F.ngw;
    for (int it = first; it < nitems; it += F.ngw) p0_transpose_item(W, K, pitch, nblk, WT, scr, it, F.lane, upperm);
    rot = (rot + nitems) % F.ngw;
}
__device__ __forceinline__ void mod_phase(const Frame& F, const float* c, const float* cctx, const float* ada_w, const float* ada_b, float* MOD) {
    LAS float* sc = (LAS float*)F.lds;
    LAS float* red = (LAS float*)(F.lds + 20480);
    { float cv[10];
#pragma unroll
      for (int i2 = 0; i2 < 10; ++i2) { const int i = F.tid + 512 * i2; cv[i2] = i < 4096 ? c[i] : cctx[i - 4096]; }
#pragma unroll
      for (int i2 = 0; i2 < 10; ++i2) sc[F.tid + 512 * i2] = cv[i2] / (1.f + expf(-cv[i2])); }
    __syncthreads();
    const int ks = F.tid >> 5, cn = F.tid & 31;
    for (int item = blockIdx.x; item < 768; item += F.G) {
        const int layer = item / 192, n0 = (item % 192) * 32;
        const float* wp = ada_w + (size_t)layer * 1024 * 6144 + (size_t)(ks * 64) * 6144 + n0 + cn;
        float a0 = 0.f, a1 = 0.f, a2 = 0.f, a3 = 0.f, a4 = 0.f;
#pragma unroll 32
        for (int k = 0; k < 64; ++k) { const float w = wp[(size_t)k * 6144]; const int kk = ks * 64 + k;
            a0 += w * sc[kk]; a1 += w * sc[1024 + kk]; a2 += w * sc[2048 + kk]; a3 += w * sc[3072 + kk]; a4 += w * sc[4096 + kk]; }
        LAS float* rp = red + (ks * 32 + cn) * 5; rp[0] = a0; rp[1] = a1; rp[2] = a2; rp[3] = a3; rp[4] = a4;
        __syncthreads();
        if (F.tid < 160) { const int cn2 = F.tid & 31, b = F.tid >> 5; float s = 0.f;
#pragma unroll
            for (int k2 = 0; k2 < 16; ++k2) s += red[(k2 * 32 + cn2) * 5 + b];
            MOD[(size_t)(layer * 5 + b) * 6144 + n0 + cn2] = s + ada_b[layer * 6144 + n0 + cn2]; }
        __syncthreads();
    }
}
__device__ __forceinline__ void rope_tables(const Frame& F, float* R64, float* R128) {
    for (int i = blockIdx.x * 512 + F.tid; i < 6144; i += F.G * 512) {
        int pos, f, nf; float* dst;
        if (i < 2048) { pos = i >> 4; f = i & 15; nf = 16; dst = R64 + 2 * i; } else { const int j = i - 2048; pos = j >> 5; f = j & 31; nf = 32; dst = R128 + 2 * j; }
        const float inv = powf(10000.f, -(float)f / (float)nf);
        const float ang = (float)pos * inv;
        dst[0] = cosf(ang); dst[1] = sinf(ang);
    }
}

#define NCOL(j) (8 * F.lane + 512 * ((j) >> 1) + 4 * ((j) & 1))
template <bool GATES, int RG>
__device__ __forceinline__ void norm_rows(const Frame& F, f32x4 (&v)[RG][4], int rbase, const f32x4 (&A)[4], const f32x4 (&Bv)[4], bf16* XN, const LAS float* WgT, const float* bgate, float* GATESb) {
#pragma unroll
    for (int q = 0; q < RG; ++q) {
        const int r = rbase + q; float ss = 0.f;
#pragma unroll
        for (int j = 0; j < 4; ++j) ss += (v[q][j].x * v[q][j].x + v[q][j].y * v[q][j].y) + (v[q][j].z * v[q][j].z + v[q][j].w * v[q][j].w);
        ss = wave_sum(ss, F.lane); const float rs = __builtin_amdgcn_rsqf(ss * (1.f / 1024.f) + EPS);
#pragma unroll
        for (int j = 0; j < 4; ++j) v[q][j] = v[q][j] * rs * A[j] + Bv[j];
#pragma unroll
        for (int i2 = 0; i2 < 2; ++i2) { v4u w; w.x = cvtpk2(v[q][2 * i2].x, v[q][2 * i2].y); w.y = cvtpk2(v[q][2 * i2].z, v[q][2 * i2].w); w.z = cvtpk2(v[q][2 * i2 + 1].x, v[q][2 * i2 + 1].y); w.w = cvtpk2(v[q][2 * i2 + 1].z, v[q][2 * i2 + 1].w);
            *(v4u*)(XN + (size_t)r * 1024 + 8 * F.lane + 512 * i2) = w; }
    }
    if (GATES) {
        float val[RG];
#pragma unroll
        for (int q = 0; q < RG; ++q) val[q] = 0.f;
#pragma unroll
        for (int jg = 0; jg < 16; ++jg) { f32x4 w[4];
#pragma unroll
            for (int j = 0; j < 4; ++j) w[j] = *(const LAS f32x4*)(WgT + jg * 1024 + NCOL(j));
#pragma unroll
            for (int q = 0; q < RG; ++q) { float s = 0.f;
#pragma unroll
                for (int j = 0; j < 4; ++j) s += (v[q][j].x * w[j].x + v[q][j].y * w[j].y) + (v[q][j].z * w[j].z + v[q][j].w * w[j].w);
                s = wave_sum(s, F.lane); val[q] = (F.lane == jg) ? s : val[q]; } }
        if (F.lane < 16) { const float bg = bgate[F.lane]; const int kind = F.lane >> 2;
#pragma unroll
            for (int q = 0; q < RG; ++q) { float x = val[q] + bg;
                if (kind & 1) x = fminf(x, 0.f) - 0.6931471805599453f * __builtin_amdgcn_logf(1.f + __builtin_amdgcn_exp2f(-1.4426950408889634f * fabsf(x)));
                GATESb[(size_t)(rbase + q) * 16 + F.lane] = x; } }
    }
}
template <bool GATES>
__device__ __forceinline__ void norm_phase(const Frame& F, const void* hlat, bool lat_bf16, float* hctx, const float* slab, int nslab, int nrows, const float* gain, const float* mod, int sh_off, int sc_off, bf16* XN,
                                           const float* wg_src, const float* bgate, float* GATESb) {
    LAS float* WgT = (LAS float*)F.lds;
    if (GATES) { float wv[32];
#pragma unroll
        for (int i2 = 0; i2 < 32; ++i2) wv[i2] = wg_src[(size_t)((F.tid >> 4) + 32 * i2) * 3088 + 3072 + (F.tid & 15)];
#pragma unroll
        for (int i2 = 0; i2 < 32; ++i2) WgT[(F.tid & 15) * 1024 + (F.tid >> 4) + 32 * i2] = wv[i2];
        __syncthreads(); }
    constexpr int RG = 4;
    const int nlat = ML / 16, nitems = nlat + (nrows > ML ? MC : 0);
    for (int it = F.gw; it < nitems; it += F.ngw) {
        const int r0 = it < nlat ? it * 16 : ML + (it - nlat), mb = r0 < ML ? (r0 >> 13) : 4;
        const bool pipe = r0 < ML && lat_bf16;
        const bf16* src = (const bf16*)hlat + (size_t)(pipe ? r0 : 0) * 1024 + 8 * F.lane;
        v4u raw[RG][2];
        if (pipe) {
#pragma unroll
            for (int q = 0; q < RG; ++q) { raw[q][0] = *(const v4u*)(src + q * 1024); raw[q][1] = *(const v4u*)(src + q * 1024 + 512); } }
        f32x4 A[4], Bv[4];
        { f32x4 g[4], s[4];
#pragma unroll
          for (int j = 0; j < 4; ++j) { const int col = NCOL(j); g[j] = *(const f32x4*)(gain + col); s[j] = *(const f32x4*)(mod + mb * 6144 + sc_off + col); Bv[j] = *(const f32x4*)(mod + mb * 6144 + sh_off + col); }
#pragma unroll
          for (int j = 0; j < 4; ++j) A[j] = g[j] * (1.f + s[j]); }
        if (pipe) {
#pragma nounroll
            for (int rr = 0; rr < 16; rr += RG) {
                f32x4 v[RG][4];
#pragma unroll
                for (int q = 0; q < RG; ++q)
#pragma unroll
                    for (int i2 = 0; i2 < 2; ++i2) { const v4u w = raw[q][i2];
                        v[q][2 * i2] = (f32x4){bflo(w.x), bfhi(w.x), bflo(w.y), bfhi(w.y)}; v[q][2 * i2 + 1] = (f32x4){bflo(w.z), bfhi(w.z), bflo(w.w), bfhi(w.w)}; }
                { const int rn = rr + RG < 16 ? rr + RG : rr;
#pragma unroll
                  for (int q = 0; q < RG; ++q) { raw[q][0] = *(const v4u*)(src + (size_t)(rn + q) * 1024); raw[q][1] = *(const v4u*)(src + (size_t)(rn + q) * 1024 + 512); } }
                norm_rows<GATES, RG>(F, v, r0 + rr, A, Bv, XN, WgT, bgate, GATESb);
            }
            continue;
        }
        if (r0 < ML) {
            for (int rr = 0; rr < 16; rr += RG) {
                f32x4 v[RG][4];
#pragma unroll
                for (int q = 0; q < RG; ++q) { const float* src = (const float*)hlat + (size_t)(r0 + rr + q) * 1024;
#pragma unroll
                    for (int j = 0; j < 4; ++j) v[q][j] = *(const f32x4*)(src + NCOL(j)); }
                norm_rows<GATES, RG>(F, v, r0 + rr, A, Bv, XN, WgT, bgate, GATESb);
            }
            continue;
        }
        { f32x4 v[1][4]; float* src = hctx + (size_t)(r0 - ML) * 1024;
#pragma unroll
          for (int j = 0; j < 4; ++j) v[0][j] = *(const f32x4*)(src + NCOL(j));
          if (nslab > 0) {
#pragma nounroll
              for (int s0 = 0; s0 < nslab; s0 += 4) { f32x4 sv[4][4];
#pragma unroll
                  for (int qq = 0; qq < 4; ++qq) { const int s = s0 + qq < nslab ? s0 + qq : nslab - 1; const float* sp = slab + ((size_t)s * 1024 + (r0 - ML)) * 1024;
#pragma unroll
                      for (int j = 0; j < 4; ++j) sv[qq][j] = *(const f32x4*)(sp + NCOL(j)); }
#pragma unroll
                  for (int qq = 0; qq < 4; ++qq) if (s0 + qq < nslab) {
#pragma unroll
                      for (int j = 0; j < 4; ++j) v[0][j] += sv[qq][j]; } }
#pragma unroll
              for (int j = 0; j < 4; ++j) *(f32x4*)(src + NCOL(j)) = v[0][j]; }
          norm_rows<GATES, 1>(F, v, r0, A, Bv, XN, WgT, bgate, GATESb); }
    }
}
#undef NCOL
template <int HD>
__device__ __forceinline__ void qk_head8(const v4u raw, const float (&g)[8], float qs, bool rope, const float (&cs)[8], const float (&sn)[8], int lane, v4u& out) {
    constexpr int LPH = HD / 8;
    float x[8]; unpack8(raw, x);
    float ss = 0.f;
#pragma unroll
    for (int e = 0; e < 8; ++e) ss += x[e] * x[e];
#pragma unroll
    for (int o = 1; o < LPH; o <<= 1) ss += bperm(ss, lane ^ o);
    const float rs = qs * __builtin_amdgcn_rsqf(ss * (1.f / HD) + EPS);
    float y[8], yp[8];
#pragma unroll
    for (int e = 0; e < 8; ++e) y[e] = x[e] * rs * g[e];
#pragma unroll
    for (int e = 0; e < 8; ++e) yp[e] = bperm(y[e], lane ^ (LPH / 2));
    const bool upper = (lane & (LPH / 2)) != 0;
    float o[8];
#pragma unroll
    for (int e = 0; e < 8; ++e) o[e] = rope ? (upper ? y[e] * cs[e] + yp[e] * sn[e] : y[e] * cs[e] - yp[e] * sn[e]) : y[e];
    out = pack8(o);
}
__device__ __forceinline__ void qknorm_rope64(const Frame& F, const bf16* RAW, const float* qn, const float* kn, const float* R64, bf16* Qp, bf16* Kp) {
    const int j = F.lane & 7, hq = F.lane >> 3;
    float gq[8], gk[8];
#pragma unroll
    for (int e = 0; e < 8; ++e) { gq[e] = qn[8 * j + e]; gk[e] = kn[8 * j + e]; }
    v4u rw[3]; f32x4 tw[4];
#define QK64_LOAD(r_) do { const bf16* s_ = RAW + (size_t)(r_) * 1536; _Pragma("unroll") for (int p = 0; p < 3; ++p) { const int hh = 8 * p + hq; if (hh < 20) rw[p] = *(const v4u*)(s_ + hh * 64 + 8 * j); } \
        const int t_ = (r_) & (SEQ - 1), pos_ = (j & 3) < 2 ? (t_ >> 6) : (t_ & 63); const float* tp_ = R64 + ((size_t)pos_ * 16 + 8 * (j & 1)) * 2; \
        _Pragma("unroll") for (int e2 = 0; e2 < 4; ++e2) tw[e2] = *(const f32x4*)(tp_ + 4 * e2); } while (0)
    int r = F.gw;
    if (r < MT) QK64_LOAD(r);
    for (; r < MT; r += F.ngw) {
        const bool rope = r < ML; float cs[8], sn[8];
        v4u cr[3];
#pragma unroll
        for (int p = 0; p < 3; ++p) cr[p] = rw[p];
#pragma unroll
        for (int e2 = 0; e2 < 4; ++e2) { const f32x4 w = rope ? tw[e2] : (f32x4){1.f, 0.f, 1.f, 0.f}; cs[2 * e2] = w.x; sn[2 * e2] = w.y; cs[2 * e2 + 1] = w.z; sn[2 * e2 + 1] = w.w; }
        { const int rn = r + F.ngw < MT ? r + F.ngw : r; QK64_LOAD(rn); }
#pragma unroll
        for (int p = 0; p < 3; ++p) { const int hh = 8 * p + hq;
            if (hh < 20) { const bool isq = hh < 16; v4u o; float g[8];
#pragma unroll
                for (int e = 0; e < 8; ++e) g[e] = isq ? gq[e] : gk[e];
                qk_head8<64>(cr[p], g, isq ? 0.18033688f : 1.f, rope, cs, sn, F.lane, o);
                *(v4u*)((isq ? Qp + (size_t)r * 1024 + hh * 64 : Kp + (size_t)r * 256 + (hh - 16) * 64) + 8 * j) = o; } }
    }
#undef QK64_LOAD
}
__device__ __forceinline__ void knorm_rope64(const Frame& F, const bf16* RAW, const float* kn, const float* R64, bf16* Kp) {
    float one = 1.f; asm volatile("" : "+v"(one));
    const int j = F.lane & 7, hk = (F.lane >> 3) & 3, half = F.lane >> 5;
    float gk[8];
#pragma unroll
    for (int e = 0; e < 8; ++e) gk[e] = kn[8 * j + e];
    v4u rw; f32x4 tw[4];
#define K64_LOAD(r_) do { rw = *(const v4u*)(RAW + (size_t)(r_) * 1536 + 1024 + hk * 64 + 8 * j); \
        const int t_ = (r_) & (SEQ - 1), pos_ = (j & 3) < 2 ? (t_ >> 6) : (t_ & 63); const float* tp_ = R64 + ((size_t)pos_ * 16 + 8 * (j & 1)) * 2; \
        _Pragma("unroll") for (int e2 = 0; e2 < 4; ++e2) tw[e2] = *(const f32x4*)(tp_ + 4 * e2); } while (0)
    int r = 2 * F.gw + half;
    if (r < MT) K64_LOAD(r);
    for (; r < MT; r += 2 * F.ngw) {
        const bool rope = r < ML; float cs[8], sn[8];
        const v4u cr = rw;
#pragma unroll
        for (int e2 = 0; e2 < 4; ++e2) { const f32x4 w = rope ? tw[e2] : (f32x4){one, 0.f, one, 0.f}; cs[2 * e2] = w.x; sn[2 * e2] = w.y; cs[2 * e2 + 1] = w.z; sn[2 * e2 + 1] = w.w; }
        { const int rn = r + 2 * F.ngw < MT ? r + 2 * F.ngw : r; K64_LOAD(rn); }
        v4u o; qk_head8<64>(cr, gk, 1.f, rope, cs, sn, F.lane, o);
        *(v4u*)(Kp + (size_t)r * 256 + hk * 64 + 8 * j) = o;
    }
#undef K64_LOAD
}
template <int HD, typename FR>
__device__ __forceinline__ void qnorm_rope_frag(FR (&qr)[HD / 16], const float* gq, const float* Rt, int t, bool rope, float qs, int lane) {
    constexpr int NB = HD / 16;
    const int hi = lane >> 5;
    float ss = 0.f;
#pragma unroll
    for (int d0 = 0; d0 < NB; ++d0) { float x[8]; unpack8(__builtin_bit_cast(v4u, qr[d0]), x);
#pragma unroll
        for (int e = 0; e < 8; ++e) ss += x[e] * x[e]; }
    ss += bperm(ss, lane ^ 32);
    const float rs = qs * __builtin_amdgcn_rsqf(ss * (1.f / HD) + EPS);
#pragma unroll
    for (int d0 = 0; d0 < NB / 2; ++d0) {
        float lo[8], up[8]; unpack8(__builtin_bit_cast(v4u, qr[d0]), lo); unpack8(__builtin_bit_cast(v4u, qr[d0 + NB / 2]), up);
        const float* gl = gq + d0 * 16 + hi * 8; const float* gu = gl + HD / 2;
        const f32x4 g0 = *(const f32x4*)gl, g1 = *(const f32x4*)(gl + 4), g2 = *(const f32x4*)gu, g3 = *(const f32x4*)(gu + 4);
#pragma unroll
        for (int e = 0; e < 8; ++e) { lo[e] = lo[e] * rs * (e < 4 ? g0[e & 3] : g1[e & 3]); up[e] = up[e] * rs * (e < 4 ? g2[e & 3] : g3[e & 3]); }
        if (rope) {
            const int a0 = d0 * 16 + hi * 8, pos = a0 < HD / 4 ? (t >> 6) : (t & 63), f0 = a0 < HD / 4 ? a0 : a0 - HD / 4;
            const float* tp = Rt + ((size_t)pos * (HD / 4) + f0) * 2;
#pragma unroll
            for (int e2 = 0; e2 < 4; ++e2) { const f32x4 w = *(const f32x4*)(tp + 4 * e2);
                const float l0 = lo[2 * e2], u0 = up[2 * e2], l1 = lo[2 * e2 + 1], u1 = up[2 * e2 + 1];
                lo[2 * e2] = l0 * w.x - u0 * w.y; up[2 * e2] = u0 * w.x + l0 * w.y; lo[2 * e2 + 1] = l1 * w.z - u1 * w.w; up[2 * e2 + 1] = u1 * w.z + l1 * w.w; } }
        qr[d0] = __builtin_bit_cast(FR, pack8(lo)); qr[d0 + NB / 2] = __builtin_bit_cast(FR, pack8(up));
    }
}
__device__ __forceinline__ void qknorm_rope128(const Frame& F, const bf16* RAW, const float* qn, const float* kn, const float* R128, bf16* Qp, bf16* K2, bf16* V2) {
    const int j = F.lane & 15, hq = F.lane >> 4;
    float gq[8], gk[8];
#pragma unroll
    for (int e = 0; e < 8; ++e) { gq[e] = qn[8 * j + e]; gk[e] = kn[8 * j + e]; }
    v4u rw[4]; f32x4 tw[4];
#define QK128_LOAD(r_) do { const bf16* s_ = RAW + (size_t)(r_) * 1536; _Pragma("unroll") for (int p = 0; p < 3; ++p) { const int hh = 4 * p + hq; if (hh < 10) rw[p] = *(const v4u*)(s_ + hh * 128 + 8 * j); } \
        rw[3] = *(const v4u*)(s_ + 1280 + 8 * (F.lane & 31)); \
        const int t_ = (r_) & (SEQ - 1), pos_ = (j & 7) < 4 ? (t_ >> 6) : (t_ & 63); const float* tp_ = R128 + ((size_t)pos_ * 32 + 8 * (j & 3)) * 2; \
        _Pragma("unroll") for (int e2 = 0; e2 < 4; ++e2) tw[e2] = *(const f32x4*)(tp_ + 4 * e2); } while (0)
    int r = F.gw;
    if (r < MT) QK128_LOAD(r);
    for (; r < MT; r += F.ngw) {
        const bool rope = r < ML; float cs[8], sn[8]; size_t kvrow;
        const int t = r & (SEQ - 1);
        if (rope) kvrow = (size_t)(r >> 13) * 8448 + t; else { const int rc = r - ML; kvrow = (size_t)(rc >> 8) * 8448 + 8192 + (rc & 255); }
        v4u cr[4];
#pragma unroll
        for (int p = 0; p < 4; ++p) cr[p] = rw[p];
#pragma unroll
        for (int e2 = 0; e2 < 4; ++e2) { const f32x4 w = rope ? tw[e2] : (f32x4){1.f, 0.f, 1.f, 0.f}; cs[2 * e2] = w.x; sn[2 * e2] = w.y; cs[2 * e2 + 1] = w.z; sn[2 * e2 + 1] = w.w; }
        { const int rn = r + F.ngw < MT ? r + F.ngw : r; QK128_LOAD(rn); }
#pragma unroll
        for (int p = 0; p < 3; ++p) { const int hh = 4 * p + hq;
            if (hh < 10) { const bool isq = hh < 8; v4u o; float g[8];
#pragma unroll
                for (int e = 0; e < 8; ++e) g[e] = isq ? gq[e] : gk[e];
                qk_head8<128>(cr[p], g, isq ? 0.12751743f : 1.f, rope, cs, sn, F.lane, o);
                *(v4u*)((isq ? Qp + (size_t)r * 1024 + hh * 128 : K2 + kvrow * 256 + (hh - 8) * 128) + 8 * j) = o; } }
        if (F.lane < 32) *(v4u*)(V2 + kvrow * 256 + 8 * F.lane) = cr[3];
    }
#undef QK128_LOAD
}
__device__ __forceinline__ void knorm_rope128(const Frame& F, const bf16* RAW, const float* kn, const float* R128, bf16* K2, bf16* V2) {
    float one = 1.f; asm volatile("" : "+v"(one));
    const int j = F.lane & 15, hk = (F.lane >> 4) & 1; const bool isv = F.lane >= 32;
    const int coff = isv ? 1280 + 8 * (F.lane & 31) : 1024 + hk * 128 + 8 * j;
    float gk[8];
#pragma unroll
    for (int e = 0; e < 8; ++e) gk[e] = kn[8 * j + e];
    v4u rw[2]; f32x4 tw[2][4];
#define K128_LOAD(it_) do { _Pragma("unroll") for (int q_ = 0; q_ < 2; ++q_) { const int r_ = 2 * (it_) + q_; rw[q_] = *(const v4u*)(RAW + (size_t)r_ * 1536 + coff); \
        const int t_ = r_ & (SEQ - 1), pos_ = (j & 7) < 4 ? (t_ >> 6) : (t_ & 63); const float* tp_ = R128 + ((size_t)pos_ * 32 + 8 * (j & 3)) * 2; \
        _Pragma("unroll") for (int e2 = 0; e2 < 4; ++e2) tw[q_][e2] = *(const f32x4*)(tp_ + 4 * e2); } } while (0)
    int it = F.gw;
    if (it < MT / 2) K128_LOAD(it);
    for (; it < MT / 2; it += F.ngw) {
        v4u cr[2]; f32x4 ct[2][4];
#pragma unroll
        for (int q = 0; q < 2; ++q) { cr[q] = rw[q];
#pragma unroll
            for (int e2 = 0; e2 < 4; ++e2) ct[q][e2] = tw[q][e2]; }
        { const int itn = it + F.ngw < MT / 2 ? it + F.ngw : it; K128_LOAD(itn); }
#pragma unroll
        for (int q = 0; q < 2; ++q) { const int r = 2 * it + q; const bool rope = r < ML; size_t kvrow;
            if (rope) kvrow = (size_t)(r >> 13) * 8448 + (r & (SEQ - 1)); else { const int rc = r - ML; kvrow = (size_t)(rc >> 8) * 8448 + 8192 + (rc & 255); }
            float cs[8], sn[8];
#pragma unroll
            for (int e2 = 0; e2 < 4; ++e2) { const f32x4 w = rope ? ct[q][e2] : (f32x4){one, 0.f, one, 0.f}; cs[2 * e2] = w.x; sn[2 * e2] = w.y; cs[2 * e2 + 1] = w.z; sn[2 * e2 + 1] = w.w; }
            v4u o; qk_head8<128>(cr[q], gk, 1.f, rope, cs, sn, F.lane, o);
            if (isv) *(v4u*)(V2 + kvrow * 256 + 8 * (F.lane & 31)) = cr[q]; else *(v4u*)(K2 + kvrow * 256 + hk * 128 + 8 * j) = o; }
    }
#undef K128_LOAD
}
__device__ __forceinline__ void sconv_phase(const Frame& F, const bf16* RAW, const float* cw  , bf16* O) {
    const int c0 = (F.tid & 127) * 8, qd = F.tid >> 7;
    f32x4 w[3][2];
#pragma unroll
    for (int j = 0; j < 3; ++j) { w[j][0] = *(const f32x4*)(cw + j * 1024 + c0); w[j][1] = *(const f32x4*)(cw + j * 1024 + c0 + 4); }
    for (int blk = F.gw >> 3; blk < MT / 132; blk += F.G) {
        const int rs = blk * 132 + qd * 33;
        float pm[8], pc[8];
        { const bf16* rp = RAW + (size_t)(rs > 0 ? rs - 1 : 0) * 3072 + c0; float a[8], b[8];
          const v4u x0 = *(const v4u*)(rp + 1024), x1 = *(const v4u*)(rp + 2048); const bf16* rq = RAW + (size_t)rs * 3072 + c0; const v4u y0 = *(const v4u*)(rq + 1024), y1 = *(const v4u*)(rq + 2048);
          unpack8(x0, a); unpack8(x1, b);
#pragma unroll
          for (int e2 = 0; e2 < 8; ++e2) pm[e2] = a[e2] * b[e2];
          unpack8(y0, a); unpack8(y1, b);
#pragma unroll
          for (int e2 = 0; e2 < 8; ++e2) pc[e2] = a[e2] * b[e2]; }
        v4u ngc, nu, ngb;
        { const int rn = rs + 1 < MT ? rs + 1 : rs; const bf16* rp = RAW + (size_t)rn * 3072 + c0; ngc = *(const v4u*)(rp + 1024); nu = *(const v4u*)(rp + 2048); ngb = *(const v4u*)(RAW + (size_t)rs * 3072 + c0); }
#pragma nounroll
        for (int k = 0; k < 33; ++k) {
            const int r = rs + k;
            const v4u cgc = ngc, cu = nu, cgb = ngb;
            { const int r2 = r + 2 < MT ? r + 2 : MT - 1, r1 = r + 1 < MT ? r + 1 : MT - 1;
              const bf16* rp = RAW + (size_t)r2 * 3072 + c0; ngc = *(const v4u*)(rp + 1024); nu = *(const v4u*)(rp + 2048); ngb = *(const v4u*)(RAW + (size_t)r1 * 3072 + c0); }
            const int tl = r < ML ? (r & (SEQ - 1)) : ((r - ML) & (CTXL - 1)), len = r < ML ? SEQ : CTXL;
            const float mp = tl > 0 ? 1.f : 0.f, mn = tl < len - 1 ? 1.f : 0.f;
            float a[8], b[8], pn[8], gb[8], z[8];
            unpack8(cgc, a); unpack8(cu, b); unpack8(cgb, gb);
#pragma unroll
            for (int e2 = 0; e2 < 8; ++e2) pn[e2] = a[e2] * b[e2];
#pragma unroll
            for (int e2 = 0; e2 < 8; ++e2) { const float w0 = w[0][e2 >> 2][e2 & 3] * mp, w1 = w[1][e2 >> 2][e2 & 3], w2 = w[2][e2 >> 2][e2 & 3] * mn;
                z[e2] = gb[e2] * (w0 * pm[e2] + w1 * pc[e2] + w2 * pn[e2]); pm[e2] = pc[e2]; pc[e2] = pn[e2]; }
            *(v4u*)(O + (size_t)r * 1024 + c0) = pack8(z);
        }
    }
}
struct FixItem { f32x4 gm, um, gp, up, g0, u0, wg0, wg1, wg2, wu0, wu1, wu2; size_t off; };
__device__ __forceinline__ void fix_load(FixItem& x, int tile, int i, const float* HALO, const float* cw) {
    const bool has_prev = tile < 128 && (tile & 31) != 0, has_next = tile < 128 && (tile & 31) != 31;
    const int which = i >= DFF / 4 ? 1 : 0, c = 4 * (i - which * (DFF / 4));
    const float* hm = HALO + ((size_t)tile * 4 + (which ? 2 : -1)) * NUP;
    const float* h0 = HALO + ((size_t)tile * 4 + (which ? 3 : 0)) * NUP;
    const float* hp = HALO + ((size_t)tile * 4 + (which ? 4 : 1)) * NUP;
    const bool vm = which ? true : has_prev, vp = which ? has_next : true;
    const f32x4 z4 = {0.f, 0.f, 0.f, 0.f};
    x.gm = vm ? *(const f32x4*)(hm + c) : z4; x.um = vm ? *(const f32x4*)(hm + DFF + c) : z4; x.gp = vp ? *(const f32x4*)(hp + c) : z4; x.up = vp ? *(const f32x4*)(hp + DFF + c) : z4;
    x.g0 = *(const f32x4*)(h0 + c); x.u0 = *(const f32x4*)(h0 + DFF + c);
    x.wg0 = *(const f32x4*)(cw + c); x.wg1 = *(const f32x4*)(cw + NUP + c); x.wg2 = *(const f32x4*)(cw + 2 * NUP + c);
    x.wu0 = *(const f32x4*)(cw + DFF + c); x.wu1 = *(const f32x4*)(cw + NUP + DFF + c); x.wu2 = *(const f32x4*)(cw + 2 * NUP + DFF + c);
    x.off = ((size_t)tile * 256 + (which ? 255 : 0)) * DFF + c;
}
__device__ __forceinline__ void fix_store(const FixItem& x, bf16* ACT) {
    float a[4];
#pragma unroll
    for (int e2 = 0; e2 < 4; ++e2) { const float g = x.wg0[e2] * x.gm[e2] + x.wg1[e2] * x.g0[e2] + x.wg2[e2] * x.gp[e2], u = x.wu0[e2] * x.um[e2] + x.wu1[e2] * x.u0[e2] + x.wu2[e2] * x.up[e2];
        a[e2] = g / (1.f + expf(-g)) * u; }
    uint2 o; o.x = cvtpk2(a[0], a[1]); o.y = cvtpk2(a[2], a[3]);
    *(uint2*)(ACT + x.off) = o;
}
__device__ __forceinline__ void ffn_fixup(const Frame& F, int tile, const float* HALO, const float* cw  , bf16* ACT) {
    constexpr int NI = 2 * (DFF / 4);
    const int i2 = F.tid + 1024; const bool v2 = i2 < NI;
    FixItem a, b, c;
    fix_load(a, tile, F.tid, HALO, cw); fix_load(b, tile, F.tid + 512, HALO, cw); fix_load(c, tile, v2 ? i2 : F.tid, HALO, cw);
    fix_store(a, ACT); fix_store(b, ACT); if (v2) fix_store(c, ACT);
}

namespace exd {
typedef unsigned short bf16;
constexpr int   D = 128, NW = 8, QBLK = 32, KVBLK = 64;
constexpr float SCALE = 0.6931471805599453f;
constexpr float THR = 8.f;
constexpr int SDEPTH = 1;
constexpr int LDQ = 1024, LDK = 256, LDO = 1024;
constexpr size_t SHM_V = KVBLK * D * 2, SHM_K = KVBLK * D * 2, SHM_ATTN = 2 * SHM_V + 2 * SHM_K + NW * 64 * 4;
using bf16x8 = __attribute__((ext_vector_type(8))) short;
using s16x4  = __attribute__((ext_vector_type(4))) short;
using f32x16 = __attribute__((ext_vector_type(16))) float;
using f32x8  = __attribute__((ext_vector_type(8))) float;
using u32x4  = __attribute__((ext_vector_type(4))) unsigned;
#define KSWZ(row, colB) ((row) * 256 + ((colB) ^ (((row) & 7) << 4)))
#define SBAR() __builtin_amdgcn_sched_barrier(0)
__device__ __forceinline__ int crow(int r, int hi) { return (r & 3) + 8 * (r >> 2) + 4 * hi; }
__device__ __forceinline__ unsigned cvtpk(float lo, float hi) {
  unsigned r; asm volatile("v_cvt_pk_bf16_f32 %0, %1, %2" : "=v"(r) : "v"(lo), "v"(hi)); return r;
}
template <typename TIn> struct Stage;
template <> struct Stage<bf16>  { using T = bf16x8;
  __device__ static __forceinline__ T ld8(const bf16* p) { return *reinterpret_cast<const bf16x8*>(p); }
  __device__ static __forceinline__ bf16x8 tobf(T x) { return x; } };
template <> struct Stage<float> { using T = f32x8;
  __device__ static __forceinline__ T ld8(const float* p) { return *reinterpret_cast<const f32x8*>(p); }
  __device__ static __forceinline__ bf16x8 tobf(T x) {
    u32x4 w = {cvtpk(x[0], x[1]), cvtpk(x[2], x[3]), cvtpk(x[4], x[5]), cvtpk(x[6], x[7])}; return *reinterpret_cast<bf16x8*>(&w); } };

__device__ __forceinline__ void partialSM(f32x16& p0, f32x16& p1, float& m_reg, float& mn, float& alpha) {
  constexpr float C = SCALE * 1.4426950408889634f;
  float pmax = p0[0]; for (int r = 1; r < 16; ++r) pmax = fmaxf(pmax, p0[r]); for (int r = 0; r < 16; ++r) pmax = fmaxf(pmax, p1[r]);
  { auto rr = __builtin_amdgcn_permlane32_swap(__float_as_uint(pmax), __float_as_uint(pmax), false, false);
    pmax = fmaxf(__uint_as_float(rr[0]), __uint_as_float(rr[1])); }
  if (__builtin_expect(__all(pmax - m_reg <= THR / SCALE), 1)) { mn = m_reg; alpha = 1.f; }
  else { mn = fmaxf(m_reg, pmax); alpha = __builtin_amdgcn_exp2f((m_reg - mn) * C); m_reg = mn; }
  float mnC = -mn * C;
  for (int r = 0; r < 16; ++r) p0[r] = fmaf(p0[r], C, mnC); for (int r = 0; r < 16; ++r) p1[r] = fmaf(p1[r], C, mnC);
  for (int r = 0; r < 16; ++r) p0[r] = __builtin_amdgcn_exp2f(p0[r]);
}
__device__ __forceinline__ void finishSM(f32x16& p0, f32x16& p1, float alpha, float& l_reg, bf16x8& pa0, bf16x8& pa1, bf16x8& pa2, bf16x8& pa3) {
  for (int r = 0; r < 16; ++r) p1[r] = __builtin_amdgcn_exp2f(p1[r]);
  float ps = 0; for (int r = 0; r < 16; ++r) ps += p0[r]; for (int r = 0; r < 16; ++r) ps += p1[r];
  { auto rr = __builtin_amdgcn_permlane32_swap(__float_as_uint(ps), __float_as_uint(ps), false, false);
    ps = __uint_as_float(rr[0]) + __uint_as_float(rr[1]); }
  l_reg = l_reg * alpha + ps;
#define PK4(P, BASE, OUT) do { unsigned a0 = cvtpk(P[BASE + 0], P[BASE + 1]), a1 = cvtpk(P[BASE + 2], P[BASE + 3]);   \
    unsigned b0 = cvtpk(P[BASE + 4], P[BASE + 5]), b1 = cvtpk(P[BASE + 6], P[BASE + 7]);                              \
    auto r0 = __builtin_amdgcn_permlane32_swap(a0, b0, false, false); auto r1 = __builtin_amdgcn_permlane32_swap(a1, b1, false, false); \
    u32x4 w = {r0[0], r1[0], r0[1], r1[1]}; OUT = *reinterpret_cast<bf16x8*>(&w); } while (0)
  PK4(p0, 0, pa0); PK4(p0, 8, pa1); PK4(p1, 0, pa2); PK4(p1, 8, pa3);
#undef PK4
}
__device__ __forceinline__ void qkt(f32x16& p0, f32x16& p1, const bf16* Ks, const bf16x8* qr, int r32, int hi) {
  p0 = f32x16{}; p1 = f32x16{};
  for (int d0 = 0; d0 < 8; ++d0) { int cb = (d0 * 16 + hi * 8) * 2;
    bf16x8 b0 = *reinterpret_cast<const bf16x8*>((const char*)Ks + KSWZ(r32, cb));
    bf16x8 b1 = *reinterpret_cast<const bf16x8*>((const char*)Ks + KSWZ(32 + r32, cb));
    p0 = __builtin_amdgcn_mfma_f32_32x32x16_bf16(b0, qr[d0], p0, 0, 0, 0);
    p1 = __builtin_amdgcn_mfma_f32_32x32x16_bf16(b1, qr[d0], p1, 0, 0, 0); }
}
__device__ __forceinline__ int v_st(int k, int c) { const int kk = (k & ~0xC) | ((k & 4) << 1) | ((k & 8) >> 1); return ((kk >> 3) * 4 + (c >> 5)) * 512 + ((kk & 7) * 32 + (c & 31)) * 2; }
__device__ __forceinline__ int v_rd_base(int lane) { return ((lane & 3) << 3) | (((lane >> 2) & 3) << 6) | (((lane >> 4) & 1) << 5) | (((lane >> 5) & 1) << 8); }
constexpr int v_rd_off(int d0, int ks, int half) { return d0 * 512 + ks * 4096 + half * 2048; }
template <int OFF> __device__ __forceinline__ s16x4 tr_read(int vb) {
  s16x4 r; asm volatile("ds_read_b64_tr_b16 %0, %1 offset:%2" : "=&v"(r) : "v"(vb), "i"(OFF) : "memory"); return r;
}
template <int D0> __device__ __forceinline__ void pv_one(f32x16& od, int vb, bf16x8 pa0, bf16x8 pa1, bf16x8 pa2, bf16x8 pa3) {
  const s16x4 l0 = tr_read<v_rd_off(D0, 0, 0)>(vb), h0 = tr_read<v_rd_off(D0, 0, 1)>(vb), l1 = tr_read<v_rd_off(D0, 1, 0)>(vb), h1 = tr_read<v_rd_off(D0, 1, 1)>(vb);
  const s16x4 l2 = tr_read<v_rd_off(D0, 2, 0)>(vb), h2 = tr_read<v_rd_off(D0, 2, 1)>(vb), l3 = tr_read<v_rd_off(D0, 3, 0)>(vb), h3 = tr_read<v_rd_off(D0, 3, 1)>(vb);
  asm volatile("s_waitcnt lgkmcnt(0)" ::: "memory"); SBAR();
#define PK(L, H) (bf16x8){L[0], L[1], L[2], L[3], H[0], H[1], H[2], H[3]}
  od = __builtin_amdgcn_mfma_f32_32x32x16_bf16(pa0, PK(l0, h0), od, 0, 0, 0);
  od = __builtin_amdgcn_mfma_f32_32x32x16_bf16(pa1, PK(l1, h1), od, 0, 0, 0);
  od = __builtin_amdgcn_mfma_f32_32x32x16_bf16(pa2, PK(l2, h2), od, 0, 0, 0);
  od = __builtin_amdgcn_mfma_f32_32x32x16_bf16(pa3, PK(l3, h3), od, 0, 0, 0);
#undef PK
}
__device__ __forceinline__ void pv_d0(f32x16* o, int vb, bf16x8 pa0, bf16x8 pa1, bf16x8 pa2, bf16x8 pa3) {
  pv_one<0>(o[0], vb, pa0, pa1, pa2, pa3); pv_one<1>(o[1], vb, pa0, pa1, pa2, pa3); pv_one<2>(o[2], vb, pa0, pa1, pa2, pa3); pv_one<3>(o[3], vb, pa0, pa1, pa2, pa3);
}

template <typename TQ>
__device__ __forceinline__ void attn_dense_body(const TQ* __restrict__ Qb, const bf16* __restrict__ Kh, const bf16* __restrict__ Vh,
                                                bf16* __restrict__ Ob, int seq, char* lds, const int tid) {
  using St = Stage<bf16>; using SQ = Stage<TQ>;
  const int wid = tid >> 6, lane = tid & 63, r32 = lane & 31, hi = lane >> 5;
  bf16* V_lds = (bf16*)lds; bf16* K_lds = (bf16*)(lds + 2 * SHM_V);
  float* ws = (float*)(lds + 2 * SHM_V + 2 * SHM_K) + wid * 64; float* li_l = ws; float* al_l = ws + 32;
  float m_reg = -1e30f, l_reg = 0; f32x16 o[4] = {}; bf16x8 qr[8];
  const TQ* Qw = Qb + (long)(wid * QBLK + r32) * LDQ + hi * 8;
#pragma unroll
  for (int d0 = 0; d0 < 8; ++d0) qr[d0] = SQ::tobf(SQ::ld8(Qw + d0 * 16));
  const int sr = tid >> 4, sc = (tid & 15) * 8, vst0 = v_st(sr, sc), vst1 = v_st(32 + sr, sc);
  const int vb0 = (int)(uintptr_t)V_lds + v_rd_base(lane);
  struct { typename St::T vs0, vs1, ks0, ks1; } sr_[SDEPTH];
  const unsigned lo0 = (unsigned)(sr * LDK + sc) * 2u, lo1 = lo0 + 32u * LDK * 2u;
#define SLOAD(i, k0) do { const char* vt_ = (const char*)Vh + (size_t)(k0) * (LDK * 2); const char* kt_ = (const char*)Kh + (size_t)(k0) * (LDK * 2); \
    sr_[i].vs0 = *reinterpret_cast<const bf16x8*>(vt_ + lo0); sr_[i].vs1 = *reinterpret_cast<const bf16x8*>(vt_ + lo1); \
    sr_[i].ks0 = *reinterpret_cast<const bf16x8*>(kt_ + lo0); sr_[i].ks1 = *reinterpret_cast<const bf16x8*>(kt_ + lo1); } while (0)
#define SWRITE(b, i) do { *(bf16x8*)((char*)V_lds + (b) * SHM_V + vst0) = St::tobf(sr_[i].vs0);          \
    *(bf16x8*)((char*)V_lds + (b) * SHM_V + vst1) = St::tobf(sr_[i].vs1); int kc = sc * 2;               \
    *(bf16x8*)((char*)K_lds + (b) * SHM_K + KSWZ(sr, kc)) = St::tobf(sr_[i].ks0);                       \
    *(bf16x8*)((char*)K_lds + (b) * SHM_K + KSWZ(32 + sr, kc)) = St::tobf(sr_[i].ks1); } while (0)
#define SWAIT() do { if constexpr (SDEPTH == 2) asm volatile("s_waitcnt vmcnt(4)" ::: "memory"); else asm volatile("s_waitcnt vmcnt(0)" ::: "memory"); } while (0)
#define RESC(a) do { if (__any((a) < 1.f)) { if (hi == 0) al_l[r32] = (a); asm volatile("s_waitcnt lgkmcnt(0)" ::: "memory"); \
    for (int d = 0; d < 4; ++d) for (int r = 0; r < 16; ++r) o[d][r] *= al_l[crow(r, hi)]; } } while (0)
  f32x16 pA0, pA1, pB0, pB1; float mnA, mnB, alA, alB; bf16x8 pa0, pa1, pa2, pa3; const int NT = seq / KVBLK;
  constexpr int SE = 0, SO = SDEPTH - 1;
  SLOAD(SE, 0); asm volatile("s_waitcnt vmcnt(0)" ::: "memory"); SWRITE(0, SE); __syncthreads();
  qkt(pA0, pA1, K_lds, qr, r32, hi); partialSM(pA0, pA1, m_reg, mnA, alA);
  SLOAD(SO, KVBLK); if constexpr (SDEPTH == 2) { if (2 < NT) SLOAD(SE, 2 * KVBLK); }
  SWAIT(); SWRITE(1, SO); __syncthreads();
  for (int j = 1; j + 1 < NT; j += 2) {
    SBAR(); qkt(pB0, pB1, (bf16*)((char*)K_lds + SHM_K), qr, r32, hi);
    finishSM(pA0, pA1, alA, l_reg, pa0, pa1, pa2, pa3); SBAR();
    SLOAD(SO, (j + SDEPTH) * KVBLK); SBAR();
    pv_d0(o, vb0, pa0, pa1, pa2, pa3); partialSM(pB0, pB1, m_reg, mnB, alB);
    __syncthreads(); SWAIT(); SWRITE(0, SE);
    RESC(alB); __syncthreads();
    SBAR(); qkt(pA0, pA1, K_lds, qr, r32, hi);
    finishSM(pB0, pB1, alB, l_reg, pa0, pa1, pa2, pa3); SBAR();
    if (SDEPTH == 1 || j + 3 < NT) SLOAD(SE, (j + 1 + SDEPTH) * KVBLK); SBAR();
    pv_d0(o, vb0 + (int)SHM_V, pa0, pa1, pa2, pa3); partialSM(pA0, pA1, m_reg, mnA, alA);
    __syncthreads(); SWAIT(); SWRITE(1, SO);
    RESC(alA); __syncthreads();
  }
  SBAR(); qkt(pB0, pB1, (bf16*)((char*)K_lds + SHM_K), qr, r32, hi);
  finishSM(pA0, pA1, alA, l_reg, pa0, pa1, pa2, pa3); SBAR();
  pv_d0(o, vb0, pa0, pa1, pa2, pa3); partialSM(pB0, pB1, m_reg, mnB, alB);
  __syncthreads(); RESC(alB);
  finishSM(pB0, pB1, alB, l_reg, pa0, pa1, pa2, pa3); SBAR();
  pv_d0(o, vb0 + (int)SHM_V, pa0, pa1, pa2, pa3);
  if (hi == 0) li_l[r32] = l_reg; asm volatile("s_waitcnt lgkmcnt(0)" ::: "memory");
  float rli[16];
#pragma unroll
  for (int r = 0; r < 16; ++r) rli[r] = __builtin_amdgcn_rcpf(li_l[crow(r, hi)]);
  bf16* Ow = Ob + (long)(wid * QBLK) * LDO;
#pragma unroll
  for (int r = 0; r < 16; ++r) { int orow = crow(r, hi);
    for (int d0 = 0; d0 < 4; ++d0) Ow[(long)orow * LDO + d0 * 32 + r32] = (bf16)(cvtpk(o[d0][r] * rli[r], 0.f) & 0xffffu); }
#undef SLOAD
#undef SWRITE
#undef SWAIT
#undef RESC
}
#undef KSWZ
#undef SBAR
}

namespace exf {
typedef unsigned short bf16;
constexpr int   D = 128, NW = 8, QBLK = 32, KVBLK = 64;
constexpr float SCALE = 0.6931471805599453f;
constexpr float THR = 8.f;
constexpr int SDEPTH = 1;
constexpr int LDQ = 1536, LDK = 256, LDO = 1024;
constexpr size_t SHM_V = KVBLK * D * 2, SHM_K = KVBLK * D * 2, SHM_ATTN = 2 * SHM_V + 2 * SHM_K + NW * 64 * 4;
using bf16x8 = __attribute__((ext_vector_type(8))) short;
using s16x4  = __attribute__((ext_vector_type(4))) short;
using f32x16 = __attribute__((ext_vector_type(16))) float;
using f32x8  = __attribute__((ext_vector_type(8))) float;
using u32x4  = __attribute__((ext_vector_type(4))) unsigned;
#define KSWZ(row, colB) ((row) * 256 + ((colB) ^ (((row) & 7) << 4)))
#define SBAR() __builtin_amdgcn_sched_barrier(0)
__device__ __forceinline__ int crow(int r, int hi) { return (r & 3) + 8 * (r >> 2) + 4 * hi; }
__device__ __forceinline__ unsigned cvtpk(float lo, float hi) {
  unsigned r; asm volatile("v_cvt_pk_bf16_f32 %0, %1, %2" : "=v"(r) : "v"(lo), "v"(hi)); return r;
}
template <typename TIn> struct Stage;
template <> struct Stage<bf16>  { using T = bf16x8;
  __device__ static __forceinline__ T ld8(const bf16* p) { return *reinterpret_cast<const bf16x8*>(p); }
  __device__ static __forceinline__ bf16x8 tobf(T x) { return x; } };
template <> struct Stage<float> { using T = f32x8;
  __device__ static __forceinline__ T ld8(const float* p) { return *reinterpret_cast<const f32x8*>(p); }
  __device__ static __forceinline__ bf16x8 tobf(T x) {
    u32x4 w = {cvtpk(x[0], x[1]), cvtpk(x[2], x[3]), cvtpk(x[4], x[5]), cvtpk(x[6], x[7])}; return *reinterpret_cast<bf16x8*>(&w); } };

__device__ __forceinline__ void partialSM(f32x16& p0, f32x16& p1, float& m_reg, float& mn, float& alpha) {
  mn = 0.f; alpha = 1.f;
  for (int r = 0; r < 16; ++r) p0[r] = __builtin_amdgcn_exp2f(p0[r]);
}
__device__ __forceinline__ void finishSM(f32x16& p0, f32x16& p1, float alpha, float& l_reg, bf16x8& pa0, bf16x8& pa1, bf16x8& pa2, bf16x8& pa3) {
  for (int r = 0; r < 16; ++r) p1[r] = __builtin_amdgcn_exp2f(p1[r]);
  float ps = 0; for (int r = 0; r < 16; ++r) ps += p0[r]; for (int r = 0; r < 16; ++r) ps += p1[r];
  { auto rr = __builtin_amdgcn_permlane32_swap(__float_as_uint(ps), __float_as_uint(ps), false, false);
    ps = __uint_as_float(rr[0]) + __uint_as_float(rr[1]); }
  l_reg = l_reg * alpha + ps;
#define PK4(P, BASE, OUT) do { unsigned a0 = cvtpk(P[BASE + 0], P[BASE + 1]), a1 = cvtpk(P[BASE + 2], P[BASE + 3]);   \
    unsigned b0 = cvtpk(P[BASE + 4], P[BASE + 5]), b1 = cvtpk(P[BASE + 6], P[BASE + 7]);                              \
    auto r0 = __builtin_amdgcn_permlane32_swap(a0, b0, false, false); auto r1 = __builtin_amdgcn_permlane32_swap(a1, b1, false, false); \
    u32x4 w = {r0[0], r1[0], r0[1], r1[1]}; OUT = *reinterpret_cast<bf16x8*>(&w); } while (0)
  PK4(p0, 0, pa0); PK4(p0, 8, pa1); PK4(p1, 0, pa2); PK4(p1, 8, pa3);
#undef PK4
}
__device__ __forceinline__ void qkt(f32x16& p0, f32x16& p1, const bf16* Ks, const bf16x8* qr, int r32, int hi) {
  p0 = f32x16{}; p1 = f32x16{};
  for (int d0 = 0; d0 < 8; ++d0) { int cb = (d0 * 16 + hi * 8) * 2;
    bf16x8 b0 = *reinterpret_cast<const bf16x8*>((const char*)Ks + KSWZ(r32, cb));
    bf16x8 b1 = *reinterpret_cast<const bf16x8*>((const char*)Ks + KSWZ(32 + r32, cb));
    p0 = __builtin_amdgcn_mfma_f32_32x32x16_bf16(b0, qr[d0], p0, 0, 0, 0);
    p1 = __builtin_amdgcn_mfma_f32_32x32x16_bf16(b1, qr[d0], p1, 0, 0, 0); }
}
__device__ __forceinline__ int v_st(int k, int c) { const int kk = (k & ~0xC) | ((k & 4) << 1) | ((k & 8) >> 1); return ((kk >> 3) * 4 + (c >> 5)) * 512 + ((kk & 7) * 32 + (c & 31)) * 2; }
__device__ __forceinline__ int v_rd_base(int lane) { return ((lane & 3) << 3) | (((lane >> 2) & 3) << 6) | (((lane >> 4) & 1) << 5) | (((lane >> 5) & 1) << 8); }
constexpr int v_rd_off(int d0, int ks, int half) { return d0 * 512 + ks * 4096 + half * 2048; }
template <int OFF> __device__ __forceinline__ s16x4 tr_read(int vb) {
  s16x4 r; asm volatile("ds_read_b64_tr_b16 %0, %1 offset:%2" : "=&v"(r) : "v"(vb), "i"(OFF) : "memory"); return r;
}
template <int D0> __device__ __forceinline__ void pv_one(f32x16& od, int vb, bf16x8 pa0, bf16x8 pa1, bf16x8 pa2, bf16x8 pa3) {
  const s16x4 l0 = tr_read<v_rd_off(D0, 0, 0)>(vb), h0 = tr_read<v_rd_off(D0, 0, 1)>(vb), l1 = tr_read<v_rd_off(D0, 1, 0)>(vb), h1 = tr_read<v_rd_off(D0, 1, 1)>(vb);
  const s16x4 l2 = tr_read<v_rd_off(D0, 2, 0)>(vb), h2 = tr_read<v_rd_off(D0, 2, 1)>(vb), l3 = tr_read<v_rd_off(D0, 3, 0)>(vb), h3 = tr_read<v_rd_off(D0, 3, 1)>(vb);
  asm volatile("s_waitcnt lgkmcnt(0)" ::: "memory"); SBAR();
#define PK(L, H) (bf16x8){L[0], L[1], L[2], L[3], H[0], H[1], H[2], H[3]}
  od = __builtin_amdgcn_mfma_f32_32x32x16_bf16(pa0, PK(l0, h0), od, 0, 0, 0);
  od = __builtin_amdgcn_mfma_f32_32x32x16_bf16(pa1, PK(l1, h1), od, 0, 0, 0);
  od = __builtin_amdgcn_mfma_f32_32x32x16_bf16(pa2, PK(l2, h2), od, 0, 0, 0);
  od = __builtin_amdgcn_mfma_f32_32x32x16_bf16(pa3, PK(l3, h3), od, 0, 0, 0);
#undef PK
}
__device__ __forceinline__ void pv_d0(f32x16* o, int vb, bf16x8 pa0, bf16x8 pa1, bf16x8 pa2, bf16x8 pa3) {
  pv_one<0>(o[0], vb, pa0, pa1, pa2, pa3); pv_one<1>(o[1], vb, pa0, pa1, pa2, pa3); pv_one<2>(o[2], vb, pa0, pa1, pa2, pa3); pv_one<3>(o[3], vb, pa0, pa1, pa2, pa3);
}

template <typename TQ>
__device__ __forceinline__ void attn_dense_body(const TQ* __restrict__ Qb, const bf16* __restrict__ Kh, const bf16* __restrict__ Vh,
                                                bf16* __restrict__ Ob, int seq, char* lds, const int tid, const float* gq, const float* R128, int t0, bool rope) {
  using St = Stage<bf16>; using SQ = Stage<TQ>;
  const int wid = tid >> 6, lane = tid & 63, r32 = lane & 31, hi = lane >> 5;
  bf16* V_lds = (bf16*)lds; bf16* K_lds = (bf16*)(lds + 2 * SHM_V);
  float* ws = (float*)(lds + 2 * SHM_V + 2 * SHM_K) + wid * 64; float* li_l = ws; float* al_l = ws + 32;
  float m_reg = -1e30f, l_reg = 0; f32x16 o[4] = {}; bf16x8 qr[8];
  const TQ* Qw = Qb + (long)(wid * QBLK + r32) * LDQ + hi * 8;
#pragma unroll
  for (int d0 = 0; d0 < 8; ++d0) qr[d0] = SQ::tobf(SQ::ld8(Qw + d0 * 16));
  qnorm_rope_frag<128>(qr, gq, R128, t0 + wid * QBLK + r32, rope, 0.12751743f, lane);
  const int sr = tid >> 4, sc = (tid & 15) * 8, vst0 = v_st(sr, sc), vst1 = v_st(32 + sr, sc);
  const int vb0 = (int)(uintptr_t)V_lds + v_rd_base(lane);
  struct { typename St::T vs0, vs1, ks0, ks1; } sr_[SDEPTH];
  const unsigned lo0 = (unsigned)(sr * LDK + sc) * 2u, lo1 = lo0 + 32u * LDK * 2u;
#define SLOAD(i, k0) do { const char* vt_ = (const char*)Vh + (size_t)(k0) * (LDK * 2); const char* kt_ = (const char*)Kh + (size_t)(k0) * (LDK * 2); \
    sr_[i].vs0 = *reinterpret_cast<const bf16x8*>(vt_ + lo0); sr_[i].vs1 = *reinterpret_cast<const bf16x8*>(vt_ + lo1); \
    sr_[i].ks0 = *reinterpret_cast<const bf16x8*>(kt_ + lo0); sr_[i].ks1 = *reinterpret_cast<const bf16x8*>(kt_ + lo1); } while (0)
#define SWRITE(b, i) do { *(bf16x8*)((char*)V_lds + (b) * SHM_V + vst0) = St::tobf(sr_[i].vs0);          \
    *(bf16x8*)((char*)V_lds + (b) * SHM_V + vst1) = St::tobf(sr_[i].vs1); int kc = sc * 2;               \
    *(bf16x8*)((char*)K_lds + (b) * SHM_K + KSWZ(sr, kc)) = St::tobf(sr_[i].ks0);                       \
    *(bf16x8*)((char*)K_lds + (b) * SHM_K + KSWZ(32 + sr, kc)) = St::tobf(sr_[i].ks1); } while (0)
#define SWAIT() do { if constexpr (SDEPTH == 2) asm volatile("s_waitcnt vmcnt(4)" ::: "memory"); else asm volatile("s_waitcnt vmcnt(0)" ::: "memory"); } while (0)
#define RESC(a) do { } while (0)
  f32x16 pA0, pA1, pB0, pB1; float mnA, mnB, alA, alB; bf16x8 pa0, pa1, pa2, pa3; const int NT = seq / KVBLK;
  constexpr int SE = 0, SO = SDEPTH - 1;
  SLOAD(SE, 0); asm volatile("s_waitcnt vmcnt(0)" ::: "memory"); SWRITE(0, SE); __syncthreads();
  qkt(pA0, pA1, K_lds, qr, r32, hi); partialSM(pA0, pA1, m_reg, mnA, alA);
  SLOAD(SO, KVBLK); if constexpr (SDEPTH == 2) { if (2 < NT) SLOAD(SE, 2 * KVBLK); }
  SWAIT(); SWRITE(1, SO); __syncthreads();
  for (int j = 1; j + 1 < NT; j += 2) {
    SBAR(); qkt(pB0, pB1, (bf16*)((char*)K_lds + SHM_K), qr, r32, hi);
    finishSM(pA0, pA1, alA, l_reg, pa0, pa1, pa2, pa3); SBAR();
    SLOAD(SO, (j + SDEPTH) * KVBLK); SBAR();
    pv_d0(o, vb0, pa0, pa1, pa2, pa3); partialSM(pB0, pB1, m_reg, mnB, alB);
    __syncthreads(); SWAIT(); SWRITE(0, SE);
    RESC(alB); __syncthreads();
    SBAR(); qkt(pA0, pA1, K_lds, qr, r32, hi);
    finishSM(pB0, pB1, alB, l_reg, pa0, pa1, pa2, pa3); SBAR();
    if (SDEPTH == 1 || j + 3 < NT) SLOAD(SE, (j + 1 + SDEPTH) * KVBLK); SBAR();
    pv_d0(o, vb0 + (int)SHM_V, pa0, pa1, pa2, pa3); partialSM(pA0, pA1, m_reg, mnA, alA);
    __syncthreads(); SWAIT(); SWRITE(1, SO);
    RESC(alA); __syncthreads();
  }
  SBAR(); qkt(pB0, pB1, (bf16*)((char*)K_lds + SHM_K), qr, r32, hi);
  finishSM(pA0, pA1, alA, l_reg, pa0, pa1, pa2, pa3); SBAR();
  pv_d0(o, vb0, pa0, pa1, pa2, pa3); partialSM(pB0, pB1, m_reg, mnB, alB);
  __syncthreads(); RESC(alB);
  finishSM(pB0, pB1, alB, l_reg, pa0, pa1, pa2, pa3); SBAR();
  pv_d0(o, vb0 + (int)SHM_V, pa0, pa1, pa2, pa3);
  if (hi == 0) li_l[r32] = l_reg; asm volatile("s_waitcnt lgkmcnt(0)" ::: "memory");
  float rli[16];
#pragma unroll
  for (int r = 0; r < 16; ++r) rli[r] = __builtin_amdgcn_rcpf(li_l[crow(r, hi)]);
  bf16* Ow = Ob + (long)(wid * QBLK) * LDO;
#pragma unroll
  for (int r = 0; r < 16; ++r) { int orow = crow(r, hi);
    for (int d0 = 0; d0 < 4; ++d0) Ow[(long)orow * LDO + d0 * 32 + r32] = (bf16)(cvtpk(o[d0][r] * rli[r], 0.f) & 0xffffu); }
#undef SLOAD
#undef SWRITE
#undef SWAIT
#undef RESC
}
#undef KSWZ
#undef SBAR
#undef KSWZ
#undef SBAR
}


namespace att {
typedef short bf16x8 __attribute__((ext_vector_type(8)));
typedef short s16x4 __attribute__((ext_vector_type(4)));
typedef float f32x16 __attribute__((ext_vector_type(16)));
typedef unsigned u32x4 __attribute__((ext_vector_type(4)));
#define SBAR() __builtin_amdgcn_sched_barrier(0)
__device__ __forceinline__ int crow(int r, int hi) { return (r & 3) + 8 * (r >> 2) + 4 * hi; }
__device__ __forceinline__ unsigned cvtpk(float lo, float hi) { unsigned r; asm volatile("v_cvt_pk_bf16_f32 %0, %1, %2" : "=v"(r) : "v"(lo), "v"(hi)); return r; }
__device__ __forceinline__ int lds_addr(const LAS void* p) { return (int)(unsigned)(unsigned long long)p; }
template <int D> __device__ __forceinline__ int kswz(int row, int colB) { return row * (2 * D) + (colB ^ ((row & 7) << 4)); }
__device__ __forceinline__ void partialSM(f32x16& p0, f32x16& p1, float& m_reg, float& mn, float& alpha, const float C, const float THRS) {
  float pmax = p0[0];
#pragma unroll
  for (int r = 1; r < 16; ++r) pmax = fmaxf(pmax, p0[r]);
#pragma unroll
  for (int r = 0; r < 16; ++r) pmax = fmaxf(pmax, p1[r]);
  { auto rr = __builtin_amdgcn_permlane32_swap(__float_as_uint(pmax), __float_as_uint(pmax), false, false);
    pmax = fmaxf(__uint_as_float(rr[0]), __uint_as_float(rr[1])); }
  if (__builtin_expect(__all(pmax - m_reg <= THRS), 1)) { mn = m_reg; alpha = 1.f; }
  else { mn = fmaxf(m_reg, pmax); alpha = __builtin_amdgcn_exp2f((m_reg - mn) * C); m_reg = mn; }
  const float mnC = -mn * C;
#pragma unroll
  for (int r = 0; r < 16; ++r) p0[r] = fmaf(p0[r], C, mnC);
#pragma unroll
  for (int r = 0; r < 16; ++r) p1[r] = fmaf(p1[r], C, mnC);
#pragma unroll
  for (int r = 0; r < 16; ++r) p0[r] = __builtin_amdgcn_exp2f(p0[r]);
}
__device__ __forceinline__ void pack_p(const f32x16& p0, const f32x16& p1, bf16x8& pa0, bf16x8& pa1, bf16x8& pa2, bf16x8& pa3) {
#define PK4(P, BASE, OUT) do { unsigned a0 = cvtpk(P[BASE + 0], P[BASE + 1]), a1 = cvtpk(P[BASE + 2], P[BASE + 3]);   \
    unsigned b0 = cvtpk(P[BASE + 4], P[BASE + 5]), b1 = cvtpk(P[BASE + 6], P[BASE + 7]);                              \
    auto r0 = __builtin_amdgcn_permlane32_swap(a0, b0, false, false); auto r1 = __builtin_amdgcn_permlane32_swap(a1, b1, false, false); \
    u32x4 w = {r0[0], r1[0], r0[1], r1[1]}; OUT = *reinterpret_cast<bf16x8*>(&w); } while (0)
  PK4(p0, 0, pa0); PK4(p0, 8, pa1); PK4(p1, 0, pa2); PK4(p1, 8, pa3);
#undef PK4
}
__device__ __forceinline__ float row_sum(const f32x16& p0, const f32x16& p1) {
  float ps = 0.f;
#pragma unroll
  for (int r = 0; r < 16; ++r) ps += p0[r];
#pragma unroll
  for (int r = 0; r < 16; ++r) ps += p1[r];
  auto rr = __builtin_amdgcn_permlane32_swap(__float_as_uint(ps), __float_as_uint(ps), false, false);
  return __uint_as_float(rr[0]) + __uint_as_float(rr[1]);
}
__device__ __forceinline__ void finishSM(f32x16& p0, f32x16& p1, float alpha, float& l_reg, bf16x8& pa0, bf16x8& pa1, bf16x8& pa2, bf16x8& pa3) {
#pragma unroll
  for (int r = 0; r < 16; ++r) p1[r] = __builtin_amdgcn_exp2f(p1[r]);
  const float ps = row_sum(p0, p1);
  l_reg = l_reg * alpha + ps;
  pack_p(p0, p1, pa0, pa1, pa2, pa3);
}
template <int D> __device__ __forceinline__ void qkt(f32x16& p0, f32x16& p1, const LAS char* Ks, const bf16x8* qr, int r32, int hi) {
  p0 = f32x16{}; p1 = f32x16{};
#pragma unroll
  for (int d0 = 0; d0 < D / 16; ++d0) { const int cb = (d0 * 16 + hi * 8) * 2;
    const bf16x8 b0 = *(const LAS bf16x8*)(Ks + kswz<D>(r32, cb));
    const bf16x8 b1 = *(const LAS bf16x8*)(Ks + kswz<D>(32 + r32, cb));
    p0 = __builtin_amdgcn_mfma_f32_32x32x16_bf16(b0, qr[d0], p0, 0, 0, 0);
    p1 = __builtin_amdgcn_mfma_f32_32x32x16_bf16(b1, qr[d0], p1, 0, 0, 0); }
}
template <int D> __device__ __forceinline__ int v_st(int k, int c) { const int kk = (k & ~0xC) | ((k & 4) << 1) | ((k & 8) >> 1); return ((kk >> 3) * (D / 32) + (c >> 5)) * 512 + ((kk & 7) * 32 + (c & 31)) * 2; }
__device__ __forceinline__ int v_rd_base(int lane) { return ((lane & 3) << 3) | (((lane >> 2) & 3) << 6) | (((lane >> 4) & 1) << 5) | (((lane >> 5) & 1) << 8); }
template <int D> constexpr int v_rd_off(int d0, int ks, int half) { return d0 * 512 + ks * (D / 32) * 1024 + half * (D / 32) * 512; }
template <int OFF> __device__ __forceinline__ s16x4 tr_read(int vb) {
  s16x4 r; asm volatile("ds_read_b64_tr_b16 %0, %1 offset:%2" : "=&v"(r) : "v"(vb), "i"(OFF) : "memory"); return r;
}
template <int D, int D0> __device__ __forceinline__ void pv_one(f32x16& od, int vb, bf16x8 pa0, bf16x8 pa1, bf16x8 pa2, bf16x8 pa3) {
  const s16x4 l0 = tr_read<v_rd_off<D>(D0, 0, 0)>(vb), h0 = tr_read<v_rd_off<D>(D0, 0, 1)>(vb), l1 = tr_read<v_rd_off<D>(D0, 1, 0)>(vb), h1 = tr_read<v_rd_off<D>(D0, 1, 1)>(vb);
  const s16x4 l2 = tr_read<v_rd_off<D>(D0, 2, 0)>(vb), h2 = tr_read<v_rd_off<D>(D0, 2, 1)>(vb), l3 = tr_read<v_rd_off<D>(D0, 3, 0)>(vb), h3 = tr_read<v_rd_off<D>(D0, 3, 1)>(vb);
  asm volatile("s_waitcnt lgkmcnt(0)" ::: "memory"); SBAR();
#define PK(L, H) (bf16x8){L[0], L[1], L[2], L[3], H[0], H[1], H[2], H[3]}
  od = __builtin_amdgcn_mfma_f32_32x32x16_bf16(pa0, PK(l0, h0), od, 0, 0, 0);
  od = __builtin_amdgcn_mfma_f32_32x32x16_bf16(pa1, PK(l1, h1), od, 0, 0, 0);
  od = __builtin_amdgcn_mfma_f32_32x32x16_bf16(pa2, PK(l2, h2), od, 0, 0, 0);
  od = __builtin_amdgcn_mfma_f32_32x32x16_bf16(pa3, PK(l3, h3), od, 0, 0, 0);
#undef PK
}
}

template <bool FAST>
__device__ __forceinline__ void win_attn_unit(const Frame& F, bool ctxq, int b, int h, int qb, const bf16* Qp, const bf16* Kp, const bf16* RAW, bf16* O, float sink, LAS char* lds, const float* qn, const float* R64) {
  using namespace att;
  constexpr float C = 1.f, THRS = 8.f * LOG2E;
  const int tid = F.tid, wid = F.wave, lane = F.lane, r32 = lane & 31, hi = lane >> 5;
  LAS char* Kl = lds; LAS char* Vl = lds + 16384; LAS float* li_l = (LAS float*)(lds + 32768) + wid * 64; LAS float* al_l = li_l + 32;
  const int g = h >> 2;
  const int q0 = ctxq ? 0 : qb * 256;
  const long qrow_w = (ctxq ? (long)ML + b * CTXL : (long)b * SEQ + q0) + wid * 32;
  bf16x8 qr[4];
  if constexpr (FAST) {
#pragma unroll
    for (int d0 = 0; d0 < 4; ++d0) qr[d0] = *(const bf16x8*)(Qp + (qrow_w + r32) * 1536 + h * 64 + d0 * 16 + hi * 8);
    qnorm_rope_frag<64>(qr, qn, R64, q0 + wid * 32 + r32, !ctxq, 0.18033688f, lane);
  } else {
#pragma unroll
    for (int d0 = 0; d0 < 4; ++d0) qr[d0] = *(const bf16x8*)(Qp + (qrow_w + r32) * 1024 + h * 64 + d0 * 16 + hi * 8);
  }
  int jlo = 0, jhi = 0;
  if (!ctxq) { jlo = (q0 == 0) ? 2 : 0; jhi = (SEQ - (q0 - 128)) / 64; if (jhi > 8) jhi = 8; }
  const int NT = 4 + (jhi - jlo);
  const int srow = tid >> 3, sch = tid & 7;
  const int vb0 = lds_addr(Vl) + v_rd_base(lane);
  float m_reg = -1e30f, l_reg = 0.f; f32x16 o[2]; o[0] = f32x16{}; o[1] = f32x16{};
  v4u kreg, vreg;
#define TROW(i) ((i) < 4 ? (long)ML + b * CTXL + 64 * (i) : (long)b * SEQ + q0 - 128 + 64 * (jlo + (i) - 4))
#define WLOAD(i) do { const long tr_ = TROW(i) + srow; kreg = *(const v4u*)(Kp + tr_ * 256 + g * 64 + sch * 8); vreg = *(const v4u*)(RAW + tr_ * 1536 + 1280 + g * 64 + sch * 8); } while (0)
  WLOAD(0);
  for (int i = 0; i < NT; ++i) {
    const int buf = i & 1;
    *(LAS v4u*)(Kl + buf * 8192 + kswz<64>(srow, sch * 16)) = kreg;
    *(LAS v4u*)(Vl + buf * 8192 + v_st<64>(srow, sch * 8)) = vreg;
    __syncthreads();
    if (i + 1 < NT) WLOAD(i + 1);
    bool need = true; int T = 0;
    if (i >= 4) { T = q0 - 128 + 64 * (jlo + i - 4); const int qw0 = q0 + wid * 32; need = (T + 63 >= qw0 - 128) && (T <= qw0 + 31 + 128); }
    if (need) {
      f32x16 p0, p1; qkt<64>(p0, p1, Kl + buf * 8192, qr, r32, hi);
      if (i >= 4) { const int dq = q0 + wid * 32 + r32 - T;
#pragma unroll
        for (int r = 0; r < 16; ++r) { const int d0_ = dq - crow(r, hi), d1_ = d0_ - 32;
          if (d0_ > 128 || d0_ < -128) p0[r] = -1e30f;
          if (d1_ > 128 || d1_ < -128) p1[r] = -1e30f; } }
      bf16x8 pa0, pa1, pa2, pa3;
      if constexpr (FAST) {
#pragma unroll
        for (int r = 0; r < 16; ++r) { p0[r] = __builtin_amdgcn_exp2f(p0[r]); p1[r] = __builtin_amdgcn_exp2f(p1[r]); }
        l_reg += row_sum(p0, p1); pack_p(p0, p1, pa0, pa1, pa2, pa3); SBAR();
      } else {
      float mn, alpha; partialSM(p0, p1, m_reg, mn, alpha, C, THRS);
      if (__any(alpha < 1.f)) { if (hi == 0) al_l[r32] = alpha; asm volatile("s_waitcnt lgkmcnt(0)" ::: "memory");
#pragma unroll
        for (int d = 0; d < 2; ++d)
#pragma unroll
          for (int r = 0; r < 16; ++r) o[d][r] *= al_l[crow(r, hi)]; }
      finishSM(p0, p1, alpha, l_reg, pa0, pa1, pa2, pa3); SBAR();
      }
      pv_one<64, 0>(o[0], vb0 + buf * 8192, pa0, pa1, pa2, pa3); pv_one<64, 1>(o[1], vb0 + buf * 8192, pa0, pa1, pa2, pa3);
    }
  }
#undef TROW
#undef WLOAD
  l_reg += __builtin_amdgcn_exp2f(sink * LOG2E - (FAST ? 0.f : m_reg * C));
  if (hi == 0) li_l[r32] = l_reg; asm volatile("s_waitcnt lgkmcnt(0)" ::: "memory");
  float rli[16];
#pragma unroll
  for (int r = 0; r < 16; ++r) rli[r] = __builtin_amdgcn_rcpf(li_l[crow(r, hi)]);
  bf16* Ow = O + qrow_w * 1024 + h * 64;
#pragma unroll
  for (int r = 0; r < 16; ++r) { const int orow = crow(r, hi);
#pragma unroll
    for (int d0 = 0; d0 < 2; ++d0) Ow[(long)orow * 1024 + d0 * 32 + r32] = f2bf16(o[d0][r] * rli[r]); }
  __syncthreads();
}


__device__ __forceinline__ void ml_decode(int uid, int& b, int& h, int& dir, int& c, long& base, int& sgn) {
  c = uid % 66; const int sid = uid / 66; dir = sid & 1; h = (sid >> 1) & 3; b = sid >> 3;
  if (dir == 0) { base = c < 2 ? (long)ML + b * CTXL + 128 * c : (long)b * SEQ + 128 * (c - 2); sgn = 1; }
  else { base = c < 2 ? (long)ML + b * CTXL + 255 - 128 * c : (long)b * SEQ + 8191 - 128 * (c - 2); sgn = -1; }
}
__device__ __forceinline__ float wave_incl_scan_add(float v, int lane) {
#pragma unroll
  for (int o = 1; o < 64; o <<= 1) { const float t = bperm(v, lane - o); if (lane >= o) v += t; }
  return v;
}
__device__ __forceinline__ float wave_incl_scan_max(float v, int lane) {
#pragma unroll
  for (int o = 1; o < 64; o <<= 1) { const float t = bperm(v, lane - o); if (lane >= o) v = fmaxf(v, t); }
  return v;
}
__device__ __forceinline__ void ml1_load(const Frame& F, int uid, const bf16* RAW, const float* GATESb, v4u (&kq)[4], v4u (&vq)[8], float (&gt)[4]) {
  int b, h, dir, c, sgn; long base; ml_decode(uid, b, h, dir, c, base, sgn);
  const int wid = F.wave, ln = xb_lane(), tid = (wid << 6) | ln;
  if (wid == 0) { const long ra = base + sgn * ln, rb = base + sgn * (ln + 64);
    gt[0] = GATESb[ra * 16 + dir * 8 + h]; gt[1] = GATESb[ra * 16 + dir * 8 + 4 + h]; gt[2] = GATESb[rb * 16 + dir * 8 + h]; gt[3] = GATESb[rb * 16 + dir * 8 + 4 + h]; }
#pragma unroll
  for (int ii = 0; ii < 4; ++ii) { const int l = (tid >> 4) + 32 * ii; kq[ii] = *(const v4u*)(RAW + (size_t)(base + sgn * l) * 3072 + 512 + 128 * h + (tid & 15) * 8); }
#pragma unroll
  for (int ii = 0; ii < 8; ++ii) { const int l = (tid >> 5) + 16 * ii; vq[ii] = *(const v4u*)(RAW + (size_t)(base + sgn * l) * 3072 + 1024 + 256 * h + (tid & 31) * 8); }
}
__device__ __forceinline__ void ml1_unit(const Frame& F, int uid, int uid_next, const bf16* RAW, const float* GATESb, bf16* CBAR, float* NBAR, float* MSC, LAS char* lds, v4u (&kq)[4], v4u (&vq)[8], float (&gt)[4]) {
  using namespace att;
  LAS char* Kt = lds; LAS char* Vt = lds + 32768; LAS float* wS = (LAS float*)(lds + 98304); LAS float* nP = wS + 128;
  const int tid = F.tid, wid = F.wave, lane = F.lane, r32 = lane & 31, hi = lane >> 5;
  const float lia = gt[0], lfa = gt[1], lib = gt[2], lfb = gt[3];
  if (wid == 0) {
    const int lane = xb_lane();
    const float ca = wave_incl_scan_add(lfa, lane); const float tot = __int_as_float(__builtin_amdgcn_readlane(__float_as_int(ca), 63));
    const float cb = wave_incl_scan_add(lfb, lane) + tot; const float g = __int_as_float(__builtin_amdgcn_readlane(__float_as_int(cb), 63));
    const float ua = lia - ca, ub = lib - cb; const float um = wave_max(fmaxf(ua, ub), lane);
    wS[lane] = expf(ua - um); wS[lane + 64] = expf(ub - um);
    if (lane == 0) { MSC[(size_t)uid * 4 + 0] = g; MSC[(size_t)uid * 4 + 1] = g + um; }
  }
  __syncthreads();
  float kacc[8];
#pragma unroll
  for (int e = 0; e < 8; ++e) kacc[e] = 0.f;
#pragma unroll
  for (int ii = 0; ii < 4; ++ii) { const int l = (tid >> 4) + 32 * ii, cc = (tid & 15) * 8;
    *(LAS v4u*)(Kt + (l >> 6) * 16384 + v_st<128>(l & 63, cc)) = kq[ii];
    float f[8]; unpack8(kq[ii], f); const float wl = wS[l];
#pragma unroll
    for (int e = 0; e < 8; ++e) kacc[e] += wl * f[e]; }
#pragma unroll
  for (int ii = 0; ii < 8; ++ii) { const int l = (tid >> 5) + 16 * ii, cc = (tid & 31) * 8;
    float f[8]; unpack8(vq[ii], f); const float wl = wS[l];
#pragma unroll
    for (int e = 0; e < 8; ++e) f[e] *= wl;
    *(LAS v4u*)(Vt + ((l >> 6) * 2 + (cc >> 7)) * 16384 + v_st<128>(l & 63, cc & 127)) = pack8(f); }
#pragma unroll
  for (int e = 0; e < 8; ++e) { kacc[e] += bperm(kacc[e], lane ^ 16); kacc[e] += bperm(kacc[e], lane ^ 32); }
  if (lane < 16) {
#pragma unroll
    for (int e = 0; e < 8; ++e) nP[wid * 128 + lane * 8 + e] = kacc[e]; }
  __syncthreads();
  if (uid_next < ML_NUID) ml1_load(F, uid_next, RAW, GATESb, kq, vq, gt);
  if (wid < 2) { float s = 0.f; const int t2 = (wid << 6) + xb_lane();
#pragma unroll
    for (int w8 = 0; w8 < 8; ++w8) s += nP[w8 * 128 + t2];
    NBAR[(size_t)uid * 128 + t2] = s; }
  f32x16 acc[4]; acc[0] = f32x16{}; acc[1] = f32x16{}; acc[2] = f32x16{}; acc[3] = f32x16{};
  const int vbA = lds_addr(Vt) + (wid >> 2) * 16384 + (wid & 3) * 512 + v_rd_base(lane);
  const int vbB = lds_addr(Kt) + v_rd_base(lane);
#define ML1_STEP(KT, KS) do { \
    const s16x4 al = tr_read<(KT) * 32768 + (KS) * 4096>(vbA), ah = tr_read<(KT) * 32768 + (KS) * 4096 + 2048>(vbA); \
    const s16x4 b0l = tr_read<(KT) * 16384 + 0 * 512 + (KS) * 4096>(vbB), b0h = tr_read<(KT) * 16384 + 0 * 512 + (KS) * 4096 + 2048>(vbB); \
    const s16x4 b1l = tr_read<(KT) * 16384 + 1 * 512 + (KS) * 4096>(vbB), b1h = tr_read<(KT) * 16384 + 1 * 512 + (KS) * 4096 + 2048>(vbB); \
    const s16x4 b2l = tr_read<(KT) * 16384 + 2 * 512 + (KS) * 4096>(vbB), b2h = tr_read<(KT) * 16384 + 2 * 512 + (KS) * 4096 + 2048>(vbB); \
    const s16x4 b3l = tr_read<(KT) * 16384 + 3 * 512 + (KS) * 4096>(vbB), b3h = tr_read<(KT) * 16384 + 3 * 512 + (KS) * 4096 + 2048>(vbB); \
    asm volatile("s_waitcnt lgkmcnt(0)" ::: "memory"); SBAR(); \
    const bf16x8 a_ = (bf16x8){al[0], al[1], al[2], al[3], ah[0], ah[1], ah[2], ah[3]}; \
    acc[0] = __builtin_amdgcn_mfma_f32_32x32x16_bf16((bf16x8){b0l[0], b0l[1], b0l[2], b0l[3], b0h[0], b0h[1], b0h[2], b0h[3]}, a_, acc[0], 0, 0, 0); \
    acc[1] = __builtin_amdgcn_mfma_f32_32x32x16_bf16((bf16x8){b1l[0], b1l[1], b1l[2], b1l[3], b1h[0], b1h[1], b1h[2], b1h[3]}, a_, acc[1], 0, 0, 0); \
    acc[2] = __builtin_amdgcn_mfma_f32_32x32x16_bf16((bf16x8){b2l[0], b2l[1], b2l[2], b2l[3], b2h[0], b2h[1], b2h[2], b2h[3]}, a_, acc[2], 0, 0, 0); \
    acc[3] = __builtin_amdgcn_mfma_f32_32x32x16_bf16((bf16x8){b3l[0], b3l[1], b3l[2], b3l[3], b3h[0], b3h[1], b3h[2], b3h[3]}, a_, acc[3], 0, 0, 0); \
    SBAR(); } while (0)
  ML1_STEP(0, 0); ML1_STEP(0, 1); ML1_STEP(0, 2); ML1_STEP(0, 3); ML1_STEP(1, 0); ML1_STEP(1, 1); ML1_STEP(1, 2); ML1_STEP(1, 3);
#undef ML1_STEP
  bf16* cbp = CBAR + (size_t)uid * 32768;
#pragma unroll
  for (int nb = 0; nb < 4; ++nb)
#pragma unroll
    for (int g = 0; g < 4; ++g) { uint2 w; w.x = pg8::cvt_pk_bf16(acc[nb][4 * g], acc[nb][4 * g + 1]); w.y = pg8::cvt_pk_bf16(acc[nb][4 * g + 2], acc[nb][4 * g + 3]);
      *(uint2*)(cbp + ((wid * 8 + 2 * nb + (g >> 1)) * 64 + (g & 1) * 32 + r32) * 8 + 4 * hi) = w; }
  __syncthreads();
}
__device__ __forceinline__ void ml2_scan(const Frame& F, int s, bf16* CBAR, float* NBAR, float* MSC, LAS char* lds) {
  const int sid = s >> 3, slice = s & 7, uid0 = sid * 66;
  LAS float* gS = (LAS float*)lds; LAS float* mbS = gS + 66;
  __syncthreads();
  if (F.tid < 66) { gS[F.tid] = MSC[(size_t)(uid0 + F.tid) * 4 + 0]; mbS[F.tid] = MSC[(size_t)(uid0 + F.tid) * 4 + 1]; }
  __syncthreads();
  const size_t e0 = (size_t)(slice * 32 + (F.tid >> 4)) * 128 + (F.tid & 15) * 8;
  const bool nthr = (slice == 0) && (F.tid < 128);
  float Cs[8]; float m = -1e30f, nst = 0.f;
#pragma unroll
  for (int e = 0; e < 8; ++e) Cs[e] = 0.f;
  for (int grp = 0; grp < 3; ++grp) {
    v4u cb[22]; float nbv[22];
#pragma unroll
    for (int i = 0; i < 22; ++i) { cb[i] = *(const v4u*)(CBAR + (size_t)(uid0 + grp * 22 + i) * 32768 + e0); nbv[i] = nthr ? NBAR[(size_t)(uid0 + grp * 22 + i) * 128 + F.tid] : 0.f; }
#pragma unroll
    for (int i = 0; i < 22; ++i) {
      const int c = grp * 22 + i, uid = uid0 + c;
      const float g = gS[c], mb = mbS[c];
      *(v4u*)(CBAR + (size_t)uid * 32768 + e0) = pack8(Cs);
      if (slice == 0 && F.tid == 0) MSC[(size_t)uid * 4 + 2] = m;
      if (nthr) NBAR[(size_t)uid * 128 + F.tid] = nst;
      const float m_new = fmaxf(g + m, mb), decay = __expf(g + m - m_new), inj = __expf(mb - m_new);
      float f[8]; unpack8(cb[i], f);
#pragma unroll
      for (int e = 0; e < 8; ++e) Cs[e] = decay * Cs[e] + inj * f[e];
      nst = decay * nst + inj * nbv[i]; m = m_new;
    }
  }
}
__device__ __forceinline__ void ml3_load(const Frame& F, int uid, const bf16* RAW, const float* GATESb, const float* MSC, const float* NBAR, bf16x8 (&qr)[8], v4u (&kq)[4], float (&gt)[5], float& nbv) {
  int b, h, dir, c, sgn; long base; ml_decode(uid, b, h, dir, c, base, sgn);
  const int wid = F.wave, ln = xb_lane(), tid = (wid << 6) | ln, r32 = ln & 31, hi = ln >> 5, lq = 32 * (wid & 3) + r32;
  if (wid == 0) { const long ra = base + sgn * ln, rb = base + sgn * (ln + 64);
    gt[0] = GATESb[ra * 16 + dir * 8 + h]; gt[1] = GATESb[ra * 16 + dir * 8 + 4 + h]; gt[2] = GATESb[rb * 16 + dir * 8 + h]; gt[3] = GATESb[rb * 16 + dir * 8 + 4 + h]; gt[4] = MSC[(size_t)uid * 4 + 2]; }
  else if (wid == 2 || wid == 3) nbv = NBAR[(size_t)uid * 128 + tid - 128];
  { const bf16* qp = RAW + (size_t)(base + sgn * lq) * 3072 + 128 * h + hi * 8;
#pragma unroll
    for (int d0 = 0; d0 < 8; ++d0) qr[d0] = *(const bf16x8*)(qp + d0 * 16); }
#pragma unroll
  for (int ii = 0; ii < 4; ++ii) { const int l = (tid >> 4) + 32 * ii; kq[ii] = *(const v4u*)(RAW + (size_t)(base + sgn * l) * 3072 + 512 + 128 * h + (tid & 15) * 8); }
}
__device__ __forceinline__ void ml3_unit(const Frame& F, int uid, int uid_next, const bf16* RAW, const float* GATESb, const bf16* CBAR, const float* NBAR, const float* MSC, bf16* HX, LAS char* lds,
                                         bf16x8 (&qr)[8], v4u (&kq)[4], float (&gt)[5], float& nbv) {
  using namespace att;
  constexpr float SCQ = 0.08838834764831845f;
  LAS char* Kl = lds; LAS char* Vl = lds + 32768;
  LAS float* uS = (LAS float*)(lds + 98304); LAS float* MS_ = uS + 128; LAS float* wiS = uS + 256; LAS float* emS = uS + 384; LAS float* nS = uS + 512;
  int b, h, dir, c, sgn; long base; ml_decode(uid, b, h, dir, c, base, sgn);
  const int tid = F.tid, wid = F.wave, lane = F.lane, r32 = lane & 31, hi = lane >> 5;
  LAS float* wsf = (LAS float*)(lds + 98304 + 2560) + wid * 64;
  const int rblk = wid & 3, dh = wid >> 2, lq = 32 * rblk + r32;
  const float lia = gt[0], lfa = gt[1], lib = gt[2], lfb = gt[3], ms = gt[4];
  v4u vq[8];
#pragma unroll
  for (int ii = 0; ii < 8; ++ii) { const int l = (tid >> 5) + 16 * ii; vq[ii] = *(const v4u*)(RAW + (size_t)(base + sgn * l) * 3072 + 1024 + 256 * h + (tid & 31) * 8); }
  if (wid == 0) {
    const int lane = xb_lane();
    const float ca = wave_incl_scan_add(lfa, lane); const float tot = __int_as_float(__builtin_amdgcn_readlane(__float_as_int(ca), 63));
    const float cb = wave_incl_scan_add(lfb, lane) + tot;
    const float ua = lia - ca, ub = lib - cb;
    const float pa = wave_incl_scan_max(ua, lane); const float pma = __int_as_float(__builtin_amdgcn_readlane(__float_as_int(pa), 63));
    const float pb = fmaxf(wave_incl_scan_max(ub, lane), pma);
    const float Ma = fmaxf(ms, pa), Mb = fmaxf(ms, pb);
    uS[lane] = ua; uS[lane + 64] = ub; MS_[lane] = Ma; MS_[lane + 64] = Mb;
    wiS[lane] = expf(ms - Ma); wiS[lane + 64] = expf(ms - Mb);
    emS[lane] = expf(-(ca + Ma)); emS[lane + 64] = expf(-(cb + Mb));
  } else if (wid == 2 || wid == 3) { const int t2 = (wid << 6) + xb_lane() - 128; nS[t2] = nbv; }
#pragma unroll
  for (int ii = 0; ii < 4; ++ii) { const int l = (tid >> 4) + 32 * ii; *(LAS v4u*)(Kl + kswz<128>(l, (tid & 15) * 16)) = kq[ii]; }
  f32x16 o[4]; o[0] = f32x16{}; o[1] = f32x16{}; o[2] = f32x16{}; o[3] = f32x16{};
  { const bf16* cp = CBAR + (size_t)uid * 32768 + (size_t)(dh * 4 * 8 * 64 + lane) * 8;
#pragma unroll
    for (int j = 0; j < 4; ++j) {
#pragma unroll
      for (int dh0 = 0; dh0 < 8; dh0 += 4) {
        bf16x8 cf[4];
#pragma unroll
        for (int d0 = 0; d0 < 4; ++d0) cf[d0] = *(const bf16x8*)(cp + (size_t)((j * 8 + dh0 + d0) * 64) * 8);
#pragma unroll
        for (int d0 = 0; d0 < 4; ++d0) o[j] = __builtin_amdgcn_mfma_f32_32x32x16_bf16(qr[dh0 + d0], cf[d0], o[j], 0, 0, 0); } } }
#pragma unroll
  for (int ii = 0; ii < 8; ++ii) { const int l = (tid >> 5) + 16 * ii, cc = (tid & 31) * 8; *(LAS v4u*)(Vl + ((l >> 6) * 2 + (cc >> 7)) * 16384 + v_st<128>(l & 63, cc & 127)) = vq[ii]; }
  __syncthreads();
  float qn = 0.f;
#pragma unroll
  for (int d0 = 0; d0 < 8; ++d0)
#pragma unroll
    for (int e = 0; e < 8; ++e) qn += bf2f((unsigned short)qr[d0][e]) * nS[d0 * 16 + hi * 8 + e];
  qn += bperm(qn, lane ^ 32);
#pragma unroll
  for (int r = 0; r < 16; ++r) { const float wi = wiS[32 * rblk + crow(r, hi)]; o[0][r] *= wi; o[1][r] *= wi; o[2][r] *= wi; o[3][r] *= wi; }
  float den = 0.f; const float Mq = MS_[lq];
  const int vb0 = lds_addr(Vl) + dh * 16384 + v_rd_base(lane);
#pragma nounroll
  for (int kt = 0; kt < 2; ++kt) {
    if (64 * kt <= 32 * rblk + 31) {
      f32x16 p0, p1; qkt<128>(p0, p1, Kl + kt * 16384, qr, r32, hi);
      const LAS float* up = uS + 64 * kt + 4 * hi; const int dql = lq - 64 * kt - 4 * hi;
#pragma unroll
      for (int r = 0; r < 16; ++r) { const int cr = (r & 3) + 8 * (r >> 2);
        const float u0 = up[cr], u1 = up[cr + 32];
        const float a0 = (cr <= dql) ? (u0 - Mq) * LOG2E : -1e30f, a1 = (cr + 32 <= dql) ? (u1 - Mq) * LOG2E : -1e30f;
        p0[r] *= __builtin_amdgcn_exp2f(a0); p1[r] *= __builtin_amdgcn_exp2f(a1); }
      asm volatile("" : "+v"(p0), "+v"(p1));
      den += row_sum(p0, p1);
      bf16x8 pa0, pa1, pa2, pa3; pack_p(p0, p1, pa0, pa1, pa2, pa3); SBAR();
      const int vb = vb0 + kt * 32768;
      pv_one<128, 0>(o[0], vb, pa0, pa1, pa2, pa3); pv_one<128, 1>(o[1], vb, pa0, pa1, pa2, pa3); pv_one<128, 2>(o[2], vb, pa0, pa1, pa2, pa3); pv_one<128, 3>(o[3], vb, pa0, pa1, pa2, pa3);
    }
  }
  if (uid_next >= 0) ml3_load(F, uid_next, RAW, GATESb, MSC, NBAR, qr, kq, gt, nbv);
  const float dtot = den + wiS[lq] * qn;
  const float fac = SCQ / fmaxf(SCQ * fabsf(dtot), emS[lq]);
  if (hi == 0) wsf[r32] = fac; asm volatile("s_waitcnt lgkmcnt(0)" ::: "memory");
  int r32e = r32, hie = hi; asm volatile("" : "+v"(r32e), "+v"(hie));
#pragma unroll
  for (int r = 0; r < 16; ++r) { const int lo_ = 32 * rblk + crow(r, hie); const float fr_ = wsf[crow(r, hie)];
    bf16* op = HX + (size_t)(base + sgn * lo_) * 1024 + 256 * h + 128 * dh + r32e;
    op[0] = f2bf16(o[0][r] * fr_); op[32] = f2bf16(o[1][r] * fr_); op[64] = f2bf16(o[2][r] * fr_); op[96] = f2bf16(o[3][r] * fr_); }
  __syncthreads();
}
__device__ __forceinline__ void mln_phase(const Frame& F, bf16* HF, const bf16* HB, const bf16* RAW, const float* hnorm) {
  const int j = F.lane & 31, hh = F.lane >> 5;
  float hn[8];
#pragma unroll
  for (int e = 0; e < 8; ++e) hn[e] = hnorm[8 * j + e];
  for (int r = F.gw; r < ML; r += F.ngw) {
#pragma unroll
    for (int p = 0; p < 2; ++p) { const size_t off = (size_t)r * 1024 + 256 * (2 * p + hh) + 8 * j;
      float a[8], b[8], g[8]; unpack8(*(const v4u*)(HF + off), a); unpack8(*(const v4u*)(HB + off), b); unpack8(*(const v4u*)(RAW + (size_t)r * 3072 + 2048 + 256 * (2 * p + hh) + 8 * j), g);
      float ss = 0.f;
#pragma unroll
      for (int e = 0; e < 8; ++e) { a[e] += b[e]; ss += a[e] * a[e]; }
#pragma unroll
      for (int o = 1; o < 32; o <<= 1) ss += bperm(ss, F.lane ^ o);
      const float rs = __builtin_amdgcn_rsqf(ss * (1.f / 256.f) + EPS);
#pragma unroll
      for (int e = 0; e < 8; ++e) a[e] = sigmoidf_(g[e]) * a[e] * rs * hn[e];
      *(v4u*)(HF + off) = pack8(a); }
  }
}

struct Args { const float* in[27]; float* out; unsigned char* ws; };
enum { I_X = 0, I_C, I_CTX, I_CCTX, I_ADAW, I_ADAB, I_NMIX, I_NFFN, I_WUP, I_FCONV, I_WDOWN, I_WINQKV, I_WINQN, I_WINKN, I_WINSINK, I_WINWO,
       I_SCWIN, I_SCCONV, I_SCWOUT, I_AXQKV, I_AXQN, I_AXKN, I_AXWO, I_MLWIN, I_MLBG, I_MLHN, I_MLWOUT };
typedef const __attribute__((address_space(4))) Args* ArgsP;

typedef pg8::StaticOrder SOrd;
#define GEMM_BF16(Aptr, Bptr, Mrows, Ncols, Kdim, Optr, ldc_) do { pg8::Gemm g_{(const pg8::bf16_t*)(Aptr), (const pg8::bf16_t*)(Bptr), (Mrows), (Ncols), (Kdim)}; SOrd S_; S_.init((Mrows), (Ncols), F.G, bid); \
    pg8::EpiStoreBf16 E_{(pg8::bf16_t*)(Optr), (ldc_)}; pg8::gemm_phase<pg8::EpiStoreBf16, SOrd, true, true>(F.lds, g_, S_, E_, F.tid); } while (0)
#define GEMM_RESID(Aptr, Bptr, Mrows, Kdim, blat, bctx, olat, octx, gatep, tile0_, bin_, bout_) do { pg8::Gemm g_{(const pg8::bf16_t*)(Aptr), (const pg8::bf16_t*)(Bptr), (Mrows), 1024, (Kdim)}; pg8::CtxSplitOrder S_; S_.init((Kdim), (Mrows) > ML, F.G, bid); \
    pg8::EpiResid E_{(blat), (bctx), (olat), (octx), (gatep), (tile0_), (bin_), (bout_)}; pg8::gemm_phase<pg8::EpiResid, pg8::CtxSplitOrder, true, true>(F.lds, g_, S_, E_, F.tid); } while (0)
#define PHASE() do { asm volatile("" : "+s"(F.wave)); F.tid = (F.wave << 6) | xb_lane(); asm volatile("" : "+v"(F.tid)); F.lane = F.tid & 63; asm volatile("" : "+s"(bid), "+s"(F.G)); \
    F.gw = bid * NWAVES + F.wave; F.ngw = F.G * NWAVES; asm volatile("" : "+s"(ap)); ws = ap->ws; asm volatile("" : "+s"(F.lds)); ldsc = (LAS char*)F.lds; asm volatile("" : "+s"(bar.bar), "+s"(bar.x), "+s"(bar.st)); } while (0)
#define AIN(k) (ap->in[k])
__device__ __forceinline__ int ml1_uid(int u) { const int sid = u / 66; int c = u - sid * 66; if (sid & 1) { const int cf = c + 2 >= 66 ? c + 2 - 66 : c + 2; c = cf >= 2 ? 67 - cf : 1 - cf; } return sid * 66 + c; }
__device__ __forceinline__ int ml3_uid(int u) { const int sid = u >> 6; int cc = u & 63; if (sid & 1) cc = 63 - cc; return sid * 66 + cc + 2; }

__global__ void __launch_bounds__(NWAVES * 64, 2) hybrid_fwd(Args args_unused) {
    extern __shared__ __attribute__((aligned(16))) unsigned char lds_raw[];
    ArgsP ap = (ArgsP)__builtin_amdgcn_kernarg_segment_ptr();
    Frame F;
    F.lds = (LAS unsigned char*)lds_raw;
    F.tid = threadIdx.x; F.lane = F.tid & 63; F.wave = __builtin_amdgcn_readfirstlane(F.tid >> 6);
    int bid = blockIdx.x;
    F.G = gridDim.x; F.gw = bid * NWAVES + F.wave; F.ngw = F.G * NWAVES;
    unsigned char* ws = ap->ws;
    for (int u = F.tid; u < (LDS_BYTES - LDSCTL_OFF) / 4; u += NWAVES * 64) ((LAS unsigned*)(F.lds + LDSCTL_OFF))[u] = 0u;
    __syncthreads();
    XcdBarrier bar = xcd_barrier_post((unsigned*)((gu32*)(ws + WS_CTL) + CW_BAR), (volatile LAS unsigned*)(F.lds + MISC_OFF) + 8, F.wave);
#define GRID_BAR() xcd_barrier(bar, F.wave)
    LAS char* ldsc = (LAS char*)F.lds;

    {
        __syncthreads();
        PHASE();
        mod_phase(F, AIN(I_C), AIN(I_CCTX), AIN(I_ADAW), AIN(I_ADAB), (float*)(ws + WS_MOD));
        rope_tables(F, (float*)(ws + WS_ROPE64), (float*)(ws + WS_ROPE128));
        for (int i = bid * 512 + F.tid; i < MC * DM / 4; i += F.G * 512) ((f32x4*)(ws + WS_HC))[i] = ((const f32x4*)AIN(I_CTX))[i];
        int rot = 0;
#pragma nounroll
        for (int l = 0; l < 4; ++l) {
            const size_t lb = l == 0 ? WT_L0 : l == 1 ? WT_L1 : l == 2 ? WT_L2 : WT_L3;
            const size_t szin = (l == 0 || l == 2) ? SZ_W1536 : SZ_W3072;
            const float* win = l == 0 ? AIN(I_WINQKV) : l == 1 ? AIN(I_SCWIN) : l == 2 ? AIN(I_AXQKV) : AIN(I_MLWIN);
            const float* wout = l == 0 ? AIN(I_WINWO) : l == 1 ? AIN(I_SCWOUT) : l == 2 ? AIN(I_AXWO) : AIN(I_MLWOUT);
            const int nin = (l == 0 || l == 2) ? 1536 : 3072, pin = l == 3 ? 3088 : nin;
            transpose_matrix(F, win, 1024, pin, nin, (bf16*)(ws + lb), rot);
            transpose_matrix(F, wout, 1024, 1024, 1024, (bf16*)(ws + lb + szin), rot);
            transpose_matrix(F, AIN(I_WUP) + (size_t)l * 1024 * NUP, 1024, NUP, NUP, (bf16*)(ws + lb + szin + SZ_W1024), rot, true);
            transpose_matrix(F, AIN(I_WDOWN) + (size_t)l * DFF * 1024, DFF, 1024, 1024, (bf16*)(ws + lb + szin + SZ_W1024 + SZ_UP), rot);
        }
    }
    GRID_BAR();

#pragma nounroll
    for (int layer = 0; layer < 4; ++layer) {
        asm volatile("" : "+s"(layer));
#define LB() (layer == 0 ? WT_L0 : layer == 1 ? WT_L1 : layer == 2 ? WT_L2 : WT_L3)
#define SZIN() ((layer == 0 || layer == 2) ? SZ_W1536 : SZ_W3072)
#define MODP() ((const float*)(ws + WS_MOD) + (size_t)layer * 5 * 6144)
#define HB_A() ((void*)ap->out)
#define HB_B() ((void*)((bf16*)ap->out + (size_t)ML * 1024))
#define HLAT() (layer == 0 ? (const void*)AIN(I_X) : (const void*)HB_B())
#define HMID() (layer == 3 ? (void*)(ws + WS_WT) : HB_A())
#define HCTX() ((const float*)(ws + WS_HC))
#define ROWS_OUT() (layer == 3 ? ML : MT)

        PHASE();
        if (layer == 3) norm_phase<true>(F, HLAT(), layer != 0, (float*)(ws + WS_HC), (const float*)(ws + BG_SLAB), layer == 0 ? 0 : 11, MT, AIN(I_NMIX) + layer * 1024, MODP(), 0, 1024, (bf16*)(ws + WS_XN), AIN(I_MLWIN), AIN(I_MLBG), (float*)(ws + WS_GATES));
        else norm_phase<false>(F, HLAT(), layer != 0, (float*)(ws + WS_HC), (const float*)(ws + BG_SLAB), layer == 0 ? 0 : 11, MT, AIN(I_NMIX) + layer * 1024, MODP(), 0, 1024, (bf16*)(ws + WS_XN), nullptr, nullptr, nullptr);
        GRID_BAR();
        PHASE();
        { const int nin = (layer == 0 || layer == 2) ? 1536 : 3072;
          GEMM_BF16(ws + WS_XN, ws + LB(), MT, nin, 1024, ws + BG_RAW, nin); }
        GRID_BAR();
        if (layer == 0) {
            PHASE();
            bool fast_w;
            { const float* gq_ = AIN(I_WINQN); const float* gk_ = AIN(I_WINKN);
              const float gqm = wave_max(fabsf(gq_[F.lane]), F.lane), gkm = wave_max(fabsf(gk_[F.lane]), F.lane);
              fast_w = __builtin_amdgcn_readfirstlane((11.55f * gqm * gkm <= 80.f) ? 1 : 0) != 0; }
            if (fast_w) knorm_rope64(F, (const bf16*)(ws + BG_RAW), AIN(I_WINKN), (const float*)(ws + WS_ROPE64), (bf16*)(ws + BG_K));
            else qknorm_rope64(F, (const bf16*)(ws + BG_RAW), AIN(I_WINQN), AIN(I_WINKN), (const float*)(ws + WS_ROPE64), (bf16*)(ws + BG_Q), (bf16*)(ws + BG_K));
            GRID_BAR();
            PHASE();
            for (int i_ = 0; i_ < 9; ++i_) {
                int u;
                if (F.G == 256) { if (i_ < 8) { const int x = bid & 7, li = 32 * i_ + (bid >> 3), pg = 2 * x + (li >> 7); u = (pg >> 2) * 512 + ((pg & 3) * 4 + ((li >> 5) & 3)) * 32 + (li & 31); }
                                  else { if (bid >= 64) break; u = 2048 + bid; } }
                else { u = bid + i_ * F.G; if (u >= 2048 + 64) break; }
                const bf16* Qp = (const bf16*)(ws + BG_Q); const bf16* Kp = (const bf16*)(ws + BG_K); const bf16* RAW = (const bf16*)(ws + BG_RAW); bf16* Ob = (bf16*)(ws + BG_O);
                const bool cq = u >= 2048; const int v = cq ? u - 2048 : u, qb = cq ? 0 : (v & 31), h = cq ? (v & 15) : ((v >> 5) & 15), b = cq ? (v >> 4) : (v >> 9);
                if (fast_w) win_attn_unit<true>(F, cq, b, h, qb, RAW, Kp, RAW, Ob, AIN(I_WINSINK)[h], ldsc, AIN(I_WINQN), (const float*)(ws + WS_ROPE64));
                else win_attn_unit<false>(F, cq, b, h, qb, Qp, Kp, RAW, Ob, AIN(I_WINSINK)[h], ldsc, AIN(I_WINQN), (const float*)(ws + WS_ROPE64));
            }
        } else if (layer == 1) {
            PHASE();
            sconv_phase(F, (const bf16*)(ws + BG_RAW), AIN(I_SCCONV), (bf16*)(ws + BG_O));
        } else if (layer == 2) {
            PHASE();
            bool fast_sm;
            { const float* gq_ = AIN(I_AXQN); const float* gk_ = AIN(I_AXKN);
              const float gqm = wave_max(fmaxf(fabsf(gq_[F.lane]), fabsf(gq_[F.lane + 64])), F.lane), gkm = wave_max(fmaxf(fabsf(gk_[F.lane]), fabsf(gk_[F.lane + 64])), F.lane);
              fast_sm = __builtin_amdgcn_readfirstlane((16.33f * gqm * gkm <= 80.f) ? 1 : 0) != 0; }
            if (fast_sm) knorm_rope128(F, (const bf16*)(ws + BG_RAW), AIN(I_AXKN), (const float*)(ws + WS_ROPE128), (bf16*)(ws + BG_K), (bf16*)(ws + BG_V));
            else qknorm_rope128(F, (const bf16*)(ws + BG_RAW), AIN(I_AXQN), AIN(I_AXKN), (const float*)(ws + WS_ROPE128), (bf16*)(ws + BG_Q), (bf16*)(ws + BG_K), (bf16*)(ws + BG_V));
            GRID_BAR();
            PHASE();
            for (int i_ = 0; i_ < 5; ++i_) {
                int u;
                if (F.G == 256) { if (i_ < 4) { const int x = bid & 7, j_ = (bid >> 3) + 32 * i_; u = ((x >> 1) * 8 + (x & 1) * 4 + (j_ >> 5)) * 32 + (j_ & 31); } else { if (bid >= 32) break; u = 1024 + bid; } }
                else { u = bid + i_ * F.G; if (u >= 1024 + 32) break; }
                const unsigned short* Qp = (const unsigned short*)(ws + BG_Q); const unsigned short* K2 = (const unsigned short*)(ws + BG_K); const unsigned short* V2 = (const unsigned short*)(ws + BG_V); unsigned short* Ob = (unsigned short*)(ws + BG_O);
                unsigned qoff, kvo, qraw; int seq_, t0_;
                if (u < 1024) { const int qb = u & 31, h = (u >> 5) & 7, b = u >> 8; qoff = (unsigned)(b * SEQ + qb * 256) * 1024u + h * 128; qraw = (unsigned)(b * SEQ + qb * 256) * 1536u + h * 128; t0_ = qb * 256;
                                kvo = (unsigned)b * (8448u * 256u) + (h >> 2) * 128; seq_ = 8448; }
                else { const int v = u - 1024, h = v & 7, b = v >> 3; qoff = (unsigned)(ML + b * CTXL) * 1024u + h * 128; qraw = (unsigned)(ML + b * CTXL) * 1536u + h * 128; t0_ = 0;
                       kvo = ((unsigned)b * 8448u + 8192u) * 256u + (h >> 2) * 128; seq_ = 256; }
                qoff = __builtin_amdgcn_readfirstlane(qoff); kvo = __builtin_amdgcn_readfirstlane(kvo); seq_ = __builtin_amdgcn_readfirstlane(seq_); qraw = __builtin_amdgcn_readfirstlane(qraw); t0_ = __builtin_amdgcn_readfirstlane(t0_);
                const int tid_ = (F.wave << 6) | xb_lane();
                if (fast_sm) exf::attn_dense_body<exf::bf16>((const unsigned short*)(ws + BG_RAW) + qraw, K2 + kvo, V2 + kvo, Ob + qoff, seq_, (char*)F.lds, tid_, AIN(I_AXQN), (const float*)(ws + WS_ROPE128), t0_, u < 1024);
                else exd::attn_dense_body<exd::bf16>(Qp + qoff, K2 + kvo, V2 + kvo, Ob + qoff, seq_, (char*)F.lds, tid_);
                __syncthreads();
            }
        } else {
            PHASE();
            { v4u kq_[4], vq_[8]; float gt_[4] = {0.f, 0.f, 0.f, 0.f}; int u = bid;
#pragma unroll
              for (int i_ = 0; i_ < 4; ++i_) kq_[i_] = (v4u){0u, 0u, 0u, 0u};
#pragma unroll
              for (int i_ = 0; i_ < 8; ++i_) vq_[i_] = (v4u){0u, 0u, 0u, 0u};
              if (u < ML_NUID) ml1_load(F, ml1_uid(u), (const bf16*)(ws + BG_RAW), (const float*)(ws + WS_GATES), kq_, vq_, gt_);
              for (; u < ML_NUID; u += F.G) ml1_unit(F, ml1_uid(u), u + F.G < ML_NUID ? ml1_uid(u + F.G) : ML_NUID, (const bf16*)(ws + BG_RAW), (const float*)(ws + WS_GATES), (bf16*)(ws + BG_CBAR), (float*)(ws + BG_NBAR), (float*)(ws + BG_MSC), ldsc, kq_, vq_, gt_); }
            GRID_BAR();
            PHASE();
            for (int s = bid; s < 256; s += F.G) ml2_scan(F, s, (bf16*)(ws + BG_CBAR), (float*)(ws + BG_NBAR), (float*)(ws + BG_MSC), ldsc);
            GRID_BAR();
            PHASE();
            { bf16x8 qr_[8]; v4u kq_[4]; float gt_[5] = {0.f, 0.f, 0.f, 0.f, 0.f}, nbv_ = 0.f;
#pragma unroll
              for (int i_ = 0; i_ < 8; ++i_) qr_[i_] = bf16x8{};
#pragma unroll
              for (int i_ = 0; i_ < 4; ++i_) kq_[i_] = (v4u){0u, 0u, 0u, 0u};
              int u = bid;
              if (u < 2048) ml3_load(F, ml3_uid(u), (const bf16*)(ws + BG_RAW), (const float*)(ws + WS_GATES), (const float*)(ws + BG_MSC), (const float*)(ws + BG_NBAR), qr_, kq_, gt_, nbv_);
              for (; u < 2048; u += F.G) { const int sid = u >> 6, un = u + F.G;
                ml3_unit(F, ml3_uid(u), un < 2048 ? ml3_uid(un) : -1, (const bf16*)(ws + BG_RAW), (const float*)(ws + WS_GATES), (const bf16*)(ws + BG_CBAR), (const float*)(ws + BG_NBAR),
                         (const float*)(ws + BG_MSC), (sid & 1) ? (bf16*)(ws + WS_HB) : (bf16*)(ws + WS_HF), ldsc, qr_, kq_, gt_, nbv_); } }
            GRID_BAR();
            PHASE();
            mln_phase(F, (bf16*)(ws + WS_HF), (const bf16*)(ws + WS_HB), (const bf16*)(ws + BG_RAW), AIN(I_MLHN));
        }
        GRID_BAR();
        PHASE();
        GEMM_RESID(layer == 3 ? ws + WS_HF : ws + BG_O, ws + LB() + SZIN(), ROWS_OUT(), 1024, HLAT(), HCTX(), HMID(), (float*)(ws + BG_SLAB), MODP() + 2048, 0, layer != 0, true);
        GRID_BAR();
        PHASE();
        norm_phase<false>(F, HMID(), true, (float*)(ws + WS_HC), (const float*)(ws + BG_SLAB), layer == 3 ? 0 : 4, ROWS_OUT(), AIN(I_NFFN) + layer * 1024, MODP(), 3072, 4096, (bf16*)(ws + WS_XN), nullptr, nullptr, nullptr);
        GRID_BAR();
        PHASE();
        { pg8::Gemm g_{(const pg8::bf16_t*)(ws + WS_XN), (const pg8::bf16_t*)(ws + LB() + SZIN() + SZ_W1024), ROWS_OUT(), NUP, 1024}; SOrd S_; S_.init(ROWS_OUT(), NUP, F.G, bid);
          pg8::EpiConvAct E_{(pg8::bf16_t*)(ws + BG_ACT), (float*)(ws + BG_HALO), AIN(I_FCONV) + (size_t)layer * 3 * NUP, (LAS float*)(F.lds + XB_OFF)};
          pg8::gemm_phase<pg8::EpiConvAct, SOrd, true, true>(F.lds, g_, S_, E_, F.tid); }
        GRID_BAR();
        PHASE();
        { SOrd S_; S_.init(ML, 1024, F.G, bid); pg8::Unit u_;
          for (int i_ = 0; S_.next(i_, u_); ++i_) ffn_fixup(F, u_.pm, (const float*)(ws + BG_HALO), AIN(I_FCONV) + (size_t)layer * 3 * NUP, (bf16*)(ws + BG_ACT));
          asm volatile("s_waitcnt vmcnt(0)" ::: "memory"); __syncthreads(); }
        GEMM_RESID(ws + BG_ACT, ws + LB() + SZIN() + SZ_W1024 + SZ_UP, ROWS_OUT(), DFF, HMID(), (const float*)(ws + WS_HC), layer == 3 ? (void*)ap->out : HB_B(), (float*)(ws + BG_SLAB), MODP() + 5120, 0, true, layer != 3);
        GRID_BAR();
    }
}

extern "C" void kernel_launch(void* const* d_in, const int* in_sizes, int n_in, void* d_out, int out_size, void* d_ws, size_t ws_size, hipStream_t stream) {
    static int grid = 0;
    if (grid == 0) {
        if (n_in != 27 || out_size != ML * DM || ws_size < WS_END) { fprintf(stderr, "kernel_launch: unexpected shapes: n_in %d out %d ws %zu (need %zu)\n", n_in, out_size, ws_size, (size_t)WS_END); grid = -1; return; }
        int dev = 0, cus = 0;
        if (hipGetDevice(&dev) != hipSuccess || hipDeviceGetAttribute(&cus, hipDeviceAttributeMultiprocessorCount, dev) != hipSuccess) { grid = -1; return; }
        if (hipFuncSetAttribute((const void*)hybrid_fwd, hipFuncAttributeMaxDynamicSharedMemorySize, LDS_BYTES) != hipSuccess) { fprintf(stderr, "kernel_launch: hipFuncSetAttribute failed\n"); grid = -1; return; }
        int per_cu = 0;
        if (hipOccupancyMaxActiveBlocksPerMultiprocessor(&per_cu, (const void*)hybrid_fwd, NWAVES * 64, LDS_BYTES) != hipSuccess || per_cu < 1) { fprintf(stderr, "kernel_launch: occupancy query reports %d\n", per_cu); }
        (void)hipGetLastError();
        grid = cus;
    }
    if (grid < 0) return;
    if (hipMemsetAsync((char*)d_ws + WS_CTL, 0, CTL_ZERO_BYTES, stream) != hipSuccess) return;
    Args a{};
    for (int i = 0; i < 27; ++i) a.in[i] = (const float*)d_in[i];
    a.out = (float*)d_out; a.ws = (unsigned char*)d_ws;
    hipLaunchKernelGGL(hybrid_fwd, dim3(grid), dim3(NWAVES * 64), LDS_BYTES, stream, a);
}
```

```cpp
#include <hip/hip_runtime.h>
#include <cstdio>
#include <cstdint>
namespace pg8 {
#define PG8_LAS __attribute__((address_space(3)))
typedef unsigned short bf16_t;
typedef short bf16x8 __attribute__((ext_vector_type(8)));
typedef float f32x4 __attribute__((ext_vector_type(4)));
typedef unsigned u32x4 __attribute__((ext_vector_type(4)));
constexpr int BM = 256, BK = 64, HALF = 128, HTB = HALF * BK * 2  , STAGE_BYTES = 8 * HTB, NXCD = 8, WGM = 8;

__host__ __device__ __forceinline__ int lds_byte(int r, int c) { const int st = (r >> 4) * 2 + (c >> 5), rr = r & 15, cc = c & 31, ob = rr * 64 + cc * 2; return st * 1024 + (ob ^ (((ob >> 9) & 1) << 5)); }
__host__ __device__ __forceinline__ void stage_rc(int b, int& R, int& C) { const int st = b / 1024, sb = b % 1024, swz = sb ^ (((sb >> 9) & 1) << 5); R = (st >> 1) * 16 + swz / 64; C = (st & 1) * 32 + (swz % 64) / 2; }
__host__ __device__ __forceinline__ int perm32(int rho) { const int n = rho >> 4, i = rho & 15; return 8 * (i >> 2) + 4 * n + (i & 3); }

struct Unit { int pm, pn, ko, nt; };
struct Gemm { const bf16_t* A; const bf16_t* Bt; int M, N, K; };

struct StaticOrder {
    int nM, nN, nwg, G, c;
    __host__ __device__ __forceinline__ void init(int M, int N, int G_, int c_) { nM = M / BM; nN = N / BM; nwg = nM * nN; G = G_; c = c_; }
    __host__ __device__ __forceinline__ bool next(int i, Unit& u) const {
        const long L = (long)i * G + c; if (L >= nwg) return false;
        int wgid = (int)L; { const int q = nwg / NXCD, r = nwg % NXCD, xcd = wgid % NXCD, off = wgid / NXCD; wgid = (xcd < r ? xcd * (q + 1) : r * (q + 1) + (xcd - r) * q) + off; }
        const int nig = WGM * nN, gid = wgid / nig, fm = gid * WGM, gsz = (nM - fm) < WGM ? (nM - fm) : WGM;
        u.pm = fm + ((wgid % nig) % gsz); u.pn = (wgid % nig) / gsz; u.ko = 0; u.nt = 0; return true;
    }
    __device__ __forceinline__ void a_ready(const Unit&) const {}
    __device__ __forceinline__ void done(const Unit&) const {}
};

__device__ __forceinline__ unsigned cvt_pk_bf16(float lo, float hi) { typedef float f32x2cv_ __attribute__((ext_vector_type(2))); typedef __bf16 bf16x2cv_ __attribute__((ext_vector_type(2))); const f32x2cv_ v_ = {lo, hi}; const bf16x2cv_ b_ = __builtin_convertvector(v_, bf16x2cv_); return __builtin_bit_cast(unsigned, b_); }
typedef float f32x2 __attribute__((ext_vector_type(2)));
struct EpiStoreBf16 {
    static constexpr bool PERM = true, AFTER_DRAIN = false, PERMA = false;
    bf16_t* O; int ldc;
    __device__ __forceinline__ void operator()(const f32x4 (&acc)[2][2][4][2], const Unit& u, int wr, int wc, int fr, int fq) const {
        const int row0 = u.pm * BM + wr * 64 + fr, col0 = u.pn * BM + wc * 32 + 8 * fq;
#pragma unroll
        for (int ai = 0; ai < 2; ++ai)
#pragma unroll
            for (int m = 0; m < 4; ++m) { bf16_t* rowp = O + (size_t)(row0 + ai * HALF + m * 16) * ldc + col0;
#pragma unroll
                for (int bj = 0; bj < 2; ++bj) { const f32x4 v0 = acc[ai][bj][m][0], v1 = acc[ai][bj][m][1];
                    u32x4 w; w.x = cvt_pk_bf16(v0[0], v0[1]); w.y = cvt_pk_bf16(v0[2], v0[3]); w.z = cvt_pk_bf16(v1[0], v1[1]); w.w = cvt_pk_bf16(v1[2], v1[3]);
                    *(u32x4*)(rowp + bj * HALF) = w; } }
    }
};
struct CtxSplitOrder {
    StaticOrder lat; int nlat, nsub, G, c;
    __device__ __forceinline__ void init(int K, bool with_ctx, int G_, int c_) { lat.init(128 * BM, 1024, G_, c_); nlat = 128 * 4; nsub = with_ctx ? 16 * (K / 256) : 0; G = G_; c = c_; }
    __device__ __forceinline__ bool next(int i, Unit& u) const {
        const int L = i * G + c;
        if (L < nlat) return lat.next(i, u);
        const int s = L - nlat; if (s >= nsub) return false;
        u.pm = 128 + (s & 3); u.pn = (s >> 2) & 3; u.ko = (s >> 4) * 256; u.nt = 4; return true;
    }
    __device__ __forceinline__ void a_ready(const Unit&) const {}
    __device__ __forceinline__ void done(const Unit&) const {}
};
struct EpiResid {
    static constexpr bool PERM = true, AFTER_DRAIN = false, PERMA = false;
    const void* base_lat; const float* base_ctx; void* out_lat; float* out_ctx; const float* gate; int tile0; bool bin, bout;
    template <bool BIN, bool BOUT>
    __device__ __forceinline__ void body(const f32x4 (&acc)[2][2][4][2], const void* bp_, void* op_, const float* gp, int wr, int fr) const {
        f32x4 g[2][2];
#pragma unroll
        for (int bj = 0; bj < 2; ++bj)
#pragma unroll
            for (int n = 0; n < 2; ++n) g[bj][n] = *(const f32x4*)(gp + bj * HALF + n * 4);
        if constexpr (BIN) {
            u32x4 rb[8][2];
#define RB_LOAD(it_) do { _Pragma("unroll") for (int bj = 0; bj < 2; ++bj) rb[it_][bj] = *(const u32x4*)((const bf16_t*)bp_ + (size_t)(((it_) >> 2) * HALF + wr * 64 + ((it_) & 3) * 16 + fr) * 1024 + bj * HALF); } while (0)
            RB_LOAD(0); RB_LOAD(1); RB_LOAD(2); RB_LOAD(3); RB_LOAD(4);
#pragma unroll
            for (int it = 0; it < 8; ++it) { const int ai = it >> 2, m = it & 3; const size_t off = (size_t)(ai * HALF + wr * 64 + m * 16 + fr) * 1024;
#pragma unroll
                for (int bj = 0; bj < 2; ++bj) { const size_t o = off + bj * HALF; const u32x4 w = rb[it][bj];
                    const f32x4 b0 = (f32x4){__uint_as_float(w.x << 16), __uint_as_float(w.x & 0xffff0000u), __uint_as_float(w.y << 16), __uint_as_float(w.y & 0xffff0000u)};
                    const f32x4 b1 = (f32x4){__uint_as_float(w.z << 16), __uint_as_float(w.z & 0xffff0000u), __uint_as_float(w.w << 16), __uint_as_float(w.w & 0xffff0000u)};
                    const f32x4 r0 = b0 + g[bj][0] * acc[ai][bj][m][0], r1 = b1 + g[bj][1] * acc[ai][bj][m][1];
                    if (BOUT) { u32x4 w2; w2.x = cvt_pk_bf16(r0[0], r0[1]); w2.y = cvt_pk_bf16(r0[2], r0[3]); w2.z = cvt_pk_bf16(r1[0], r1[1]); w2.w = cvt_pk_bf16(r1[2], r1[3]); *(u32x4*)((bf16_t*)op_ + o) = w2; }
                    else { *(f32x4*)((float*)op_ + o) = r0; *(f32x4*)((float*)op_ + o + 4) = r1; } }
                if (it + 5 < 8) RB_LOAD(it + 5);
                __builtin_amdgcn_sched_barrier(0); }
#undef RB_LOAD
        } else {
#pragma unroll
            for (int ai = 0; ai < 2; ++ai)
#pragma unroll
                for (int m = 0; m < 4; ++m) { const size_t off = (size_t)(ai * HALF + wr * 64 + m * 16 + fr) * 1024;
#pragma unroll
                    for (int bj = 0; bj < 2; ++bj) { const size_t o = off + bj * HALF;
                        const f32x4 b0 = *(const f32x4*)((const float*)bp_ + o), b1 = *(const f32x4*)((const float*)bp_ + o + 4);
                        const f32x4 r0 = b0 + g[bj][0] * acc[ai][bj][m][0], r1 = b1 + g[bj][1] * acc[ai][bj][m][1];
                        if (BOUT) { u32x4 w2; w2.x = cvt_pk_bf16(r0[0], r0[1]); w2.y = cvt_pk_bf16(r0[2], r0[3]); w2.z = cvt_pk_bf16(r1[0], r1[1]); w2.w = cvt_pk_bf16(r1[2], r1[3]); *(u32x4*)((bf16_t*)op_ + o) = w2; }
                        else { *(f32x4*)((float*)op_ + o) = r0; *(f32x4*)((float*)op_ + o + 4) = r1; } }
                    asm volatile("" ::: "memory"); }
        }
    }
    __device__ __forceinline__ void operator()(const f32x4 (&acc)[2][2][4][2], const Unit& u, int wr, int wc, int fr, int fq) const {
        asm volatile("" : "+v"(fr), "+v"(fq));
        const int tile = tile0 + u.pm; const bool lat = tile < 128; const int mb = lat ? (tile >> 5) : 4;
        const int col0 = u.pn * BM + wc * 32 + 8 * fq;
        const size_t toff = (lat ? (size_t)tile : (size_t)(tile - 128)) * (256 * 1024) + col0;
        const float* gp = gate + mb * 6144 + col0;
        if (!lat) {
            f32x4 g[2][2];
#pragma unroll
            for (int bj = 0; bj < 2; ++bj)
#pragma unroll
                for (int n = 0; n < 2; ++n) g[bj][n] = *(const f32x4*)(gp + bj * HALF + n * 4);
            float* op = out_ctx + (size_t)(u.ko >> 8) * (1024 * 1024) + toff;
#pragma unroll
            for (int ai = 0; ai < 2; ++ai)
#pragma unroll
                for (int m = 0; m < 4; ++m) { const size_t off = (size_t)(ai * HALF + wr * 64 + m * 16 + fr) * 1024;
#pragma unroll
                    for (int bj = 0; bj < 2; ++bj)
#pragma unroll
                        for (int n = 0; n < 2; ++n) *(f32x4*)(op + off + bj * HALF + n * 4) = g[bj][n] * acc[ai][bj][m][n]; }
        }
        else if (bin && bout) body<true, true>(acc, (const bf16_t*)base_lat + toff, (bf16_t*)out_lat + toff, gp, wr, fr);
        else if (bout) body<false, true>(acc, (const float*)base_lat + toff, (bf16_t*)out_lat + toff, gp, wr, fr);
        else body<true, false>(acc, (const bf16_t*)base_lat + toff, (float*)out_lat + toff, gp, wr, fr);
    }
};
struct EpiConvAct {
    static constexpr bool PERM = true, AFTER_DRAIN = false, PERMA = true;
    bf16_t* ACT; float* HALO; const float* cw; PG8_LAS float* XB;
    __device__ __forceinline__ void operator()(const f32x4 (&acc)[2][2][4][2], const Unit& u, int wr, int wc, int fr, int fq) const {
        { int l_; asm volatile("v_mbcnt_lo_u32_b32 %0, -1, 0\n\tv_mbcnt_hi_u32_b32 %0, -1, %0" : "=v"(l_)); fr = l_ & 15; fq = l_ >> 4; }
        const int lane = fq * 16 + fr, cloc = wc * 32 + 8 * fq;
        const int chan = u.pn * 128 + cloc;
#pragma unroll
        for (int ai = 0; ai < 2; ++ai) { const int k = 2 * ai + wr;
            if (fr == 0 || fr == 15) { const int slot = 2 * k + (fr == 15 ? 1 : 0), m = fr == 15 ? 3 : 0;
#pragma unroll
                for (int bj = 0; bj < 2; ++bj)
#pragma unroll
                    for (int n = 0; n < 2; ++n) *(PG8_LAS f32x4*)(XB + slot * 256 + bj * 128 + cloc + 4 * n) = (m == 0) ? acc[ai][bj][0][n] : acc[ai][bj][3][n]; } }
        if ((wr == 0 && fr == 0) || (wr == 1 && fr == 15)) { float* hp = HALO + ((size_t)u.pm * 4 + (wr == 0 ? 0 : 2)) * 5632 + chan;
#pragma unroll
            for (int bj = 0; bj < 2; ++bj)
#pragma unroll
                for (int n = 0; n < 2; ++n) { *(f32x4*)(hp + bj * 2816 + 4 * n) = (wr == 0) ? acc[0][bj][0][n] : acc[1][bj][2][n]; *(f32x4*)(hp + 5632 + bj * 2816 + 4 * n) = (wr == 0) ? acc[0][bj][1][n] : acc[1][bj][3][n]; } }
        asm volatile("s_waitcnt lgkmcnt(0)" ::: "memory"); __builtin_amdgcn_s_barrier(); asm volatile("" ::: "memory");
        const int ldn = ((lane & 48) | ((fr + 15) & 15)) << 2, lup = ((lane & 48) | ((fr + 1) & 15)) << 2;
        f32x4 w[2][3][2];
#pragma unroll
        for (int n = 0; n < 2; ++n)
#pragma unroll
            for (int t = 0; t < 3; ++t)
#pragma unroll
                for (int bj = 0; bj < 2; ++bj) w[n][t][bj] = *(const f32x4*)(cw + t * 5632 + bj * 2816 + chan + 4 * n) * (bj == 0 ? -1.4426950408889634f : -0.6931471805599453f);
#pragma unroll
        for (int ai = 0; ai < 2; ++ai) { const int k = 2 * ai + wr;
#pragma unroll
            for (int m = 0; m < 4; ++m) {
                u32x4 o;
#pragma unroll
                for (int n = 0; n < 2; ++n) {
                    f32x4 y[2];
#pragma unroll
                    for (int bj = 0; bj < 2; ++bj) {
                        const f32x4 x = acc[ai][bj][m][n];
                        f32x4 prev, next;
                        if (m > 0) prev = acc[ai][bj][m > 0 ? m - 1 : 0][n];
                        else { const f32x4 t3 = acc[ai][bj][3][n];
#pragma unroll
                            for (int e = 0; e < 4; ++e) prev[e] = __int_as_float(__builtin_amdgcn_ds_bpermute(ldn, __float_as_int(t3[e])));
                            f32x4 xb = (f32x4){0.f, 0.f, 0.f, 0.f}; if (k > 0) xb = *(const PG8_LAS f32x4*)(XB + (2 * k - 1) * 256 + bj * 128 + cloc + 4 * n); if (fr == 0) prev = xb; }
                        if (m < 3) next = acc[ai][bj][m < 3 ? m + 1 : 3][n];
                        else { const f32x4 t0 = acc[ai][bj][0][n];
#pragma unroll
                            for (int e = 0; e < 4; ++e) next[e] = __int_as_float(__builtin_amdgcn_ds_bpermute(lup, __float_as_int(t0[e])));
                            f32x4 xb = (f32x4){0.f, 0.f, 0.f, 0.f}; if (k < 3) xb = *(const PG8_LAS f32x4*)(XB + (2 * k + 2) * 256 + bj * 128 + cloc + 4 * n); if (fr == 15) next = xb; }
                        y[bj] = w[n][0][bj] * prev + w[n][1][bj] * x + w[n][2][bj] * next;
                    }
                    float a[4];
#pragma unroll
                    for (int e = 0; e < 4; ++e) a[e] = y[0][e] * __builtin_amdgcn_rcpf(1.f + __builtin_amdgcn_exp2f(y[0][e])) * y[1][e];
                    if (n == 0) { o.x = cvt_pk_bf16(a[0], a[1]); o.y = cvt_pk_bf16(a[2], a[3]); } else { o.z = cvt_pk_bf16(a[0], a[1]); o.w = cvt_pk_bf16(a[2], a[3]); }
                }
                *(u32x4*)(ACT + (size_t)(u.pm * BM + ai * HALF + wr * 64 + fr * 4 + m) * 2816 + chan) = o;
            }
        }
    }
};
template <class Epi, class Sched, bool ALIGN_EPI = false, bool SP2 = false>
__device__ __forceinline__ void gemm_phase(PG8_LAS unsigned char* lds, const Gemm g, const Sched& S, const Epi& E, const int tid) {
    const int wid = __builtin_amdgcn_readfirstlane(tid >> 6), lane = tid & 63, wr = wid >> 2, wc = wid & 3, fr = lane & 15, fq = lane >> 4;
    const int K = g.K;
    unsigned voffA[2], voffB[2];
#pragma unroll
    for (int i = 0; i < 2; ++i) { int R, C; stage_rc(tid * 16 + i * 8192, R, C); const int Rb = Epi::PERM ? ((R & ~31) + perm32(R & 31)) : R;
        const int Ra = Epi::PERMA ? ((R & ~63) + ((R & 15) << 2) + ((R >> 4) & 3)) : R;
        voffA[i] = (unsigned)(Ra * K + C) * 2u; voffB[i] = (unsigned)(Rb * K + C) * 2u; }
    const size_t kstep = (size_t)(BK * 2);
    const size_t hstep = (size_t)HALF * K * 2;
    const size_t tstep = 2 * hstep;
    const unsigned ldsw = (unsigned)wid * 1024u;
    const int aoff = lds_byte(wr * 64 + fr, fq * 8), boff = lds_byte(wc * 32 + fr, fq * 8);
#define PG8_SA(b, h) (((b) * 2 + (h)) * HTB)
#define PG8_SB(b, h) ((4 + (b) * 2 + (h)) * HTB)
#define PG8_STAGE(bufoff, gbase, voff) do { _Pragma("unroll") for (int _i = 0; _i < 2; ++_i) \
        __builtin_amdgcn_global_load_lds((const unsigned*)((const char*)(gbase) + (voff)[_i]), (PG8_LAS unsigned*)(lds + (bufoff) + ldsw + _i * 8192), 16, 0, 0); } while (0)
#define PG8_LDA(dst, b, h) do { _Pragma("unroll") for (int m = 0; m < 4; ++m) _Pragma("unroll") for (int k = 0; k < 2; ++k) dst[m][k] = *(const PG8_LAS bf16x8*)(lds + PG8_SA(b, h) + aoff + m * 2048 + k * 1024); } while (0)
#define PG8_LDB(dst, b, h) do { _Pragma("unroll") for (int n = 0; n < 2; ++n) _Pragma("unroll") for (int k = 0; k < 2; ++k) dst[n][k] = *(const PG8_LAS bf16x8*)(lds + PG8_SB(b, h) + boff + n * 2048 + k * 1024); } while (0)
#define PG8_MMA(ai, bj, At, Bt) do { __builtin_amdgcn_s_setprio(1); _Pragma("unroll") for (int m = 0; m < 4; ++m) _Pragma("unroll") for (int n = 0; n < 2; ++n) _Pragma("unroll") for (int k = 0; k < 2; ++k) \
        acc[ai][bj][m][n] = __builtin_amdgcn_mfma_f32_16x16x32_bf16(Bt[n][k], At[m][k], acc[ai][bj][m][n], 0, 0, 0); __builtin_amdgcn_s_setprio(0); } while (0)
#define PG8_WAIT_V(n) asm volatile("s_waitcnt vmcnt(" #n ")" ::: "memory")
#define PG8_WAIT_L(n) asm volatile("s_waitcnt lgkmcnt(" #n ")" ::: "memory")
#define PG8_BAR __builtin_amdgcn_s_barrier()
#define PG8_SCHED __builtin_amdgcn_sched_barrier(0)
    Unit cur, nxt; int ui = 0;
    if (!S.next(0, cur)) return;
    f32x4 acc[2][2][4][2];
#pragma unroll
    for (int a = 0; a < 2; ++a)
#pragma unroll
        for (int b = 0; b < 2; ++b)
#pragma unroll
            for (int m = 0; m < 4; ++m)
#pragma unroll
                for (int n = 0; n < 2; ++n) acc[a][b][m][n] = (f32x4){0.f, 0.f, 0.f, 0.f};
    bf16x8 At[4][2], B0[2][2], B1[2][2];
    const char* cA = (const char*)g.A + (size_t)cur.pm * tstep + (size_t)cur.ko * 2; const char* cB = (const char*)g.Bt + (size_t)cur.pn * tstep + (size_t)cur.ko * 2;
    S.a_ready(cur);
    if constexpr (SP2) {
        PG8_STAGE(PG8_SB(0, 0), cB, voffB); PG8_STAGE(PG8_SB(0, 1), cB + hstep, voffB); PG8_STAGE(PG8_SA(0, 0), cA, voffA); PG8_STAGE(PG8_SA(0, 1), cA + hstep, voffA);
        if (wr == 1) PG8_BAR;
        PG8_WAIT_V(2); PG8_BAR;
        PG8_STAGE(PG8_SB(1, 0), cB + kstep, voffB); PG8_STAGE(PG8_SA(1, 0), cA + kstep, voffA); PG8_STAGE(PG8_SB(1, 1), cB + hstep + kstep, voffB);
        PG8_WAIT_V(6); PG8_BAR;
    } else {
        PG8_STAGE(PG8_SB(0, 0), cB, voffB); PG8_STAGE(PG8_SA(0, 0), cA, voffA); PG8_STAGE(PG8_SB(0, 1), cB + hstep, voffB); PG8_STAGE(PG8_SA(0, 1), cA + hstep, voffA);
        if (wr == 1) PG8_BAR;
        PG8_WAIT_V(4); PG8_BAR;
        PG8_STAGE(PG8_SB(1, 0), cB + kstep, voffB); PG8_STAGE(PG8_SA(1, 0), cA + kstep, voffA); PG8_STAGE(PG8_SB(1, 1), cB + hstep + kstep, voffB);
        PG8_WAIT_V(6); PG8_BAR;
    }
    for (;;) {
        const bool has_next = S.next(ui + 1, nxt);
        const char* nA = has_next ? (const char*)g.A + (size_t)nxt.pm * tstep + (size_t)nxt.ko * 2 : cA; const char* nB = has_next ? (const char*)g.Bt + (size_t)nxt.pn * tstep + (size_t)nxt.ko * 2 : cB;
        const int nt = cur.nt ? cur.nt : K / BK;
        for (int t = 0; t < nt; t += 2) {
            const bool last = (t == nt - 2);
            const char* a1 = cA + (size_t)(t + 1) * kstep;
            const char* a2 = last ? nA : cA + (size_t)(t + 2) * kstep; const char* b2 = last ? nB : cB + (size_t)(t + 2) * kstep;
            const char* a3 = a2 + kstep; const char* b3 = b2 + kstep;
            if (last && has_next) S.a_ready(nxt);
            if constexpr (SP2) {
            PG8_LDB(B0, 0, 0); PG8_LDB(B1, 0, 1); PG8_SCHED; PG8_LDA(At, 0, 0); PG8_STAGE(PG8_SA(1, 1), a1 + hstep, voffA);
            PG8_WAIT_V(8); PG8_WAIT_L(0); PG8_BAR; PG8_MMA(0, 0, At, B0); PG8_MMA(0, 1, At, B1); PG8_BAR; PG8_SCHED;
            PG8_LDA(At, 0, 1); PG8_STAGE(PG8_SB(0, 0), b2, voffB); PG8_STAGE(PG8_SB(0, 1), b2 + hstep, voffB); PG8_STAGE(PG8_SA(0, 0), a2, voffA);
            PG8_WAIT_V(8); PG8_WAIT_L(0); PG8_BAR; PG8_MMA(1, 0, At, B0); PG8_MMA(1, 1, At, B1); PG8_BAR; PG8_SCHED;
            PG8_LDB(B0, 1, 0); PG8_LDB(B1, 1, 1); PG8_SCHED; PG8_LDA(At, 1, 0); PG8_STAGE(PG8_SA(0, 1), a2 + hstep, voffA);
            PG8_WAIT_V(8); PG8_WAIT_L(0); PG8_BAR; PG8_MMA(0, 0, At, B0); PG8_MMA(0, 1, At, B1); PG8_BAR; PG8_SCHED;
            PG8_LDA(At, 1, 1); PG8_STAGE(PG8_SB(1, 0), b3, voffB); PG8_STAGE(PG8_SB(1, 1), b3 + hstep, voffB); PG8_STAGE(PG8_SA(1, 0), a3, voffA);
            PG8_WAIT_V(8); PG8_WAIT_L(0); PG8_BAR; PG8_MMA(1, 0, At, B0); PG8_MMA(1, 1, At, B1); PG8_BAR; PG8_SCHED;
            } else {
            PG8_LDB(B0, 0, 0); PG8_SCHED; PG8_LDA(At, 0, 0); PG8_STAGE(PG8_SA(1, 1), a1 + hstep, voffA);
            PG8_WAIT_L(8); PG8_BAR; PG8_WAIT_L(0); PG8_MMA(0, 0, At, B0); PG8_BAR; PG8_SCHED;
            PG8_LDB(B1, 0, 1); PG8_STAGE(PG8_SB(0, 0), b2, voffB);
            PG8_BAR; PG8_WAIT_L(0); PG8_MMA(0, 1, At, B1); PG8_BAR;
            PG8_LDA(At, 0, 1); PG8_STAGE(PG8_SA(0, 0), a2, voffA);
            PG8_BAR; PG8_WAIT_L(0); PG8_MMA(1, 0, At, B0); PG8_BAR; PG8_SCHED;
            PG8_STAGE(PG8_SB(0, 1), b2 + hstep, voffB);
            PG8_WAIT_V(6); PG8_BAR; PG8_MMA(1, 1, At, B1); PG8_BAR;
            PG8_LDB(B0, 1, 0); PG8_SCHED; PG8_LDA(At, 1, 0); PG8_STAGE(PG8_SA(0, 1), a2 + hstep, voffA);
            PG8_WAIT_L(8); PG8_BAR; PG8_WAIT_L(0); PG8_MMA(0, 0, At, B0); PG8_BAR; PG8_SCHED;
            PG8_LDB(B1, 1, 1); PG8_STAGE(PG8_SB(1, 0), b3, voffB);
            PG8_BAR; PG8_WAIT_L(0); PG8_MMA(0, 1, At, B1); PG8_BAR;
            PG8_LDA(At, 1, 1); PG8_STAGE(PG8_SA(1, 0), a3, voffA);
            PG8_BAR; PG8_WAIT_L(0); PG8_MMA(1, 0, At, B0); PG8_BAR; PG8_SCHED;
            PG8_STAGE(PG8_SB(1, 1), b3 + hstep, voffB);
            PG8_WAIT_V(6); PG8_BAR; PG8_MMA(1, 1, At, B1); PG8_BAR;
            }
        }
        if constexpr (ALIGN_EPI) { if (wr == 0) PG8_BAR; }
        if constexpr (!Epi::AFTER_DRAIN) { E(acc, cur, wr, wc, fr, fq); S.done(cur); }
        if (!has_next) break;
#pragma unroll
        for (int a = 0; a < 2; ++a)
#pragma unroll
            for (int b = 0; b < 2; ++b)
#pragma unroll
                for (int m = 0; m < 4; ++m)
#pragma unroll
                    for (int n = 0; n < 2; ++n) acc[a][b][m][n] = (f32x4){0.f, 0.f, 0.f, 0.f};
        cur = nxt; cA = nA; cB = nB; ++ui;
        if constexpr (ALIGN_EPI) { if (wr == 1) PG8_BAR; }
    }
    PG8_WAIT_V(0);
    if constexpr (!ALIGN_EPI) { if (wr == 0) PG8_BAR; }
    PG8_BAR;
    if constexpr (Epi::AFTER_DRAIN) { E.fused(acc, cur, wr, wc, fr, fq, lds, wid, lane); S.done(cur); }
#undef PG8_SA
#undef PG8_SB
#undef PG8_STAGE
#undef PG8_LDA
#undef PG8_LDB
#undef PG8_MMA
#undef PG8_WAIT_V
#undef PG8_WAIT_L
#undef PG8_BAR
#undef PG8_SCHED
}
}

constexpr int DM = 1024, NB = 4, SEQ = 8192, CTXL = 256, ML = NB * SEQ, MC = NB * CTXL, MT = ML + MC;
constexpr int DFF = 2816, NUP = 2 * DFF;
constexpr float EPS = 1e-6f;
constexpr int NWAVES = 8;
constexpr float LOG2E = 1.4426950408889634f;

constexpr size_t MiB = 1u << 20;
constexpr size_t WS_CTL = 0, CTL_ZERO_BYTES = 64 * 1024;
constexpr int CW_BAR = 1024;
constexpr size_t WS_MOD = 1 * MiB;
constexpr size_t WS_ROPE64 = 1 * MiB + 512 * 1024;
constexpr size_t WS_ROPE128 = WS_ROPE64 + 16384;
constexpr size_t WS_HC = 2 * MiB;
constexpr size_t WS_WT = 6 * MiB;
constexpr size_t SZ_UP = (size_t)NUP * DM * 2, SZ_DOWN = (size_t)DM * DFF * 2, SZ_W1536 = 1536u * 1024 * 2, SZ_W1024 = 1024u * 1024 * 2, SZ_W3072 = 3072u * 1024 * 2;
constexpr size_t SZ_LA = SZ_W1536 + SZ_W1024 + SZ_UP + SZ_DOWN, SZ_LB = SZ_W3072 + SZ_W1024 + SZ_UP + SZ_DOWN;
constexpr size_t WT_L0 = WS_WT, WT_L1 = WT_L0 + SZ_LA, WT_L2 = WT_L1 + SZ_LB, WT_L3 = WT_L2 + SZ_LA, WT_END = WT_L3 + SZ_LB;
static_assert(WT_END <= 98 * MiB, "weights");
constexpr size_t WS_XN = 98 * MiB;
constexpr size_t WS_GATES = 164 * MiB;
constexpr size_t WS_BIG = 168 * MiB;
constexpr size_t WS_END = 512 * MiB;
constexpr size_t BG_RAW = WS_BIG, BG_Q = WS_BIG + 100 * MiB, BG_K = WS_BIG + 166 * MiB, BG_V = WS_BIG + 183 * MiB, BG_O = WS_BIG + 200 * MiB;
constexpr size_t BG_CBAR = WS_BIG + 200 * MiB, BG_NBAR = WS_BIG + 332 * MiB, BG_MSC = WS_BIG + 334 * MiB;
constexpr size_t WS_HF = WS_XN, WS_HB = WS_WT;
static_assert((size_t)ML * 1024 * 2 <= WT_L3 - WS_WT, "HB fits below layer 3's weights");
constexpr size_t BG_ACT = WS_BIG, BG_HALO = WS_BIG + 184 * MiB;
constexpr size_t BG_SLAB = WS_BIG + 270 * MiB;
constexpr int XB_OFF = 135168;
constexpr int ML_NUID = 32 * 66;

constexpr int RING_BYTES = 131072, LDSCTL_OFF = RING_BYTES, MISC_OFF = LDSCTL_OFF + 320, LDS_BYTES = 147456;
#define GAS __attribute__((address_space(1)))
#define LAS __attribute__((address_space(3)))
typedef unsigned short bf16;
typedef unsigned v4u __attribute__((ext_vector_type(4)));
typedef float f32x4 __attribute__((ext_vector_type(4)));
typedef short bf16x8 __attribute__((ext_vector_type(8)));
typedef GAS unsigned gu32;
typedef GAS unsigned long long gu64;
#define RLX_AGENT __ATOMIC_RELAXED, __HIP_MEMORY_SCOPE_AGENT
#define LDS_WAIT() asm volatile("s_waitcnt lgkmcnt(0)" ::: "memory")
#define VM_WAIT() asm volatile("s_waitcnt vmcnt(0)" ::: "memory")
__device__ __forceinline__ unsigned long long rt() { return __builtin_amdgcn_s_memrealtime(); }
__device__ __forceinline__ unsigned f2bf(float f) { unsigned u = __builtin_bit_cast(unsigned, f); return (u + 0x7fffu + ((u >> 16) & 1u)) >> 16; }
__device__ __forceinline__ unsigned pk2(float lo, float hi) { return f2bf(lo) | (f2bf(hi) << 16); }

#define XB_TMO      128
#define XB_XCNT(j)  (256  + 64 * (j))
#define XB_XSUB(j)  (1280 + 64 * (j))
#define XB_XGEN(j)  (2304 + 64 * (j))
#define XB_TOP      3328
#define XB_TOPGEN   3392
#define XCD_BAR_WORDS 3456
#define XB_SPIN_CAP (1u << 18)

__device__ __forceinline__ unsigned xb_ld(unsigned* p)              { return __hip_atomic_load(p, __ATOMIC_RELAXED, __HIP_MEMORY_SCOPE_AGENT); }
__device__ __forceinline__ unsigned xb_add(unsigned* p, unsigned v) { return __hip_atomic_fetch_add(p, v, __ATOMIC_RELAXED, __HIP_MEMORY_SCOPE_AGENT); }
__device__ __forceinline__ unsigned xb_xcc_id() { return (unsigned)__builtin_amdgcn_s_getreg((3 << 11) | 20) & 0xFu; }
#define XB_SPIN(cond, bar) do { unsigned _sp = 0; while (cond) { __builtin_amdgcn_s_sleep(1); \
    if ((++_sp & 255u) == 0u) { if (xb_ld(&(bar)[XB_TMO])) break; if (_sp > XB_SPIN_CAP) { atomicAdd(&(bar)[XB_TMO], 1u); break; } } } } while (0)

struct XcdBarrier {
    unsigned* bar; unsigned x;
    volatile LAS unsigned* st;
};

__device__ __forceinline__ int xb_lane() { int l_; asm volatile("v_mbcnt_lo_u32_b32 %0, -1, 0\n\tv_mbcnt_hi_u32_b32 %0, -1, %0" : "=v"(l_)); return l_; }
__device__ __forceinline__ XcdBarrier xcd_barrier_post(unsigned* bar, volatile LAS unsigned* st, int wave) {
    XcdBarrier b; b.bar = bar; b.x = xb_xcc_id(); b.st = st;
    if (wave == 0 && xb_lane() == 0) (void)xb_add(&bar[XB_XCNT(b.x)], 1u);
    return b;
}
__device__ __forceinline__ void xcd_barrier_complete(unsigned* bar, unsigned x, unsigned& nloc, unsigned& nx) {
    const unsigned G = gridDim.x * gridDim.y * gridDim.z;
    unsigned sum, cnt, mine, sp = 0u;
    for (;;) {
        sum = 0u; cnt = 0u; mine = 0u;
#pragma nounroll
        for (unsigned j = 0; j < 16; ++j) { const unsigned c = xb_ld(&bar[XB_XCNT(j)]); sum += c; cnt += (c > 0u) ? 1u : 0u; mine = (j == x) ? c : mine; }
        if (sum == G) break;
        __builtin_amdgcn_s_sleep(1);
        if ((++sp & 255u) == 0u) { if (xb_ld(&bar[XB_TMO])) break; if (sp > XB_SPIN_CAP) { atomicAdd(&bar[XB_TMO], 1u); break; } }
    }
    nloc = mine > 0u ? mine : 1u; nx = cnt > 0u ? cnt : 1u;
}

__device__ __forceinline__ void xcd_barrier(const XcdBarrier& b, int wave  ) {
    asm volatile("s_waitcnt vmcnt(0)" ::: "memory");
    __syncthreads();
    if (wave == 0 && xb_lane() == 0) {
        unsigned* bar = b.bar;
        __builtin_amdgcn_s_waitcnt(0);
        unsigned nloc = b.st[0], nx = b.st[1];
        if (nloc == 0u) { xcd_barrier_complete(bar, b.x, nloc, nx); b.st[0] = nloc; b.st[1] = nx; }
        const unsigned old = xb_add(&bar[XB_XSUB(b.x)], 1u);
        const unsigned gen = old / nloc;
        if (old + 1u == (gen + 1u) * nloc) {
            __builtin_amdgcn_fence(__ATOMIC_RELEASE, "agent");
            asm volatile("s_waitcnt vmcnt(0)" ::: "memory");
            const unsigned og = xb_add(&bar[XB_TOP], 1u);
            const unsigned tg = og / nx;
            if (og + 1u == (tg + 1u) * nx) xb_add(&bar[XB_TOPGEN], 1u);
            else XB_SPIN(xb_ld(&bar[XB_TOPGEN]) == tg, bar);
            __builtin_amdgcn_fence(__ATOMIC_ACQUIRE, "agent");
            xb_add(&bar[XB_XGEN(b.x)], 1u);
            asm volatile("s_waitcnt vmcnt(0)" ::: "memory");
        } else {
            XB_SPIN(xb_ld(&bar[XB_XGEN(b.x)]) == gen, bar);
            __builtin_amdgcn_fence(__ATOMIC_ACQUIRE, "agent");
            asm volatile("s_waitcnt vmcnt(0)" ::: "memory");
        }
    }
    __syncthreads();
}

typedef unsigned u32x2 __attribute__((ext_vector_type(2)));
struct Frame { LAS unsigned char* lds; int tid, lane, wave, G, gw, ngw; };

__device__ __forceinline__ float bperm(float v, int srclane) { return __int_as_float(__builtin_amdgcn_ds_bpermute(srclane << 2, __float_as_int(v))); }
#define DPP_ADD(v, ctrl) ((v) + __int_as_float(__builtin_amdgcn_update_dpp(0, __float_as_int(v), (ctrl), 0xf, 0xf, true)))
__device__ __forceinline__ float row_sum16(float v) {
    v = DPP_ADD(v, 0xB1); v = DPP_ADD(v, 0x4E); v = DPP_ADD(v, 0x141); v = DPP_ADD(v, 0x140); return v;
}
__device__ __forceinline__ float wave_sum(float v, int lane) {
    v = row_sum16(v);
    const float a = __int_as_float(__builtin_amdgcn_readlane(__float_as_int(v), 0)), b = __int_as_float(__builtin_amdgcn_readlane(__float_as_int(v), 16));
    const float c = __int_as_float(__builtin_amdgcn_readlane(__float_as_int(v), 32)), d = __int_as_float(__builtin_amdgcn_readlane(__float_as_int(v), 48));
    return (a + b) + (c + d);
}
__device__ __forceinline__ float wave_max(float v, int lane) {
#pragma unroll
    for (int o = 1; o < 64; o <<= 1) v = fmaxf(v, bperm(v, lane ^ o));
    return v;
}
__device__ __forceinline__ float bf2f(unsigned short x) { return __uint_as_float((unsigned)x << 16); }
__device__ __forceinline__ float bflo(unsigned w) { return __uint_as_float(w << 16); }
__device__ __forceinline__ float bfhi(unsigned w) { return __uint_as_float(w & 0xffff0000u); }
__device__ __forceinline__ unsigned cvtpk2(float lo, float hi) { unsigned r; asm volatile("v_cvt_pk_bf16_f32 %0, %1, %2" : "=v"(r) : "v"(lo), "v"(hi)); return r; }
__device__ __forceinline__ unsigned short f2bf16_mfma(float f) { const __bf16 b = (__bf16)f; return __builtin_bit_cast(unsigned short, b); }
__device__ __forceinline__ unsigned short f2bf16(float f) { return (unsigned short)(cvtpk2(f, 0.f) & 0xffffu); }
__device__ __forceinline__ void unpack8(const v4u w, float (&f)[8]) { f[0] = bflo(w.x); f[1] = bfhi(w.x); f[2] = bflo(w.y); f[3] = bfhi(w.y); f[4] = bflo(w.z); f[5] = bfhi(w.z); f[6] = bflo(w.w); f[7] = bfhi(w.w); }
__device__ __forceinline__ v4u pack8(const float (&f)[8]) { v4u w; w.x = cvtpk2(f[0], f[1]); w.y = cvtpk2(f[2], f[3]); w.z = cvtpk2(f[4], f[5]); w.w = cvtpk2(f[6], f[7]); return w; }
__device__ __forceinline__ float sigmoidf_(float x) { return __builtin_amdgcn_rcpf(1.f + __builtin_amdgcn_exp2f(-1.4426950408889634f * x)); }

__device__ __forceinline__ void p0_transpose_item(const float* W, int K, int pitch, int nblk, bf16* WT, LAS float* scr, int item, int lane, bool upperm) {
    const int kb = item / nblk, nb = item % nblk, k0 = 64 * kb, n0 = 32 * nb;
    int d0 = n0; if (upperm) { const int c = n0 < DFF ? n0 : n0 - DFF; d0 = 256 * (c >> 7) + (c & 127) + (n0 < DFF ? 0 : 128); }
    float wv[32];
#pragma unroll
    for (int i = 0; i < 32; ++i) { const int kk = 2 * i + (lane >> 5); wv[i] = W[(size_t)(k0 + kk) * pitch + n0 + (lane & 31)]; }
#pragma unroll
    for (int i = 0; i < 32; ++i) { const int kk = 2 * i + (lane >> 5); scr[kk * 33 + (lane & 31)] = wv[i]; }
    LDS_WAIT(); asm volatile("" ::: "memory");
    const int c = lane & 7;
#pragma unroll
    for (int j = 0; j < 4; ++j) { const int n = (lane >> 3) + 8 * j; const LAS float* s = scr + (8 * c) * 33 + n;
        v4u o; o.x = pk2(s[0 * 33], s[1 * 33]); o.y = pk2(s[2 * 33], s[3 * 33]); o.z = pk2(s[4 * 33], s[5 * 33]); o.w = pk2(s[6 * 33], s[7 * 33]);
        *(v4u*)(WT + (size_t)(d0 + n) * K + k0 + 8 * c) = o; }
    LDS_WAIT(); asm volatile("" ::: "memory");
}
__device__ __forceinline__ void transpose_matrix(const Frame& F, const float* W, int K, int pitch, int Nused, bf16* WT, int& rot, bool upperm = false) {
    const int nblk = Nused / 32, nitems = (K / 64) * nblk;
    LAS float* scr = (LAS float*)(F.lds + F.wave * 16384);
    int first = (F.gw - rot) % F.ngw; if (first < 0) first += F.ngw;
    for (int it = first; it < nitems; it += F.ngw) p0_transpose_item(W, K, pitch, nblk, WT, scr, it, F.lane, upperm);
    rot = (rot + nitems) % F.ngw;
}
__device__ __forceinline__ void mod_phase(const Frame& F, const float* c, const float* cctx, const float* ada_w, const float* ada_b, float* MOD) {
    LAS float* sc = (LAS float*)F.lds;
    LAS float* red = (LAS float*)(F.lds + 20480);
    { float cv[10];
#pragma unroll
      for (int i2 = 0; i2 < 10; ++i2) { const int i = F.tid + 512 * i2; cv[i2] = i < 4096 ? c[i] : cctx[i - 4096]; }
#pragma unroll
      for (int i2 = 0; i2 < 10; ++i2) sc[F.tid + 512 * i2] = cv[i2] / (1.f + expf(-cv[i2])); }
    __syncthreads();
    const int ks = F.tid >> 5, cn = F.tid & 31;
    for (int item = blockIdx.x; item < 768; item += F.G) {
        const int layer = item / 192, n0 = (item % 192) * 32;
        const float* wp = ada_w + (size_t)layer * 1024 * 6144 + (size_t)(ks * 64) * 6144 + n0 + cn;
        float a0 = 0.f, a1 = 0.f, a2 = 0.f, a3 = 0.f, a4 = 0.f;
#pragma unroll 32
        for (int k = 0; k < 64; ++k) { const float w = wp[(size_t)k * 6144]; const int kk = ks * 64 + k;
            a0 += w * sc[kk]; a1 += w * sc[1024 + kk]; a2 += w * sc[2048 + kk]; a3 += w * sc[3072 + kk]; a4 += w * sc[4096 + kk]; }
        LAS float* rp = red + (ks * 32 + cn) * 5; rp[0] = a0; rp[1] = a1; rp[2] = a2; rp[3] = a3; rp[4] = a4;
        __syncthreads();
        if (F.tid < 160) { const int cn2 = F.tid & 31, b = F.tid >> 5; float s = 0.f;
#pragma unroll
            for (int k2 = 0; k2 < 16; ++k2) s += red[(k2 * 32 + cn2) * 5 + b];
            MOD[(size_t)(layer * 5 + b) * 6144 + n0 + cn2] = s + ada_b[layer * 6144 + n0 + cn2]; }
        __syncthreads();
    }
}
__device__ __forceinline__ void rope_tables(const Frame& F, float* R64, float* R128) {
    for (int i = blockIdx.x * 512 + F.tid; i < 6144; i += F.G * 512) {
        int pos, f, nf; float* dst;
        if (i < 2048) { pos = i >> 4; f = i & 15; nf = 16; dst = R64 + 2 * i; } else { const int j = i - 2048; pos = j >> 5; f = j & 31; nf = 32; dst = R128 + 2 * j; }
        const float inv = powf(10000.f, -(float)f / (float)nf);
        const float ang = (float)pos * inv;
        dst[0] = cosf(ang); dst[1] = sinf(ang);
    }
}

#define NCOL(j) (8 * F.lane + 512 * ((j) >> 1) + 4 * ((j) & 1))
template <bool GATES, int RG>
__device__ __forceinline__ void norm_rows(const Frame& F, f32x4 (&v)[RG][4], int rbase, const f32x4 (&A)[4], const f32x4 (&Bv)[4], bf16* XN, const LAS float* WgT, const float* bgate, float* GATESb) {
#pragma unroll
    for (int q = 0; q < RG; ++q) {
        const int r = rbase + q; float ss = 0.f;
#pragma unroll
        for (int j = 0; j < 4; ++j) ss += (v[q][j].x * v[q][j].x + v[q][j].y * v[q][j].y) + (v[q][j].z * v[q][j].z + v[q][j].w * v[q][j].w);
        ss = wave_sum(ss, F.lane); const float rs = __builtin_amdgcn_rsqf(ss * (1.f / 1024.f) + EPS);
#pragma unroll
        for (int j = 0; j < 4; ++j) v[q][j] = v[q][j] * rs * A[j] + Bv[j];
#pragma unroll
        for (int i2 = 0; i2 < 2; ++i2) { v4u w; w.x = cvtpk2(v[q][2 * i2].x, v[q][2 * i2].y); w.y = cvtpk2(v[q][2 * i2].z, v[q][2 * i2].w); w.z = cvtpk2(v[q][2 * i2 + 1].x, v[q][2 * i2 + 1].y); w.w = cvtpk2(v[q][2 * i2 + 1].z, v[q][2 * i2 + 1].w);
            *(v4u*)(XN + (size_t)r * 1024 + 8 * F.lane + 512 * i2) = w; }
    }
    if (GATES) {
        float val[RG];
#pragma unroll
        for (int q = 0; q < RG; ++q) val[q] = 0.f;
#pragma unroll
        for (int jg = 0; jg < 16; ++jg) { f32x4 w[4];
#pragma unroll
            for (int j = 0; j < 4; ++j) w[j] = *(const LAS f32x4*)(WgT + jg * 1024 + NCOL(j));
#pragma unroll
            for (int q = 0; q < RG; ++q) { float s = 0.f;
#pragma unroll
                for (int j = 0; j < 4; ++j) s += (v[q][j].x * w[j].x + v[q][j].y * w[j].y) + (v[q][j].z * w[j].z + v[q][j].w * w[j].w);
                s = wave_sum(s, F.lane); val[q] = (F.lane == jg) ? s : val[q]; } }
        if (F.lane < 16) { const float bg = bgate[F.lane]; const int kind = F.lane >> 2;
#pragma unroll
            for (int q = 0; q < RG; ++q) { float x = val[q] + bg;
                if (kind & 1) x = fminf(x, 0.f) - 0.6931471805599453f * __builtin_amdgcn_logf(1.f + __builtin_amdgcn_exp2f(-1.4426950408889634f * fabsf(x)));
                GATESb[(size_t)(rbase + q) * 16 + F.lane] = x; } }
    }
}
template <bool GATES>
__device__ __forceinline__ void norm_phase(const Frame& F, const void* hlat, bool lat_bf16, float* hctx, const float* slab, int nslab, int nrows, const float* gain, const float* mod, int sh_off, int sc_off, bf16* XN,
                                           const float* wg_src, const float* bgate, float* GATESb) {
    LAS float* WgT = (LAS float*)F.lds;
    if (GATES) { float wv[32];
#pragma unroll
        for (int i2 = 0; i2 < 32; ++i2) wv[i2] = wg_src[(size_t)((F.tid >> 4) + 32 * i2) * 3088 + 3072 + (F.tid & 15)];
#pragma unroll
        for (int i2 = 0; i2 < 32; ++i2) WgT[(F.tid & 15) * 1024 + (F.tid >> 4) + 32 * i2] = wv[i2];
        __syncthreads(); }
    constexpr int RG = 4;
    const int nlat = ML / 16, nitems = nlat + (nrows > ML ? MC : 0);
    for (int it = F.gw; it < nitems; it += F.ngw) {
        const int r0 = it < nlat ? it * 16 : ML + (it - nlat), mb = r0 < ML ? (r0 >> 13) : 4;
        const bool pipe = r0 < ML && lat_bf16;
        const bf16* src = (const bf16*)hlat + (size_t)(pipe ? r0 : 0) * 1024 + 8 * F.lane;
        v4u raw[RG][2];
        if (pipe) {
#pragma unroll
            for (int q = 0; q < RG; ++q) { raw[q][0] = *(const v4u*)(src + q * 1024); raw[q][1] = *(const v4u*)(src + q * 1024 + 512); } }
        f32x4 A[4], Bv[4];
        { f32x4 g[4], s[4];
#pragma unroll
          for (int j = 0; j < 4; ++j) { const int col = NCOL(j); g[j] = *(const f32x4*)(gain + col); s[j] = *(const f32x4*)(mod + mb * 6144 + sc_off + col); Bv[j] = *(const f32x4*)(mod + mb * 6144 + sh_off + col); }
#pragma unroll
          for (int j = 0; j < 4; ++j) A[j] = g[j] * (1.f + s[j]); }
        if (pipe) {
#pragma nounroll
            for (int rr = 0; rr < 16; rr += RG) {
                f32x4 v[RG][4];
#pragma unroll
                for (int q = 0; q < RG; ++q)
#pragma unroll
                    for (int i2 = 0; i2 < 2; ++i2) { const v4u w = raw[q][i2];
                        v[q][2 * i2] = (f32x4){bflo(w.x), bfhi(w.x), bflo(w.y), bfhi(w.y)}; v[q][2 * i2 + 1] = (f32x4){bflo(w.z), bfhi(w.z), bflo(w.w), bfhi(w.w)}; }
                { const int rn = rr + RG < 16 ? rr + RG : rr;
#pragma unroll
                  for (int q = 0; q < RG; ++q) { raw[q][0] = *(const v4u*)(src + (size_t)(rn + q) * 1024); raw[q][1] = *(const v4u*)(src + (size_t)(rn + q) * 1024 + 512); } }
                norm_rows<GATES, RG>(F, v, r0 + rr, A, Bv, XN, WgT, bgate, GATESb);
            }
            continue;
        }
        if (r0 < ML) {
            for (int rr = 0; rr < 16; rr += RG) {
                f32x4 v[RG][4];
#pragma unroll
                for (int q = 0; q < RG; ++q) { const float* src = (const float*)hlat + (size_t)(r0 + rr + q) * 1024;
#pragma unroll
                    for (int j = 0; j < 4; ++j) v[q][j] = *(const f32x4*)(src + NCOL(j)); }
                norm_rows<GATES, RG>(F, v, r0 + rr, A, Bv, XN, WgT, bgate, GATESb);
            }
            continue;
        }
        { f32x4 v[1][4]; float* src = hctx + (size_t)(r0 - ML) * 1024;
#pragma unroll
          for (int j = 0; j < 4; ++j) v[0][j] = *(const f32x4*)(src + NCOL(j));
          if (nslab > 0) {
#pragma nounroll
              for (int s0 = 0; s0 < nslab; s0 += 4) { f32x4 sv[4][4];
#pragma unroll
                  for (int qq = 0; qq < 4; ++qq) { const int s = s0 + qq < nslab ? s0 + qq : nslab - 1; const float* sp = slab + ((size_t)s * 1024 + (r0 - ML)) * 1024;
#pragma unroll
                      for (int j = 0; j < 4; ++j) sv[qq][j] = *(const f32x4*)(sp + NCOL(j)); }
#pragma unroll
                  for (int qq = 0; qq < 4; ++qq) if (s0 + qq < nslab) {
#pragma unroll
                      for (int j = 0; j < 4; ++j) v[0][j] += sv[qq][j]; } }
#pragma unroll
              for (int j = 0; j < 4; ++j) *(f32x4*)(src + NCOL(j)) = v[0][j]; }
          norm_rows<GATES, 1>(F, v, r0, A, Bv, XN, WgT, bgate, GATESb); }
    }
}
#undef NCOL
template <int HD>
__device__ __forceinline__ void qk_head8(const v4u raw, const float (&g)[8], float qs, bool rope, const float (&cs)[8], const float (&sn)[8], int lane, v4u& out) {
    constexpr int LPH = HD / 8;
    float x[8]; unpack8(raw, x);
    float ss = 0.f;
#pragma unroll
    for (int e = 0; e < 8; ++e) ss += x[e] * x[e];
#pragma unroll
    for (int o = 1; o < LPH; o <<= 1) ss += bperm(ss, lane ^ o);
    const float rs = qs * __builtin_amdgcn_rsqf(ss * (1.f / HD) + EPS);
    float y[8], yp[8];
#pragma unroll
    for (int e = 0; e < 8; ++e) y[e] = x[e] * rs * g[e];
#pragma unroll
    for (int e = 0; e < 8; ++e) yp[e] = bperm(y[e], lane ^ (LPH / 2));
    const bool upper = (lane & (LPH / 2)) != 0;
    float o[8];
#pragma unroll
    for (int e = 0; e < 8; ++e) o[e] = rope ? (upper ? y[e] * cs[e] + yp[e] * sn[e] : y[e] * cs[e] - yp[e] * sn[e]) : y[e];
    out = pack8(o);
}
__device__ __forceinline__ void qknorm_rope64(const Frame& F, const bf16* RAW, const float* qn, const float* kn, const float* R64, bf16* Qp, bf16* Kp) {
    const int j = F.lane & 7, hq = F.lane >> 3;
    float gq[8], gk[8];
#pragma unroll
    for (int e = 0; e < 8; ++e) { gq[e] = qn[8 * j + e]; gk[e] = kn[8 * j + e]; }
    v4u rw[3]; f32x4 tw[4];
#define QK64_LOAD(r_) do { const bf16* s_ = RAW + (size_t)(r_) * 1536; _Pragma("unroll") for (int p = 0; p < 3; ++p) { const int hh = 8 * p + hq; if (hh < 20) rw[p] = *(const v4u*)(s_ + hh * 64 + 8 * j); } \
        const int t_ = (r_) & (SEQ - 1), pos_ = (j & 3) < 2 ? (t_ >> 6) : (t_ & 63); const float* tp_ = R64 + ((size_t)pos_ * 16 + 8 * (j & 1)) * 2; \
        _Pragma("unroll") for (int e2 = 0; e2 < 4; ++e2) tw[e2] = *(const f32x4*)(tp_ + 4 * e2); } while (0)
    int r = F.gw;
    if (r < MT) QK64_LOAD(r);
    for (; r < MT; r += F.ngw) {
        const bool rope = r < ML; float cs[8], sn[8];
        v4u cr[3];
#pragma unroll
        for (int p = 0; p < 3; ++p) cr[p] = rw[p];
#pragma unroll
        for (int e2 = 0; e2 < 4; ++e2) { const f32x4 w = rope ? tw[e2] : (f32x4){1.f, 0.f, 1.f, 0.f}; cs[2 * e2] = w.x; sn[2 * e2] = w.y; cs[2 * e2 + 1] = w.z; sn[2 * e2 + 1] = w.w; }
        { const int rn = r + F.ngw < MT ? r + F.ngw : r; QK64_LOAD(rn); }
#pragma unroll
        for (int p = 0; p < 3; ++p) { const int hh = 8 * p + hq;
            if (hh < 20) { const bool isq = hh < 16; v4u o; float g[8];
#pragma unroll
                for (int e = 0; e < 8; ++e) g[e] = isq ? gq[e] : gk[e];
                qk_head8<64>(cr[p], g, isq ? 0.18033688f : 1.f, rope, cs, sn, F.lane, o);
                *(v4u*)((isq ? Qp + (size_t)r * 1024 + hh * 64 : Kp + (size_t)r * 256 + (hh - 16) * 64) + 8 * j) = o; } }
    }
#undef QK64_LOAD
}
__device__ __forceinline__ void knorm_rope64(const Frame& F, const bf16* RAW, const float* kn, const float* R64, bf16* Kp) {
    float one = 1.f; asm volatile("" : "+v"(one));
    const int j = F.lane & 7, hk = (F.lane >> 3) & 3, half = F.lane >> 5;
    float gk[8];
#pragma unroll
    for (int e = 0; e < 8; ++e) gk[e] = kn[8 * j + e];
    v4u rw; f32x4 tw[4];
#define K64_LOAD(r_) do { rw = *(const v4u*)(RAW + (size_t)(r_) * 1536 + 1024 + hk * 64 + 8 * j); \
        const int t_ = (r_) & (SEQ - 1), pos_ = (j & 3) < 2 ? (t_ >> 6) : (t_ & 63); const float* tp_ = R64 + ((size_t)pos_ * 16 + 8 * (j & 1)) * 2; \
        _Pragma("unroll") for (int e2 = 0; e2 < 4; ++e2) tw[e2] = *(const f32x4*)(tp_ + 4 * e2); } while (0)
    int r = 2 * F.gw + half;
    if (r < MT) K64_LOAD(r);
    for (; r < MT; r += 2 * F.ngw) {
        const bool rope = r < ML; float cs[8], sn[8];
        const v4u cr = rw;
#pragma unroll
        for (int e2 = 0; e2 < 4; ++e2) { const f32x4 w = rope ? tw[e2] : (f32x4){one, 0.f, one, 0.f}; cs[2 * e2] = w.x; sn[2 * e2] = w.y; cs[2 * e2 + 1] = w.z; sn[2 * e2 + 1] = w.w; }
        { const int rn = r + 2 * F.ngw < MT ? r + 2 * F.ngw : r; K64_LOAD(rn); }
        v4u o; qk_head8<64>(cr, gk, 1.f, rope, cs, sn, F.lane, o);
        *(v4u*)(Kp + (size_t)r * 256 + hk * 64 + 8 * j) = o;
    }
#undef K64_LOAD
}
template <int HD, typename FR>
__device__ __forceinline__ void qnorm_rope_frag(FR (&qr)[HD / 16], const float* gq, const float* Rt, int t, bool rope, float qs, int lane) {
    constexpr int NB = HD / 16;
    const int hi = lane >> 5;
    float ss = 0.f;
#pragma unroll
    for (int d0 = 0; d0 < NB; ++d0) { float x[8]; unpack8(__builtin_bit_cast(v4u, qr[d0]), x);
#pragma unroll
        for (int e = 0; e < 8; ++e) ss += x[e] * x[e]; }
    ss += bperm(ss, lane ^ 32);
    const float rs = qs * __builtin_amdgcn_rsqf(ss * (1.f / HD) + EPS);
#pragma unroll
    for (int d0 = 0; d0 < NB / 2; ++d0) {
        float lo[8], up[8]; unpack8(__builtin_bit_cast(v4u, qr[d0]), lo); unpack8(__builtin_bit_cast(v4u, qr[d0 + NB / 2]), up);
        const float* gl = gq + d0 * 16 + hi * 8; const float* gu = gl + HD / 2;
        const f32x4 g0 = *(const f32x4*)gl, g1 = *(const f32x4*)(gl + 4), g2 = *(const f32x4*)gu, g3 = *(const f32x4*)(gu + 4);
#pragma unroll
        for (int e = 0; e < 8; ++e) { lo[e] = lo[e] * rs * (e < 4 ? g0[e & 3] : g1[e & 3]); up[e] = up[e] * rs * (e < 4 ? g2[e & 3] : g3[e & 3]); }
        if (rope) {
            const int a0 = d0 * 16 + hi * 8, pos = a0 < HD / 4 ? (t >> 6) : (t & 63), f0 = a0 < HD / 4 ? a0 : a0 - HD / 4;
            const float* tp = Rt + ((size_t)pos * (HD / 4) + f0) * 2;
#pragma unroll
            for (int e2 = 0; e2 < 4; ++e2) { const f32x4 w = *(const f32x4*)(tp + 4 * e2);
                const float l0 = lo[2 * e2], u0 = up[2 * e2], l1 = lo[2 * e2 + 1], u1 = up[2 * e2 + 1];
                lo[2 * e2] = l0 * w.x - u0 * w.y; up[2 * e2] = u0 * w.x + l0 * w.y; lo[2 * e2 + 1] = l1 * w.z - u1 * w.w; up[2 * e2 + 1] = u1 * w.z + l1 * w.w; } }
        qr[d0] = __builtin_bit_cast(FR, pack8(lo)); qr[d0 + NB / 2] = __builtin_bit_cast(FR, pack8(up));
    }
}
__device__ __forceinline__ void qknorm_rope128(const Frame& F, const bf16* RAW, const float* qn, const float* kn, const float* R128, bf16* Qp, bf16* K2, bf16* V2) {
    const int j = F.lane & 15, hq = F.lane >> 4;
    float gq[8], gk[8];
#pragma unroll
    for (int e = 0; e < 8; ++e) { gq[e] = qn[8 * j + e]; gk[e] = kn[8 * j + e]; }
    v4u rw[4]; f32x4 tw[4];
#define QK128_LOAD(r_) do { const bf16* s_ = RAW + (size_t)(r_) * 1536; _Pragma("unroll") for (int p = 0; p < 3; ++p) { const int hh = 4 * p + hq; if (hh < 10) rw[p] = *(const v4u*)(s_ + hh * 128 + 8 * j); } \
        rw[3] = *(const v4u*)(s_ + 1280 + 8 * (F.lane & 31)); \
        const int t_ = (r_) & (SEQ - 1), pos_ = (j & 7) < 4 ? (t_ >> 6) : (t_ & 63); const float* tp_ = R128 + ((size_t)pos_ * 32 + 8 * (j & 3)) * 2; \
        _Pragma("unroll") for (int e2 = 0; e2 < 4; ++e2) tw[e2] = *(const f32x4*)(tp_ + 4 * e2); } while (0)
    int r = F.gw;
    if (r < MT) QK128_LOAD(r);
    for (; r < MT; r += F.ngw) {
        const bool rope = r < ML; float cs[8], sn[8]; size_t kvrow;
        const int t = r & (SEQ - 1);
        if (rope) kvrow = (size_t)(r >> 13) * 8448 + t; else { const int rc = r - ML; kvrow = (size_t)(rc >> 8) * 8448 + 8192 + (rc & 255); }
        v4u cr[4];
#pragma unroll
        for (int p = 0; p < 4; ++p) cr[p] = rw[p];
#pragma unroll
        for (int e2 = 0; e2 < 4; ++e2) { const f32x4 w = rope ? tw[e2] : (f32x4){1.f, 0.f, 1.f, 0.f}; cs[2 * e2] = w.x; sn[2 * e2] = w.y; cs[2 * e2 + 1] = w.z; sn[2 * e2 + 1] = w.w; }
        { const int rn = r + F.ngw < MT ? r + F.ngw : r; QK128_LOAD(rn); }
#pragma unroll
        for (int p = 0; p < 3; ++p) { const int hh = 4 * p + hq;
            if (hh < 10) { const bool isq = hh < 8; v4u o; float g[8];
#pragma unroll
                for (int e = 0; e < 8; ++e) g[e] = isq ? gq[e] : gk[e];
                qk_head8<128>(cr[p], g, isq ? 0.12751743f : 1.f, rope, cs, sn, F.lane, o);
                *(v4u*)((isq ? Qp + (size_t)r * 1024 + hh * 128 : K2 + kvrow * 256 + (hh - 8) * 128) + 8 * j) = o; } }
        if (F.lane < 32) *(v4u*)(V2 + kvrow * 256 + 8 * F.lane) = cr[3];
    }
#undef QK128_LOAD
}
__device__ __forceinline__ void knorm_rope128(const Frame& F, const bf16* RAW, const float* kn, const float* R128, bf16* K2, bf16* V2) {
    float one = 1.f; asm volatile("" : "+v"(one));
    const int j = F.lane & 15, hk = (F.lane >> 4) & 1; const bool isv = F.lane >= 32;
    const int coff = isv ? 1280 + 8 * (F.lane & 31) : 1024 + hk * 128 + 8 * j;
    float gk[8];
#pragma unroll
    for (int e = 0; e < 8; ++e) gk[e] = kn[8 * j + e];
    v4u rw[2]; f32x4 tw[2][4];
#define K128_LOAD(it_) do { _Pragma("unroll") for (int q_ = 0; q_ < 2; ++q_) { const int r_ = 2 * (it_) + q_; rw[q_] = *(const v4u*)(RAW + (size_t)r_ * 1536 + coff); \
        const int t_ = r_ & (SEQ - 1), pos_ = (j & 7) < 4 ? (t_ >> 6) : (t_ & 63); const float* tp_ = R128 + ((size_t)pos_ * 32 + 8 * (j & 3)) * 2; \
        _Pragma("unroll") for (int e2 = 0; e2 < 4; ++e2) tw[q_][e2] = *(const f32x4*)(tp_ + 4 * e2); } } while (0)
    int it = F.gw;
    if (it < MT / 2) K128_LOAD(it);
    for (; it < MT / 2; it += F.ngw) {
        v4u cr[2]; f32x4 ct[2][4];
#pragma unroll
        for (int q = 0; q < 2; ++q) { cr[q] = rw[q];
#pragma unroll
            for (int e2 = 0; e2 < 4; ++e2) ct[q][e2] = tw[q][e2]; }
        { const int itn = it + F.ngw < MT / 2 ? it + F.ngw : it; K128_LOAD(itn); }
#pragma unroll
        for (int q = 0; q < 2; ++q) { const int r = 2 * it + q; const bool rope = r < ML; size_t kvrow;
            if (rope) kvrow = (size_t)(r >> 13) * 8448 + (r & (SEQ - 1)); else { const int rc = r - ML; kvrow = (size_t)(rc >> 8) * 8448 + 8192 + (rc & 255); }
            float cs[8], sn[8];
#pragma unroll
            for (int e2 = 0; e2 < 4; ++e2) { const f32x4 w = rope ? ct[q][e2] : (f32x4){one, 0.f, one, 0.f}; cs[2 * e2] = w.x; sn[2 * e2] = w.y; cs[2 * e2 + 1] = w.z; sn[2 * e2 + 1] = w.w; }
            v4u o; qk_head8<128>(cr[q], gk, 1.f, rope, cs, sn, F.lane, o);
            if (isv) *(v4u*)(V2 + kvrow * 256 + 8 * (F.lane & 31)) = cr[q]; else *(v4u*)(K2 + kvrow * 256 + hk * 128 + 8 * j) = o; }
    }
#undef K128_LOAD
}
__device__ __forceinline__ void sconv_phase(const Frame& F, const bf16* RAW, const float* cw  , bf16* O) {
    const int c0 = (F.tid & 127) * 8, qd = F.tid >> 7;
    f32x4 w[3][2];
#pragma unroll
    for (int j = 0; j < 3; ++j) { w[j][0] = *(const f32x4*)(cw + j * 1024 + c0); w[j][1] = *(const f32x4*)(cw + j * 1024 + c0 + 4); }
    for (int blk = F.gw >> 3; blk < MT / 132; blk += F.G) {
        const int rs = blk * 132 + qd * 33;
        float pm[8], pc[8];
        { const bf16* rp = RAW + (size_t)(rs > 0 ? rs - 1 : 0) * 3072 + c0; float a[8], b[8];
          const v4u x0 = *(const v4u*)(rp + 1024), x1 = *(const v4u*)(rp + 2048); const bf16* rq = RAW + (size_t)rs * 3072 + c0; const v4u y0 = *(const v4u*)(rq + 1024), y1 = *(const v4u*)(rq + 2048);
          unpack8(x0, a); unpack8(x1, b);
#pragma unroll
          for (int e2 = 0; e2 < 8; ++e2) pm[e2] = a[e2] * b[e2];
          unpack8(y0, a); unpack8(y1, b);
#pragma unroll
          for (int e2 = 0; e2 < 8; ++e2) pc[e2] = a[e2] * b[e2]; }
        v4u ngc, nu, ngb;
        { const int rn = rs + 1 < MT ? rs + 1 : rs; const bf16* rp = RAW + (size_t)rn * 3072 + c0; ngc = *(const v4u*)(rp + 1024); nu = *(const v4u*)(rp + 2048); ngb = *(const v4u*)(RAW + (size_t)rs * 3072 + c0); }
#pragma nounroll
        for (int k = 0; k < 33; ++k) {
            const int r = rs + k;
            const v4u cgc = ngc, cu = nu, cgb = ngb;
            { const int r2 = r + 2 < MT ? r + 2 : MT - 1, r1 = r + 1 < MT ? r + 1 : MT - 1;
              const bf16* rp = RAW + (size_t)r2 * 3072 + c0; ngc = *(const v4u*)(rp + 1024); nu = *(const v4u*)(rp + 2048); ngb = *(const v4u*)(RAW + (size_t)r1 * 3072 + c0); }
            const int tl = r < ML ? (r & (SEQ - 1)) : ((r - ML) & (CTXL - 1)), len = r < ML ? SEQ : CTXL;
            const float mp = tl > 0 ? 1.f : 0.f, mn = tl < len - 1 ? 1.f : 0.f;
            float a[8], b[8], pn[8], gb[8], z[8];
            unpack8(cgc, a); unpack8(cu, b); unpack8(cgb, gb);
#pragma unroll
            for (int e2 = 0; e2 < 8; ++e2) pn[e2] = a[e2] * b[e2];
#pragma unroll
            for (int e2 = 0; e2 < 8; ++e2) { const float w0 = w[0][e2 >> 2][e2 & 3] * mp, w1 = w[1][e2 >> 2][e2 & 3], w2 = w[2][e2 >> 2][e2 & 3] * mn;
                z[e2] = gb[e2] * (w0 * pm[e2] + w1 * pc[e2] + w2 * pn[e2]); pm[e2] = pc[e2]; pc[e2] = pn[e2]; }
            *(v4u*)(O + (size_t)r * 1024 + c0) = pack8(z);
        }
    }
}
__device__ __forceinline__ void ffn_fixup(const Frame& F, int tile, const float* HALO, const float* cw  , bf16* ACT) {
    const bool has_prev = tile < 128 && (tile & 31) != 0, has_next = tile < 128 && (tile & 31) != 31;
    for (int i = F.tid; i < 2 * (DFF / 4); i += 512) {
        const int which = i >= DFF / 4 ? 1 : 0, c = 4 * (i - which * (DFF / 4));
        const float* hm = HALO + ((size_t)tile * 4 + (which ? 2 : -1)) * NUP;
        const float* h0 = HALO + ((size_t)tile * 4 + (which ? 3 : 0)) * NUP;
        const float* hp = HALO + ((size_t)tile * 4 + (which ? 4 : 1)) * NUP;
        const bool vm = which ? true : has_prev, vp = which ? has_next : true;
        const f32x4 z4 = {0.f, 0.f, 0.f, 0.f};
        const f32x4 gm = vm ? *(const f32x4*)(hm + c) : z4, um = vm ? *(const f32x4*)(hm + DFF + c) : z4, gp = vp ? *(const f32x4*)(hp + c) : z4, up = vp ? *(const f32x4*)(hp + DFF + c) : z4;
        const f32x4 g0 = *(const f32x4*)(h0 + c), u0 = *(const f32x4*)(h0 + DFF + c);
        const f32x4 wg0 = *(const f32x4*)(cw + c), wg1 = *(const f32x4*)(cw + NUP + c), wg2 = *(const f32x4*)(cw + 2 * NUP + c);
        const f32x4 wu0 = *(const f32x4*)(cw + DFF + c), wu1 = *(const f32x4*)(cw + NUP + DFF + c), wu2 = *(const f32x4*)(cw + 2 * NUP + DFF + c);
        float a[4];
#pragma unroll
        for (int e2 = 0; e2 < 4; ++e2) { const float g = wg0[e2] * gm[e2] + wg1[e2] * g0[e2] + wg2[e2] * gp[e2], u = wu0[e2] * um[e2] + wu1[e2] * u0[e2] + wu2[e2] * up[e2];
            a[e2] = g / (1.f + expf(-g)) * u; }
        uint2 o; o.x = cvtpk2(a[0], a[1]); o.y = cvtpk2(a[2], a[3]);
        *(uint2*)(ACT + ((size_t)tile * 256 + (which ? 255 : 0)) * DFF + c) = o;
    }
}

namespace exd {
typedef unsigned short bf16;
constexpr int   D = 128, NW = 8, QBLK = 32, KVBLK = 64;
constexpr float SCALE = 0.6931471805599453f;
constexpr float THR = 8.f;
constexpr int SDEPTH = 1;
constexpr int LDQ = 1024, LDK = 256, LDO = 1024;
constexpr size_t SHM_V = KVBLK * D * 2, SHM_K = KVBLK * D * 2, SHM_ATTN = 2 * SHM_V + 2 * SHM_K + NW * 64 * 4;
using bf16x8 = __attribute__((ext_vector_type(8))) short;
using s16x4  = __attribute__((ext_vector_type(4))) short;
using f32x16 = __attribute__((ext_vector_type(16))) float;
using f32x8  = __attribute__((ext_vector_type(8))) float;
using u32x4  = __attribute__((ext_vector_type(4))) unsigned;
#define KSWZ(row, colB) ((row) * 256 + ((colB) ^ (((row) & 7) << 4)))
#define SBAR() __builtin_amdgcn_sched_barrier(0)
__device__ __forceinline__ int crow(int r, int hi) { return (r & 3) + 8 * (r >> 2) + 4 * hi; }
__device__ __forceinline__ unsigned cvtpk(float lo, float hi) {
  unsigned r; asm volatile("v_cvt_pk_bf16_f32 %0, %1, %2" : "=v"(r) : "v"(lo), "v"(hi)); return r;
}
template <typename TIn> struct Stage;
template <> struct Stage<bf16>  { using T = bf16x8;
  __device__ static __forceinline__ T ld8(const bf16* p) { return *reinterpret_cast<const bf16x8*>(p); }
  __device__ static __forceinline__ bf16x8 tobf(T x) { return x; } };
template <> struct Stage<float> { using T = f32x8;
  __device__ static __forceinline__ T ld8(const float* p) { return *reinterpret_cast<const f32x8*>(p); }
  __device__ static __forceinline__ bf16x8 tobf(T x) {
    u32x4 w = {cvtpk(x[0], x[1]), cvtpk(x[2], x[3]), cvtpk(x[4], x[5]), cvtpk(x[6], x[7])}; return *reinterpret_cast<bf16x8*>(&w); } };

__device__ __forceinline__ void partialSM(f32x16& p0, f32x16& p1, float& m_reg, float& mn, float& alpha) {
  constexpr float C = SCALE * 1.4426950408889634f;
  float pmax = p0[0]; for (int r = 1; r < 16; ++r) pmax = fmaxf(pmax, p0[r]); for (int r = 0; r < 16; ++r) pmax = fmaxf(pmax, p1[r]);
  { auto rr = __builtin_amdgcn_permlane32_swap(__float_as_uint(pmax), __float_as_uint(pmax), false, false);
    pmax = fmaxf(__uint_as_float(rr[0]), __uint_as_float(rr[1])); }
  if (__builtin_expect(__all(pmax - m_reg <= THR / SCALE), 1)) { mn = m_reg; alpha = 1.f; }
  else { mn = fmaxf(m_reg, pmax); alpha = __builtin_amdgcn_exp2f((m_reg - mn) * C); m_reg = mn; }
  float mnC = -mn * C;
  for (int r = 0; r < 16; ++r) p0[r] = fmaf(p0[r], C, mnC); for (int r = 0; r < 16; ++r) p1[r] = fmaf(p1[r], C, mnC);
  for (int r = 0; r < 16; ++r) p0[r] = __builtin_amdgcn_exp2f(p0[r]);
}
__device__ __forceinline__ void finishSM(f32x16& p0, f32x16& p1, float alpha, float& l_reg, bf16x8& pa0, bf16x8& pa1, bf16x8& pa2, bf16x8& pa3) {
  for (int r = 0; r < 16; ++r) p1[r] = __builtin_amdgcn_exp2f(p1[r]);
  float ps = 0; for (int r = 0; r < 16; ++r) ps += p0[r]; for (int r = 0; r < 16; ++r) ps += p1[r];
  { auto rr = __builtin_amdgcn_permlane32_swap(__float_as_uint(ps), __float_as_uint(ps), false, false);
    ps = __uint_as_float(rr[0]) + __uint_as_float(rr[1]); }
  l_reg = l_reg * alpha + ps;
#define PK4(P, BASE, OUT) do { unsigned a0 = cvtpk(P[BASE + 0], P[BASE + 1]), a1 = cvtpk(P[BASE + 2], P[BASE + 3]);   \
    unsigned b0 = cvtpk(P[BASE + 4], P[BASE + 5]), b1 = cvtpk(P[BASE + 6], P[BASE + 7]);                              \
    auto r0 = __builtin_amdgcn_permlane32_swap(a0, b0, false, false); auto r1 = __builtin_amdgcn_permlane32_swap(a1, b1, false, false); \
    u32x4 w = {r0[0], r1[0], r0[1], r1[1]}; OUT = *reinterpret_cast<bf16x8*>(&w); } while (0)
  PK4(p0, 0, pa0); PK4(p0, 8, pa1); PK4(p1, 0, pa2); PK4(p1, 8, pa3);
#undef PK4
}
__device__ __forceinline__ void qkt(f32x16& p0, f32x16& p1, const bf16* Ks, const bf16x8* qr, int r32, int hi) {
  p0 = f32x16{}; p1 = f32x16{};
  for (int d0 = 0; d0 < 8; ++d0) { int cb = (d0 * 16 + hi * 8) * 2;
    bf16x8 b0 = *reinterpret_cast<const bf16x8*>((const char*)Ks + KSWZ(r32, cb));
    bf16x8 b1 = *reinterpret_cast<const bf16x8*>((const char*)Ks + KSWZ(32 + r32, cb));
    p0 = __builtin_amdgcn_mfma_f32_32x32x16_bf16(b0, qr[d0], p0, 0, 0, 0);
    p1 = __builtin_amdgcn_mfma_f32_32x32x16_bf16(b1, qr[d0], p1, 0, 0, 0); }
}
__device__ __forceinline__ int v_st(int k, int c) { const int kk = (k & ~0xC) | ((k & 4) << 1) | ((k & 8) >> 1); return ((kk >> 3) * 4 + (c >> 5)) * 512 + ((kk & 7) * 32 + (c & 31)) * 2; }
__device__ __forceinline__ int v_rd_base(int lane) { return ((lane & 3) << 3) | (((lane >> 2) & 3) << 6) | (((lane >> 4) & 1) << 5) | (((lane >> 5) & 1) << 8); }
constexpr int v_rd_off(int d0, int ks, int half) { return d0 * 512 + ks * 4096 + half * 2048; }
template <int OFF> __device__ __forceinline__ s16x4 tr_read(int vb) {
  s16x4 r; asm volatile("ds_read_b64_tr_b16 %0, %1 offset:%2" : "=&v"(r) : "v"(vb), "i"(OFF) : "memory"); return r;
}
template <int D0> __device__ __forceinline__ void pv_one(f32x16& od, int vb, bf16x8 pa0, bf16x8 pa1, bf16x8 pa2, bf16x8 pa3) {
  const s16x4 l0 = tr_read<v_rd_off(D0, 0, 0)>(vb), h0 = tr_read<v_rd_off(D0, 0, 1)>(vb), l1 = tr_read<v_rd_off(D0, 1, 0)>(vb), h1 = tr_read<v_rd_off(D0, 1, 1)>(vb);
  const s16x4 l2 = tr_read<v_rd_off(D0, 2, 0)>(vb), h2 = tr_read<v_rd_off(D0, 2, 1)>(vb), l3 = tr_read<v_rd_off(D0, 3, 0)>(vb), h3 = tr_read<v_rd_off(D0, 3, 1)>(vb);
  asm volatile("s_waitcnt lgkmcnt(0)" ::: "memory"); SBAR();
#define PK(L, H) (bf16x8){L[0], L[1], L[2], L[3], H[0], H[1], H[2], H[3]}
  od = __builtin_amdgcn_mfma_f32_32x32x16_bf16(pa0, PK(l0, h0), od, 0, 0, 0);
  od = __builtin_amdgcn_mfma_f32_32x32x16_bf16(pa1, PK(l1, h1), od, 0, 0, 0);
  od = __builtin_amdgcn_mfma_f32_32x32x16_bf16(pa2, PK(l2, h2), od, 0, 0, 0);
  od = __builtin_amdgcn_mfma_f32_32x32x16_bf16(pa3, PK(l3, h3), od, 0, 0, 0);
#undef PK
}
__device__ __forceinline__ void pv_d0(f32x16* o, int vb, bf16x8 pa0, bf16x8 pa1, bf16x8 pa2, bf16x8 pa3) {
  pv_one<0>(o[0], vb, pa0, pa1, pa2, pa3); pv_one<1>(o[1], vb, pa0, pa1, pa2, pa3); pv_one<2>(o[2], vb, pa0, pa1, pa2, pa3); pv_one<3>(o[3], vb, pa0, pa1, pa2, pa3);
}

template <typename TQ>
__device__ __forceinline__ void attn_dense_body(const TQ* __restrict__ Qb, const bf16* __restrict__ Kh, const bf16* __restrict__ Vh,
                                                bf16* __restrict__ Ob, int seq, char* lds, const int tid) {
  using St = Stage<bf16>; using SQ = Stage<TQ>;
  const int wid = tid >> 6, lane = tid & 63, r32 = lane & 31, hi = lane >> 5;
  bf16* V_lds = (bf16*)lds; bf16* K_lds = (bf16*)(lds + 2 * SHM_V);
  float* ws = (float*)(lds + 2 * SHM_V + 2 * SHM_K) + wid * 64; float* li_l = ws; float* al_l = ws + 32;
  float m_reg = -1e30f, l_reg = 0; f32x16 o[4] = {}; bf16x8 qr[8];
  const TQ* Qw = Qb + (long)(wid * QBLK + r32) * LDQ + hi * 8;
#pragma unroll
  for (int d0 = 0; d0 < 8; ++d0) qr[d0] = SQ::tobf(SQ::ld8(Qw + d0 * 16));
  const int sr = tid >> 4, sc = (tid & 15) * 8, vst0 = v_st(sr, sc), vst1 = v_st(32 + sr, sc);
  const int vb0 = (int)(uintptr_t)V_lds + v_rd_base(lane);
  struct { typename St::T vs0, vs1, ks0, ks1; } sr_[SDEPTH];
  const unsigned lo0 = (unsigned)(sr * LDK + sc) * 2u, lo1 = lo0 + 32u * LDK * 2u;
#define SLOAD(i, k0) do { const char* vt_ = (const char*)Vh + (size_t)(k0) * (LDK * 2); const char* kt_ = (const char*)Kh + (size_t)(k0) * (LDK * 2); \
    sr_[i].vs0 = *reinterpret_cast<const bf16x8*>(vt_ + lo0); sr_[i].vs1 = *reinterpret_cast<const bf16x8*>(vt_ + lo1); \
    sr_[i].ks0 = *reinterpret_cast<const bf16x8*>(kt_ + lo0); sr_[i].ks1 = *reinterpret_cast<const bf16x8*>(kt_ + lo1); } while (0)
#define SWRITE(b, i) do { *(bf16x8*)((char*)V_lds + (b) * SHM_V + vst0) = St::tobf(sr_[i].vs0);          \
    *(bf16x8*)((char*)V_lds + (b) * SHM_V + vst1) = St::tobf(sr_[i].vs1); int kc = sc * 2;               \
    *(bf16x8*)((char*)K_lds + (b) * SHM_K + KSWZ(sr, kc)) = St::tobf(sr_[i].ks0);                       \
    *(bf16x8*)((char*)K_lds + (b) * SHM_K + KSWZ(32 + sr, kc)) = St::tobf(sr_[i].ks1); } while (0)
#define SWAIT() do { if constexpr (SDEPTH == 2) asm volatile("s_waitcnt vmcnt(4)" ::: "memory"); else asm volatile("s_waitcnt vmcnt(0)" ::: "memory"); } while (0)
#define RESC(a) do { if (__any((a) < 1.f)) { if (hi == 0) al_l[r32] = (a); asm volatile("s_waitcnt lgkmcnt(0)" ::: "memory"); \
    for (int d = 0; d < 4; ++d) for (int r = 0; r < 16; ++r) o[d][r] *= al_l[crow(r, hi)]; } } while (0)
  f32x16 pA0, pA1, pB0, pB1; float mnA, mnB, alA, alB; bf16x8 pa0, pa1, pa2, pa3; const int NT = seq / KVBLK;
  constexpr int SE = 0, SO = SDEPTH - 1;
  SLOAD(SE, 0); asm volatile("s_waitcnt vmcnt(0)" ::: "memory"); SWRITE(0, SE); __syncthreads();
  qkt(pA0, pA1, K_lds, qr, r32, hi); partialSM(pA0, pA1, m_reg, mnA, alA);
  SLOAD(SO, KVBLK); if constexpr (SDEPTH == 2) { if (2 < NT) SLOAD(SE, 2 * KVBLK); }
  SWAIT(); SWRITE(1, SO); __syncthreads();
  for (int j = 1; j + 1 < NT; j += 2) {
    SBAR(); qkt(pB0, pB1, (bf16*)((char*)K_lds + SHM_K), qr, r32, hi);
    finishSM(pA0, pA1, alA, l_reg, pa0, pa1, pa2, pa3); SBAR();
    SLOAD(SO, (j + SDEPTH) * KVBLK); SBAR();
    pv_d0(o, vb0, pa0, pa1, pa2, pa3); partialSM(pB0, pB1, m_reg, mnB, alB);
    __syncthreads(); SWAIT(); SWRITE(0, SE);
    RESC(alB); __syncthreads();
    SBAR(); qkt(pA0, pA1, K_lds, qr, r32, hi);
    finishSM(pB0, pB1, alB, l_reg, pa0, pa1, pa2, pa3); SBAR();
    if (SDEPTH == 1 || j + 3 < NT) SLOAD(SE, (j + 1 + SDEPTH) * KVBLK); SBAR();
    pv_d0(o, vb0 + (int)SHM_V, pa0, pa1, pa2, pa3); partialSM(pA0, pA1, m_reg, mnA, alA);
    __syncthreads(); SWAIT(); SWRITE(1, SO);
    RESC(alA); __syncthreads();
  }
  SBAR(); qkt(pB0, pB1, (bf16*)((char*)K_lds + SHM_K), qr, r32, hi);
  finishSM(pA0, pA1, alA, l_reg, pa0, pa1, pa2, pa3); SBAR();
  pv_d0(o, vb0, pa0, pa1, pa2, pa3); partialSM(pB0, pB1, m_reg, mnB, alB);
  __syncthreads(); RESC(alB);
  finishSM(pB0, pB1, alB, l_reg, pa0, pa1, pa2, pa3); SBAR();
  pv_d0(o, vb0 + (int)SHM_V, pa0, pa1, pa2, pa3);
  if (hi == 0) li_l[r32] = l_reg; asm volatile("s_waitcnt lgkmcnt(0)" ::: "memory");
  float rli[16];
#pragma unroll
  for (int r = 0; r < 16; ++r) rli[r] = __builtin_amdgcn_rcpf(li_l[crow(r, hi)]);
  bf16* Ow = Ob + (long)(wid * QBLK) * LDO;
#pragma unroll
  for (int r = 0; r < 16; ++r) { int orow = crow(r, hi);
    for (int d0 = 0; d0 < 4; ++d0) Ow[(long)orow * LDO + d0 * 32 + r32] = (bf16)(cvtpk(o[d0][r] * rli[r], 0.f) & 0xffffu); }
#undef SLOAD
#undef SWRITE
#undef SWAIT
#undef RESC
}
#undef KSWZ
#undef SBAR
}

namespace exf {
typedef unsigned short bf16;
constexpr int   D = 128, NW = 8, QBLK = 32, KVBLK = 64;
constexpr float SCALE = 0.6931471805599453f;
constexpr float THR = 8.f;
constexpr int SDEPTH = 1;
constexpr int LDQ = 1536, LDK = 256, LDO = 1024;
constexpr size_t SHM_V = KVBLK * D * 2, SHM_K = KVBLK * D * 2, SHM_ATTN = 2 * SHM_V + 2 * SHM_K + NW * 64 * 4;
using bf16x8 = __attribute__((ext_vector_type(8))) short;
using s16x4  = __attribute__((ext_vector_type(4))) short;
using f32x16 = __attribute__((ext_vector_type(16))) float;
using f32x8  = __attribute__((ext_vector_type(8))) float;
using u32x4  = __attribute__((ext_vector_type(4))) unsigned;
#define KSWZ(row, colB) ((row) * 256 + ((colB) ^ (((row) & 7) << 4)))
#define SBAR() __builtin_amdgcn_sched_barrier(0)
__device__ __forceinline__ int crow(int r, int hi) { return (r & 3) + 8 * (r >> 2) + 4 * hi; }
__device__ __forceinline__ unsigned cvtpk(float lo, float hi) {
  unsigned r; asm volatile("v_cvt_pk_bf16_f32 %0, %1, %2" : "=v"(r) : "v"(lo), "v"(hi)); return r;
}
template <typename TIn> struct Stage;
template <> struct Stage<bf16>  { using T = bf16x8;
  __device__ static __forceinline__ T ld8(const bf16* p) { return *reinterpret_cast<const bf16x8*>(p); }
  __device__ static __forceinline__ bf16x8 tobf(T x) { return x; } };
template <> struct Stage<float> { using T = f32x8;
  __device__ static __forceinline__ T ld8(const float* p) { return *reinterpret_cast<const f32x8*>(p); }
  __device__ static __forceinline__ bf16x8 tobf(T x) {
    u32x4 w = {cvtpk(x[0], x[1]), cvtpk(x[2], x[3]), cvtpk(x[4], x[5]), cvtpk(x[6], x[7])}; return *reinterpret_cast<bf16x8*>(&w); } };

__device__ __forceinline__ void partialSM(f32x16& p0, f32x16& p1, float& m_reg, float& mn, float& alpha) {
  mn = 0.f; alpha = 1.f;
  for (int r = 0; r < 16; ++r) p0[r] = __builtin_amdgcn_exp2f(p0[r]);
}
__device__ __forceinline__ void finishSM(f32x16& p0, f32x16& p1, float alpha, float& l_reg, bf16x8& pa0, bf16x8& pa1, bf16x8& pa2, bf16x8& pa3) {
  for (int r = 0; r < 16; ++r) p1[r] = __builtin_amdgcn_exp2f(p1[r]);
  float ps = 0; for (int r = 0; r < 16; ++r) ps += p0[r]; for (int r = 0; r < 16; ++r) ps += p1[r];
  { auto rr = __builtin_amdgcn_permlane32_swap(__float_as_uint(ps), __float_as_uint(ps), false, false);
    ps = __uint_as_float(rr[0]) + __uint_as_float(rr[1]); }
  l_reg = l_reg * alpha + ps;
#define PK4(P, BASE, OUT) do { unsigned a0 = cvtpk(P[BASE + 0], P[BASE + 1]), a1 = cvtpk(P[BASE + 2], P[BASE + 3]);   \
    unsigned b0 = cvtpk(P[BASE + 4], P[BASE + 5]), b1 = cvtpk(P[BASE + 6], P[BASE + 7]);                              \
    auto r0 = __builtin_amdgcn_permlane32_swap(a0, b0, false, false); auto r1 = __builtin_amdgcn_permlane32_swap(a1, b1, false, false); \
    u32x4 w = {r0[0], r1[0], r0[1], r1[1]}; OUT = *reinterpret_cast<bf16x8*>(&w); } while (0)
  PK4(p0, 0, pa0); PK4(p0, 8, pa1); PK4(p1, 0, pa2); PK4(p1, 8, pa3);
#undef PK4
}
__device__ __forceinline__ void qkt(f32x16& p0, f32x16& p1, const bf16* Ks, const bf16x8* qr, int r32, int hi) {
  p0 = f32x16{}; p1 = f32x16{};
  for (int d0 = 0; d0 < 8; ++d0) { int cb = (d0 * 16 + hi * 8) * 2;
    bf16x8 b0 = *reinterpret_cast<const bf16x8*>((const char*)Ks + KSWZ(r32, cb));
    bf16x8 b1 = *reinterpret_cast<const bf16x8*>((const char*)Ks + KSWZ(32 + r32, cb));
    p0 = __builtin_amdgcn_mfma_f32_32x32x16_bf16(b0, qr[d0], p0, 0, 0, 0);
    p1 = __builtin_amdgcn_mfma_f32_32x32x16_bf16(b1, qr[d0], p1, 0, 0, 0); }
}
__device__ __forceinline__ int v_st(int k, int c) { const int kk = (k & ~0xC) | ((k & 4) << 1) | ((k & 8) >> 1); return ((kk >> 3) * 4 + (c >> 5)) * 512 + ((kk & 7) * 32 + (c & 31)) * 2; }
__device__ __forceinline__ int v_rd_base(int lane) { return ((lane & 3) << 3) | (((lane >> 2) & 3) << 6) | (((lane >> 4) & 1) << 5) | (((lane >> 5) & 1) << 8); }
constexpr int v_rd_off(int d0, int ks, int half) { return d0 * 512 + ks * 4096 + half * 2048; }
template <int OFF> __device__ __forceinline__ s16x4 tr_read(int vb) {
  s16x4 r; asm volatile("ds_read_b64_tr_b16 %0, %1 offset:%2" : "=&v"(r) : "v"(vb), "i"(OFF) : "memory"); return r;
}
template <int D0> __device__ __forceinline__ void pv_one(f32x16& od, int vb, bf16x8 pa0, bf16x8 pa1, bf16x8 pa2, bf16x8 pa3) {
  const s16x4 l0 = tr_read<v_rd_off(D0, 0, 0)>(vb), h0 = tr_read<v_rd_off(D0, 0, 1)>(vb), l1 = tr_read<v_rd_off(D0, 1, 0)>(vb), h1 = tr_read<v_rd_off(D0, 1, 1)>(vb);
  const s16x4 l2 = tr_read<v_rd_off(D0, 2, 0)>(vb), h2 = tr_read<v_rd_off(D0, 2, 1)>(vb), l3 = tr_read<v_rd_off(D0, 3, 0)>(vb), h3 = tr_read<v_rd_off(D0, 3, 1)>(vb);
  asm volatile("s_waitcnt lgkmcnt(0)" ::: "memory"); SBAR();
#define PK(L, H) (bf16x8){L[0], L[1], L[2], L[3], H[0], H[1], H[2], H[3]}
  od = __builtin_amdgcn_mfma_f32_32x32x16_bf16(pa0, PK(l0, h0), od, 0, 0, 0);
  od = __builtin_amdgcn_mfma_f32_32x32x16_bf16(pa1, PK(l1, h1), od, 0, 0, 0);
  od = __builtin_amdgcn_mfma_f32_32x32x16_bf16(pa2, PK(l2, h2), od, 0, 0, 0);
  od = __builtin_amdgcn_mfma_f32_32x32x16_bf16(pa3, PK(l3, h3), od, 0, 0, 0);
#undef PK
}
__device__ __forceinline__ void pv_d0(f32x16* o, int vb, bf16x8 pa0, bf16x8 pa1, bf16x8 pa2, bf16x8 pa3) {
  pv_one<0>(o[0], vb, pa0, pa1, pa2, pa3); pv_one<1>(o[1], vb, pa0, pa1, pa2, pa3); pv_one<2>(o[2], vb, pa0, pa1, pa2, pa3); pv_one<3>(o[3], vb, pa0, pa1, pa2, pa3);
}

template <typename TQ>
__device__ __forceinline__ void attn_dense_body(const TQ* __restrict__ Qb, const bf16* __restrict__ Kh, const bf16* __restrict__ Vh,
                                                bf16* __restrict__ Ob, int seq, char* lds, const int tid, const float* gq, const float* R128, int t0, bool rope) {
  using St = Stage<bf16>; using SQ = Stage<TQ>;
  const int wid = tid >> 6, lane = tid & 63, r32 = lane & 31, hi = lane >> 5;
  bf16* V_lds = (bf16*)lds; bf16* K_lds = (bf16*)(lds + 2 * SHM_V);
  float* ws = (float*)(lds + 2 * SHM_V + 2 * SHM_K) + wid * 64; float* li_l = ws; float* al_l = ws + 32;
  float m_reg = -1e30f, l_reg = 0; f32x16 o[4] = {}; bf16x8 qr[8];
  const TQ* Qw = Qb + (long)(wid * QBLK + r32) * LDQ + hi * 8;
#pragma unroll
  for (int d0 = 0; d0 < 8; ++d0) qr[d0] = SQ::tobf(SQ::ld8(Qw + d0 * 16));
  qnorm_rope_frag<128>(qr, gq, R128, t0 + wid * QBLK + r32, rope, 0.12751743f, lane);
  const int sr = tid >> 4, sc = (tid & 15) * 8, vst0 = v_st(sr, sc), vst1 = v_st(32 + sr, sc);
  const int vb0 = (int)(uintptr_t)V_lds + v_rd_base(lane);
  struct { typename St::T vs0, vs1, ks0, ks1; } sr_[SDEPTH];
  const unsigned lo0 = (unsigned)(sr * LDK + sc) * 2u, lo1 = lo0 + 32u * LDK * 2u;
#define SLOAD(i, k0) do { const char* vt_ = (const char*)Vh + (size_t)(k0) * (LDK * 2); const char* kt_ = (const char*)Kh + (size_t)(k0) * (LDK * 2); \
    sr_[i].vs0 = *reinterpret_cast<const bf16x8*>(vt_ + lo0); sr_[i].vs1 = *reinterpret_cast<const bf16x8*>(vt_ + lo1); \
    sr_[i].ks0 = *reinterpret_cast<const bf16x8*>(kt_ + lo0); sr_[i].ks1 = *reinterpret_cast<const bf16x8*>(kt_ + lo1); } while (0)
#define SWRITE(b, i) do { *(bf16x8*)((char*)V_lds + (b) * SHM_V + vst0) = St::tobf(sr_[i].vs0);          \
    *(bf16x8*)((char*)V_lds + (b) * SHM_V + vst1) = St::tobf(sr_[i].vs1); int kc = sc * 2;               \
    *(bf16x8*)((char*)K_lds + (b) * SHM_K + KSWZ(sr, kc)) = St::tobf(sr_[i].ks0);                       \
    *(bf16x8*)((char*)K_lds + (b) * SHM_K + KSWZ(32 + sr, kc)) = St::tobf(sr_[i].ks1); } while (0)
#define SWAIT() do { if constexpr (SDEPTH == 2) asm volatile("s_waitcnt vmcnt(4)" ::: "memory"); else asm volatile("s_waitcnt vmcnt(0)" ::: "memory"); } while (0)
#define RESC(a) do { } while (0)
  f32x16 pA0, pA1, pB0, pB1; float mnA, mnB, alA, alB; bf16x8 pa0, pa1, pa2, pa3; const int NT = seq / KVBLK;
  constexpr int SE = 0, SO = SDEPTH - 1;
  SLOAD(SE, 0); asm volatile("s_waitcnt vmcnt(0)" ::: "memory"); SWRITE(0, SE); __syncthreads();
  qkt(pA0, pA1, K_lds, qr, r32, hi); partialSM(pA0, pA1, m_reg, mnA, alA);
  SLOAD(SO, KVBLK); if constexpr (SDEPTH == 2) { if (2 < NT) SLOAD(SE, 2 * KVBLK); }
  SWAIT(); SWRITE(1, SO); __syncthreads();
  for (int j = 1; j + 1 < NT; j += 2) {
    SBAR(); qkt(pB0, pB1, (bf16*)((char*)K_lds + SHM_K), qr, r32, hi);
    finishSM(pA0, pA1, alA, l_reg, pa0, pa1, pa2, pa3); SBAR();
    SLOAD(SO, (j + SDEPTH) * KVBLK); SBAR();
    pv_d0(o, vb0, pa0, pa1, pa2, pa3); partialSM(pB0, pB1, m_reg, mnB, alB);
    __syncthreads(); SWAIT(); SWRITE(0, SE);
    RESC(alB); __syncthreads();
    SBAR(); qkt(pA0, pA1, K_lds, qr, r32, hi);
    finishSM(pB0, pB1, alB, l_reg, pa0, pa1, pa2, pa3); SBAR();
    if (SDEPTH == 1 || j + 3 < NT) SLOAD(SE, (j + 1 + SDEPTH) * KVBLK); SBAR();
    pv_d0(o, vb0 + (int)SHM_V, pa0, pa1, pa2, pa3); partialSM(pA0, pA1, m_reg, mnA, alA);
    __syncthreads(); SWAIT(); SWRITE(1, SO);
    RESC(alA); __syncthreads();
  }
  SBAR(); qkt(pB0, pB1, (bf16*)((char*)K_lds + SHM_K), qr, r32, hi);
  finishSM(pA0, pA1, alA, l_reg, pa0, pa1, pa2, pa3); SBAR();
  pv_d0(o, vb0, pa0, pa1, pa2, pa3); partialSM(pB0, pB1, m_reg, mnB, alB);
  __syncthreads(); RESC(alB);
  finishSM(pB0, pB1, alB, l_reg, pa0, pa1, pa2, pa3); SBAR();
  pv_d0(o, vb0 + (int)SHM_V, pa0, pa1, pa2, pa3);
  if (hi == 0) li_l[r32] = l_reg; asm volatile("s_waitcnt lgkmcnt(0)" ::: "memory");
  float rli[16];
#pragma unroll
  for (int r = 0; r < 16; ++r) rli[r] = __builtin_amdgcn_rcpf(li_l[crow(r, hi)]);
  bf16* Ow = Ob + (long)(wid * QBLK) * LDO;
#pragma unroll
  for (int r = 0; r < 16; ++r) { int orow = crow(r, hi);
    for (int d0 = 0; d0 < 4; ++d0) Ow[(long)orow * LDO + d0 * 32 + r32] = (bf16)(cvtpk(o[d0][r] * rli[r], 0.f) & 0xffffu); }
#undef SLOAD
#undef SWRITE
#undef SWAIT
#undef RESC
}
#undef KSWZ
#undef SBAR
#undef KSWZ
#undef SBAR
}


namespace att {
typedef short bf16x8 __attribute__((ext_vector_type(8)));
typedef short s16x4 __attribute__((ext_vector_type(4)));
typedef float f32x16 __attribute__((ext_vector_type(16)));
typedef unsigned u32x4 __attribute__((ext_vector_type(4)));
#define SBAR() __builtin_amdgcn_sched_barrier(0)
__device__ __forceinline__ int crow(int r, int hi) { return (r & 3) + 8 * (r >> 2) + 4 * hi; }
__device__ __forceinline__ unsigned cvtpk(float lo, float hi) { unsigned r; asm volatile("v_cvt_pk_bf16_f32 %0, %1, %2" : "=v"(r) : "v"(lo), "v"(hi)); return r; }
__device__ __forceinline__ int lds_addr(const LAS void* p) { return (int)(unsigned)(unsigned long long)p; }
template <int D> __device__ __forceinline__ int kswz(int row, int colB) { return row * (2 * D) + (colB ^ ((row & 7) << 4)); }
__device__ __forceinline__ void partialSM(f32x16& p0, f32x16& p1, float& m_reg, float& mn, float& alpha, const float C, const float THRS) {
  float pmax = p0[0];
#pragma unroll
  for (int r = 1; r < 16; ++r) pmax = fmaxf(pmax, p0[r]);
#pragma unroll
  for (int r = 0; r < 16; ++r) pmax = fmaxf(pmax, p1[r]);
  { auto rr = __builtin_amdgcn_permlane32_swap(__float_as_uint(pmax), __float_as_uint(pmax), false, false);
    pmax = fmaxf(__uint_as_float(rr[0]), __uint_as_float(rr[1])); }
  if (__builtin_expect(__all(pmax - m_reg <= THRS), 1)) { mn = m_reg; alpha = 1.f; }
  else { mn = fmaxf(m_reg, pmax); alpha = __builtin_amdgcn_exp2f((m_reg - mn) * C); m_reg = mn; }
  const float mnC = -mn * C;
#pragma unroll
  for (int r = 0; r < 16; ++r) p0[r] = fmaf(p0[r], C, mnC);
#pragma unroll
  for (int r = 0; r < 16; ++r) p1[r] = fmaf(p1[r], C, mnC);
#pragma unroll
  for (int r = 0; r < 16; ++r) p0[r] = __builtin_amdgcn_exp2f(p0[r]);
}
__device__ __forceinline__ void pack_p(const f32x16& p0, const f32x16& p1, bf16x8& pa0, bf16x8& pa1, bf16x8& pa2, bf16x8& pa3) {
#define PK4(P, BASE, OUT) do { unsigned a0 = cvtpk(P[BASE + 0], P[BASE + 1]), a1 = cvtpk(P[BASE + 2], P[BASE + 3]);   \
    unsigned b0 = cvtpk(P[BASE + 4], P[BASE + 5]), b1 = cvtpk(P[BASE + 6], P[BASE + 7]);                              \
    auto r0 = __builtin_amdgcn_permlane32_swap(a0, b0, false, false); auto r1 = __builtin_amdgcn_permlane32_swap(a1, b1, false, false); \
    u32x4 w = {r0[0], r1[0], r0[1], r1[1]}; OUT = *reinterpret_cast<bf16x8*>(&w); } while (0)
  PK4(p0, 0, pa0); PK4(p0, 8, pa1); PK4(p1, 0, pa2); PK4(p1, 8, pa3);
#undef PK4
}
__device__ __forceinline__ float row_sum(const f32x16& p0, const f32x16& p1) {
  float ps = 0.f;
#pragma unroll
  for (int r = 0; r < 16; ++r) ps += p0[r];
#pragma unroll
  for (int r = 0; r < 16; ++r) ps += p1[r];
  auto rr = __builtin_amdgcn_permlane32_swap(__float_as_uint(ps), __float_as_uint(ps), false, false);
  return __uint_as_float(rr[0]) + __uint_as_float(rr[1]);
}
__device__ __forceinline__ void finishSM(f32x16& p0, f32x16& p1, float alpha, float& l_reg, bf16x8& pa0, bf16x8& pa1, bf16x8& pa2, bf16x8& pa3) {
#pragma unroll
  for (int r = 0; r < 16; ++r) p1[r] = __builtin_amdgcn_exp2f(p1[r]);
  const float ps = row_sum(p0, p1);
  l_reg = l_reg * alpha + ps;
  pack_p(p0, p1, pa0, pa1, pa2, pa3);
}
template <int D> __device__ __forceinline__ void qkt(f32x16& p0, f32x16& p1, const LAS char* Ks, const bf16x8* qr, int r32, int hi) {
  p0 = f32x16{}; p1 = f32x16{};
#pragma unroll
  for (int d0 = 0; d0 < D / 16; ++d0) { const int cb = (d0 * 16 + hi * 8) * 2;
    const bf16x8 b0 = *(const LAS bf16x8*)(Ks + kswz<D>(r32, cb));
    const bf16x8 b1 = *(const LAS bf16x8*)(Ks + kswz<D>(32 + r32, cb));
    p0 = __builtin_amdgcn_mfma_f32_32x32x16_bf16(b0, qr[d0], p0, 0, 0, 0);
    p1 = __builtin_amdgcn_mfma_f32_32x32x16_bf16(b1, qr[d0], p1, 0, 0, 0); }
}
template <int D> __device__ __forceinline__ int v_st(int k, int c) { const int kk = (k & ~0xC) | ((k & 4) << 1) | ((k & 8) >> 1); return ((kk >> 3) * (D / 32) + (c >> 5)) * 512 + ((kk & 7) * 32 + (c & 31)) * 2; }
__device__ __forceinline__ int v_rd_base(int lane) { return ((lane & 3) << 3) | (((lane >> 2) & 3) << 6) | (((lane >> 4) & 1) << 5) | (((lane >> 5) & 1) << 8); }
template <int D> constexpr int v_rd_off(int d0, int ks, int half) { return d0 * 512 + ks * (D / 32) * 1024 + half * (D / 32) * 512; }
template <int OFF> __device__ __forceinline__ s16x4 tr_read(int vb) {
  s16x4 r; asm volatile("ds_read_b64_tr_b16 %0, %1 offset:%2" : "=&v"(r) : "v"(vb), "i"(OFF) : "memory"); return r;
}
template <int D, int D0> __device__ __forceinline__ void pv_one(f32x16& od, int vb, bf16x8 pa0, bf16x8 pa1, bf16x8 pa2, bf16x8 pa3) {
  const s16x4 l0 = tr_read<v_rd_off<D>(D0, 0, 0)>(vb), h0 = tr_read<v_rd_off<D>(D0, 0, 1)>(vb), l1 = tr_read<v_rd_off<D>(D0, 1, 0)>(vb), h1 = tr_read<v_rd_off<D>(D0, 1, 1)>(vb);
  const s16x4 l2 = tr_read<v_rd_off<D>(D0, 2, 0)>(vb), h2 = tr_read<v_rd_off<D>(D0, 2, 1)>(vb), l3 = tr_read<v_rd_off<D>(D0, 3, 0)>(vb), h3 = tr_read<v_rd_off<D>(D0, 3, 1)>(vb);
  asm volatile("s_waitcnt lgkmcnt(0)" ::: "memory"); SBAR();
#define PK(L, H) (bf16x8){L[0], L[1], L[2], L[3], H[0], H[1], H[2], H[3]}
  od = __builtin_amdgcn_mfma_f32_32x32x16_bf16(pa0, PK(l0, h0), od, 0, 0, 0);
  od = __builtin_amdgcn_mfma_f32_32x32x16_bf16(pa1, PK(l1, h1), od, 0, 0, 0);
  od = __builtin_amdgcn_mfma_f32_32x32x16_bf16(pa2, PK(l2, h2), od, 0, 0, 0);
  od = __builtin_amdgcn_mfma_f32_32x32x16_bf16(pa3, PK(l3, h3), od, 0, 0, 0);
#undef PK
}
}

template <bool FAST>
__device__ __forceinline__ void win_attn_unit(const Frame& F, bool ctxq, int b, int h, int qb, const bf16* Qp, const bf16* Kp, const bf16* RAW, bf16* O, float sink, LAS char* lds, const float* qn, const float* R64) {
  using namespace att;
  constexpr float C = 1.f, THRS = 8.f * LOG2E;
  const int tid = F.tid, wid = F.wave, lane = F.lane, r32 = lane & 31, hi = lane >> 5;
  LAS char* Kl = lds; LAS char* Vl = lds + 16384; LAS float* li_l = (LAS float*)(lds + 32768) + wid * 64; LAS float* al_l = li_l + 32;
  const int g = h >> 2;
  const int q0 = ctxq ? 0 : qb * 256;
  const long qrow_w = (ctxq ? (long)ML + b * CTXL : (long)b * SEQ + q0) + wid * 32;
  bf16x8 qr[4];
  if constexpr (FAST) {
#pragma unroll
    for (int d0 = 0; d0 < 4; ++d0) qr[d0] = *(const bf16x8*)(Qp + (qrow_w + r32) * 1536 + h * 64 + d0 * 16 + hi * 8);
    qnorm_rope_frag<64>(qr, qn, R64, q0 + wid * 32 + r32, !ctxq, 0.18033688f, lane);
  } else {
#pragma unroll
    for (int d0 = 0; d0 < 4; ++d0) qr[d0] = *(const bf16x8*)(Qp + (qrow_w + r32) * 1024 + h * 64 + d0 * 16 + hi * 8);
  }
  int jlo = 0, jhi = 0;
  if (!ctxq) { jlo = (q0 == 0) ? 2 : 0; jhi = (SEQ - (q0 - 128)) / 64; if (jhi > 8) jhi = 8; }
  const int NT = 4 + (jhi - jlo);
  const int srow = tid >> 3, sch = tid & 7;
  const int vb0 = lds_addr(Vl) + v_rd_base(lane);
  float m_reg = -1e30f, l_reg = 0.f; f32x16 o[2]; o[0] = f32x16{}; o[1] = f32x16{};
  v4u kreg, vreg;
#define TROW(i) ((i) < 4 ? (long)ML + b * CTXL + 64 * (i) : (long)b * SEQ + q0 - 128 + 64 * (jlo + (i) - 4))
#define WLOAD(i) do { const long tr_ = TROW(i) + srow; kreg = *(const v4u*)(Kp + tr_ * 256 + g * 64 + sch * 8); vreg = *(const v4u*)(RAW + tr_ * 1536 + 1280 + g * 64 + sch * 8); } while (0)
  WLOAD(0);
  for (int i = 0; i < NT; ++i) {
    const int buf = i & 1;
    *(LAS v4u*)(Kl + buf * 8192 + kswz<64>(srow, sch * 16)) = kreg;
    *(LAS v4u*)(Vl + buf * 8192 + v_st<64>(srow, sch * 8)) = vreg;
    __syncthreads();
    if (i + 1 < NT) WLOAD(i + 1);
    bool need = true; int T = 0;
    if (i >= 4) { T = q0 - 128 + 64 * (jlo + i - 4); const int qw0 = q0 + wid * 32; need = (T + 63 >= qw0 - 128) && (T <= qw0 + 31 + 128); }
    if (need) {
      f32x16 p0, p1; qkt<64>(p0, p1, Kl + buf * 8192, qr, r32, hi);
      if (i >= 4) { const int dq = q0 + wid * 32 + r32 - T;
#pragma unroll
        for (int r = 0; r < 16; ++r) { const int d0_ = dq - crow(r, hi), d1_ = d0_ - 32;
          if (d0_ > 128 || d0_ < -128) p0[r] = -1e30f;
          if (d1_ > 128 || d1_ < -128) p1[r] = -1e30f; } }
      bf16x8 pa0, pa1, pa2, pa3;
      if constexpr (FAST) {
#pragma unroll
        for (int r = 0; r < 16; ++r) { p0[r] = __builtin_amdgcn_exp2f(p0[r]); p1[r] = __builtin_amdgcn_exp2f(p1[r]); }
        l_reg += row_sum(p0, p1); pack_p(p0, p1, pa0, pa1, pa2, pa3); SBAR();
      } else {
      float mn, alpha; partialSM(p0, p1, m_reg, mn, alpha, C, THRS);
      if (__any(alpha < 1.f)) { if (hi == 0) al_l[r32] = alpha; asm volatile("s_waitcnt lgkmcnt(0)" ::: "memory");
#pragma unroll
        for (int d = 0; d < 2; ++d)
#pragma unroll
          for (int r = 0; r < 16; ++r) o[d][r] *= al_l[crow(r, hi)]; }
      finishSM(p0, p1, alpha, l_reg, pa0, pa1, pa2, pa3); SBAR();
      }
      pv_one<64, 0>(o[0], vb0 + buf * 8192, pa0, pa1, pa2, pa3); pv_one<64, 1>(o[1], vb0 + buf * 8192, pa0, pa1, pa2, pa3);
    }
  }
#undef TROW
#undef WLOAD
  l_reg += __builtin_amdgcn_exp2f(sink * LOG2E - (FAST ? 0.f : m_reg * C));
  if (hi == 0) li_l[r32] = l_reg; asm volatile("s_waitcnt lgkmcnt(0)" ::: "memory");
  float rli[16];
#pragma unroll
  for (int r = 0; r < 16; ++r) rli[r] = __builtin_amdgcn_rcpf(li_l[crow(r, hi)]);
  bf16* Ow = O + qrow_w * 1024 + h * 64;
#pragma unroll
  for (int r = 0; r < 16; ++r) { const int orow = crow(r, hi);
#pragma unroll
    for (int d0 = 0; d0 < 2; ++d0) Ow[(long)orow * 1024 + d0 * 32 + r32] = f2bf16(o[d0][r] * rli[r]); }
  __syncthreads();
}


__device__ __forceinline__ void ml_decode(int uid, int& b, int& h, int& dir, int& c, long& base, int& sgn) {
  c = uid % 66; const int sid = uid / 66; dir = sid & 1; h = (sid >> 1) & 3; b = sid >> 3;
  if (dir == 0) { base = c < 2 ? (long)ML + b * CTXL + 128 * c : (long)b * SEQ + 128 * (c - 2); sgn = 1; }
  else { base = c < 2 ? (long)ML + b * CTXL + 255 - 128 * c : (long)b * SEQ + 8191 - 128 * (c - 2); sgn = -1; }
}
__device__ __forceinline__ float wave_incl_scan_add(float v, int lane) {
#pragma unroll
  for (int o = 1; o < 64; o <<= 1) { const float t = bperm(v, lane - o); if (lane >= o) v += t; }
  return v;
}
__device__ __forceinline__ float wave_incl_scan_max(float v, int lane) {
#pragma unroll
  for (int o = 1; o < 64; o <<= 1) { const float t = bperm(v, lane - o); if (lane >= o) v = fmaxf(v, t); }
  return v;
}
__device__ __forceinline__ void ml1_load(const Frame& F, int uid, const bf16* RAW, const float* GATESb, v4u (&kq)[4], v4u (&vq)[8], float (&gt)[4]) {
  int b, h, dir, c, sgn; long base; ml_decode(uid, b, h, dir, c, base, sgn);
  const int wid = F.wave, ln = xb_lane(), tid = (wid << 6) | ln;
  if (wid == 0) { const long ra = base + sgn * ln, rb = base + sgn * (ln + 64);
    gt[0] = GATESb[ra * 16 + dir * 8 + h]; gt[1] = GATESb[ra * 16 + dir * 8 + 4 + h]; gt[2] = GATESb[rb * 16 + dir * 8 + h]; gt[3] = GATESb[rb * 16 + dir * 8 + 4 + h]; }
#pragma unroll
  for (int ii = 0; ii < 4; ++ii) { const int l = (tid >> 4) + 32 * ii; kq[ii] = *(const v4u*)(RAW + (size_t)(base + sgn * l) * 3072 + 512 + 128 * h + (tid & 15) * 8); }
#pragma unroll
  for (int ii = 0; ii < 8; ++ii) { const int l = (tid >> 5) + 16 * ii; vq[ii] = *(const v4u*)(RAW + (size_t)(base + sgn * l) * 3072 + 1024 + 256 * h + (tid & 31) * 8); }
}
__device__ __forceinline__ void ml1_unit(const Frame& F, int uid, int uid_next, const bf16* RAW, const float* GATESb, bf16* CBAR, float* NBAR, float* MSC, LAS char* lds, v4u (&kq)[4], v4u (&vq)[8], float (&gt)[4]) {
  using namespace att;
  LAS char* Kt = lds; LAS char* Vt = lds + 32768; LAS float* wS = (LAS float*)(lds + 98304); LAS float* nP = wS + 128;
  const int tid = F.tid, wid = F.wave, lane = F.lane, r32 = lane & 31, hi = lane >> 5;
  const float lia = gt[0], lfa = gt[1], lib = gt[2], lfb = gt[3];
  if (wid == 0) {
    const int lane = xb_lane();
    const float ca = wave_incl_scan_add(lfa, lane); const float tot = __int_as_float(__builtin_amdgcn_readlane(__float_as_int(ca), 63));
    const float cb = wave_incl_scan_add(lfb, lane) + tot; const float g = __int_as_float(__builtin_amdgcn_readlane(__float_as_int(cb), 63));
    const float ua = lia - ca, ub = lib - cb; const float um = wave_max(fmaxf(ua, ub), lane);
    wS[lane] = expf(ua - um); wS[lane + 64] = expf(ub - um);
    if (lane == 0) { MSC[(size_t)uid * 4 + 0] = g; MSC[(size_t)uid * 4 + 1] = g + um; }
  }
  __syncthreads();
  float kacc[8];
#pragma unroll
  for (int e = 0; e < 8; ++e) kacc[e] = 0.f;
#pragma unroll
  for (int ii = 0; ii < 4; ++ii) { const int l = (tid >> 4) + 32 * ii, cc = (tid & 15) * 8;
    *(LAS v4u*)(Kt + (l >> 6) * 16384 + v_st<128>(l & 63, cc)) = kq[ii];
    float f[8]; unpack8(kq[ii], f); const float wl = wS[l];
#pragma unroll
    for (int e = 0; e < 8; ++e) kacc[e] += wl * f[e]; }
#pragma unroll
  for (int ii = 0; ii < 8; ++ii) { const int l = (tid >> 5) + 16 * ii, cc = (tid & 31) * 8;
    float f[8]; unpack8(vq[ii], f); const float wl = wS[l];
#pragma unroll
    for (int e = 0; e < 8; ++e) f[e] *= wl;
    *(LAS v4u*)(Vt + ((l >> 6) * 2 + (cc >> 7)) * 16384 + v_st<128>(l & 63, cc & 127)) = pack8(f); }
#pragma unroll
  for (int e = 0; e < 8; ++e) { kacc[e] += bperm(kacc[e], lane ^ 16); kacc[e] += bperm(kacc[e], lane ^ 32); }
  if (lane < 16) {
#pragma unroll
    for (int e = 0; e < 8; ++e) nP[wid * 128 + lane * 8 + e] = kacc[e]; }
  __syncthreads();
  if (uid_next < ML_NUID) ml1_load(F, uid_next, RAW, GATESb, kq, vq, gt);
  if (wid < 2) { float s = 0.f; const int t2 = (wid << 6) + xb_lane();
#pragma unroll
    for (int w8 = 0; w8 < 8; ++w8) s += nP[w8 * 128 + t2];
    NBAR[(size_t)uid * 128 + t2] = s; }
  f32x16 acc[4]; acc[0] = f32x16{}; acc[1] = f32x16{}; acc[2] = f32x16{}; acc[3] = f32x16{};
  const int vbA = lds_addr(Vt) + (wid >> 2) * 16384 + (wid & 3) * 512 + v_rd_base(lane);
  const int vbB = lds_addr(Kt) + v_rd_base(lane);
#define ML1_STEP(KT, KS) do { \
    const s16x4 al = tr_read<(KT) * 32768 + (KS) * 4096>(vbA), ah = tr_read<(KT) * 32768 + (KS) * 4096 + 2048>(vbA); \
    const s16x4 b0l = tr_read<(KT) * 16384 + 0 * 512 + (KS) * 4096>(vbB), b0h = tr_read<(KT) * 16384 + 0 * 512 + (KS) * 4096 + 2048>(vbB); \
    const s16x4 b1l = tr_read<(KT) * 16384 + 1 * 512 + (KS) * 4096>(vbB), b1h = tr_read<(KT) * 16384 + 1 * 512 + (KS) * 4096 + 2048>(vbB); \
    const s16x4 b2l = tr_read<(KT) * 16384 + 2 * 512 + (KS) * 4096>(vbB), b2h = tr_read<(KT) * 16384 + 2 * 512 + (KS) * 4096 + 2048>(vbB); \
    const s16x4 b3l = tr_read<(KT) * 16384 + 3 * 512 + (KS) * 4096>(vbB), b3h = tr_read<(KT) * 16384 + 3 * 512 + (KS) * 4096 + 2048>(vbB); \
    asm volatile("s_waitcnt lgkmcnt(0)" ::: "memory"); SBAR(); \
    const bf16x8 a_ = (bf16x8){al[0], al[1], al[2], al[3], ah[0], ah[1], ah[2], ah[3]}; \
    acc[0] = __builtin_amdgcn_mfma_f32_32x32x16_bf16((bf16x8){b0l[0], b0l[1], b0l[2], b0l[3], b0h[0], b0h[1], b0h[2], b0h[3]}, a_, acc[0], 0, 0, 0); \
    acc[1] = __builtin_amdgcn_mfma_f32_32x32x16_bf16((bf16x8){b1l[0], b1l[1], b1l[2], b1l[3], b1h[0], b1h[1], b1h[2], b1h[3]}, a_, acc[1], 0, 0, 0); \
    acc[2] = __builtin_amdgcn_mfma_f32_32x32x16_bf16((bf16x8){b2l[0], b2l[1], b2l[2], b2l[3], b2h[0], b2h[1], b2h[2], b2h[3]}, a_, acc[2], 0, 0, 0); \
    acc[3] = __builtin_amdgcn_mfma_f32_32x32x16_bf16((bf16x8){b3l[0], b3l[1], b3l[2], b3l[3], b3h[0], b3h[1], b3h[2], b3h[3]}, a_, acc[3], 0, 0, 0); \
    SBAR(); } while (0)
  ML1_STEP(0, 0); ML1_STEP(0, 1); ML1_STEP(0, 2); ML1_STEP(0, 3); ML1_STEP(1, 0); ML1_STEP(1, 1); ML1_STEP(1, 2); ML1_STEP(1, 3);
#undef ML1_STEP
  bf16* cbp = CBAR + (size_t)uid * 32768;
#pragma unroll
  for (int nb = 0; nb < 4; ++nb)
#pragma unroll
    for (int g = 0; g < 4; ++g) { uint2 w; w.x = pg8::cvt_pk_bf16(acc[nb][4 * g], acc[nb][4 * g + 1]); w.y = pg8::cvt_pk_bf16(acc[nb][4 * g + 2], acc[nb][4 * g + 3]);
      *(uint2*)(cbp + ((wid * 8 + 2 * nb + (g >> 1)) * 64 + (g & 1) * 32 + r32) * 8 + 4 * hi) = w; }
  __syncthreads();
}
__device__ __forceinline__ void ml2_scan(const Frame& F, int s, bf16* CBAR, float* NBAR, float* MSC, LAS char* lds) {
  const int sid = s >> 3, slice = s & 7, uid0 = sid * 66;
  LAS float* gS = (LAS float*)lds; LAS float* mbS = gS + 66;
  __syncthreads();
  if (F.tid < 66) { gS[F.tid] = MSC[(size_t)(uid0 + F.tid) * 4 + 0]; mbS[F.tid] = MSC[(size_t)(uid0 + F.tid) * 4 + 1]; }
  __syncthreads();
  const size_t e0 = (size_t)(slice * 32 + (F.tid >> 4)) * 128 + (F.tid & 15) * 8;
  const bool nthr = (slice == 0) && (F.tid < 128);
  float Cs[8]; float m = -1e30f, nst = 0.f;
#pragma unroll
  for (int e = 0; e < 8; ++e) Cs[e] = 0.f;
  for (int grp = 0; grp < 3; ++grp) {
    v4u cb[22]; float nbv[22];
#pragma unroll
    for (int i = 0; i < 22; ++i) { cb[i] = *(const v4u*)(CBAR + (size_t)(uid0 + grp * 22 + i) * 32768 + e0); nbv[i] = nthr ? NBAR[(size_t)(uid0 + grp * 22 + i) * 128 + F.tid] : 0.f; }
#pragma unroll
    for (int i = 0; i < 22; ++i) {
      const int c = grp * 22 + i, uid = uid0 + c;
      const float g = gS[c], mb = mbS[c];
      *(v4u*)(CBAR + (size_t)uid * 32768 + e0) = pack8(Cs);
      if (slice == 0 && F.tid == 0) MSC[(size_t)uid * 4 + 2] = m;
      if (nthr) NBAR[(size_t)uid * 128 + F.tid] = nst;
      const float m_new = fmaxf(g + m, mb), decay = __expf(g + m - m_new), inj = __expf(mb - m_new);
      float f[8]; unpack8(cb[i], f);
#pragma unroll
      for (int e = 0; e < 8; ++e) Cs[e] = decay * Cs[e] + inj * f[e];
      nst = decay * nst + inj * nbv[i]; m = m_new;
    }
  }
}
__device__ __forceinline__ void ml3_load(const Frame& F, int uid, const bf16* RAW, const float* GATESb, const float* MSC, const float* NBAR, bf16x8 (&qr)[8], v4u (&kq)[4], float (&gt)[5], float& nbv) {
  int b, h, dir, c, sgn; long base; ml_decode(uid, b, h, dir, c, base, sgn);
  const int wid = F.wave, ln = xb_lane(), tid = (wid << 6) | ln, r32 = ln & 31, hi = ln >> 5, lq = 32 * (wid & 3) + r32;
  if (wid == 0) { const long ra = base + sgn * ln, rb = base + sgn * (ln + 64);
    gt[0] = GATESb[ra * 16 + dir * 8 + h]; gt[1] = GATESb[ra * 16 + dir * 8 + 4 + h]; gt[2] = GATESb[rb * 16 + dir * 8 + h]; gt[3] = GATESb[rb * 16 + dir * 8 + 4 + h]; gt[4] = MSC[(size_t)uid * 4 + 2]; }
  else if (wid == 2 || wid == 3) nbv = NBAR[(size_t)uid * 128 + tid - 128];
  { const bf16* qp = RAW + (size_t)(base + sgn * lq) * 3072 + 128 * h + hi * 8;
#pragma unroll
    for (int d0 = 0; d0 < 8; ++d0) qr[d0] = *(const bf16x8*)(qp + d0 * 16); }
#pragma unroll
  for (int ii = 0; ii < 4; ++ii) { const int l = (tid >> 4) + 32 * ii; kq[ii] = *(const v4u*)(RAW + (size_t)(base + sgn * l) * 3072 + 512 + 128 * h + (tid & 15) * 8); }
}
__device__ __forceinline__ void ml3_unit(const Frame& F, int uid, int uid_next, const bf16* RAW, const float* GATESb, const bf16* CBAR, const float* NBAR, const float* MSC, bf16* HX, LAS char* lds,
                                         bf16x8 (&qr)[8], v4u (&kq)[4], float (&gt)[5], float& nbv) {
  using namespace att;
  constexpr float SCQ = 0.08838834764831845f;
  LAS char* Kl = lds; LAS char* Vl = lds + 32768;
  LAS float* uS = (LAS float*)(lds + 98304); LAS float* MS_ = uS + 128; LAS float* wiS = uS + 256; LAS float* emS = uS + 384; LAS float* nS = uS + 512;
  int b, h, dir, c, sgn; long base; ml_decode(uid, b, h, dir, c, base, sgn);
  const int tid = F.tid, wid = F.wave, lane = F.lane, r32 = lane & 31, hi = lane >> 5;
  LAS float* wsf = (LAS float*)(lds + 98304 + 2560) + wid * 64;
  const int rblk = wid & 3, dh = wid >> 2, lq = 32 * rblk + r32;
  const float lia = gt[0], lfa = gt[1], lib = gt[2], lfb = gt[3], ms = gt[4];
  v4u vq[8];
#pragma unroll
  for (int ii = 0; ii < 8; ++ii) { const int l = (tid >> 5) + 16 * ii; vq[ii] = *(const v4u*)(RAW + (size_t)(base + sgn * l) * 3072 + 1024 + 256 * h + (tid & 31) * 8); }
  if (wid == 0) {
    const int lane = xb_lane();
    const float ca = wave_incl_scan_add(lfa, lane); const float tot = __int_as_float(__builtin_amdgcn_readlane(__float_as_int(ca), 63));
    const float cb = wave_incl_scan_add(lfb, lane) + tot;
    const float ua = lia - ca, ub = lib - cb;
    const float pa = wave_incl_scan_max(ua, lane); const float pma = __int_as_float(__builtin_amdgcn_readlane(__float_as_int(pa), 63));
    const float pb = fmaxf(wave_incl_scan_max(ub, lane), pma);
    const float Ma = fmaxf(ms, pa), Mb = fmaxf(ms, pb);
    uS[lane] = ua; uS[lane + 64] = ub; MS_[lane] = Ma; MS_[lane + 64] = Mb;
    wiS[lane] = expf(ms - Ma); wiS[lane + 64] = expf(ms - Mb);
    emS[lane] = expf(-(ca + Ma)); emS[lane + 64] = expf(-(cb + Mb));
  } else if (wid == 2 || wid == 3) { const int t2 = (wid << 6) + xb_lane() - 128; nS[t2] = nbv; }
#pragma unroll
  for (int ii = 0; ii < 4; ++ii) { const int l = (tid >> 4) + 32 * ii; *(LAS v4u*)(Kl + kswz<128>(l, (tid & 15) * 16)) = kq[ii]; }
  f32x16 o[4]; o[0] = f32x16{}; o[1] = f32x16{}; o[2] = f32x16{}; o[3] = f32x16{};
  { const bf16* cp = CBAR + (size_t)uid * 32768 + (size_t)(dh * 4 * 8 * 64 + lane) * 8;
#pragma unroll
    for (int j = 0; j < 4; ++j) {
#pragma unroll
      for (int dh0 = 0; dh0 < 8; dh0 += 4) {
        bf16x8 cf[4];
#pragma unroll
        for (int d0 = 0; d0 < 4; ++d0) cf[d0] = *(const bf16x8*)(cp + (size_t)((j * 8 + dh0 + d0) * 64) * 8);
#pragma unroll
        for (int d0 = 0; d0 < 4; ++d0) o[j] = __builtin_amdgcn_mfma_f32_32x32x16_bf16(qr[dh0 + d0], cf[d0], o[j], 0, 0, 0); } } }
#pragma unroll
  for (int ii = 0; ii < 8; ++ii) { const int l = (tid >> 5) + 16 * ii, cc = (tid & 31) * 8; *(LAS v4u*)(Vl + ((l >> 6) * 2 + (cc >> 7)) * 16384 + v_st<128>(l & 63, cc & 127)) = vq[ii]; }
  __syncthreads();
  float qn = 0.f;
#pragma unroll
  for (int d0 = 0; d0 < 8; ++d0)
#pragma unroll
    for (int e = 0; e < 8; ++e) qn += bf2f((unsigned short)qr[d0][e]) * nS[d0 * 16 + hi * 8 + e];
  qn += bperm(qn, lane ^ 32);
#pragma unroll
  for (int r = 0; r < 16; ++r) { const float wi = wiS[32 * rblk + crow(r, hi)]; o[0][r] *= wi; o[1][r] *= wi; o[2][r] *= wi; o[3][r] *= wi; }
  float den = 0.f; const float Mq = MS_[lq];
  const int vb0 = lds_addr(Vl) + dh * 16384 + v_rd_base(lane);
#pragma nounroll
  for (int kt = 0; kt < 2; ++kt) {
    if (64 * kt <= 32 * rblk + 31) {
      f32x16 p0, p1; qkt<128>(p0, p1, Kl + kt * 16384, qr, r32, hi);
      const LAS float* up = uS + 64 * kt + 4 * hi; const int dql = lq - 64 * kt - 4 * hi;
#pragma unroll
      for (int r = 0; r < 16; ++r) { const int cr = (r & 3) + 8 * (r >> 2);
        const float u0 = up[cr], u1 = up[cr + 32];
        const float a0 = (cr <= dql) ? (u0 - Mq) * LOG2E : -1e30f, a1 = (cr + 32 <= dql) ? (u1 - Mq) * LOG2E : -1e30f;
        p0[r] *= __builtin_amdgcn_exp2f(a0); p1[r] *= __builtin_amdgcn_exp2f(a1); }
      asm volatile("" : "+v"(p0), "+v"(p1));
      den += row_sum(p0, p1);
      bf16x8 pa0, pa1, pa2, pa3; pack_p(p0, p1, pa0, pa1, pa2, pa3); SBAR();
      const int vb = vb0 + kt * 32768;
      pv_one<128, 0>(o[0], vb, pa0, pa1, pa2, pa3); pv_one<128, 1>(o[1], vb, pa0, pa1, pa2, pa3); pv_one<128, 2>(o[2], vb, pa0, pa1, pa2, pa3); pv_one<128, 3>(o[3], vb, pa0, pa1, pa2, pa3);
    }
  }
  if (uid_next >= 0) ml3_load(F, uid_next, RAW, GATESb, MSC, NBAR, qr, kq, gt, nbv);
  const float dtot = den + wiS[lq] * qn;
  const float fac = SCQ / fmaxf(SCQ * fabsf(dtot), emS[lq]);
  if (hi == 0) wsf[r32] = fac; asm volatile("s_waitcnt lgkmcnt(0)" ::: "memory");
  int r32e = r32, hie = hi; asm volatile("" : "+v"(r32e), "+v"(hie));
#pragma unroll
  for (int r = 0; r < 16; ++r) { const int lo_ = 32 * rblk + crow(r, hie); const float fr_ = wsf[crow(r, hie)];
    bf16* op = HX + (size_t)(base + sgn * lo_) * 1024 + 256 * h + 128 * dh + r32e;
    op[0] = f2bf16(o[0][r] * fr_); op[32] = f2bf16(o[1][r] * fr_); op[64] = f2bf16(o[2][r] * fr_); op[96] = f2bf16(o[3][r] * fr_); }
  __syncthreads();
}
__device__ __forceinline__ void mln_phase(const Frame& F, bf16* HF, const bf16* HB, const bf16* RAW, const float* hnorm) {
  const int j = F.lane & 31, hh = F.lane >> 5;
  float hn[8];
#pragma unroll
  for (int e = 0; e < 8; ++e) hn[e] = hnorm[8 * j + e];
  for (int r = F.gw; r < ML; r += F.ngw) {
#pragma unroll
    for (int p = 0; p < 2; ++p) { const size_t off = (size_t)r * 1024 + 256 * (2 * p + hh) + 8 * j;
      float a[8], b[8], g[8]; unpack8(*(const v4u*)(HF + off), a); unpack8(*(const v4u*)(HB + off), b); unpack8(*(const v4u*)(RAW + (size_t)r * 3072 + 2048 + 256 * (2 * p + hh) + 8 * j), g);
      float ss = 0.f;
#pragma unroll
      for (int e = 0; e < 8; ++e) { a[e] += b[e]; ss += a[e] * a[e]; }
#pragma unroll
      for (int o = 1; o < 32; o <<= 1) ss += bperm(ss, F.lane ^ o);
      const float rs = __builtin_amdgcn_rsqf(ss * (1.f / 256.f) + EPS);
#pragma unroll
      for (int e = 0; e < 8; ++e) a[e] = sigmoidf_(g[e]) * a[e] * rs * hn[e];
      *(v4u*)(HF + off) = pack8(a); }
  }
}

struct Args { const float* in[27]; float* out; unsigned char* ws; };
enum { I_X = 0, I_C, I_CTX, I_CCTX, I_ADAW, I_ADAB, I_NMIX, I_NFFN, I_WUP, I_FCONV, I_WDOWN, I_WINQKV, I_WINQN, I_WINKN, I_WINSINK, I_WINWO,
       I_SCWIN, I_SCCONV, I_SCWOUT, I_AXQKV, I_AXQN, I_AXKN, I_AXWO, I_MLWIN, I_MLBG, I_MLHN, I_MLWOUT };
typedef const __attribute__((address_space(4))) Args* ArgsP;

typedef pg8::StaticOrder SOrd;
#define GEMM_BF16(Aptr, Bptr, Mrows, Ncols, Kdim, Optr, ldc_) do { pg8::Gemm g_{(const pg8::bf16_t*)(Aptr), (const pg8::bf16_t*)(Bptr), (Mrows), (Ncols), (Kdim)}; SOrd S_; S_.init((Mrows), (Ncols), F.G, bid); \
    pg8::EpiStoreBf16 E_{(pg8::bf16_t*)(Optr), (ldc_)}; pg8::gemm_phase<pg8::EpiStoreBf16, SOrd, true, true>(F.lds, g_, S_, E_, F.tid); } while (0)
#define GEMM_RESID(Aptr, Bptr, Mrows, Kdim, blat, bctx, olat, octx, gatep, tile0_, bin_, bout_) do { pg8::Gemm g_{(const pg8::bf16_t*)(Aptr), (const pg8::bf16_t*)(Bptr), (Mrows), 1024, (Kdim)}; pg8::CtxSplitOrder S_; S_.init((Kdim), (Mrows) > ML, F.G, bid); \
    pg8::EpiResid E_{(blat), (bctx), (olat), (octx), (gatep), (tile0_), (bin_), (bout_)}; pg8::gemm_phase<pg8::EpiResid, pg8::CtxSplitOrder, true, true>(F.lds, g_, S_, E_, F.tid); } while (0)
#define PHASE() do { asm volatile("" : "+s"(F.wave)); F.tid = (F.wave << 6) | xb_lane(); asm volatile("" : "+v"(F.tid)); F.lane = F.tid & 63; asm volatile("" : "+s"(bid), "+s"(F.G)); \
    F.gw = bid * NWAVES + F.wave; F.ngw = F.G * NWAVES; asm volatile("" : "+s"(ap)); ws = ap->ws; asm volatile("" : "+s"(F.lds)); ldsc = (LAS char*)F.lds; asm volatile("" : "+s"(bar.bar), "+s"(bar.x), "+s"(bar.st)); } while (0)
#define AIN(k) (ap->in[k])
__device__ __forceinline__ int ml1_uid(int u) { const int sid = u / 66; int c = u - sid * 66; if (sid & 1) { const int cf = c + 2 >= 66 ? c + 2 - 66 : c + 2; c = cf >= 2 ? 67 - cf : 1 - cf; } return sid * 66 + c; }
__device__ __forceinline__ int ml3_uid(int u) { const int sid = u >> 6; int cc = u & 63; if (sid & 1) cc = 63 - cc; return sid * 66 + cc + 2; }

__global__ void __launch_bounds__(NWAVES * 64, 2) hybrid_fwd(Args args_unused) {
    extern __shared__ __attribute__((aligned(16))) unsigned char lds_raw[];
    ArgsP ap = (ArgsP)__builtin_amdgcn_kernarg_segment_ptr();
    Frame F;
    F.lds = (LAS unsigned char*)lds_raw;
    F.tid = threadIdx.x; F.lane = F.tid & 63; F.wave = __builtin_amdgcn_readfirstlane(F.tid >> 6);
    int bid = blockIdx.x;
    F.G = gridDim.x; F.gw = bid * NWAVES + F.wave; F.ngw = F.G * NWAVES;
    unsigned char* ws = ap->ws;
    for (int u = F.tid; u < (LDS_BYTES - LDSCTL_OFF) / 4; u += NWAVES * 64) ((LAS unsigned*)(F.lds + LDSCTL_OFF))[u] = 0u;
    __syncthreads();
    XcdBarrier bar = xcd_barrier_post((unsigned*)((gu32*)(ws + WS_CTL) + CW_BAR), (volatile LAS unsigned*)(F.lds + MISC_OFF) + 8, F.wave);
#define GRID_BAR() xcd_barrier(bar, F.wave)
    LAS char* ldsc = (LAS char*)F.lds;

    {
        __syncthreads();
        PHASE();
        mod_phase(F, AIN(I_C), AIN(I_CCTX), AIN(I_ADAW), AIN(I_ADAB), (float*)(ws + WS_MOD));
        rope_tables(F, (float*)(ws + WS_ROPE64), (float*)(ws + WS_ROPE128));
        for (int i = bid * 512 + F.tid; i < MC * DM / 4; i += F.G * 512) ((f32x4*)(ws + WS_HC))[i] = ((const f32x4*)AIN(I_CTX))[i];
        int rot = 0;
#pragma nounroll
        for (int l = 0; l < 4; ++l) {
            const size_t lb = l == 0 ? WT_L0 : l == 1 ? WT_L1 : l == 2 ? WT_L2 : WT_L3;
            const size_t szin = (l == 0 || l == 2) ? SZ_W1536 : SZ_W3072;
            const float* win = l == 0 ? AIN(I_WINQKV) : l == 1 ? AIN(I_SCWIN) : l == 2 ? AIN(I_AXQKV) : AIN(I_MLWIN);
            const float* wout = l == 0 ? AIN(I_WINWO) : l == 1 ? AIN(I_SCWOUT) : l == 2 ? AIN(I_AXWO) : AIN(I_MLWOUT);
            const int nin = (l == 0 || l == 2) ? 1536 : 3072, pin = l == 3 ? 3088 : nin;
            transpose_matrix(F, win, 1024, pin, nin, (bf16*)(ws + lb), rot);
            transpose_matrix(F, wout, 1024, 1024, 1024, (bf16*)(ws + lb + szin), rot);
            transpose_matrix(F, AIN(I_WUP) + (size_t)l * 1024 * NUP, 1024, NUP, NUP, (bf16*)(ws + lb + szin + SZ_W1024), rot, true);
            transpose_matrix(F, AIN(I_WDOWN) + (size_t)l * DFF * 1024, DFF, 1024, 1024, (bf16*)(ws + lb + szin + SZ_W1024 + SZ_UP), rot);
        }
    }
    GRID_BAR();

#pragma nounroll
    for (int layer = 0; layer < 4; ++layer) {
        asm volatile("" : "+s"(layer));
#define LB() (layer == 0 ? WT_L0 : layer == 1 ? WT_L1 : layer == 2 ? WT_L2 : WT_L3)
#define SZIN() ((layer == 0 || layer == 2) ? SZ_W1536 : SZ_W3072)
#define MODP() ((const float*)(ws + WS_MOD) + (size_t)layer * 5 * 6144)
#define HB_A() ((void*)ap->out)
#define HB_B() ((void*)((bf16*)ap->out + (size_t)ML * 1024))
#define HLAT() (layer == 0 ? (const void*)AIN(I_X) : (const void*)HB_B())
#define HMID() (layer == 3 ? (void*)(ws + WS_WT) : HB_A())
#define HCTX() ((const float*)(ws + WS_HC))
#define ROWS_OUT() (layer == 3 ? ML : MT)

        PHASE();
        if (layer == 3) norm_phase<true>(F, HLAT(), layer != 0, (float*)(ws + WS_HC), (const float*)(ws + BG_SLAB), layer == 0 ? 0 : 11, MT, AIN(I_NMIX) + layer * 1024, MODP(), 0, 1024, (bf16*)(ws + WS_XN), AIN(I_MLWIN), AIN(I_MLBG), (float*)(ws + WS_GATES));
        else norm_phase<false>(F, HLAT(), layer != 0, (float*)(ws + WS_HC), (const float*)(ws + BG_SLAB), layer == 0 ? 0 : 11, MT, AIN(I_NMIX) + layer * 1024, MODP(), 0, 1024, (bf16*)(ws + WS_XN), nullptr, nullptr, nullptr);
        GRID_BAR();
        PHASE();
        { const int nin = (layer == 0 || layer == 2) ? 1536 : 3072;
          GEMM_BF16(ws + WS_XN, ws + LB(), MT, nin, 1024, ws + BG_RAW, nin); }
        GRID_BAR();
        if (layer == 0) {
            PHASE();
            bool fast_w;
            { const float* gq_ = AIN(I_WINQN); const float* gk_ = AIN(I_WINKN);
              const float gqm = wave_max(fabsf(gq_[F.lane]), F.lane), gkm = wave_max(fabsf(gk_[F.lane]), F.lane);
              fast_w = __builtin_amdgcn_readfirstlane((11.55f * gqm * gkm <= 80.f) ? 1 : 0) != 0; }
            if (fast_w) knorm_rope64(F, (const bf16*)(ws + BG_RAW), AIN(I_WINKN), (const float*)(ws + WS_ROPE64), (bf16*)(ws + BG_K));
            else qknorm_rope64(F, (const bf16*)(ws + BG_RAW), AIN(I_WINQN), AIN(I_WINKN), (const float*)(ws + WS_ROPE64), (bf16*)(ws + BG_Q), (bf16*)(ws + BG_K));
            GRID_BAR();
            PHASE();
            for (int i_ = 0; i_ < 9; ++i_) {
                int u;
                if (F.G == 256) { if (i_ < 8) { const int x = bid & 7, li = 32 * i_ + (bid >> 3), pg = 2 * x + (li >> 7); u = (pg >> 2) * 512 + ((pg & 3) * 4 + ((li >> 5) & 3)) * 32 + (li & 31); }
                                  else { if (bid >= 64) break; u = 2048 + bid; } }
                else { u = bid + i_ * F.G; if (u >= 2048 + 64) break; }
                const bf16* Qp = (const bf16*)(ws + BG_Q); const bf16* Kp = (const bf16*)(ws + BG_K); const bf16* RAW = (const bf16*)(ws + BG_RAW); bf16* Ob = (bf16*)(ws + BG_O);
                const bool cq = u >= 2048; const int v = cq ? u - 2048 : u, qb = cq ? 0 : (v & 31), h = cq ? (v & 15) : ((v >> 5) & 15), b = cq ? (v >> 4) : (v >> 9);
                if (fast_w) win_attn_unit<true>(F, cq, b, h, qb, RAW, Kp, RAW, Ob, AIN(I_WINSINK)[h], ldsc, AIN(I_WINQN), (const float*)(ws + WS_ROPE64));
                else win_attn_unit<false>(F, cq, b, h, qb, Qp, Kp, RAW, Ob, AIN(I_WINSINK)[h], ldsc, AIN(I_WINQN), (const float*)(ws + WS_ROPE64));
            }
        } else if (layer == 1) {
            PHASE();
            sconv_phase(F, (const bf16*)(ws + BG_RAW), AIN(I_SCCONV), (bf16*)(ws + BG_O));
        } else if (layer == 2) {
            PHASE();
            bool fast_sm;
            { const float* gq_ = AIN(I_AXQN); const float* gk_ = AIN(I_AXKN);
              const float gqm = wave_max(fmaxf(fabsf(gq_[F.lane]), fabsf(gq_[F.lane + 64])), F.lane), gkm = wave_max(fmaxf(fabsf(gk_[F.lane]), fabsf(gk_[F.lane + 64])), F.lane);
              fast_sm = __builtin_amdgcn_readfirstlane((16.33f * gqm * gkm <= 80.f) ? 1 : 0) != 0; }
            if (fast_sm) knorm_rope128(F, (const bf16*)(ws + BG_RAW), AIN(I_AXKN), (const float*)(ws + WS_ROPE128), (bf16*)(ws + BG_K), (bf16*)(ws + BG_V));
            else qknorm_rope128(F, (const bf16*)(ws + BG_RAW), AIN(I_AXQN), AIN(I_AXKN), (const float*)(ws + WS_ROPE128), (bf16*)(ws + BG_Q), (bf16*)(ws + BG_K), (bf16*)(ws + BG_V));
            GRID_BAR();
            PHASE();
            for (int i_ = 0; i_ < 5; ++i_) {
                int u;
                if (F.G == 256) { if (i_ < 4) { const int x = bid & 7, j_ = (bid >> 3) + 32 * i_; u = ((x >> 1) * 8 + (x & 1) * 4 + (j_ >> 5)) * 32 + (j_ & 31); } else { if (bid >= 32) break; u = 1024 + bid; } }
                else { u = bid + i_ * F.G; if (u >= 1024 + 32) break; }
                const unsigned short* Qp = (const unsigned short*)(ws + BG_Q); const unsigned short* K2 = (const unsigned short*)(ws + BG_K); const unsigned short* V2 = (const unsigned short*)(ws + BG_V); unsigned short* Ob = (unsigned short*)(ws + BG_O);
                unsigned qoff, kvo, qraw; int seq_, t0_;
                if (u < 1024) { const int qb = u & 31, h = (u >> 5) & 7, b = u >> 8; qoff = (unsigned)(b * SEQ + qb * 256) * 1024u + h * 128; qraw = (unsigned)(b * SEQ + qb * 256) * 1536u + h * 128; t0_ = qb * 256;
                                kvo = (unsigned)b * (8448u * 256u) + (h >> 2) * 128; seq_ = 8448; }
                else { const int v = u - 1024, h = v & 7, b = v >> 3; qoff = (unsigned)(ML + b * CTXL) * 1024u + h * 128; qraw = (unsigned)(ML + b * CTXL) * 1536u + h * 128; t0_ = 0;
                       kvo = ((unsigned)b * 8448u + 8192u) * 256u + (h >> 2) * 128; seq_ = 256; }
                qoff = __builtin_amdgcn_readfirstlane(qoff); kvo = __builtin_amdgcn_readfirstlane(kvo); seq_ = __builtin_amdgcn_readfirstlane(seq_); qraw = __builtin_amdgcn_readfirstlane(qraw); t0_ = __builtin_amdgcn_readfirstlane(t0_);
                const int tid_ = (F.wave << 6) | xb_lane();
                if (fast_sm) exf::attn_dense_body<exf::bf16>((const unsigned short*)(ws + BG_RAW) + qraw, K2 + kvo, V2 + kvo, Ob + qoff, seq_, (char*)F.lds, tid_, AIN(I_AXQN), (const float*)(ws + WS_ROPE128), t0_, u < 1024);
                else exd::attn_dense_body<exd::bf16>(Qp + qoff, K2 + kvo, V2 + kvo, Ob + qoff, seq_, (char*)F.lds, tid_);
                __syncthreads();
            }
        } else {
            PHASE();
            { v4u kq_[4], vq_[8]; float gt_[4] = {0.f, 0.f, 0.f, 0.f}; int u = bid;
#pragma unroll
              for (int i_ = 0; i_ < 4; ++i_) kq_[i_] = (v4u){0u, 0u, 0u, 0u};
#pragma unroll
              for (int i_ = 0; i_ < 8; ++i_) vq_[i_] = (v4u){0u, 0u, 0u, 0u};
              if (u < ML_NUID) ml1_load(F, ml1_uid(u), (const bf16*)(ws + BG_RAW), (const float*)(ws + WS_GATES), kq_, vq_, gt_);
              for (; u < ML_NUID; u += F.G) ml1_unit(F, ml1_uid(u), u + F.G < ML_NUID ? ml1_uid(u + F.G) : ML_NUID, (const bf16*)(ws + BG_RAW), (const float*)(ws + WS_GATES), (bf16*)(ws + BG_CBAR), (float*)(ws + BG_NBAR), (float*)(ws + BG_MSC), ldsc, kq_, vq_, gt_); }
            GRID_BAR();
            PHASE();
            for (int s = bid; s < 256; s += F.G) ml2_scan(F, s, (bf16*)(ws + BG_CBAR), (float*)(ws + BG_NBAR), (float*)(ws + BG_MSC), ldsc);
            GRID_BAR();
            PHASE();
            { bf16x8 qr_[8]; v4u kq_[4]; float gt_[5] = {0.f, 0.f, 0.f, 0.f, 0.f}, nbv_ = 0.f;
#pragma unroll
              for (int i_ = 0; i_ < 8; ++i_) qr_[i_] = bf16x8{};
#pragma unroll
              for (int i_ = 0; i_ < 4; ++i_) kq_[i_] = (v4u){0u, 0u, 0u, 0u};
              int u = bid;
              if (u < 2048) ml3_load(F, ml3_uid(u), (const bf16*)(ws + BG_RAW), (const float*)(ws + WS_GATES), (const float*)(ws + BG_MSC), (const float*)(ws + BG_NBAR), qr_, kq_, gt_, nbv_);
              for (; u < 2048; u += F.G) { const int sid = u >> 6, un = u + F.G;
                ml3_unit(F, ml3_uid(u), un < 2048 ? ml3_uid(un) : -1, (const bf16*)(ws + BG_RAW), (const float*)(ws + WS_GATES), (const bf16*)(ws + BG_CBAR), (const float*)(ws + BG_NBAR),
                         (const float*)(ws + BG_MSC), (sid & 1) ? (bf16*)(ws + WS_HB) : (bf16*)(ws + WS_HF), ldsc, qr_, kq_, gt_, nbv_); } }
            GRID_BAR();
            PHASE();
            mln_phase(F, (bf16*)(ws + WS_HF), (const bf16*)(ws + WS_HB), (const bf16*)(ws + BG_RAW), AIN(I_MLHN));
        }
        GRID_BAR();
        PHASE();
        GEMM_RESID(layer == 3 ? ws + WS_HF : ws + BG_O, ws + LB() + SZIN(), ROWS_OUT(), 1024, HLAT(), HCTX(), HMID(), (float*)(ws + BG_SLAB), MODP() + 2048, 0, layer != 0, true);
        GRID_BAR();
        PHASE();
        norm_phase<false>(F, HMID(), true, (float*)(ws + WS_HC), (const float*)(ws + BG_SLAB), layer == 3 ? 0 : 4, ROWS_OUT(), AIN(I_NFFN) + layer * 1024, MODP(), 3072, 4096, (bf16*)(ws + WS_XN), nullptr, nullptr, nullptr);
        GRID_BAR();
        PHASE();
        { pg8::Gemm g_{(const pg8::bf16_t*)(ws + WS_XN), (const pg8::bf16_t*)(ws + LB() + SZIN() + SZ_W1024), ROWS_OUT(), NUP, 1024}; SOrd S_; S_.init(ROWS_OUT(), NUP, F.G, bid);
          pg8::EpiConvAct E_{(pg8::bf16_t*)(ws + BG_ACT), (float*)(ws + BG_HALO), AIN(I_FCONV) + (size_t)layer * 3 * NUP, (LAS float*)(F.lds + XB_OFF)};
          pg8::gemm_phase<pg8::EpiConvAct, SOrd, true, true>(F.lds, g_, S_, E_, F.tid); }
        GRID_BAR();
        PHASE();
        { SOrd S_; S_.init(ML, 1024, F.G, bid); pg8::Unit u_;
          for (int i_ = 0; S_.next(i_, u_); ++i_) ffn_fixup(F, u_.pm, (const float*)(ws + BG_HALO), AIN(I_FCONV) + (size_t)layer * 3 * NUP, (bf16*)(ws + BG_ACT));
          asm volatile("s_waitcnt vmcnt(0)" ::: "memory"); __syncthreads(); }
        GEMM_RESID(ws + BG_ACT, ws + LB() + SZIN() + SZ_W1024 + SZ_UP, ROWS_OUT(), DFF, HMID(), (const float*)(ws + WS_HC), layer == 3 ? (void*)ap->out : HB_B(), (float*)(ws + BG_SLAB), MODP() + 5120, 0, true, layer != 3);
        GRID_BAR();
    }
}

extern "C" void kernel_launch(void* const* d_in, const int* in_sizes, int n_in, void* d_out, int out_size, void* d_ws, size_t ws_size, hipStream_t stream) {
    static int grid = 0;
    if (grid == 0) {
        if (n_in != 27 || out_size != ML * DM || ws_size < WS_END) { fprintf(stderr, "kernel_launch: unexpected shapes: n_in %d out %d ws %zu (need %zu)\n", n_in, out_size, ws_size, (size_t)WS_END); grid = -1; return; }
        int dev = 0, cus = 0;
        if (hipGetDevice(&dev) != hipSuccess || hipDeviceGetAttribute(&cus, hipDeviceAttributeMultiprocessorCount, dev) != hipSuccess) { grid = -1; return; }
        if (hipFuncSetAttribute((const void*)hybrid_fwd, hipFuncAttributeMaxDynamicSharedMemorySize, LDS_BYTES) != hipSuccess) { fprintf(stderr, "kernel_launch: hipFuncSetAttribute failed\n"); grid = -1; return; }
        int per_cu = 0;
        if (hipOccupancyMaxActiveBlocksPerMultiprocessor(&per_cu, (const void*)hybrid_fwd, NWAVES * 64, LDS_BYTES) != hipSuccess || per_cu < 1) { fprintf(stderr, "kernel_launch: occupancy query reports %d\n", per_cu); }
        (void)hipGetLastError();
        grid = cus;
    }
    if (grid < 0) return;
    if (hipMemsetAsync((char*)d_ws + WS_CTL, 0, CTL_ZERO_BYTES, stream) != hipSuccess) return;
    Args a{};
    for (int i = 0; i < 27; ++i) a.in[i] = (const float*)d_in[i];
    a.out = (float*)d_out; a.ws = (unsigned char*)d_ws;
    hipLaunchKernelGGL(hybrid_fwd, dim3(grid), dim3(NWAVES * 64), LDS_BYTES, stream, a);
}
```

```cpp
#include <hip/hip_runtime.h>
#include <cstdio>
#include <cstdint>
namespace pg8 {
#define PG8_LAS __attribute__((address_space(3)))
typedef unsigned short bf16_t;
typedef short bf16x8 __attribute__((ext_vector_type(8)));
typedef float f32x4 __attribute__((ext_vector_type(4)));
typedef unsigned u32x4 __attribute__((ext_vector_type(4)));
constexpr int BM = 256, BK = 64, HALF = 128, HTB = HALF * BK * 2  , STAGE_BYTES = 8 * HTB, NXCD = 8, WGM = 8;

__host__ __device__ __forceinline__ int lds_byte(int r, int c) { const int st = (r >> 4) * 2 + (c >> 5), rr = r & 15, cc = c & 31, ob = rr * 64 + cc * 2; return st * 1024 + (ob ^ (((ob >> 9) & 1) << 5)); }
__host__ __device__ __forceinline__ void stage_rc(int b, int& R, int& C) { const int st = b / 1024, sb = b % 1024, swz = sb ^ (((sb >> 9) & 1) << 5); R = (st >> 1) * 16 + swz / 64; C = (st & 1) * 32 + (swz % 64) / 2; }
__host__ __device__ __forceinline__ int perm32(int rho) { const int n = rho >> 4, i = rho & 15; return 8 * (i >> 2) + 4 * n + (i & 3); }

struct Unit { int pm, pn, ko, nt; };
struct Gemm { const bf16_t* A; const bf16_t* Bt; int M, N, K; };

struct StaticOrder {
    int nM, nN, nwg, G, c;
    __host__ __device__ __forceinline__ void init(int M, int N, int G_, int c_) { nM = M / BM; nN = N / BM; nwg = nM * nN; G = G_; c = c_; }
    __host__ __device__ __forceinline__ bool next(int i, Unit& u) const {
        const long L = (long)i * G + c; if (L >= nwg) return false;
        int wgid = (int)L; { const int q = nwg / NXCD, r = nwg % NXCD, xcd = wgid % NXCD, off = wgid / NXCD; wgid = (xcd < r ? xcd * (q + 1) : r * (q + 1) + (xcd - r) * q) + off; }
        const int nig = WGM * nN, gid = wgid / nig, fm = gid * WGM, gsz = (nM - fm) < WGM ? (nM - fm) : WGM;
        u.pm = fm + ((wgid % nig) % gsz); u.pn = (wgid % nig) / gsz; u.ko = 0; u.nt = 0; return true;
    }
    __device__ __forceinline__ void a_ready(const Unit&) const {}
    __device__ __forceinline__ void done(const Unit&) const {}
};

__device__ __forceinline__ unsigned cvt_pk_bf16(float lo, float hi) { typedef float f32x2cv_ __attribute__((ext_vector_type(2))); typedef __bf16 bf16x2cv_ __attribute__((ext_vector_type(2))); const f32x2cv_ v_ = {lo, hi}; const bf16x2cv_ b_ = __builtin_convertvector(v_, bf16x2cv_); return __builtin_bit_cast(unsigned, b_); }
typedef float f32x2 __attribute__((ext_vector_type(2)));
struct EpiStoreBf16 {
    static constexpr bool PERM = true, AFTER_DRAIN = false, PERMA = false;
    bf16_t* O; int ldc;
    __device__ __forceinline__ void operator()(const f32x4 (&acc)[2][2][4][2], const Unit& u, int wr, int wc, int fr, int fq) const {
        const int row0 = u.pm * BM + wr * 64 + fr, col0 = u.pn * BM + wc * 32 + 8 * fq;
#pragma unroll
        for (int ai = 0; ai < 2; ++ai)
#pragma unroll
            for (int m = 0; m < 4; ++m) { bf16_t* rowp = O + (size_t)(row0 + ai * HALF + m * 16) * ldc + col0;
#pragma unroll
                for (int bj = 0; bj < 2; ++bj) { const f32x4 v0 = acc[ai][bj][m][0], v1 = acc[ai][bj][m][1];
                    u32x4 w; w.x = cvt_pk_bf16(v0[0], v0[1]); w.y = cvt_pk_bf16(v0[2], v0[3]); w.z = cvt_pk_bf16(v1[0], v1[1]); w.w = cvt_pk_bf16(v1[2], v1[3]);
                    *(u32x4*)(rowp + bj * HALF) = w; } }
    }
};
struct CtxSplitOrder {
    StaticOrder lat; int nlat, nsub, G, c;
    __device__ __forceinline__ void init(int K, bool with_ctx, int G_, int c_) { lat.init(128 * BM, 1024, G_, c_); nlat = 128 * 4; nsub = with_ctx ? 16 * (K / 256) : 0; G = G_; c = c_; }
    __device__ __forceinline__ bool next(int i, Unit& u) const {
        const int L = i * G + c;
        if (L < nlat) return lat.next(i, u);
        const int s = L - nlat; if (s >= nsub) return false;
        u.pm = 128 + (s & 3); u.pn = (s >> 2) & 3; u.ko = (s >> 4) * 256; u.nt = 4; return true;
    }
    __device__ __forceinline__ void a_ready(const Unit&) const {}
    __device__ __forceinline__ void done(const Unit&) const {}
};
struct EpiResid {
    static constexpr bool PERM = true, AFTER_DRAIN = false, PERMA = false;
    const void* base_lat; const float* base_ctx; void* out_lat; float* out_ctx; const float* gate; int tile0; bool bin, bout;
    template <bool BIN, bool BOUT>
    __device__ __forceinline__ void body(const f32x4 (&acc)[2][2][4][2], const void* bp_, void* op_, const float* gp, int wr, int fr) const {
        f32x4 g[2][2];
#pragma unroll
        for (int bj = 0; bj < 2; ++bj)
#pragma unroll
            for (int n = 0; n < 2; ++n) g[bj][n] = *(const f32x4*)(gp + bj * HALF + n * 4);
        if constexpr (BIN) {
            u32x4 rb[8][2];
#define RB_LOAD(it_) do { _Pragma("unroll") for (int bj = 0; bj < 2; ++bj) rb[it_][bj] = *(const u32x4*)((const bf16_t*)bp_ + (size_t)(((it_) >> 2) * HALF + wr * 64 + ((it_) & 3) * 16 + fr) * 1024 + bj * HALF); } while (0)
            RB_LOAD(0); RB_LOAD(1); RB_LOAD(2); RB_LOAD(3); RB_LOAD(4);
#pragma unroll
            for (int it = 0; it < 8; ++it) { const int ai = it >> 2, m = it & 3; const size_t off = (size_t)(ai * HALF + wr * 64 + m * 16 + fr) * 1024;
#pragma unroll
                for (int bj = 0; bj < 2; ++bj) { const size_t o = off + bj * HALF; const u32x4 w = rb[it][bj];
                    const f32x4 b0 = (f32x4){__uint_as_float(w.x << 16), __uint_as_float(w.x & 0xffff0000u), __uint_as_float(w.y << 16), __uint_as_float(w.y & 0xffff0000u)};
                    const f32x4 b1 = (f32x4){__uint_as_float(w.z << 16), __uint_as_float(w.z & 0xffff0000u), __uint_as_float(w.w << 16), __uint_as_float(w.w & 0xffff0000u)};
                    const f32x4 r0 = b0 + g[bj][0] * acc[ai][bj][m][0], r1 = b1 + g[bj][1] * acc[ai][bj][m][1];
                    if (BOUT) { u32x4 w2; w2.x = cvt_pk_bf16(r0[0], r0[1]); w2.y = cvt_pk_bf16(r0[2], r0[3]); w2.z = cvt_pk_bf16(r1[0], r1[1]); w2.w = cvt_pk_bf16(r1[2], r1[3]); *(u32x4*)((bf16_t*)op_ + o) = w2; }
                    else { *(f32x4*)((float*)op_ + o) = r0; *(f32x4*)((float*)op_ + o + 4) = r1; } }
                if (it + 5 < 8) RB_LOAD(it + 5);
                __builtin_amdgcn_sched_barrier(0); }
#undef RB_LOAD
        } else {
#pragma unroll
            for (int ai = 0; ai < 2; ++ai)
#pragma unroll
                for (int m = 0; m < 4; ++m) { const size_t off = (size_t)(ai * HALF + wr * 64 + m * 16 + fr) * 1024;
#pragma unroll
                    for (int bj = 0; bj < 2; ++bj) { const size_t o = off + bj * HALF;
                        const f32x4 b0 = *(const f32x4*)((const float*)bp_ + o), b1 = *(const f32x4*)((const float*)bp_ + o + 4);
                        const f32x4 r0 = b0 + g[bj][0] * acc[ai][bj][m][0], r1 = b1 + g[bj][1] * acc[ai][bj][m][1];
                        if (BOUT) { u32x4 w2; w2.x = cvt_pk_bf16(r0[0], r0[1]); w2.y = cvt_pk_bf16(r0[2], r0[3]); w2.z = cvt_pk_bf16(r1[0], r1[1]); w2.w = cvt_pk_bf16(r1[2], r1[3]); *(u32x4*)((bf16_t*)op_ + o) = w2; }
                        else { *(f32x4*)((float*)op_ + o) = r0; *(f32x4*)((float*)op_ + o + 4) = r1; } }
                    asm volatile("" ::: "memory"); }
        }
    }
    __device__ __forceinline__ void operator()(const f32x4 (&acc)[2][2][4][2], const Unit& u, int wr, int wc, int fr, int fq) const {
        asm volatile("" : "+v"(fr), "+v"(fq));
        const int tile = tile0 + u.pm; const bool lat = tile < 128; const int mb = lat ? (tile >> 5) : 4;
        const int col0 = u.pn * BM + wc * 32 + 8 * fq;
        const size_t toff = (lat ? (size_t)tile : (size_t)(tile - 128)) * (256 * 1024) + col0;
        const float* gp = gate + mb * 6144 + col0;
        if (!lat) {
            f32x4 g[2][2];
#pragma unroll
            for (int bj = 0; bj < 2; ++bj)
#pragma unroll
                for (int n = 0; n < 2; ++n) g[bj][n] = *(const f32x4*)(gp + bj * HALF + n * 4);
            float* op = out_ctx + (size_t)(u.ko >> 8) * (1024 * 1024) + toff;
#pragma unroll
            for (int ai = 0; ai < 2; ++ai)
#pragma unroll
                for (int m = 0; m < 4; ++m) { const size_t off = (size_t)(ai * HALF + wr * 64 + m * 16 + fr) * 1024;
#pragma unroll
                    for (int bj = 0; bj < 2; ++bj)
#pragma unroll
                        for (int n = 0; n < 2; ++n) *(f32x4*)(op + off + bj * HALF + n * 4) = g[bj][n] * acc[ai][bj][m][n]; }
        }
        else if (bin && bout) body<true, true>(acc, (const bf16_t*)base_lat + toff, (bf16_t*)out_lat + toff, gp, wr, fr);
        else if (bout) body<false, true>(acc, (const float*)base_lat + toff, (bf16_t*)out_lat + toff, gp, wr, fr);
        else body<true, false>(acc, (const bf16_t*)base_lat + toff, (float*)out_lat + toff, gp, wr, fr);
    }
};
struct EpiConvAct {
    static constexpr bool PERM = true, AFTER_DRAIN = false, PERMA = true;
    bf16_t* ACT; float* HALO; const float* cw; PG8_LAS float* XB;
    __device__ __forceinline__ void operator()(const f32x4 (&acc)[2][2][4][2], const Unit& u, int wr, int wc, int fr, int fq) const {
        { int l_; asm volatile("v_mbcnt_lo_u32_b32 %0, -1, 0\n\tv_mbcnt_hi_u32_b32 %0, -1, %0" : "=v"(l_)); fr = l_ & 15; fq = l_ >> 4; }
        const int lane = fq * 16 + fr, cloc = wc * 32 + 8 * fq;
        const int chan = u.pn * 128 + cloc;
        f32x4 w[2][3][2];
#pragma unroll
        for (int n = 0; n < 2; ++n)
#pragma unroll
            for (int t = 0; t < 3; ++t)
#pragma unroll
                for (int bj = 0; bj < 2; ++bj) w[n][t][bj] = *(const f32x4*)(cw + t * 5632 + bj * 2816 + chan + 4 * n) * (bj == 0 ? -1.4426950408889634f : -0.6931471805599453f);
#pragma unroll
        for (int ai = 0; ai < 2; ++ai) { const int k = 2 * ai + wr;
            if (fr == 0 || fr == 15) { const int slot = 2 * k + (fr == 15 ? 1 : 0), m = fr == 15 ? 3 : 0;
#pragma unroll
                for (int bj = 0; bj < 2; ++bj)
#pragma unroll
                    for (int n = 0; n < 2; ++n) *(PG8_LAS f32x4*)(XB + slot * 256 + bj * 128 + cloc + 4 * n) = (m == 0) ? acc[ai][bj][0][n] : acc[ai][bj][3][n]; } }
        if ((wr == 0 && fr == 0) || (wr == 1 && fr == 15)) { float* hp = HALO + ((size_t)u.pm * 4 + (wr == 0 ? 0 : 2)) * 5632 + chan;
#pragma unroll
            for (int bj = 0; bj < 2; ++bj)
#pragma unroll
                for (int n = 0; n < 2; ++n) { *(f32x4*)(hp + bj * 2816 + 4 * n) = (wr == 0) ? acc[0][bj][0][n] : acc[1][bj][2][n]; *(f32x4*)(hp + 5632 + bj * 2816 + 4 * n) = (wr == 0) ? acc[0][bj][1][n] : acc[1][bj][3][n]; } }
        asm volatile("s_waitcnt lgkmcnt(0)" ::: "memory"); __builtin_amdgcn_s_barrier(); asm volatile("" ::: "memory");
        const int ldn = ((lane & 48) | ((fr + 15) & 15)) << 2, lup = ((lane & 48) | ((fr + 1) & 15)) << 2;
#pragma unroll
        for (int ai = 0; ai < 2; ++ai) { const int k = 2 * ai + wr;
#pragma unroll
            for (int m = 0; m < 4; ++m) {
                u32x4 o;
#pragma unroll
                for (int n = 0; n < 2; ++n) {
                    f32x4 y[2];
#pragma unroll
                    for (int bj = 0; bj < 2; ++bj) {
                        const f32x4 x = acc[ai][bj][m][n];
                        f32x4 prev, next;
                        if (m > 0) prev = acc[ai][bj][m > 0 ? m - 1 : 0][n];
                        else { const f32x4 t3 = acc[ai][bj][3][n];
#pragma unroll
                            for (int e = 0; e < 4; ++e) prev[e] = __int_as_float(__builtin_amdgcn_ds_bpermute(ldn, __float_as_int(t3[e])));
                            f32x4 xb = (f32x4){0.f, 0.f, 0.f, 0.f}; if (k > 0) xb = *(const PG8_LAS f32x4*)(XB + (2 * k - 1) * 256 + bj * 128 + cloc + 4 * n); if (fr == 0) prev = xb; }
                        if (m < 3) next = acc[ai][bj][m < 3 ? m + 1 : 3][n];
                        else { const f32x4 t0 = acc[ai][bj][0][n];
#pragma unroll
                            for (int e = 0; e < 4; ++e) next[e] = __int_as_float(__builtin_amdgcn_ds_bpermute(lup, __float_as_int(t0[e])));
                            f32x4 xb = (f32x4){0.f, 0.f, 0.f, 0.f}; if (k < 3) xb = *(const PG8_LAS f32x4*)(XB + (2 * k + 2) * 256 + bj * 128 + cloc + 4 * n); if (fr == 15) next = xb; }
                        y[bj] = w[n][0][bj] * prev + w[n][1][bj] * x + w[n][2][bj] * next;
                    }
                    float a[4];
#pragma unroll
                    for (int e = 0; e < 4; ++e) a[e] = y[0][e] * __builtin_amdgcn_rcpf(1.f + __builtin_amdgcn_exp2f(y[0][e])) * y[1][e];
                    if (n == 0) { o.x = cvt_pk_bf16(a[0], a[1]); o.y = cvt_pk_bf16(a[2], a[3]); } else { o.z = cvt_pk_bf16(a[0], a[1]); o.w = cvt_pk_bf16(a[2], a[3]); }
                }
                *(u32x4*)(ACT + (size_t)(u.pm * BM + ai * HALF + wr * 64 + fr * 4 + m) * 2816 + chan) = o;
                __builtin_amdgcn_sched_barrier(0);
            }
        }
    }
};
template <class Epi, class Sched, bool ALIGN_EPI = false, bool SP2 = false>
__device__ __forceinline__ void gemm_phase(PG8_LAS unsigned char* lds, const Gemm g, const Sched& S, const Epi& E, const int tid) {
    const int wid = __builtin_amdgcn_readfirstlane(tid >> 6), lane = tid & 63, wr = wid >> 2, wc = wid & 3, fr = lane & 15, fq = lane >> 4;
    const int K = g.K;
    unsigned voffA[2], voffB[2];
#pragma unroll
    for (int i = 0; i < 2; ++i) { int R, C; stage_rc(tid * 16 + i * 8192, R, C); const int Rb = Epi::PERM ? ((R & ~31) + perm32(R & 31)) : R;
        const int Ra = Epi::PERMA ? ((R & ~63) + ((R & 15) << 2) + ((R >> 4) & 3)) : R;
        voffA[i] = (unsigned)(Ra * K + C) * 2u; voffB[i] = (unsigned)(Rb * K + C) * 2u; }
    const size_t kstep = (size_t)(BK * 2);
    const size_t hstep = (size_t)HALF * K * 2;
    const size_t tstep = 2 * hstep;
    const unsigned ldsw = (unsigned)wid * 1024u;
    const int aoff = lds_byte(wr * 64 + fr, fq * 8), boff = lds_byte(wc * 32 + fr, fq * 8);
#define PG8_SA(b, h) (((b) * 2 + (h)) * HTB)
#define PG8_SB(b, h) ((4 + (b) * 2 + (h)) * HTB)
#define PG8_STAGE(bufoff, gbase, voff) do { _Pragma("unroll") for (int _i = 0; _i < 2; ++_i) \
        __builtin_amdgcn_global_load_lds((const unsigned*)((const char*)(gbase) + (voff)[_i]), (PG8_LAS unsigned*)(lds + (bufoff) + ldsw + _i * 8192), 16, 0, 0); } while (0)
#define PG8_LDA(dst, b, h) do { _Pragma("unroll") for (int m = 0; m < 4; ++m) _Pragma("unroll") for (int k = 0; k < 2; ++k) dst[m][k] = *(const PG8_LAS bf16x8*)(lds + PG8_SA(b, h) + aoff + m * 2048 + k * 1024); } while (0)
#define PG8_LDB(dst, b, h) do { _Pragma("unroll") for (int n = 0; n < 2; ++n) _Pragma("unroll") for (int k = 0; k < 2; ++k) dst[n][k] = *(const PG8_LAS bf16x8*)(lds + PG8_SB(b, h) + boff + n * 2048 + k * 1024); } while (0)
#define PG8_MMA(ai, bj, At, Bt) do { __builtin_amdgcn_s_setprio(1); _Pragma("unroll") for (int m = 0; m < 4; ++m) _Pragma("unroll") for (int n = 0; n < 2; ++n) _Pragma("unroll") for (int k = 0; k < 2; ++k) \
        acc[ai][bj][m][n] = __builtin_amdgcn_mfma_f32_16x16x32_bf16(Bt[n][k], At[m][k], acc[ai][bj][m][n], 0, 0, 0); __builtin_amdgcn_s_setprio(0); } while (0)
#define PG8_WAIT_V(n) asm volatile("s_waitcnt vmcnt(" #n ")" ::: "memory")
#define PG8_WAIT_L(n) asm volatile("s_waitcnt lgkmcnt(" #n ")" ::: "memory")
#define PG8_BAR __builtin_amdgcn_s_barrier()
#define PG8_SCHED __builtin_amdgcn_sched_barrier(0)
    Unit cur, nxt; int ui = 0;
    if (!S.next(0, cur)) return;
    f32x4 acc[2][2][4][2];
#pragma unroll
    for (int a = 0; a < 2; ++a)
#pragma unroll
        for (int b = 0; b < 2; ++b)
#pragma unroll
            for (int m = 0; m < 4; ++m)
#pragma unroll
                for (int n = 0; n < 2; ++n) acc[a][b][m][n] = (f32x4){0.f, 0.f, 0.f, 0.f};
    bf16x8 At[4][2], B0[2][2], B1[2][2];
    const char* cA = (const char*)g.A + (size_t)cur.pm * tstep + (size_t)cur.ko * 2; const char* cB = (const char*)g.Bt + (size_t)cur.pn * tstep + (size_t)cur.ko * 2;
    S.a_ready(cur);
    if constexpr (SP2) {
        PG8_STAGE(PG8_SB(0, 0), cB, voffB); PG8_STAGE(PG8_SB(0, 1), cB + hstep, voffB); PG8_STAGE(PG8_SA(0, 0), cA, voffA); PG8_STAGE(PG8_SA(0, 1), cA + hstep, voffA);
        if (wr == 1) PG8_BAR;
        PG8_WAIT_V(2); PG8_BAR;
        PG8_STAGE(PG8_SB(1, 0), cB + kstep, voffB); PG8_STAGE(PG8_SA(1, 0), cA + kstep, voffA); PG8_STAGE(PG8_SB(1, 1), cB + hstep + kstep, voffB);
        PG8_WAIT_V(6); PG8_BAR;
    } else {
        PG8_STAGE(PG8_SB(0, 0), cB, voffB); PG8_STAGE(PG8_SA(0, 0), cA, voffA); PG8_STAGE(PG8_SB(0, 1), cB + hstep, voffB); PG8_STAGE(PG8_SA(0, 1), cA + hstep, voffA);
        if (wr == 1) PG8_BAR;
        PG8_WAIT_V(4); PG8_BAR;
        PG8_STAGE(PG8_SB(1, 0), cB + kstep, voffB); PG8_STAGE(PG8_SA(1, 0), cA + kstep, voffA); PG8_STAGE(PG8_SB(1, 1), cB + hstep + kstep, voffB);
        PG8_WAIT_V(6); PG8_BAR;
    }
    for (;;) {
        const bool has_next = S.next(ui + 1, nxt);
        const char* nA = has_next ? (const char*)g.A + (size_t)nxt.pm * tstep + (size_t)nxt.ko * 2 : cA; const char* nB = has_next ? (const char*)g.Bt + (size_t)nxt.pn * tstep + (size_t)nxt.ko * 2 : cB;
        const int nt = cur.nt ? cur.nt : K / BK;
        for (int t = 0; t < nt; t += 2) {
            const bool last = (t == nt - 2);
            const char* a1 = cA + (size_t)(t + 1) * kstep;
            const char* a2 = last ? nA : cA + (size_t)(t + 2) * kstep; const char* b2 = last ? nB : cB + (size_t)(t + 2) * kstep;
            const char* a3 = a2 + kstep; const char* b3 = b2 + kstep;
            if (last && has_next) S.a_ready(nxt);
            if constexpr (SP2) {
            PG8_LDB(B0, 0, 0); PG8_LDB(B1, 0, 1); PG8_SCHED; PG8_LDA(At, 0, 0); PG8_STAGE(PG8_SA(1, 1), a1 + hstep, voffA);
            PG8_WAIT_V(8); PG8_WAIT_L(0); PG8_BAR; PG8_MMA(0, 0, At, B0); PG8_MMA(0, 1, At, B1); PG8_BAR; PG8_SCHED;
            PG8_LDA(At, 0, 1); PG8_STAGE(PG8_SB(0, 0), b2, voffB); PG8_STAGE(PG8_SB(0, 1), b2 + hstep, voffB); PG8_STAGE(PG8_SA(0, 0), a2, voffA);
            PG8_WAIT_V(8); PG8_WAIT_L(0); PG8_BAR; PG8_MMA(1, 0, At, B0); PG8_MMA(1, 1, At, B1); PG8_BAR; PG8_SCHED;
            PG8_LDB(B0, 1, 0); PG8_LDB(B1, 1, 1); PG8_SCHED; PG8_LDA(At, 1, 0); PG8_STAGE(PG8_SA(0, 1), a2 + hstep, voffA);
            PG8_WAIT_V(8); PG8_WAIT_L(0); PG8_BAR; PG8_MMA(0, 0, At, B0); PG8_MMA(0, 1, At, B1); PG8_BAR; PG8_SCHED;
            PG8_LDA(At, 1, 1); PG8_STAGE(PG8_SB(1, 0), b3, voffB); PG8_STAGE(PG8_SB(1, 1), b3 + hstep, voffB); PG8_STAGE(PG8_SA(1, 0), a3, voffA);
            PG8_WAIT_V(8); PG8_WAIT_L(0); PG8_BAR; PG8_MMA(1, 0, At, B0); PG8_MMA(1, 1, At, B1); PG8_BAR; PG8_SCHED;
            } else {
            PG8_LDB(B0, 0, 0); PG8_SCHED; PG8_LDA(At, 0, 0); PG8_STAGE(PG8_SA(1, 1), a1 + hstep, voffA);
            PG8_WAIT_L(8); PG8_BAR; PG8_WAIT_L(0); PG8_MMA(0, 0, At, B0); PG8_BAR; PG8_SCHED;
            PG8_LDB(B1, 0, 1); PG8_STAGE(PG8_SB(0, 0), b2, voffB);
            PG8_BAR; PG8_WAIT_L(0); PG8_MMA(0, 1, At, B1); PG8_BAR;
            PG8_LDA(At, 0, 1); PG8_STAGE(PG8_SA(0, 0), a2, voffA);
            PG8_BAR; PG8_WAIT_L(0); PG8_MMA(1, 0, At, B0); PG8_BAR; PG8_SCHED;
            PG8_STAGE(PG8_SB(0, 1), b2 + hstep, voffB);
            PG8_WAIT_V(6); PG8_BAR; PG8_MMA(1, 1, At, B1); PG8_BAR;
            PG8_LDB(B0, 1, 0); PG8_SCHED; PG8_LDA(At, 1, 0); PG8_STAGE(PG8_SA(0, 1), a2 + hstep, voffA);
            PG8_WAIT_L(8); PG8_BAR; PG8_WAIT_L(0); PG8_MMA(0, 0, At, B0); PG8_BAR; PG8_SCHED;
            PG8_LDB(B1, 1, 1); PG8_STAGE(PG8_SB(1, 0), b3, voffB);
            PG8_BAR; PG8_WAIT_L(0); PG8_MMA(0, 1, At, B1); PG8_BAR;
            PG8_LDA(At, 1, 1); PG8_STAGE(PG8_SA(1, 0), a3, voffA);
            PG8_BAR; PG8_WAIT_L(0); PG8_MMA(1, 0, At, B0); PG8_BAR; PG8_SCHED;
            PG8_STAGE(PG8_SB(1, 1), b3 + hstep, voffB);
            PG8_WAIT_V(6); PG8_BAR; PG8_MMA(1, 1, At, B1); PG8_BAR;
            }
        }
        if constexpr (ALIGN_EPI) { if (wr == 0) PG8_BAR; }
        if constexpr (!Epi::AFTER_DRAIN) { E(acc, cur, wr, wc, fr, fq); S.done(cur); }
        if (!has_next) break;
#pragma unroll
        for (int a = 0; a < 2; ++a)
#pragma unroll
            for (int b = 0; b < 2; ++b)
#pragma unroll
                for (int m = 0; m < 4; ++m)
#pragma unroll
                    for (int n = 0; n < 2; ++n) acc[a][b][m][n] = (f32x4){0.f, 0.f, 0.f, 0.f};
        cur = nxt; cA = nA; cB = nB; ++ui;
        if constexpr (ALIGN_EPI) { if (wr == 1) PG8_BAR; }
    }
    PG8_WAIT_V(0);
    if constexpr (!ALIGN_EPI) { if (wr == 0) PG8_BAR; }
    PG8_BAR;
    if constexpr (Epi::AFTER_DRAIN) { E.fused(acc, cur, wr, wc, fr, fq, lds, wid, lane); S.done(cur); }
#undef PG8_SA
#undef PG8_SB
#undef PG8_STAGE
#undef PG8_LDA
#undef PG8_LDB
#undef PG8_MMA
#undef PG8_WAIT_V
#undef PG8_WAIT_L
#undef PG8_BAR
#undef PG8_SCHED
}
}

constexpr int DM = 1024, NB = 4, SEQ = 8192, CTXL = 256, ML = NB * SEQ, MC = NB * CTXL, MT = ML + MC;
constexpr int DFF = 2816, NUP = 2 * DFF;
constexpr float EPS = 1e-6f;
constexpr int NWAVES = 8;
constexpr float LOG2E = 1.4426950408889634f;

constexpr size_t MiB = 1u << 20;
constexpr size_t WS_CTL = 0, CTL_ZERO_BYTES = 64 * 1024;
constexpr int CW_BAR = 1024;
constexpr size_t WS_MOD = 1 * MiB;
constexpr size_t WS_ROPE64 = 1 * MiB + 512 * 1024;
constexpr size_t WS_ROPE128 = WS_ROPE64 + 16384;
constexpr size_t WS_HC = 2 * MiB;
constexpr size_t WS_WT = 6 * MiB;
constexpr size_t SZ_UP = (size_t)NUP * DM * 2, SZ_DOWN = (size_t)DM * DFF * 2, SZ_W1536 = 1536u * 1024 * 2, SZ_W1024 = 1024u * 1024 * 2, SZ_W3072 = 3072u * 1024 * 2;
constexpr size_t SZ_LA = SZ_W1536 + SZ_W1024 + SZ_UP + SZ_DOWN, SZ_LB = SZ_W3072 + SZ_W1024 + SZ_UP + SZ_DOWN;
constexpr size_t WT_L0 = WS_WT, WT_L1 = WT_L0 + SZ_LA, WT_L2 = WT_L1 + SZ_LB, WT_L3 = WT_L2 + SZ_LA, WT_END = WT_L3 + SZ_LB;
static_assert(WT_END <= 98 * MiB, "weights");
constexpr size_t WS_XN = 98 * MiB;
constexpr size_t WS_GATES = 164 * MiB;
constexpr size_t WS_BIG = 168 * MiB;
constexpr size_t WS_END = 512 * MiB;
constexpr size_t BG_RAW = WS_BIG, BG_Q = WS_BIG + 100 * MiB, BG_K = WS_BIG + 166 * MiB, BG_V = WS_BIG + 183 * MiB, BG_O = WS_BIG + 200 * MiB;
constexpr size_t BG_CBAR = WS_BIG + 200 * MiB, BG_NBAR = WS_BIG + 332 * MiB, BG_MSC = WS_BIG + 334 * MiB;
constexpr size_t WS_HF = WS_XN, WS_HB = WS_WT;
static_assert((size_t)ML * 1024 * 2 <= WT_L3 - WS_WT, "HB fits below layer 3's weights");
constexpr size_t BG_ACT = WS_BIG, BG_HALO = WS_BIG + 184 * MiB;
constexpr size_t BG_SLAB = WS_BIG + 270 * MiB;
constexpr int XB_OFF = 135168;
constexpr int ML_NUID = 32 * 66;

constexpr int RING_BYTES = 131072, LDSCTL_OFF = RING_BYTES, MISC_OFF = LDSCTL_OFF + 320, LDS_BYTES = 147456;
#define GAS __attribute__((address_space(1)))
#define LAS __attribute__((address_space(3)))
typedef unsigned short bf16;
typedef unsigned v4u __attribute__((ext_vector_type(4)));
typedef float f32x4 __attribute__((ext_vector_type(4)));
typedef short bf16x8 __attribute__((ext_vector_type(8)));
typedef GAS unsigned gu32;
typedef GAS unsigned long long gu64;
#define RLX_AGENT __ATOMIC_RELAXED, __HIP_MEMORY_SCOPE_AGENT
#define LDS_WAIT() asm volatile("s_waitcnt lgkmcnt(0)" ::: "memory")
#define VM_WAIT() asm volatile("s_waitcnt vmcnt(0)" ::: "memory")
__device__ __forceinline__ unsigned long long rt() { return __builtin_amdgcn_s_memrealtime(); }
__device__ __forceinline__ unsigned f2bf(float f) { unsigned u = __builtin_bit_cast(unsigned, f); return (u + 0x7fffu + ((u >> 16) & 1u)) >> 16; }
__device__ __forceinline__ unsigned pk2(float lo, float hi) { return f2bf(lo) | (f2bf(hi) << 16); }

#define XB_TMO      128
#define XB_XCNT(j)  (256  + 64 * (j))
#define XB_XSUB(j)  (1280 + 64 * (j))
#define XB_XGEN(j)  (2304 + 64 * (j))
#define XB_TOP      3328
#define XB_TOPGEN   3392
#define XCD_BAR_WORDS 3456
#define XB_SPIN_CAP (1u << 18)

__device__ __forceinline__ unsigned xb_ld(unsigned* p)              { return __hip_atomic_load(p, __ATOMIC_RELAXED, __HIP_MEMORY_SCOPE_AGENT); }
__device__ __forceinline__ unsigned xb_add(unsigned* p, unsigned v) { return __hip_atomic_fetch_add(p, v, __ATOMIC_RELAXED, __HIP_MEMORY_SCOPE_AGENT); }
__device__ __forceinline__ unsigned xb_xcc_id() { return (unsigned)__builtin_amdgcn_s_getreg((3 << 11) | 20) & 0xFu; }
#define XB_SPIN(cond, bar) do { unsigned _sp = 0; while (cond) { __builtin_amdgcn_s_sleep(1); \
    if ((++_sp & 255u) == 0u) { if (xb_ld(&(bar)[XB_TMO])) break; if (_sp > XB_SPIN_CAP) { atomicAdd(&(bar)[XB_TMO], 1u); break; } } } } while (0)

struct XcdBarrier {
    unsigned* bar; unsigned x;
    volatile LAS unsigned* st;
};

__device__ __forceinline__ int xb_lane() { int l_; asm volatile("v_mbcnt_lo_u32_b32 %0, -1, 0\n\tv_mbcnt_hi_u32_b32 %0, -1, %0" : "=v"(l_)); return l_; }
__device__ __forceinline__ XcdBarrier xcd_barrier_post(unsigned* bar, volatile LAS unsigned* st, int wave) {
    XcdBarrier b; b.bar = bar; b.x = xb_xcc_id(); b.st = st;
    if (wave == 0 && xb_lane() == 0) (void)xb_add(&bar[XB_XCNT(b.x)], 1u);
    return b;
}
__device__ __forceinline__ void xcd_barrier_complete(unsigned* bar, unsigned x, unsigned& nloc, unsigned& nx) {
    const unsigned G = gridDim.x * gridDim.y * gridDim.z;
    unsigned sum, cnt, mine, sp = 0u;
    for (;;) {
        sum = 0u; cnt = 0u; mine = 0u;
#pragma nounroll
        for (unsigned j = 0; j < 16; ++j) { const unsigned c = xb_ld(&bar[XB_XCNT(j)]); sum += c; cnt += (c > 0u) ? 1u : 0u; mine = (j == x) ? c : mine; }
        if (sum == G) break;
        __builtin_amdgcn_s_sleep(1);
        if ((++sp & 255u) == 0u) { if (xb_ld(&bar[XB_TMO])) break; if (sp > XB_SPIN_CAP) { atomicAdd(&bar[XB_TMO], 1u); break; } }
    }
    nloc = mine > 0u ? mine : 1u; nx = cnt > 0u ? cnt : 1u;
}

__device__ __forceinline__ void xcd_barrier(const XcdBarrier& b, int wave  ) {
    asm volatile("s_waitcnt vmcnt(0)" ::: "memory");
    __syncthreads();
    if (wave == 0 && xb_lane() == 0) {
        unsigned* bar = b.bar;
        __builtin_amdgcn_s_waitcnt(0);
        unsigned nloc = b.st[0], nx = b.st[1];
        if (nloc == 0u) { xcd_barrier_complete(bar, b.x, nloc, nx); b.st[0] = nloc; b.st[1] = nx; }
        const unsigned old = xb_add(&bar[XB_XSUB(b.x)], 1u);
        const unsigned gen = old / nloc;
        if (old + 1u == (gen + 1u) * nloc) {
            __builtin_amdgcn_fence(__ATOMIC_RELEASE, "agent");
            asm volatile("s_waitcnt vmcnt(0)" ::: "memory");
            const unsigned og = xb_add(&bar[XB_TOP], 1u);
            const unsigned tg = og / nx;
            if (og + 1u == (tg + 1u) * nx) xb_add(&bar[XB_TOPGEN], 1u);
            else XB_SPIN(xb_ld(&bar[XB_TOPGEN]) == tg, bar);
            __builtin_amdgcn_fence(__ATOMIC_ACQUIRE, "agent");
            xb_add(&bar[XB_XGEN(b.x)], 1u);
            asm volatile("s_waitcnt vmcnt(0)" ::: "memory");
        } else {
            XB_SPIN(xb_ld(&bar[XB_XGEN(b.x)]) == gen, bar);
            __builtin_amdgcn_fence(__ATOMIC_ACQUIRE, "agent");
            asm volatile("s_waitcnt vmcnt(0)" ::: "memory");
        }
    }
    __syncthreads();
}

typedef unsigned u32x2 __attribute__((ext_vector_type(2)));
struct Frame { LAS unsigned char* lds; int tid, lane, wave, G, gw, ngw; };

__device__ __forceinline__ float bperm(float v, int srclane) { return __int_as_float(__builtin_amdgcn_ds_bpermute(srclane << 2, __float_as_int(v))); }
#define DPP_ADD(v, ctrl) ((v) + __int_as_float(__builtin_amdgcn_update_dpp(0, __float_as_int(v), (ctrl), 0xf, 0xf, true)))
__device__ __forceinline__ float row_sum16(float v) {
    v = DPP_ADD(v, 0xB1); v = DPP_ADD(v, 0x4E); v = DPP_ADD(v, 0x141); v = DPP_ADD(v, 0x140); return v;
}
__device__ __forceinline__ float wave_sum(float v, int lane) {
    v = row_sum16(v);
    const float a = __int_as_float(__builtin_amdgcn_readlane(__float_as_int(v), 0)), b = __int_as_float(__builtin_amdgcn_readlane(__float_as_int(v), 16));
    const float c = __int_as_float(__builtin_amdgcn_readlane(__float_as_int(v), 32)), d = __int_as_float(__builtin_amdgcn_readlane(__float_as_int(v), 48));
    return (a + b) + (c + d);
}
__device__ __forceinline__ float wave_max(float v, int lane) {
#pragma unroll
    for (int o = 1; o < 64; o <<= 1) v = fmaxf(v, bperm(v, lane ^ o));
    return v;
}
__device__ __forceinline__ float bf2f(unsigned short x) { return __uint_as_float((unsigned)x << 16); }
__device__ __forceinline__ float bflo(unsigned w) { return __uint_as_float(w << 16); }
__device__ __forceinline__ float bfhi(unsigned w) { return __uint_as_float(w & 0xffff0000u); }
__device__ __forceinline__ unsigned cvtpk2(float lo, float hi) { unsigned r; asm volatile("v_cvt_pk_bf16_f32 %0, %1, %2" : "=v"(r) : "v"(lo), "v"(hi)); return r; }
__device__ __forceinline__ unsigned short f2bf16_mfma(float f) { const __bf16 b = (__bf16)f; return __builtin_bit_cast(unsigned short, b); }
__device__ __forceinline__ unsigned short f2bf16(float f) { return (unsigned short)(cvtpk2(f, 0.f) & 0xffffu); }
__device__ __forceinline__ void unpack8(const v4u w, float (&f)[8]) { f[0] = bflo(w.x); f[1] = bfhi(w.x); f[2] = bflo(w.y); f[3] = bfhi(w.y); f[4] = bflo(w.z); f[5] = bfhi(w.z); f[6] = bflo(w.w); f[7] = bfhi(w.w); }
__device__ __forceinline__ v4u pack8(const float (&f)[8]) { v4u w; w.x = cvtpk2(f[0], f[1]); w.y = cvtpk2(f[2], f[3]); w.z = cvtpk2(f[4], f[5]); w.w = cvtpk2(f[6], f[7]); return w; }
__device__ __forceinline__ float sigmoidf_(float x) { return __builtin_amdgcn_rcpf(1.f + __builtin_amdgcn_exp2f(-1.4426950408889634f * x)); }

__device__ __forceinline__ void p0_transpose_item(const float* W, int K, int pitch, int nblk, bf16* WT, LAS float* scr, int item, int lane, bool upperm) {
    const int kb = item / nblk, nb = item % nblk, k0 = 64 * kb, n0 = 32 * nb;
    int d0 = n0; if (upperm) { const int c = n0 < DFF ? n0 : n0 - DFF; d0 = 256 * (c >> 7) + (c & 127) + (n0 < DFF ? 0 : 128); }
    float wv[32];
#pragma unroll
    for (int i = 0; i < 32; ++i) { const int kk = 2 * i + (lane >> 5); wv[i] = W[(size_t)(k0 + kk) * pitch + n0 + (lane & 31)]; }
#pragma unroll
    for (int i = 0; i < 32; ++i) { const int kk = 2 * i + (lane >> 5); scr[kk * 33 + (lane & 31)] = wv[i]; }
    LDS_WAIT(); asm volatile("" ::: "memory");
    const int c = lane & 7;
#pragma unroll
    for (int j = 0; j < 4; ++j) { const int n = (lane >> 3) + 8 * j; const LAS float* s = scr + (8 * c) * 33 + n;
        v4u o; o.x = pk2(s[0 * 33], s[1 * 33]); o.y = pk2(s[2 * 33], s[3 * 33]); o.z = pk2(s[4 * 33], s[5 * 33]); o.w = pk2(s[6 * 33], s[7 * 33]);
        *(v4u*)(WT + (size_t)(d0 + n) * K + k0 + 8 * c) = o; }
    LDS_WAIT(); asm volatile("" ::: "memory");
}
__device__ __forceinline__ void transpose_matrix(const Frame& F, const float* W, int K, int pitch, int Nused, bf16* WT, int& rot, bool upperm = false) {
    const int nblk = Nused / 32, nitems = (K / 64) * nblk;
    LAS float* scr = (LAS float*)(F.lds + F.wave * 16384);
    int first = (F.gw - rot) % F.ngw; if (first < 0) first += F.ngw;
    for (int it = first; it < nitems; it += F.ngw) p0_transpose_item(W, K, pitch, nblk, WT, scr, it, F.lane, upperm);
    rot = (rot + nitems) % F.ngw;
}
__device__ __forceinline__ void mod_phase(const Frame& F, const float* c, const float* cctx, const float* ada_w, const float* ada_b, float* MOD) {
    LAS float* sc = (LAS float*)F.lds;
    LAS float* red = (LAS float*)(F.lds + 20480);
    { float cv[10];
#pragma unroll
      for (int i2 = 0; i2 < 10; ++i2) { const int i = F.tid + 512 * i2; cv[i2] = i < 4096 ? c[i] : cctx[i - 4096]; }
#pragma unroll
      for (int i2 = 0; i2 < 10; ++i2) sc[F.tid + 512 * i2] = cv[i2] / (1.f + expf(-cv[i2])); }
    __syncthreads();
    const int ks = F.tid >> 5, cn = F.tid & 31;
    for (int item = blockIdx.x; item < 768; item += F.G) {
        const int layer = item / 192, n0 = (item % 192) * 32;
        const float* wp = ada_w + (size_t)layer * 1024 * 6144 + (size_t)(ks * 64) * 6144 + n0 + cn;
        float a0 = 0.f, a1 = 0.f, a2 = 0.f, a3 = 0.f, a4 = 0.f;
#pragma unroll 32
        for (int k = 0; k < 64; ++k) { const float w = wp[(size_t)k * 6144]; const int kk = ks * 64 + k;
            a0 += w * sc[kk]; a1 += w * sc[1024 + kk]; a2 += w * sc[2048 + kk]; a3 += w * sc[3072 + kk]; a4 += w * sc[4096 + kk]; }
        LAS float* rp = red + (ks * 32 + cn) * 5; rp[0] = a0; rp[1] = a1; rp[2] = a2; rp[3] = a3; rp[4] = a4;
        __syncthreads();
        if (F.tid < 160) { const int cn2 = F.tid & 31, b = F.tid >> 5; float s = 0.f;
#pragma unroll
            for (int k2 = 0; k2 < 16; ++k2) s += red[(k2 * 32 + cn2) * 5 + b];
            MOD[(size_t)(layer * 5 + b) * 6144 + n0 + cn2] = s + ada_b[layer * 6144 + n0 + cn2]; }
        __syncthreads();
    }
}
__device__ __forceinline__ void rope_tables(const Frame& F, float* R64, float* R128) {
    for (int i = blockIdx.x * 512 + F.tid; i < 6144; i += F.G * 512) {
        int pos, f, nf; float* dst;
        if (i < 2048) { pos = i >> 4; f = i & 15; nf = 16; dst = R64 + 2 * i; } else { const int j = i - 2048; pos = j >> 5; f = j & 31; nf = 32; dst = R128 + 2 * j; }
        const float inv = powf(10000.f, -(float)f / (float)nf);
        const float ang = (float)pos * inv;
        dst[0] = cosf(ang); dst[1] = sinf(ang);
    }
}

#define NCOL(j) (8 * F.lane + 512 * ((j) >> 1) + 4 * ((j) & 1))
template <bool GATES, int RG>
__device__ __forceinline__ void norm_rows(const Frame& F, f32x4 (&v)[RG][4], int rbase, const f32x4 (&A)[4], const f32x4 (&Bv)[4], bf16* XN, const LAS float* WgT, const float* bgate, float* GATESb) {
#pragma unroll
    for (int q = 0; q < RG; ++q) {
        const int r = rbase + q; float ss = 0.f;
#pragma unroll
        for (int j = 0; j < 4; ++j) ss += (v[q][j].x * v[q][j].x + v[q][j].y * v[q][j].y) + (v[q][j].z * v[q][j].z + v[q][j].w * v[q][j].w);
        ss = wave_sum(ss, F.lane); const float rs = __builtin_amdgcn_rsqf(ss * (1.f / 1024.f) + EPS);
#pragma unroll
        for (int j = 0; j < 4; ++j) v[q][j] = v[q][j] * rs * A[j] + Bv[j];
#pragma unroll
        for (int i2 = 0; i2 < 2; ++i2) { v4u w; w.x = cvtpk2(v[q][2 * i2].x, v[q][2 * i2].y); w.y = cvtpk2(v[q][2 * i2].z, v[q][2 * i2].w); w.z = cvtpk2(v[q][2 * i2 + 1].x, v[q][2 * i2 + 1].y); w.w = cvtpk2(v[q][2 * i2 + 1].z, v[q][2 * i2 + 1].w);
            *(v4u*)(XN + (size_t)r * 1024 + 8 * F.lane + 512 * i2) = w; }
    }
    if (GATES) {
        float val[RG];
#pragma unroll
        for (int q = 0; q < RG; ++q) val[q] = 0.f;
#pragma unroll
        for (int jg = 0; jg < 16; ++jg) { f32x4 w[4];
#pragma unroll
            for (int j = 0; j < 4; ++j) w[j] = *(const LAS f32x4*)(WgT + jg * 1024 + NCOL(j));
#pragma unroll
            for (int q = 0; q < RG; ++q) { float s = 0.f;
#pragma unroll
                for (int j = 0; j < 4; ++j) s += (v[q][j].x * w[j].x + v[q][j].y * w[j].y) + (v[q][j].z * w[j].z + v[q][j].w * w[j].w);
                s = wave_sum(s, F.lane); val[q] = (F.lane == jg) ? s : val[q]; } }
        if (F.lane < 16) { const float bg = bgate[F.lane]; const int kind = F.lane >> 2;
#pragma unroll
            for (int q = 0; q < RG; ++q) { float x = val[q] + bg;
                if (kind & 1) x = fminf(x, 0.f) - 0.6931471805599453f * __builtin_amdgcn_logf(1.f + __builtin_amdgcn_exp2f(-1.4426950408889634f * fabsf(x)));
                GATESb[(size_t)(rbase + q) * 16 + F.lane] = x; } }
    }
}
template <bool GATES>
__device__ __forceinline__ void norm_phase(const Frame& F, const void* hlat, bool lat_bf16, float* hctx, const float* slab, int nslab, int nrows, const float* gain, const float* mod, int sh_off, int sc_off, bf16* XN,
                                           const float* wg_src, const float* bgate, float* GATESb) {
    LAS float* WgT = (LAS float*)F.lds;
    if (GATES) { float wv[32];
#pragma unroll
        for (int i2 = 0; i2 < 32; ++i2) wv[i2] = wg_src[(size_t)((F.tid >> 4) + 32 * i2) * 3088 + 3072 + (F.tid & 15)];
#pragma unroll
        for (int i2 = 0; i2 < 32; ++i2) WgT[(F.tid & 15) * 1024 + (F.tid >> 4) + 32 * i2] = wv[i2];
        __syncthreads(); }
    constexpr int RG = 4;
    const int nlat = ML / 16, nitems = nlat + (nrows > ML ? MC : 0);
    for (int it = F.gw; it < nitems; it += F.ngw) {
        const int r0 = it < nlat ? it * 16 : ML + (it - nlat), mb = r0 < ML ? (r0 >> 13) : 4;
        const bool pipe = r0 < ML && lat_bf16;
        const bf16* src = (const bf16*)hlat + (size_t)(pipe ? r0 : 0) * 1024 + 8 * F.lane;
        v4u raw[RG][2];
        if (pipe) {
#pragma unroll
            for (int q = 0; q < RG; ++q) { raw[q][0] = *(const v4u*)(src + q * 1024); raw[q][1] = *(const v4u*)(src + q * 1024 + 512); } }
        f32x4 A[4], Bv[4];
        { f32x4 g[4], s[4];
#pragma unroll
          for (int j = 0; j < 4; ++j) { const int col = NCOL(j); g[j] = *(const f32x4*)(gain + col); s[j] = *(const f32x4*)(mod + mb * 6144 + sc_off + col); Bv[j] = *(const f32x4*)(mod + mb * 6144 + sh_off + col); }
#pragma unroll
          for (int j = 0; j < 4; ++j) A[j] = g[j] * (1.f + s[j]); }
        if (pipe) {
#pragma nounroll
            for (int rr = 0; rr < 16; rr += RG) {
                f32x4 v[RG][4];
#pragma unroll
                for (int q = 0; q < RG; ++q)
#pragma unroll
                    for (int i2 = 0; i2 < 2; ++i2) { const v4u w = raw[q][i2];
                        v[q][2 * i2] = (f32x4){bflo(w.x), bfhi(w.x), bflo(w.y), bfhi(w.y)}; v[q][2 * i2 + 1] = (f32x4){bflo(w.z), bfhi(w.z), bflo(w.w), bfhi(w.w)}; }
                { const int rn = rr + RG < 16 ? rr + RG : rr;
#pragma unroll
                  for (int q = 0; q < RG; ++q) { raw[q][0] = *(const v4u*)(src + (size_t)(rn + q) * 1024); raw[q][1] = *(const v4u*)(src + (size_t)(rn + q) * 1024 + 512); } }
                norm_rows<GATES, RG>(F, v, r0 + rr, A, Bv, XN, WgT, bgate, GATESb);
            }
            continue;
        }
        if (r0 < ML) {
            for (int rr = 0; rr < 16; rr += RG) {
                f32x4 v[RG][4];
#pragma unroll
                for (int q = 0; q < RG; ++q) { const float* src = (const float*)hlat + (size_t)(r0 + rr + q) * 1024;
#pragma unroll
                    for (int j = 0; j < 4; ++j) v[q][j] = *(const f32x4*)(src + NCOL(j)); }
                norm_rows<GATES, RG>(F, v, r0 + rr, A, Bv, XN, WgT, bgate, GATESb);
            }
            continue;
        }
        { f32x4 v[1][4]; float* src = hctx + (size_t)(r0 - ML) * 1024;
#pragma unroll
          for (int j = 0; j < 4; ++j) v[0][j] = *(const f32x4*)(src + NCOL(j));
          if (nslab > 0) {
#pragma nounroll
              for (int s0 = 0; s0 < nslab; s0 += 4) { f32x4 sv[4][4];
#pragma unroll
                  for (int qq = 0; qq < 4; ++qq) { const int s = s0 + qq < nslab ? s0 + qq : nslab - 1; const float* sp = slab + ((size_t)s * 1024 + (r0 - ML)) * 1024;
#pragma unroll
                      for (int j = 0; j < 4; ++j) sv[qq][j] = *(const f32x4*)(sp + NCOL(j)); }
#pragma unroll
                  for (int qq = 0; qq < 4; ++qq) if (s0 + qq < nslab) {
#pragma unroll
                      for (int j = 0; j < 4; ++j) v[0][j] += sv[qq][j]; } }
#pragma unroll
              for (int j = 0; j < 4; ++j) *(f32x4*)(src + NCOL(j)) = v[0][j]; }
          norm_rows<GATES, 1>(F, v, r0, A, Bv, XN, WgT, bgate, GATESb); }
    }
}
#undef NCOL
template <int HD>
__device__ __forceinline__ void qk_head8(const v4u raw, const float (&g)[8], float qs, bool rope, const float (&cs)[8], const float (&sn)[8], int lane, v4u& out) {
    constexpr int LPH = HD / 8;
    float x[8]; unpack8(raw, x);
    float ss = 0.f;
#pragma unroll
    for (int e = 0; e < 8; ++e) ss += x[e] * x[e];
#pragma unroll
    for (int o = 1; o < LPH; o <<= 1) ss += bperm(ss, lane ^ o);
    const float rs = qs * __builtin_amdgcn_rsqf(ss * (1.f / HD) + EPS);
    float y[8], yp[8];
#pragma unroll
    for (int e = 0; e < 8; ++e) y[e] = x[e] * rs * g[e];
#pragma unroll
    for (int e = 0; e < 8; ++e) yp[e] = bperm(y[e], lane ^ (LPH / 2));
    const bool upper = (lane & (LPH / 2)) != 0;
    float o[8];
#pragma unroll
    for (int e = 0; e < 8; ++e) o[e] = rope ? (upper ? y[e] * cs[e] + yp[e] * sn[e] : y[e] * cs[e] - yp[e] * sn[e]) : y[e];
    out = pack8(o);
}
__device__ __forceinline__ void qknorm_rope64(const Frame& F, const bf16* RAW, const float* qn, const float* kn, const float* R64, bf16* Qp, bf16* Kp) {
    const int j = F.lane & 7, hq = F.lane >> 3;
    float gq[8], gk[8];
#pragma unroll
    for (int e = 0; e < 8; ++e) { gq[e] = qn[8 * j + e]; gk[e] = kn[8 * j + e]; }
    v4u rw[3]; f32x4 tw[4];
#define QK64_LOAD(r_) do { const bf16* s_ = RAW + (size_t)(r_) * 1536; _Pragma("unroll") for (int p = 0; p < 3; ++p) { const int hh = 8 * p + hq; if (hh < 20) rw[p] = *(const v4u*)(s_ + hh * 64 + 8 * j); } \
        const int t_ = (r_) & (SEQ - 1), pos_ = (j & 3) < 2 ? (t_ >> 6) : (t_ & 63); const float* tp_ = R64 + ((size_t)pos_ * 16 + 8 * (j & 1)) * 2; \
        _Pragma("unroll") for (int e2 = 0; e2 < 4; ++e2) tw[e2] = *(const f32x4*)(tp_ + 4 * e2); } while (0)
    int r = F.gw;
    if (r < MT) QK64_LOAD(r);
    for (; r < MT; r += F.ngw) {
        const bool rope = r < ML; float cs[8], sn[8];
        v4u cr[3];
#pragma unroll
        for (int p = 0; p < 3; ++p) cr[p] = rw[p];
#pragma unroll
        for (int e2 = 0; e2 < 4; ++e2) { const f32x4 w = rope ? tw[e2] : (f32x4){1.f, 0.f, 1.f, 0.f}; cs[2 * e2] = w.x; sn[2 * e2] = w.y; cs[2 * e2 + 1] = w.z; sn[2 * e2 + 1] = w.w; }
        { const int rn = r + F.ngw < MT ? r + F.ngw : r; QK64_LOAD(rn); }
#pragma unroll
        for (int p = 0; p < 3; ++p) { const int hh = 8 * p + hq;
            if (hh < 20) { const bool isq = hh < 16; v4u o; float g[8];
#pragma unroll
                for (int e = 0; e < 8; ++e) g[e] = isq ? gq[e] : gk[e];
                qk_head8<64>(cr[p], g, isq ? 0.18033688f : 1.f, rope, cs, sn, F.lane, o);
                *(v4u*)((isq ? Qp + (size_t)r * 1024 + hh * 64 : Kp + (size_t)r * 256 + (hh - 16) * 64) + 8 * j) = o; } }
    }
#undef QK64_LOAD
}
__device__ __forceinline__ void knorm_rope64(const Frame& F, const bf16* RAW, const float* kn, const float* R64, bf16* Kp) {
    float one = 1.f; asm volatile("" : "+v"(one));
    const int j = F.lane & 7, hk = (F.lane >> 3) & 3, half = F.lane >> 5;
    float gk[8];
#pragma unroll
    for (int e = 0; e < 8; ++e) gk[e] = kn[8 * j + e];
    v4u rw; f32x4 tw[4];
#define K64_LOAD(r_) do { rw = *(const v4u*)(RAW + (size_t)(r_) * 1536 + 1024 + hk * 64 + 8 * j); \
        const int t_ = (r_) & (SEQ - 1), pos_ = (j & 3) < 2 ? (t_ >> 6) : (t_ & 63); const float* tp_ = R64 + ((size_t)pos_ * 16 + 8 * (j & 1)) * 2; \
        _Pragma("unroll") for (int e2 = 0; e2 < 4; ++e2) tw[e2] = *(const f32x4*)(tp_ + 4 * e2); } while (0)
    int r = 2 * F.gw + half;
    if (r < MT) K64_LOAD(r);
    for (; r < MT; r += 2 * F.ngw) {
        const bool rope = r < ML; float cs[8], sn[8];
        const v4u cr = rw;
#pragma unroll
        for (int e2 = 0; e2 < 4; ++e2) { const f32x4 w = rope ? tw[e2] : (f32x4){one, 0.f, one, 0.f}; cs[2 * e2] = w.x; sn[2 * e2] = w.y; cs[2 * e2 + 1] = w.z; sn[2 * e2 + 1] = w.w; }
        { const int rn = r + 2 * F.ngw < MT ? r + 2 * F.ngw : r; K64_LOAD(rn); }
        v4u o; qk_head8<64>(cr, gk, 1.f, rope, cs, sn, F.lane, o);
        *(v4u*)(Kp + (size_t)r * 256 + hk * 64 + 8 * j) = o;
    }
#undef K64_LOAD
}
template <int HD, typename FR>
__device__ __forceinline__ void qnorm_rope_frag(FR (&qr)[HD / 16], const float* gq, const float* Rt, int t, bool rope, float qs, int lane) {
    constexpr int NB = HD / 16;
    const int hi = lane >> 5;
    float ss = 0.f;
#pragma unroll
    for (int d0 = 0; d0 < NB; ++d0) { float x[8]; unpack8(__builtin_bit_cast(v4u, qr[d0]), x);
#pragma unroll
        for (int e = 0; e < 8; ++e) ss += x[e] * x[e]; }
    ss += bperm(ss, lane ^ 32);
    const float rs = qs * __builtin_amdgcn_rsqf(ss * (1.f / HD) + EPS);
#pragma unroll
    for (int d0 = 0; d0 < NB / 2; ++d0) {
        float lo[8], up[8]; unpack8(__builtin_bit_cast(v4u, qr[d0]), lo); unpack8(__builtin_bit_cast(v4u, qr[d0 + NB / 2]), up);
        const float* gl = gq + d0 * 16 + hi * 8; const float* gu = gl + HD / 2;
        const f32x4 g0 = *(const f32x4*)gl, g1 = *(const f32x4*)(gl + 4), g2 = *(const f32x4*)gu, g3 = *(const f32x4*)(gu + 4);
#pragma unroll
        for (int e = 0; e < 8; ++e) { lo[e] = lo[e] * rs * (e < 4 ? g0[e & 3] : g1[e & 3]); up[e] = up[e] * rs * (e < 4 ? g2[e & 3] : g3[e & 3]); }
        if (rope) {
            const int a0 = d0 * 16 + hi * 8, pos = a0 < HD / 4 ? (t >> 6) : (t & 63), f0 = a0 < HD / 4 ? a0 : a0 - HD / 4;
            const float* tp = Rt + ((size_t)pos * (HD / 4) + f0) * 2;
#pragma unroll
            for (int e2 = 0; e2 < 4; ++e2) { const f32x4 w = *(const f32x4*)(tp + 4 * e2);
                const float l0 = lo[2 * e2], u0 = up[2 * e2], l1 = lo[2 * e2 + 1], u1 = up[2 * e2 + 1];
                lo[2 * e2] = l0 * w.x - u0 * w.y; up[2 * e2] = u0 * w.x + l0 * w.y; lo[2 * e2 + 1] = l1 * w.z - u1 * w.w; up[2 * e2 + 1] = u1 * w.z + l1 * w.w; } }
        qr[d0] = __builtin_bit_cast(FR, pack8(lo)); qr[d0 + NB / 2] = __builtin_bit_cast(FR, pack8(up));
    }
}
__device__ __forceinline__ void qknorm_rope128(const Frame& F, const bf16* RAW, const float* qn, const float* kn, const float* R128, bf16* Qp, bf16* K2, bf16* V2) {
    const int j = F.lane & 15, hq = F.lane >> 4;
    float gq[8], gk[8];
#pragma unroll
    for (int e = 0; e < 8; ++e) { gq[e] = qn[8 * j + e]; gk[e] = kn[8 * j + e]; }
    v4u rw[4]; f32x4 tw[4];
#define QK128_LOAD(r_) do { const bf16* s_ = RAW + (size_t)(r_) * 1536; _Pragma("unroll") for (int p = 0; p < 3; ++p) { const int hh = 4 * p + hq; if (hh < 10) rw[p] = *(const v4u*)(s_ + hh * 128 + 8 * j); } \
        rw[3] = *(const v4u*)(s_ + 1280 + 8 * (F.lane & 31)); \
        const int t_ = (r_) & (SEQ - 1), pos_ = (j & 7) < 4 ? (t_ >> 6) : (t_ & 63); const float* tp_ = R128 + ((size_t)pos_ * 32 + 8 * (j & 3)) * 2; \
        _Pragma("unroll") for (int e2 = 0; e2 < 4; ++e2) tw[e2] = *(const f32x4*)(tp_ + 4 * e2); } while (0)
    int r = F.gw;
    if (r < MT) QK128_LOAD(r);
    for (; r < MT; r += F.ngw) {
        const bool rope = r < ML; float cs[8], sn[8]; size_t kvrow;
        const int t = r & (SEQ - 1);
        if (rope) kvrow = (size_t)(r >> 13) * 8448 + t; else { const int rc = r - ML; kvrow = (size_t)(rc >> 8) * 8448 + 8192 + (rc & 255); }
        v4u cr[4];
#pragma unroll
        for (int p = 0; p < 4; ++p) cr[p] = rw[p];
#pragma unroll
        for (int e2 = 0; e2 < 4; ++e2) { const f32x4 w = rope ? tw[e2] : (f32x4){1.f, 0.f, 1.f, 0.f}; cs[2 * e2] = w.x; sn[2 * e2] = w.y; cs[2 * e2 + 1] = w.z; sn[2 * e2 + 1] = w.w; }
        { const int rn = r + F.ngw < MT ? r + F.ngw : r; QK128_LOAD(rn); }
#pragma unroll
        for (int p = 0; p < 3; ++p) { const int hh = 4 * p + hq;
            if (hh < 10) { const bool isq = hh < 8; v4u o; float g[8];
#pragma unroll
                for (int e = 0; e < 8; ++e) g[e] = isq ? gq[e] : gk[e];
                qk_head8<128>(cr[p], g, isq ? 0.12751743f : 1.f, rope, cs, sn, F.lane, o);
                *(v4u*)((isq ? Qp + (size_t)r * 1024 + hh * 128 : K2 + kvrow * 256 + (hh - 8) * 128) + 8 * j) = o; } }
        if (F.lane < 32) *(v4u*)(V2 + kvrow * 256 + 8 * F.lane) = cr[3];
    }
#undef QK128_LOAD
}
__device__ __forceinline__ void knorm_rope128(const Frame& F, const bf16* RAW, const float* kn, const float* R128, bf16* K2, bf16* V2) {
    float one = 1.f; asm volatile("" : "+v"(one));
    const int j = F.lane & 15, hk = (F.lane >> 4) & 1; const bool isv = F.lane >= 32;
    const int coff = isv ? 1280 + 8 * (F.lane & 31) : 1024 + hk * 128 + 8 * j;
    float gk[8];
#pragma unroll
    for (int e = 0; e < 8; ++e) gk[e] = kn[8 * j + e];
    v4u rw[2]; f32x4 tw[2][4];
#define K128_LOAD(it_) do { _Pragma("unroll") for (int q_ = 0; q_ < 2; ++q_) { const int r_ = 2 * (it_) + q_; rw[q_] = *(const v4u*)(RAW + (size_t)r_ * 1536 + coff); \
        const int t_ = r_ & (SEQ - 1), pos_ = (j & 7) < 4 ? (t_ >> 6) : (t_ & 63); const float* tp_ = R128 + ((size_t)pos_ * 32 + 8 * (j & 3)) * 2; \
        _Pragma("unroll") for (int e2 = 0; e2 < 4; ++e2) tw[q_][e2] = *(const f32x4*)(tp_ + 4 * e2); } } while (0)
    int it = F.gw;
    if (it < MT / 2) K128_LOAD(it);
    for (; it < MT / 2; it += F.ngw) {
        v4u cr[2]; f32x4 ct[2][4];
#pragma unroll
        for (int q = 0; q < 2; ++q) { cr[q] = rw[q];
#pragma unroll
            for (int e2 = 0; e2 < 4; ++e2) ct[q][e2] = tw[q][e2]; }
        { const int itn = it + F.ngw < MT / 2 ? it + F.ngw : it; K128_LOAD(itn); }
#pragma unroll
        for (int q = 0; q < 2; ++q) { const int r = 2 * it + q; const bool rope = r < ML; size_t kvrow;
            if (rope) kvrow = (size_t)(r >> 13) * 8448 + (r & (SEQ - 1)); else { const int rc = r - ML; kvrow = (size_t)(rc >> 8) * 8448 + 8192 + (rc & 255); }
            float cs[8], sn[8];
#pragma unroll
            for (int e2 = 0; e2 < 4; ++e2) { const f32x4 w = rope ? ct[q][e2] : (f32x4){one, 0.f, one, 0.f}; cs[2 * e2] = w.x; sn[2 * e2] = w.y; cs[2 * e2 + 1] = w.z; sn[2 * e2 + 1] = w.w; }
            v4u o; qk_head8<128>(cr[q], gk, 1.f, rope, cs, sn, F.lane, o);
            if (isv) *(v4u*)(V2 + kvrow * 256 + 8 * (F.lane & 31)) = cr[q]; else *(v4u*)(K2 + kvrow * 256 + hk * 128 + 8 * j) = o; }
    }
#undef K128_LOAD
}
__device__ __forceinline__ void sconv_phase(const Frame& F, const bf16* RAW, const float* cw  , bf16* O) {
    const int c0 = (F.tid & 127) * 8, qd = F.tid >> 7;
    f32x4 w[3][2];
#pragma unroll
    for (int j = 0; j < 3; ++j) { w[j][0] = *(const f32x4*)(cw + j * 1024 + c0); w[j][1] = *(const f32x4*)(cw + j * 1024 + c0 + 4); }
    for (int blk = F.gw >> 3; blk < MT / 132; blk += F.G) {
        const int rs = blk * 132 + qd * 33;
        float pm[8], pc[8];
        { const bf16* rp = RAW + (size_t)(rs > 0 ? rs - 1 : 0) * 3072 + c0; float a[8], b[8];
          const v4u x0 = *(const v4u*)(rp + 1024), x1 = *(const v4u*)(rp + 2048); const bf16* rq = RAW + (size_t)rs * 3072 + c0; const v4u y0 = *(const v4u*)(rq + 1024), y1 = *(const v4u*)(rq + 2048);
          unpack8(x0, a); unpack8(x1, b);
#pragma unroll
          for (int e2 = 0; e2 < 8; ++e2) pm[e2] = a[e2] * b[e2];
          unpack8(y0, a); unpack8(y1, b);
#pragma unroll
          for (int e2 = 0; e2 < 8; ++e2) pc[e2] = a[e2] * b[e2]; }
        v4u ngc, nu, ngb;
        { const int rn = rs + 1 < MT ? rs + 1 : rs; const bf16* rp = RAW + (size_t)rn * 3072 + c0; ngc = *(const v4u*)(rp + 1024); nu = *(const v4u*)(rp + 2048); ngb = *(const v4u*)(RAW + (size_t)rs * 3072 + c0); }
#pragma nounroll
        for (int k = 0; k < 33; ++k) {
            const int r = rs + k;
            const v4u cgc = ngc, cu = nu, cgb = ngb;
            { const int r2 = r + 2 < MT ? r + 2 : MT - 1, r1 = r + 1 < MT ? r + 1 : MT - 1;
              const bf16* rp = RAW + (size_t)r2 * 3072 + c0; ngc = *(const v4u*)(rp + 1024); nu = *(const v4u*)(rp + 2048); ngb = *(const v4u*)(RAW + (size_t)r1 * 3072 + c0); }
            const int tl = r < ML ? (r & (SEQ - 1)) : ((r - ML) & (CTXL - 1)), len = r < ML ? SEQ : CTXL;
            const float mp = tl > 0 ? 1.f : 0.f, mn = tl < len - 1 ? 1.f : 0.f;
            float a[8], b[8], pn[8], gb[8], z[8];
            unpack8(cgc, a); unpack8(cu, b); unpack8(cgb, gb);
#pragma unroll
            for (int e2 = 0; e2 < 8; ++e2) pn[e2] = a[e2] * b[e2];
#pragma unroll
            for (int e2 = 0; e2 < 8; ++e2) { const float w0 = w[0][e2 >> 2][e2 & 3] * mp, w1 = w[1][e2 >> 2][e2 & 3], w2 = w[2][e2 >> 2][e2 & 3] * mn;
                z[e2] = gb[e2] * (w0 * pm[e2] + w1 * pc[e2] + w2 * pn[e2]); pm[e2] = pc[e2]; pc[e2] = pn[e2]; }
            *(v4u*)(O + (size_t)r * 1024 + c0) = pack8(z);
        }
    }
}
__device__ __forceinline__ void ffn_fixup(const Frame& F, int tile, const float* HALO, const float* cw  , bf16* ACT) {
    const bool has_prev = tile < 128 && (tile & 31) != 0, has_next = tile < 128 && (tile & 31) != 31;
    for (int i = F.tid; i < 2 * (DFF / 4); i += 512) {
        const int which = i >= DFF / 4 ? 1 : 0, c = 4 * (i - which * (DFF / 4));
        const float* hm = HALO + ((size_t)tile * 4 + (which ? 2 : -1)) * NUP;
        const float* h0 = HALO + ((size_t)tile * 4 + (which ? 3 : 0)) * NUP;
        const float* hp = HALO + ((size_t)tile * 4 + (which ? 4 : 1)) * NUP;
        const bool vm = which ? true : has_prev, vp = which ? has_next : true;
        const f32x4 z4 = {0.f, 0.f, 0.f, 0.f};
        const f32x4 gm = vm ? *(const f32x4*)(hm + c) : z4, um = vm ? *(const f32x4*)(hm + DFF + c) : z4, gp = vp ? *(const f32x4*)(hp + c) : z4, up = vp ? *(const f32x4*)(hp + DFF + c) : z4;
        const f32x4 g0 = *(const f32x4*)(h0 + c), u0 = *(const f32x4*)(h0 + DFF + c);
        const f32x4 wg0 = *(const f32x4*)(cw + c), wg1 = *(const f32x4*)(cw + NUP + c), wg2 = *(const f32x4*)(cw + 2 * NUP + c);
        const f32x4 wu0 = *(const f32x4*)(cw + DFF + c), wu1 = *(const f32x4*)(cw + NUP + DFF + c), wu2 = *(const f32x4*)(cw + 2 * NUP + DFF + c);
        float a[4];
#pragma unroll
        for (int e2 = 0; e2 < 4; ++e2) { const float g = wg0[e2] * gm[e2] + wg1[e2] * g0[e2] + wg2[e2] * gp[e2], u = wu0[e2] * um[e2] + wu1[e2] * u0[e2] + wu2[e2] * up[e2];
            a[e2] = g / (1.f + expf(-g)) * u; }
        uint2 o; o.x = cvtpk2(a[0], a[1]); o.y = cvtpk2(a[2], a[3]);
        *(uint2*)(ACT + ((size_t)tile * 256 + (which ? 255 : 0)) * DFF + c) = o;
    }
}

namespace exd {
typedef unsigned short bf16;
constexpr int   D = 128, NW = 8, QBLK = 32, KVBLK = 64;
constexpr float SCALE = 0.6931471805599453f;
constexpr float THR = 8.f;
constexpr int SDEPTH = 1;
constexpr int LDQ = 1024, LDK = 256, LDO = 1024;
constexpr size_t SHM_V = KVBLK * D * 2, SHM_K = KVBLK * D * 2, SHM_ATTN = 2 * SHM_V + 2 * SHM_K + NW * 64 * 4;
using bf16x8 = __attribute__((ext_vector_type(8))) short;
using s16x4  = __attribute__((ext_vector_type(4))) short;
using f32x16 = __attribute__((ext_vector_type(16))) float;
using f32x8  = __attribute__((ext_vector_type(8))) float;
using u32x4  = __attribute__((ext_vector_type(4))) unsigned;
#define KSWZ(row, colB) ((row) * 256 + ((colB) ^ (((row) & 7) << 4)))
#define SBAR() __builtin_amdgcn_sched_barrier(0)
__device__ __forceinline__ int crow(int r, int hi) { return (r & 3) + 8 * (r >> 2) + 4 * hi; }
__device__ __forceinline__ unsigned cvtpk(float lo, float hi) {
  unsigned r; asm volatile("v_cvt_pk_bf16_f32 %0, %1, %2" : "=v"(r) : "v"(lo), "v"(hi)); return r;
}
template <typename TIn> struct Stage;
template <> struct Stage<bf16>  { using T = bf16x8;
  __device__ static __forceinline__ T ld8(const bf16* p) { return *reinterpret_cast<const bf16x8*>(p); }
  __device__ static __forceinline__ bf16x8 tobf(T x) { return x; } };
template <> struct Stage<float> { using T = f32x8;
  __device__ static __forceinline__ T ld8(const float* p) { return *reinterpret_cast<const f32x8*>(p); }
  __device__ static __forceinline__ bf16x8 tobf(T x) {
    u32x4 w = {cvtpk(x[0], x[1]), cvtpk(x[2], x[3]), cvtpk(x[4], x[5]), cvtpk(x[6], x[7])}; return *reinterpret_cast<bf16x8*>(&w); } };

__device__ __forceinline__ void partialSM(f32x16& p0, f32x16& p1, float& m_reg, float& mn, float& alpha) {
  constexpr float C = SCALE * 1.4426950408889634f;
  float pmax = p0[0]; for (int r = 1; r < 16; ++r) pmax = fmaxf(pmax, p0[r]); for (int r = 0; r < 16; ++r) pmax = fmaxf(pmax, p1[r]);
  { auto rr = __builtin_amdgcn_permlane32_swap(__float_as_uint(pmax), __float_as_uint(pmax), false, false);
    pmax = fmaxf(__uint_as_float(rr[0]), __uint_as_float(rr[1])); }
  if (__builtin_expect(__all(pmax - m_reg <= THR / SCALE), 1)) { mn = m_reg; alpha = 1.f; }
  else { mn = fmaxf(m_reg, pmax); alpha = __builtin_amdgcn_exp2f((m_reg - mn) * C); m_reg = mn; }
  float mnC = -mn * C;
  for (int r = 0; r < 16; ++r) p0[r] = fmaf(p0[r], C, mnC); for (int r = 0; r < 16; ++r) p1[r] = fmaf(p1[r], C, mnC);
  for (int r = 0; r < 16; ++r) p0[r] = __builtin_amdgcn_exp2f(p0[r]);
}
__device__ __forceinline__ void finishSM(f32x16& p0, f32x16& p1, float alpha, float& l_reg, bf16x8& pa0, bf16x8& pa1, bf16x8& pa2, bf16x8& pa3) {
  for (int r = 0; r < 16; ++r) p1[r] = __builtin_amdgcn_exp2f(p1[r]);
  float ps = 0; for (int r = 0; r < 16; ++r) ps += p0[r]; for (int r = 0; r < 16; ++r) ps += p1[r];
  { auto rr = __builtin_amdgcn_permlane32_swap(__float_as_uint(ps), __float_as_uint(ps), false, false);
    ps = __uint_as_float(rr[0]) + __uint_as_float(rr[1]); }
  l_reg = l_reg * alpha + ps;
#define PK4(P, BASE, OUT) do { unsigned a0 = cvtpk(P[BASE + 0], P[BASE + 1]), a1 = cvtpk(P[BASE + 2], P[BASE + 3]);   \
    unsigned b0 = cvtpk(P[BASE + 4], P[BASE + 5]), b1 = cvtpk(P[BASE + 6], P[BASE + 7]);                              \
    auto r0 = __builtin_amdgcn_permlane32_swap(a0, b0, false, false); auto r1 = __builtin_amdgcn_permlane32_swap(a1, b1, false, false); \
    u32x4 w = {r0[0], r1[0], r0[1], r1[1]}; OUT = *reinterpret_cast<bf16x8*>(&w); } while (0)
  PK4(p0, 0, pa0); PK4(p0, 8, pa1); PK4(p1, 0, pa2); PK4(p1, 8, pa3);
#undef PK4
}
__device__ __forceinline__ void qkt(f32x16& p0, f32x16& p1, const bf16* Ks, const bf16x8* qr, int r32, int hi) {
  p0 = f32x16{}; p1 = f32x16{};
  for (int d0 = 0; d0 < 8; ++d0) { int cb = (d0 * 16 + hi * 8) * 2;
    bf16x8 b0 = *reinterpret_cast<const bf16x8*>((const char*)Ks + KSWZ(r32, cb));
    bf16x8 b1 = *reinterpret_cast<const bf16x8*>((const char*)Ks + KSWZ(32 + r32, cb));
    p0 = __builtin_amdgcn_mfma_f32_32x32x16_bf16(b0, qr[d0], p0, 0, 0, 0);
    p1 = __builtin_amdgcn_mfma_f32_32x32x16_bf16(b1, qr[d0], p1, 0, 0, 0); }
}
__device__ __forceinline__ int v_st(int k, int c) { const int kk = (k & ~0xC) | ((k & 4) << 1) | ((k & 8) >> 1); return ((kk >> 3) * 4 + (c >> 5)) * 512 + ((kk & 7) * 32 + (c & 31)) * 2; }
__device__ __forceinline__ int v_rd_base(int lane) { return ((lane & 3) << 3) | (((lane >> 2) & 3) << 6) | (((lane >> 4) & 1) << 5) | (((lane >> 5) & 1) << 8); }
constexpr int v_rd_off(int d0, int ks, int half) { return d0 * 512 + ks * 4096 + half * 2048; }
template <int OFF> __device__ __forceinline__ s16x4 tr_read(int vb) {
  s16x4 r; asm volatile("ds_read_b64_tr_b16 %0, %1 offset:%2" : "=&v"(r) : "v"(vb), "i"(OFF) : "memory"); return r;
}
template <int D0> __device__ __forceinline__ void pv_one(f32x16& od, int vb, bf16x8 pa0, bf16x8 pa1, bf16x8 pa2, bf16x8 pa3) {
  const s16x4 l0 = tr_read<v_rd_off(D0, 0, 0)>(vb), h0 = tr_read<v_rd_off(D0, 0, 1)>(vb), l1 = tr_read<v_rd_off(D0, 1, 0)>(vb), h1 = tr_read<v_rd_off(D0, 1, 1)>(vb);
  const s16x4 l2 = tr_read<v_rd_off(D0, 2, 0)>(vb), h2 = tr_read<v_rd_off(D0, 2, 1)>(vb), l3 = tr_read<v_rd_off(D0, 3, 0)>(vb), h3 = tr_read<v_rd_off(D0, 3, 1)>(vb);
  asm volatile("s_waitcnt lgkmcnt(0)" ::: "memory"); SBAR();
#define PK(L, H) (bf16x8){L[0], L[1], L[2], L[3], H[0], H[1], H[2], H[3]}
  od = __builtin_amdgcn_mfma_f32_32x32x16_bf16(pa0, PK(l0, h0), od, 0, 0, 0);
  od = __builtin_amdgcn_mfma_f32_32x32x16_bf16(pa1, PK(l1, h1), od, 0, 0, 0);
  od = __builtin_amdgcn_mfma_f32_32x32x16_bf16(pa2, PK(l2, h2), od, 0, 0, 0);
  od = __builtin_amdgcn_mfma_f32_32x32x16_bf16(pa3, PK(l3, h3), od, 0, 0, 0);
#undef PK
}
__device__ __forceinline__ void pv_d0(f32x16* o, int vb, bf16x8 pa0, bf16x8 pa1, bf16x8 pa2, bf16x8 pa3) {
  pv_one<0>(o[0], vb, pa0, pa1, pa2, pa3); pv_one<1>(o[1], vb, pa0, pa1, pa2, pa3); pv_one<2>(o[2], vb, pa0, pa1, pa2, pa3); pv_one<3>(o[3], vb, pa0, pa1, pa2, pa3);
}

template <typename TQ>
__device__ __forceinline__ void attn_dense_body(const TQ* __restrict__ Qb, const bf16* __restrict__ Kh, const bf16* __restrict__ Vh,
                                                bf16* __restrict__ Ob, int seq, char* lds, const int tid) {
  using St = Stage<bf16>; using SQ = Stage<TQ>;
  const int wid = tid >> 6, lane = tid & 63, r32 = lane & 31, hi = lane >> 5;
  bf16* V_lds = (bf16*)lds; bf16* K_lds = (bf16*)(lds + 2 * SHM_V);
  float* ws = (float*)(lds + 2 * SHM_V + 2 * SHM_K) + wid * 64; float* li_l = ws; float* al_l = ws + 32;
  float m_reg = -1e30f, l_reg = 0; f32x16 o[4] = {}; bf16x8 qr[8];
  const TQ* Qw = Qb + (long)(wid * QBLK + r32) * LDQ + hi * 8;
#pragma unroll
  for (int d0 = 0; d0 < 8; ++d0) qr[d0] = SQ::tobf(SQ::ld8(Qw + d0 * 16));
  const int sr = tid >> 4, sc = (tid & 15) * 8, vst0 = v_st(sr, sc), vst1 = v_st(32 + sr, sc);
  const int vb0 = (int)(uintptr_t)V_lds + v_rd_base(lane);
  struct { typename St::T vs0, vs1, ks0, ks1; } sr_[SDEPTH];
  const unsigned lo0 = (unsigned)(sr * LDK + sc) * 2u, lo1 = lo0 + 32u * LDK * 2u;
#define SLOAD(i, k0) do { const char* vt_ = (const char*)Vh + (size_t)(k0) * (LDK * 2); const char* kt_ = (const char*)Kh + (size_t)(k0) * (LDK * 2); \
    sr_[i].vs0 = *reinterpret_cast<const bf16x8*>(vt_ + lo0); sr_[i].vs1 = *reinterpret_cast<const bf16x8*>(vt_ + lo1); \
    sr_[i].ks0 = *reinterpret_cast<const bf16x8*>(kt_ + lo0); sr_[i].ks1 = *reinterpret_cast<const bf16x8*>(kt_ + lo1); } while (0)
#define SWRITE(b, i) do { *(bf16x8*)((char*)V_lds + (b) * SHM_V + vst0) = St::tobf(sr_[i].vs0);          \
    *(bf16x8*)((char*)V_lds + (b) * SHM_V + vst1) = St::tobf(sr_[i].vs1); int kc = sc * 2;               \
    *(bf16x8*)((char*)K_lds + (b) * SHM_K + KSWZ(sr, kc)) = St::tobf(sr_[i].ks0);                       \
    *(bf16x8*)((char*)K_lds + (b) * SHM_K + KSWZ(32 + sr, kc)) = St::tobf(sr_[i].ks1); } while (0)
#define SWAIT() do { if constexpr (SDEPTH == 2) asm volatile("s_waitcnt vmcnt(4)" ::: "memory"); else asm volatile("s_waitcnt vmcnt(0)" ::: "memory"); } while (0)
#define RESC(a) do { if (__any((a) < 1.f)) { if (hi == 0) al_l[r32] = (a); asm volatile("s_waitcnt lgkmcnt(0)" ::: "memory"); \
    for (int d = 0; d < 4; ++d) for (int r = 0; r < 16; ++r) o[d][r] *= al_l[crow(r, hi)]; } } while (0)
  f32x16 pA0, pA1, pB0, pB1; float mnA, mnB, alA, alB; bf16x8 pa0, pa1, pa2, pa3; const int NT = seq / KVBLK;
  constexpr int SE = 0, SO = SDEPTH - 1;
  SLOAD(SE, 0); asm volatile("s_waitcnt vmcnt(0)" ::: "memory"); SWRITE(0, SE); __syncthreads();
  qkt(pA0, pA1, K_lds, qr, r32, hi); partialSM(pA0, pA1, m_reg, mnA, alA);
  SLOAD(SO, KVBLK); if constexpr (SDEPTH == 2) { if (2 < NT) SLOAD(SE, 2 * KVBLK); }
  SWAIT(); SWRITE(1, SO); __syncthreads();
  for (int j = 1; j + 1 < NT; j += 2) {
    SBAR(); qkt(pB0, pB1, (bf16*)((char*)K_lds + SHM_K), qr, r32, hi);
    finishSM(pA0, pA1, alA, l_reg, pa0, pa1, pa2, pa3); SBAR();
    SLOAD(SO, (j + SDEPTH) * KVBLK); SBAR();
    pv_d0(o, vb0, pa0, pa1, pa2, pa3); partialSM(pB0, pB1, m_reg, mnB, alB);
    __syncthreads(); SWAIT(); SWRITE(0, SE);
    RESC(alB); __syncthreads();
    SBAR(); qkt(pA0, pA1, K_lds, qr, r32, hi);
    finishSM(pB0, pB1, alB, l_reg, pa0, pa1, pa2, pa3); SBAR();
    if (SDEPTH == 1 || j + 3 < NT) SLOAD(SE, (j + 1 + SDEPTH) * KVBLK); SBAR();
    pv_d0(o, vb0 + (int)SHM_V, pa0, pa1, pa2, pa3); partialSM(pA0, pA1, m_reg, mnA, alA);
    __syncthreads(); SWAIT(); SWRITE(1, SO);
    RESC(alA); __syncthreads();
  }
  SBAR(); qkt(pB0, pB1, (bf16*)((char*)K_lds + SHM_K), qr, r32, hi);
  finishSM(pA0, pA1, alA, l_reg, pa0, pa1, pa2, pa3); SBAR();
  pv_d0(o, vb0, pa0, pa1, pa2, pa3); partialSM(pB0, pB1, m_reg, mnB, alB);
  __syncthreads(); RESC(alB);
  finishSM(pB0, pB1, alB, l_reg, pa0, pa1, pa2, pa3); SBAR();
  pv_d0(o, vb0 + (int)SHM_V, pa0, pa1, pa2, pa3);
  if (hi == 0) li_l[r32] = l_reg; asm volatile("s_waitcnt lgkmcnt(0)" ::: "memory");
  float rli[16];
#pragma unroll
  for (int r = 0; r < 16; ++r) rli[r] = __builtin_amdgcn_rcpf(li_l[crow(r, hi)]);
  bf16* Ow = Ob + (long)(wid * QBLK) * LDO;
#pragma unroll
  for (int r = 0; r < 16; ++r) { int orow = crow(r, hi);
    for (int d0 = 0; d0 < 4; ++d0) Ow[(long)orow * LDO + d0 * 32 + r32] = (bf16)(cvtpk(o[d0][r] * rli[r], 0.f) & 0xffffu); }
#undef SLOAD
#undef SWRITE
#undef SWAIT
#undef RESC
}
#undef KSWZ
#undef SBAR
}

namespace exf {
typedef unsigned short bf16;
constexpr int   D = 128, NW = 8, QBLK = 32, KVBLK = 64;
constexpr float SCALE = 0.6931471805599453f;
constexpr float THR = 8.f;
constexpr int SDEPTH = 1;
constexpr int LDQ = 1536, LDK = 256, LDO = 1024;
constexpr size_t SHM_V = KVBLK * D * 2, SHM_K = KVBLK * D * 2, SHM_ATTN = 2 * SHM_V + 2 * SHM_K + NW * 64 * 4;
using bf16x8 = __attribute__((ext_vector_type(8))) short;
using s16x4  = __attribute__((ext_vector_type(4))) short;
using f32x16 = __attribute__((ext_vector_type(16))) float;
using f32x8  = __attribute__((ext_vector_type(8))) float;
using u32x4  = __attribute__((ext_vector_type(4))) unsigned;
#define KSWZ(row, colB) ((row) * 256 + ((colB) ^ (((row) & 7) << 4)))
#define SBAR() __builtin_amdgcn_sched_barrier(0)
__device__ __forceinline__ int crow(int r, int hi) { return (r & 3) + 8 * (r >> 2) + 4 * hi; }
__device__ __forceinline__ unsigned cvtpk(float lo, float hi) {
  unsigned r; asm volatile("v_cvt_pk_bf16_f32 %0, %1, %2" : "=v"(r) : "v"(lo), "v"(hi)); return r;
}
template <typename TIn> struct Stage;
template <> struct Stage<bf16>  { using T = bf16x8;
  __device__ static __forceinline__ T ld8(const bf16* p) { return *reinterpret_cast<const bf16x8*>(p); }
  __device__ static __forceinline__ bf16x8 tobf(T x) { return x; } };
template <> struct Stage<float> { using T = f32x8;
  __device__ static __forceinline__ T ld8(const float* p) { return *reinterpret_cast<const f32x8*>(p); }
  __device__ static __forceinline__ bf16x8 tobf(T x) {
    u32x4 w = {cvtpk(x[0], x[1]), cvtpk(x[2], x[3]), cvtpk(x[4], x[5]), cvtpk(x[6], x[7])}; return *reinterpret_cast<bf16x8*>(&w); } };

__device__ __forceinline__ void partialSM(f32x16& p0, f32x16& p1, float& m_reg, float& mn, float& alpha) {
  mn = 0.f; alpha = 1.f;
  for (int r = 0; r < 16; ++r) p0[r] = __builtin_amdgcn_exp2f(p0[r]);
}
__device__ __forceinline__ void finishSM(f32x16& p0, f32x16& p1, float alpha, float& l_reg, bf16x8& pa0, bf16x8& pa1, bf16x8& pa2, bf16x8& pa3) {
  for (int r = 0; r < 16; ++r) p1[r] = __builtin_amdgcn_exp2f(p1[r]);
  float ps = 0; for (int r = 0; r < 16; ++r) ps += p0[r]; for (int r = 0; r < 16; ++r) ps += p1[r];
  { auto rr = __builtin_amdgcn_permlane32_swap(__float_as_uint(ps), __float_as_uint(ps), false, false);
    ps = __uint_as_float(rr[0]) + __uint_as_float(rr[1]); }
  l_reg = l_reg * alpha + ps;
#define PK4(P, BASE, OUT) do { unsigned a0 = cvtpk(P[BASE + 0], P[BASE + 1]), a1 = cvtpk(P[BASE + 2], P[BASE + 3]);   \
    unsigned b0 = cvtpk(P[BASE + 4], P[BASE + 5]), b1 = cvtpk(P[BASE + 6], P[BASE + 7]);                              \
    auto r0 = __builtin_amdgcn_permlane32_swap(a0, b0, false, false); auto r1 = __builtin_amdgcn_permlane32_swap(a1, b1, false, false); \
    u32x4 w = {r0[0], r1[0], r0[1], r1[1]}; OUT = *reinterpret_cast<bf16x8*>(&w); } while (0)
  PK4(p0, 0, pa0); PK4(p0, 8, pa1); PK4(p1, 0, pa2); PK4(p1, 8, pa3);
#undef PK4
}
__device__ __forceinline__ void qkt(f32x16& p0, f32x16& p1, const bf16* Ks, const bf16x8* qr, int r32, int hi) {
  p0 = f32x16{}; p1 = f32x16{};
  for (int d0 = 0; d0 < 8; ++d0) { int cb = (d0 * 16 + hi * 8) * 2;
    bf16x8 b0 = *reinterpret_cast<const bf16x8*>((const char*)Ks + KSWZ(r32, cb));
    bf16x8 b1 = *reinterpret_cast<const bf16x8*>((const char*)Ks + KSWZ(32 + r32, cb));
    p0 = __builtin_amdgcn_mfma_f32_32x32x16_bf16(b0, qr[d0], p0, 0, 0, 0);
    p1 = __builtin_amdgcn_mfma_f32_32x32x16_bf16(b1, qr[d0], p1, 0, 0, 0); }
}
__device__ __forceinline__ int v_st(int k, int c) { const int kk = (k & ~0xC) | ((k & 4) << 1) | ((k & 8) >> 1); return ((kk >> 3) * 4 + (c >> 5)) * 512 + ((kk & 7) * 32 + (c & 31)) * 2; }
__device__ __forceinline__ int v_rd_base(int lane) { return ((lane & 3) << 3) | (((lane >> 2) & 3) << 6) | (((lane >> 4) & 1) << 5) | (((lane >> 5) & 1) << 8); }
constexpr int v_rd_off(int d0, int ks, int half) { return d0 * 512 + ks * 4096 + half * 2048; }
template <int OFF> __device__ __forceinline__ s16x4 tr_read(int vb) {
  s16x4 r; asm volatile("ds_read_b64_tr_b16 %0, %1 offset:%2" : "=&v"(r) : "v"(vb), "i"(OFF) : "memory"); return r;
}
template <int D0> __device__ __forceinline__ void pv_one(f32x16& od, int vb, bf16x8 pa0, bf16x8 pa1, bf16x8 pa2, bf16x8 pa3) {
  const s16x4 l0 = tr_read<v_rd_off(D0, 0, 0)>(vb), h0 = tr_read<v_rd_off(D0, 0, 1)>(vb), l1 = tr_read<v_rd_off(D0, 1, 0)>(vb), h1 = tr_read<v_rd_off(D0, 1, 1)>(vb);
  const s16x4 l2 = tr_read<v_rd_off(D0, 2, 0)>(vb), h2 = tr_read<v_rd_off(D0, 2, 1)>(vb), l3 = tr_read<v_rd_off(D0, 3, 0)>(vb), h3 = tr_read<v_rd_off(D0, 3, 1)>(vb);
  asm volatile("s_waitcnt lgkmcnt(0)" ::: "memory"); SBAR();
#define PK(L, H) (bf16x8){L[0], L[1], L[2], L[3], H[0], H[1], H[2], H[3]}
  od = __builtin_amdgcn_mfma_f32_32x32x16_bf16(pa0, PK(l0, h0), od, 0, 0, 0);
  od = __builtin_amdgcn_mfma_f32_32x32x16_bf16(pa1, PK(l1, h1), od, 0, 0, 0);
  od = __builtin_amdgcn_mfma_f32_32x32x16_bf16(pa2, PK(l2, h2), od, 0, 0, 0);
  od = __builtin_amdgcn_mfma_f32_32x32x16_bf16(pa3, PK(l3, h3), od, 0, 0, 0);
#undef PK
}
__device__ __forceinline__ void pv_d0(f32x16* o, int vb, bf16x8 pa0, bf16x8 pa1, bf16x8 pa2, bf16x8 pa3) {
  pv_one<0>(o[0], vb, pa0, pa1, pa2, pa3); pv_one<1>(o[1], vb, pa0, pa1, pa2, pa3); pv_one<2>(o[2], vb, pa0, pa1, pa2, pa3); pv_one<3>(o[3], vb, pa0, pa1, pa2, pa3);
}

template <typename TQ>
__device__ __forceinline__ void attn_dense_body(const TQ* __restrict__ Qb, const bf16* __restrict__ Kh, const bf16* __restrict__ Vh,
                                                bf16* __restrict__ Ob, int seq, char* lds, const int tid, const float* gq, const float* R128, int t0, bool rope) {
  using St = Stage<bf16>; using SQ = Stage<TQ>;
  const int wid = tid >> 6, lane = tid & 63, r32 = lane & 31, hi = lane >> 5;
  bf16* V_lds = (bf16*)lds; bf16* K_lds = (bf16*)(lds + 2 * SHM_V);
  float* ws = (float*)(lds + 2 * SHM_V + 2 * SHM_K) + wid * 64; float* li_l = ws; float* al_l = ws + 32;
  float m_reg = -1e30f, l_reg = 0; f32x16 o[4] = {}; bf16x8 qr[8];
  const TQ* Qw = Qb + (long)(wid * QBLK + r32) * LDQ + hi * 8;
#pragma unroll
  for (int d0 = 0; d0 < 8; ++d0) qr[d0] = SQ::tobf(SQ::ld8(Qw + d0 * 16));
  qnorm_rope_frag<128>(qr, gq, R128, t0 + wid * QBLK + r32, rope, 0.12751743f, lane);
  const int sr = tid >> 4, sc = (tid & 15) * 8, vst0 = v_st(sr, sc), vst1 = v_st(32 + sr, sc);
  const int vb0 = (int)(uintptr_t)V_lds + v_rd_base(lane);
  struct { typename St::T vs0, vs1, ks0, ks1; } sr_[SDEPTH];
  const unsigned lo0 = (unsigned)(sr * LDK + sc) * 2u, lo1 = lo0 + 32u * LDK * 2u;
#define SLOAD(i, k0) do { const char* vt_ = (const char*)Vh + (size_t)(k0) * (LDK * 2); const char* kt_ = (const char*)Kh + (size_t)(k0) * (LDK * 2); \
    sr_[i].vs0 = *reinterpret_cast<const bf16x8*>(vt_ + lo0); sr_[i].vs1 = *reinterpret_cast<const bf16x8*>(vt_ + lo1); \
    sr_[i].ks0 = *reinterpret_cast<const bf16x8*>(kt_ + lo0); sr_[i].ks1 = *reinterpret_cast<const bf16x8*>(kt_ + lo1); } while (0)
#define SWRITE(b, i) do { *(bf16x8*)((char*)V_lds + (b) * SHM_V + vst0) = St::tobf(sr_[i].vs0);          \
    *(bf16x8*)((char*)V_lds + (b) * SHM_V + vst1) = St::tobf(sr_[i].vs1); int kc = sc * 2;               \
    *(bf16x8*)((char*)K_lds + (b) * SHM_K + KSWZ(sr, kc)) = St::tobf(sr_[i].ks0);                       \
    *(bf16x8*)((char*)K_lds + (b) * SHM_K + KSWZ(32 + sr, kc)) = St::tobf(sr_[i].ks1); } while (0)
#define SWAIT() do { if constexpr (SDEPTH == 2) asm volatile("s_waitcnt vmcnt(4)" ::: "memory"); else asm volatile("s_waitcnt vmcnt(0)" ::: "memory"); } while (0)
#define RESC(a) do { } while (0)
  f32x16 pA0, pA1, pB0, pB1; float mnA, mnB, alA, alB; bf16x8 pa0, pa1, pa2, pa3; const int NT = seq / KVBLK;
  constexpr int SE = 0, SO = SDEPTH - 1;
  SLOAD(SE, 0); asm volatile("s_waitcnt vmcnt(0)" ::: "memory"); SWRITE(0, SE); __syncthreads();
  qkt(pA0, pA1, K_lds, qr, r32, hi); partialSM(pA0, pA1, m_reg, mnA, alA);
  SLOAD(SO, KVBLK); if constexpr (SDEPTH == 2) { if (2 < NT) SLOAD(SE, 2 * KVBLK); }
  SWAIT(); SWRITE(1, SO); __syncthreads();
  for (int j = 1; j + 1 < NT; j += 2) {
    SBAR(); qkt(pB0, pB1, (bf16*)((char*)K_lds + SHM_K), qr, r32, hi);
    finishSM(pA0, pA1, alA, l_reg, pa0, pa1, pa2, pa3); SBAR();
    SLOAD(SO, (j + SDEPTH) * KVBLK); SBAR();
    pv_d0(o, vb0, pa0, pa1, pa2, pa3); partialSM(pB0, pB1, m_reg, mnB, alB);
    __syncthreads(); SWAIT(); SWRITE(0, SE);
    RESC(alB); __syncthreads();
    SBAR(); qkt(pA0, pA1, K_lds, qr, r32, hi);
    finishSM(pB0, pB1, alB, l_reg, pa0, pa1, pa2, pa3); SBAR();
    if (SDEPTH == 1 || j + 3 < NT) SLOAD(SE, (j + 1 + SDEPTH) * KVBLK); SBAR();
    pv_d0(o, vb0 + (int)SHM_V, pa0, pa1, pa2, pa3); partialSM(pA0, pA1, m_reg, mnA, alA);
    __syncthreads(); SWAIT(); SWRITE(1, SO);
    RESC(alA); __syncthreads();
  }
  SBAR(); qkt(pB0, pB1, (bf16*)((char*)K_lds + SHM_K), qr, r32, hi);
  finishSM(pA0, pA1, alA, l_reg, pa0, pa1, pa2, pa3); SBAR();
  pv_d0(o, vb0, pa0, pa1, pa2, pa3); partialSM(pB0, pB1, m_reg, mnB, alB);
  __syncthreads(); RESC(alB);
  finishSM(pB0, pB1, alB, l_reg, pa0, pa1, pa2, pa3); SBAR();
  pv_d0(o, vb0 + (int)SHM_V, pa0, pa1, pa2, pa3);
  if (hi == 0) li_l[r32] = l_reg; asm volatile("s_waitcnt lgkmcnt(0)" ::: "memory");
  float rli[16];
#pragma unroll
  for (int r = 0; r < 16; ++r) rli[r] = __builtin_amdgcn_rcpf(li_l[crow(r, hi)]);
  bf16* Ow = Ob + (long)(wid * QBLK) * LDO;
#pragma unroll
  for (int r = 0; r < 16; ++r) { int orow = crow(r, hi);
    for (int d0 = 0; d0 < 4; ++d0) Ow[(long)orow * LDO + d0 * 32 + r32] = (bf16)(cvtpk(o[d0][r] * rli[r], 0.f) & 0xffffu); }
#undef SLOAD
#undef SWRITE
#undef SWAIT
#undef RESC
}
#undef KSWZ
#undef SBAR
#undef KSWZ
#undef SBAR
}


namespace att {
typedef short bf16x8 __attribute__((ext_vector_type(8)));
typedef short s16x4 __attribute__((ext_vector_type(4)));
typedef float f32x16 __attribute__((ext_vector_type(16)));
typedef unsigned u32x4 __attribute__((ext_vector_type(4)));
#define SBAR() __builtin_amdgcn_sched_barrier(0)
__device__ __forceinline__ int crow(int r, int hi) { return (r & 3) + 8 * (r >> 2) + 4 * hi; }
__device__ __forceinline__ unsigned cvtpk(float lo, float hi) { unsigned r; asm volatile("v_cvt_pk_bf16_f32 %0, %1, %2" : "=v"(r) : "v"(lo), "v"(hi)); return r; }
__device__ __forceinline__ int lds_addr(const LAS void* p) { return (int)(unsigned)(unsigned long long)p; }
template <int D> __device__ __forceinline__ int kswz(int row, int colB) { return row * (2 * D) + (colB ^ ((row & 7) << 4)); }
__device__ __forceinline__ void partialSM(f32x16& p0, f32x16& p1, float& m_reg, float& mn, float& alpha, const float C, const float THRS) {
  float pmax = p0[0];
#pragma unroll
  for (int r = 1; r < 16; ++r) pmax = fmaxf(pmax, p0[r]);
#pragma unroll
  for (int r = 0; r < 16; ++r) pmax = fmaxf(pmax, p1[r]);
  { auto rr = __builtin_amdgcn_permlane32_swap(__float_as_uint(pmax), __float_as_uint(pmax), false, false);
    pmax = fmaxf(__uint_as_float(rr[0]), __uint_as_float(rr[1])); }
  if (__builtin_expect(__all(pmax - m_reg <= THRS), 1)) { mn = m_reg; alpha = 1.f; }
  else { mn = fmaxf(m_reg, pmax); alpha = __builtin_amdgcn_exp2f((m_reg - mn) * C); m_reg = mn; }
  const float mnC = -mn * C;
#pragma unroll
  for (int r = 0; r < 16; ++r) p0[r] = fmaf(p0[r], C, mnC);
#pragma unroll
  for (int r = 0; r < 16; ++r) p1[r] = fmaf(p1[r], C, mnC);
#pragma unroll
  for (int r = 0; r < 16; ++r) p0[r] = __builtin_amdgcn_exp2f(p0[r]);
}
__device__ __forceinline__ void pack_p(const f32x16& p0, const f32x16& p1, bf16x8& pa0, bf16x8& pa1, bf16x8& pa2, bf16x8& pa3) {
#define PK4(P, BASE, OUT) do { unsigned a0 = cvtpk(P[BASE + 0], P[BASE + 1]), a1 = cvtpk(P[BASE + 2], P[BASE + 3]);   \
    unsigned b0 = cvtpk(P[BASE + 4], P[BASE + 5]), b1 = cvtpk(P[BASE + 6], P[BASE + 7]);                              \
    auto r0 = __builtin_amdgcn_permlane32_swap(a0, b0, false, false); auto r1 = __builtin_amdgcn_permlane32_swap(a1, b1, false, false); \
    u32x4 w = {r0[0], r1[0], r0[1], r1[1]}; OUT = *reinterpret_cast<bf16x8*>(&w); } while (0)
  PK4(p0, 0, pa0); PK4(p0, 8, pa1); PK4(p1, 0, pa2); PK4(p1, 8, pa3);
#undef PK4
}
__device__ __forceinline__ float row_sum(const f32x16& p0, const f32x16& p1) {
  float ps = 0.f;
#pragma unroll
  for (int r = 0; r < 16; ++r) ps += p0[r];
#pragma unroll
  for (int r = 0; r < 16; ++r) ps += p1[r];
  auto rr = __builtin_amdgcn_permlane32_swap(__float_as_uint(ps), __float_as_uint(ps), false, false);
  return __uint_as_float(rr[0]) + __uint_as_float(rr[1]);
}
__device__ __forceinline__ void finishSM(f32x16& p0, f32x16& p1, float alpha, float& l_reg, bf16x8& pa0, bf16x8& pa1, bf16x8& pa2, bf16x8& pa3) {
#pragma unroll
  for (int r = 0; r < 16; ++r) p1[r] = __builtin_amdgcn_exp2f(p1[r]);
  const float ps = row_sum(p0, p1);
  l_reg = l_reg * alpha + ps;
  pack_p(p0, p1, pa0, pa1, pa2, pa3);
}
template <int D> __device__ __forceinline__ void qkt(f32x16& p0, f32x16& p1, const LAS char* Ks, const bf16x8* qr, int r32, int hi) {
  p0 = f32x16{}; p1 = f32x16{};
#pragma unroll
  for (int d0 = 0; d0 < D / 16; ++d0) { const int cb = (d0 * 16 + hi * 8) * 2;
    const bf16x8 b0 = *(const LAS bf16x8*)(Ks + kswz<D>(r32, cb));
    const bf16x8 b1 = *(const LAS bf16x8*)(Ks + kswz<D>(32 + r32, cb));
    p0 = __builtin_amdgcn_mfma_f32_32x32x16_bf16(b0, qr[d0], p0, 0, 0, 0);
    p1 = __builtin_amdgcn_mfma_f32_32x32x16_bf16(b1, qr[d0], p1, 0, 0, 0); }
}
template <int D> __device__ __forceinline__ int v_st(int k, int c) { const int kk = (k & ~0xC) | ((k & 4) << 1) | ((k & 8) >> 1); return ((kk >> 3) * (D / 32) + (c >> 5)) * 512 + ((kk & 7) * 32 + (c & 31)) * 2; }
__device__ __forceinline__ int v_rd_base(int lane) { return ((lane & 3) << 3) | (((lane >> 2) & 3) << 6) | (((lane >> 4) & 1) << 5) | (((lane >> 5) & 1) << 8); }
template <int D> constexpr int v_rd_off(int d0, int ks, int half) { return d0 * 512 + ks * (D / 32) * 1024 + half * (D / 32) * 512; }
template <int OFF> __device__ __forceinline__ s16x4 tr_read(int vb) {
  s16x4 r; asm volatile("ds_read_b64_tr_b16 %0, %1 offset:%2" : "=&v"(r) : "v"(vb), "i"(OFF) : "memory"); return r;
}
template <int D, int D0> __device__ __forceinline__ void pv_one(f32x16& od, int vb, bf16x8 pa0, bf16x8 pa1, bf16x8 pa2, bf16x8 pa3) {
  const s16x4 l0 = tr_read<v_rd_off<D>(D0, 0, 0)>(vb), h0 = tr_read<v_rd_off<D>(D0, 0, 1)>(vb), l1 = tr_read<v_rd_off<D>(D0, 1, 0)>(vb), h1 = tr_read<v_rd_off<D>(D0, 1, 1)>(vb);
  const s16x4 l2 = tr_read<v_rd_off<D>(D0, 2, 0)>(vb), h2 = tr_read<v_rd_off<D>(D0, 2, 1)>(vb), l3 = tr_read<v_rd_off<D>(D0, 3, 0)>(vb), h3 = tr_read<v_rd_off<D>(D0, 3, 1)>(vb);
  asm volatile("s_waitcnt lgkmcnt(0)" ::: "memory"); SBAR();
#define PK(L, H) (bf16x8){L[0], L[1], L[2], L[3], H[0], H[1], H[2], H[3]}
  od = __builtin_amdgcn_mfma_f32_32x32x16_bf16(pa0, PK(l0, h0), od, 0, 0, 0);
  od = __builtin_amdgcn_mfma_f32_32x32x16_bf16(pa1, PK(l1, h1), od, 0, 0, 0);
  od = __builtin_amdgcn_mfma_f32_32x32x16_bf16(pa2, PK(l2, h2), od, 0, 0, 0);
  od = __builtin_amdgcn_mfma_f32_32x32x16_bf16(pa3, PK(l3, h3), od, 0, 0, 0);
#undef PK
}
}

template <bool FAST>
__device__ __forceinline__ void win_attn_unit(const Frame& F, bool ctxq, int b, int h, int qb, const bf16* Qp, const bf16* Kp, const bf16* RAW, bf16* O, float sink, LAS char* lds, const float* qn, const float* R64) {
  using namespace att;
  constexpr float C = 1.f, THRS = 8.f * LOG2E;
  const int tid = F.tid, wid = F.wave, lane = F.lane, r32 = lane & 31, hi = lane >> 5;
  LAS char* Kl = lds; LAS char* Vl = lds + 16384; LAS float* li_l = (LAS float*)(lds + 32768) + wid * 64; LAS float* al_l = li_l + 32;
  const int g = h >> 2;
  const int q0 = ctxq ? 0 : qb * 256;
  const long qrow_w = (ctxq ? (long)ML + b * CTXL : (long)b * SEQ + q0) + wid * 32;
  bf16x8 qr[4];
  if constexpr (FAST) {
#pragma unroll
    for (int d0 = 0; d0 < 4; ++d0) qr[d0] = *(const bf16x8*)(Qp + (qrow_w + r32) * 1536 + h * 64 + d0 * 16 + hi * 8);
    qnorm_rope_frag<64>(qr, qn, R64, q0 + wid * 32 + r32, !ctxq, 0.18033688f, lane);
  } else {
#pragma unroll
    for (int d0 = 0; d0 < 4; ++d0) qr[d0] = *(const bf16x8*)(Qp + (qrow_w + r32) * 1024 + h * 64 + d0 * 16 + hi * 8);
  }
  int jlo = 0, jhi = 0;
  if (!ctxq) { jlo = (q0 == 0) ? 2 : 0; jhi = (SEQ - (q0 - 128)) / 64; if (jhi > 8) jhi = 8; }
  const int NT = 4 + (jhi - jlo);
  const int srow = tid >> 3, sch = tid & 7;
  const int vb0 = lds_addr(Vl) + v_rd_base(lane);
  float m_reg = -1e30f, l_reg = 0.f; f32x16 o[2]; o[0] = f32x16{}; o[1] = f32x16{};
  v4u kreg, vreg;
#define TROW(i) ((i) < 4 ? (long)ML + b * CTXL + 64 * (i) : (long)b * SEQ + q0 - 128 + 64 * (jlo + (i) - 4))
#define WLOAD(i) do { const long tr_ = TROW(i) + srow; kreg = *(const v4u*)(Kp + tr_ * 256 + g * 64 + sch * 8); vreg = *(const v4u*)(RAW + tr_ * 1536 + 1280 + g * 64 + sch * 8); } while (0)
  WLOAD(0);
  for (int i = 0; i < NT; ++i) {
    const int buf = i & 1;
    *(LAS v4u*)(Kl + buf * 8192 + kswz<64>(srow, sch * 16)) = kreg;
    *(LAS v4u*)(Vl + buf * 8192 + v_st<64>(srow, sch * 8)) = vreg;
    __syncthreads();
    if (i + 1 < NT) WLOAD(i + 1);
    bool need = true; int T = 0;
    if (i >= 4) { T = q0 - 128 + 64 * (jlo + i - 4); const int qw0 = q0 + wid * 32; need = (T + 63 >= qw0 - 128) && (T <= qw0 + 31 + 128); }
    if (need) {
      f32x16 p0, p1; qkt<64>(p0, p1, Kl + buf * 8192, qr, r32, hi);
      if (i >= 4) { const int dq = q0 + wid * 32 + r32 - T;
#pragma unroll
        for (int r = 0; r < 16; ++r) { const int d0_ = dq - crow(r, hi), d1_ = d0_ - 32;
          if (d0_ > 128 || d0_ < -128) p0[r] = -1e30f;
          if (d1_ > 128 || d1_ < -128) p1[r] = -1e30f; } }
      bf16x8 pa0, pa1, pa2, pa3;
      if constexpr (FAST) {
#pragma unroll
        for (int r = 0; r < 16; ++r) { p0[r] = __builtin_amdgcn_exp2f(p0[r]); p1[r] = __builtin_amdgcn_exp2f(p1[r]); }
        l_reg += row_sum(p0, p1); pack_p(p0, p1, pa0, pa1, pa2, pa3); SBAR();
      } else {
      float mn, alpha; partialSM(p0, p1, m_reg, mn, alpha, C, THRS);
      if (__any(alpha < 1.f)) { if (hi == 0) al_l[r32] = alpha; asm volatile("s_waitcnt lgkmcnt(0)" ::: "memory");
#pragma unroll
        for (int d = 0; d < 2; ++d)
#pragma unroll
          for (int r = 0; r < 16; ++r) o[d][r] *= al_l[crow(r, hi)]; }
      finishSM(p0, p1, alpha, l_reg, pa0, pa1, pa2, pa3); SBAR();
      }
      pv_one<64, 0>(o[0], vb0 + buf * 8192, pa0, pa1, pa2, pa3); pv_one<64, 1>(o[1], vb0 + buf * 8192, pa0, pa1, pa2, pa3);
    }
  }
#undef TROW
#undef WLOAD
  l_reg += __builtin_amdgcn_exp2f(sink * LOG2E - (FAST ? 0.f : m_reg * C));
  if (hi == 0) li_l[r32] = l_reg; asm volatile("s_waitcnt lgkmcnt(0)" ::: "memory");
  float rli[16];
#pragma unroll
  for (int r = 0; r < 16; ++r) rli[r] = __builtin_amdgcn_rcpf(li_l[crow(r, hi)]);
  bf16* Ow = O + qrow_w * 1024 + h * 64;
#pragma unroll
  for (int r = 0; r < 16; ++r) { const int orow = crow(r, hi);
#pragma unroll
    for (int d0 = 0; d0 < 2; ++d0) Ow[(long)orow * 1024 + d0 * 32 + r32] = f2bf16(o[d0][r] * rli[r]); }
  __syncthreads();
}


__device__ __forceinline__ void ml_decode(int uid, int& b, int& h, int& dir, int& c, long& base, int& sgn) {
  c = uid % 66; const int sid = uid / 66; dir = sid & 1; h = (sid >> 1) & 3; b = sid >> 3;
  if (dir == 0) { base = c < 2 ? (long)ML + b * CTXL + 128 * c : (long)b * SEQ + 128 * (c - 2); sgn = 1; }
  else { base = c < 2 ? (long)ML + b * CTXL + 255 - 128 * c : (long)b * SEQ + 8191 - 128 * (c - 2); sgn = -1; }
}
__device__ __forceinline__ float wave_incl_scan_add(float v, int lane) {
#pragma unroll
  for (int o = 1; o < 64; o <<= 1) { const float t = bperm(v, lane - o); if (lane >= o) v += t; }
  return v;
}
__device__ __forceinline__ float wave_incl_scan_max(float v, int lane) {
#pragma unroll
  for (int o = 1; o < 64; o <<= 1) { const float t = bperm(v, lane - o); if (lane >= o) v = fmaxf(v, t); }
  return v;
}
__device__ __forceinline__ void ml1_load(const Frame& F, int uid, const bf16* RAW, const float* GATESb, v4u (&kq)[4], v4u (&vq)[8], float (&gt)[4]) {
  int b, h, dir, c, sgn; long base; ml_decode(uid, b, h, dir, c, base, sgn);
  const int wid = F.wave, ln = xb_lane(), tid = (wid << 6) | ln;
  if (wid == 0) { const long ra = base + sgn * ln, rb = base + sgn * (ln + 64);
    gt[0] = GATESb[ra * 16 + dir * 8 + h]; gt[1] = GATESb[ra * 16 + dir * 8 + 4 + h]; gt[2] = GATESb[rb * 16 + dir * 8 + h]; gt[3] = GATESb[rb * 16 + dir * 8 + 4 + h]; }
#pragma unroll
  for (int ii = 0; ii < 4; ++ii) { const int l = (tid >> 4) + 32 * ii; kq[ii] = *(const v4u*)(RAW + (size_t)(base + sgn * l) * 3072 + 512 + 128 * h + (tid & 15) * 8); }
#pragma unroll
  for (int ii = 0; ii < 8; ++ii) { const int l = (tid >> 5) + 16 * ii; vq[ii] = *(const v4u*)(RAW + (size_t)(base + sgn * l) * 3072 + 1024 + 256 * h + (tid & 31) * 8); }
}
__device__ __forceinline__ void ml1_unit(const Frame& F, int uid, int uid_next, const bf16* RAW, const float* GATESb, bf16* CBAR, float* NBAR, float* MSC, LAS char* lds, v4u (&kq)[4], v4u (&vq)[8], float (&gt)[4]) {
  using namespace att;
  LAS char* Kt = lds; LAS char* Vt = lds + 32768; LAS float* wS = (LAS float*)(lds + 98304); LAS float* nP = wS + 128;
  const int tid = F.tid, wid = F.wave, lane = F.lane, r32 = lane & 31, hi = lane >> 5;
  const float lia = gt[0], lfa = gt[1], lib = gt[2], lfb = gt[3];
  if (wid == 0) {
    const int lane = xb_lane();
    const float ca = wave_incl_scan_add(lfa, lane); const float tot = __int_as_float(__builtin_amdgcn_readlane(__float_as_int(ca), 63));
    const float cb = wave_incl_scan_add(lfb, lane) + tot; const float g = __int_as_float(__builtin_amdgcn_readlane(__float_as_int(cb), 63));
    const float ua = lia - ca, ub = lib - cb; const float um = wave_max(fmaxf(ua, ub), lane);
    wS[lane] = expf(ua - um); wS[lane + 64] = expf(ub - um);
    if (lane == 0) { MSC[(size_t)uid * 4 + 0] = g; MSC[(size_t)uid * 4 + 1] = g + um; }
  }
  __syncthreads();
  float kacc[8];
#pragma unroll
  for (int e = 0; e < 8; ++e) kacc[e] = 0.f;
#pragma unroll
  for (int ii = 0; ii < 4; ++ii) { const int l = (tid >> 4) + 32 * ii, cc = (tid & 15) * 8;
    *(LAS v4u*)(Kt + (l >> 6) * 16384 + v_st<128>(l & 63, cc)) = kq[ii];
    float f[8]; unpack8(kq[ii], f); const float wl = wS[l];
#pragma unroll
    for (int e = 0; e < 8; ++e) kacc[e] += wl * f[e]; }
#pragma unroll
  for (int ii = 0; ii < 8; ++ii) { const int l = (tid >> 5) + 16 * ii, cc = (tid & 31) * 8;
    float f[8]; unpack8(vq[ii], f); const float wl = wS[l];
#pragma unroll
    for (int e = 0; e < 8; ++e) f[e] *= wl;
    *(LAS v4u*)(Vt + ((l >> 6) * 2 + (cc >> 7)) * 16384 + v_st<128>(l & 63, cc & 127)) = pack8(f); }
#pragma unroll
  for (int e = 0; e < 8; ++e) { kacc[e] += bperm(kacc[e], lane ^ 16); kacc[e] += bperm(kacc[e], lane ^ 32); }
  if (lane < 16) {
#pragma unroll
    for (int e = 0; e < 8; ++e) nP[wid * 128 + lane * 8 + e] = kacc[e]; }
  __syncthreads();
  if (uid_next < ML_NUID) ml1_load(F, uid_next, RAW, GATESb, kq, vq, gt);
  if (wid < 2) { float s = 0.f; const int t2 = (wid << 6) + xb_lane();
#pragma unroll
    for (int w8 = 0; w8 < 8; ++w8) s += nP[w8 * 128 + t2];
    NBAR[(size_t)uid * 128 + t2] = s; }
  f32x16 acc[4]; acc[0] = f32x16{}; acc[1] = f32x16{}; acc[2] = f32x16{}; acc[3] = f32x16{};
  const int vbA = lds_addr(Vt) + (wid >> 2) * 16384 + (wid & 3) * 512 + v_rd_base(lane);
  const int vbB = lds_addr(Kt) + v_rd_base(lane);
#define ML1_STEP(KT, KS) do { \
    const s16x4 al = tr_read<(KT) * 32768 + (KS) * 4096>(vbA), ah = tr_read<(KT) * 32768 + (KS) * 4096 + 2048>(vbA); \
    const s16x4 b0l = tr_read<(KT) * 16384 + 0 * 512 + (KS) * 4096>(vbB), b0h = tr_read<(KT) * 16384 + 0 * 512 + (KS) * 4096 + 2048>(vbB); \
    const s16x4 b1l = tr_read<(KT) * 16384 + 1 * 512 + (KS) * 4096>(vbB), b1h = tr_read<(KT) * 16384 + 1 * 512 + (KS) * 4096 + 2048>(vbB); \
    const s16x4 b2l = tr_read<(KT) * 16384 + 2 * 512 + (KS) * 4096>(vbB), b2h = tr_read<(KT) * 16384 + 2 * 512 + (KS) * 4096 + 2048>(vbB); \
    const s16x4 b3l = tr_read<(KT) * 16384 + 3 * 512 + (KS) * 4096>(vbB), b3h = tr_read<(KT) * 16384 + 3 * 512 + (KS) * 4096 + 2048>(vbB); \
    asm volatile("s_waitcnt lgkmcnt(0)" ::: "memory"); SBAR(); \
    const bf16x8 a_ = (bf16x8){al[0], al[1], al[2], al[3], ah[0], ah[1], ah[2], ah[3]}; \
    acc[0] = __builtin_amdgcn_mfma_f32_32x32x16_bf16((bf16x8){b0l[0], b0l[1], b0l[2], b0l[3], b0h[0], b0h[1], b0h[2], b0h[3]}, a_, acc[0], 0, 0, 0); \
    acc[1] = __builtin_amdgcn_mfma_f32_32x32x16_bf16((bf16x8){b1l[0], b1l[1], b1l[2], b1l[3], b1h[0], b1h[1], b1h[2], b1h[3]}, a_, acc[1], 0, 0, 0); \
    acc[2] = __builtin_amdgcn_mfma_f32_32x32x16_bf16((bf16x8){b2l[0], b2l[1], b2l[2], b2l[3], b2h[0], b2h[1], b2h[2], b2h[3]}, a_, acc[2], 0, 0, 0); \
    acc[3] = __builtin_amdgcn_mfma_f32_32x32x16_bf16((bf16x8){b3l[0], b3l[1], b3l[2], b3l[3], b3h[0], b3h[1], b3h[2], b3h[3]}, a_, acc[3], 0, 0, 0); \
    SBAR(); } while (0)
  ML1_STEP(0, 0); ML1_STEP(0, 1); ML1_STEP(0, 2); ML1_STEP(0, 3); ML1_STEP(1, 0); ML1_STEP(1, 1); ML1_STEP(1, 2); ML1_STEP(1, 3);
#undef ML1_STEP
  bf16* cbp = CBAR + (size_t)uid * 32768;
#pragma unroll
  for (int nb = 0; nb < 4; ++nb)
#pragma unroll
    for (int g = 0; g < 4; ++g) { uint2 w; w.x = pg8::cvt_pk_bf16(acc[nb][4 * g], acc[nb][4 * g + 1]); w.y = pg8::cvt_pk_bf16(acc[nb][4 * g + 2], acc[nb][4 * g + 3]);
      *(uint2*)(cbp + ((wid * 8 + 2 * nb + (g >> 1)) * 64 + (g & 1) * 32 + r32) * 8 + 4 * hi) = w; }
  __syncthreads();
}
__device__ __forceinline__ void ml2_scan(const Frame& F, int s, bf16* CBAR, float* NBAR, float* MSC, LAS char* lds) {
  const int sid = s >> 3, slice = s & 7, uid0 = sid * 66;
  LAS float* gS = (LAS float*)lds; LAS float* mbS = gS + 66;
  __syncthreads();
  if (F.tid < 66) { gS[F.tid] = MSC[(size_t)(uid0 + F.tid) * 4 + 0]; mbS[F.tid] = MSC[(size_t)(uid0 + F.tid) * 4 + 1]; }
  __syncthreads();
  const size_t e0 = (size_t)(slice * 32 + (F.tid >> 4)) * 128 + (F.tid & 15) * 8;
  const bool nthr = (slice == 0) && (F.tid < 128);
  float Cs[8]; float m = -1e30f, nst = 0.f;
#pragma unroll
  for (int e = 0; e < 8; ++e) Cs[e] = 0.f;
  for (int grp = 0; grp < 3; ++grp) {
    v4u cb[22]; float nbv[22];
#pragma unroll
    for (int i = 0; i < 22; ++i) { cb[i] = *(const v4u*)(CBAR + (size_t)(uid0 + grp * 22 + i) * 32768 + e0); nbv[i] = nthr ? NBAR[(size_t)(uid0 + grp * 22 + i) * 128 + F.tid] : 0.f; }
#pragma unroll
    for (int i = 0; i < 22; ++i) {
      const int c = grp * 22 + i, uid = uid0 + c;
      const float g = gS[c], mb = mbS[c];
      *(v4u*)(CBAR + (size_t)uid * 32768 + e0) = pack8(Cs);
      if (slice == 0 && F.tid == 0) MSC[(size_t)uid * 4 + 2] = m;
      if (nthr) NBAR[(size_t)uid * 128 + F.tid] = nst;
      const float m_new = fmaxf(g + m, mb), decay = __expf(g + m - m_new), inj = __expf(mb - m_new);
      float f[8]; unpack8(cb[i], f);
#pragma unroll
      for (int e = 0; e < 8; ++e) Cs[e] = decay * Cs[e] + inj * f[e];
      nst = decay * nst + inj * nbv[i]; m = m_new;
    }
  }
}
__device__ __forceinline__ void ml3_load(const Frame& F, int uid, const bf16* RAW, const float* GATESb, const float* MSC, const float* NBAR, bf16x8 (&qr)[8], v4u (&kq)[4], float (&gt)[5], float& nbv) {
  int b, h, dir, c, sgn; long base; ml_decode(uid, b, h, dir, c, base, sgn);
  const int wid = F.wave, ln = xb_lane(), tid = (wid << 6) | ln, r32 = ln & 31, hi = ln >> 5, lq = 32 * (wid & 3) + r32;
  if (wid == 0) { const long ra = base + sgn * ln, rb = base + sgn * (ln + 64);
    gt[0] = GATESb[ra * 16 + dir * 8 + h]; gt[1] = GATESb[ra * 16 + dir * 8 + 4 + h]; gt[2] = GATESb[rb * 16 + dir * 8 + h]; gt[3] = GATESb[rb * 16 + dir * 8 + 4 + h]; gt[4] = MSC[(size_t)uid * 4 + 2]; }
  else if (wid == 2 || wid == 3) nbv = NBAR[(size_t)uid * 128 + tid - 128];
  { const bf16* qp = RAW + (size_t)(base + sgn * lq) * 3072 + 128 * h + hi * 8;
#pragma unroll
    for (int d0 = 0; d0 < 8; ++d0) qr[d0] = *(const bf16x8*)(qp + d0 * 16); }
#pragma unroll
  for (int ii = 0; ii < 4; ++ii) { const int l = (tid >> 4) + 32 * ii; kq[ii] = *(const v4u*)(RAW + (size_t)(base + sgn * l) * 3072 + 512 + 128 * h + (tid & 15) * 8); }
}
__device__ __forceinline__ void ml3_unit(const Frame& F, int uid, int uid_next, const bf16* RAW, const float* GATESb, const bf16* CBAR, const float* NBAR, const float* MSC, bf16* HX, LAS char* lds,
                                         bf16x8 (&qr)[8], v4u (&kq)[4], float (&gt)[5], float& nbv) {
  using namespace att;
  constexpr float SCQ = 0.08838834764831845f;
  LAS char* Kl = lds; LAS char* Vl = lds + 32768;
  LAS float* uS = (LAS float*)(lds + 98304); LAS float* MS_ = uS + 128; LAS float* wiS = uS + 256; LAS float* emS = uS + 384; LAS float* nS = uS + 512;
  int b, h, dir, c, sgn; long base; ml_decode(uid, b, h, dir, c, base, sgn);
  const int tid = F.tid, wid = F.wave, lane = F.lane, r32 = lane & 31, hi = lane >> 5;
  LAS float* wsf = (LAS float*)(lds + 98304 + 2560) + wid * 64;
  const int rblk = wid & 3, dh = wid >> 2, lq = 32 * rblk + r32;
  const float lia = gt[0], lfa = gt[1], lib = gt[2], lfb = gt[3], ms = gt[4];
  v4u vq[8];
#pragma unroll
  for (int ii = 0; ii < 8; ++ii) { const int l = (tid >> 5) + 16 * ii; vq[ii] = *(const v4u*)(RAW + (size_t)(base + sgn * l) * 3072 + 1024 + 256 * h + (tid & 31) * 8); }
  if (wid == 0) {
    const int lane = xb_lane();
    const float ca = wave_incl_scan_add(lfa, lane); const float tot = __int_as_float(__builtin_amdgcn_readlane(__float_as_int(ca), 63));
    const float cb = wave_incl_scan_add(lfb, lane) + tot;
    const float ua = lia - ca, ub = lib - cb;
    const float pa = wave_incl_scan_max(ua, lane); const float pma = __int_as_float(__builtin_amdgcn_readlane(__float_as_int(pa), 63));
    const float pb = fmaxf(wave_incl_scan_max(ub, lane), pma);
    const float Ma = fmaxf(ms, pa), Mb = fmaxf(ms, pb);
    uS[lane] = ua; uS[lane + 64] = ub; MS_[lane] = Ma; MS_[lane + 64] = Mb;
    wiS[lane] = expf(ms - Ma); wiS[lane + 64] = expf(ms - Mb);
    emS[lane] = expf(-(ca + Ma)); emS[lane + 64] = expf(-(cb + Mb));
  } else if (wid == 2 || wid == 3) { const int t2 = (wid << 6) + xb_lane() - 128; nS[t2] = nbv; }
#pragma unroll
  for (int ii = 0; ii < 4; ++ii) { const int l = (tid >> 4) + 32 * ii; *(LAS v4u*)(Kl + kswz<128>(l, (tid & 15) * 16)) = kq[ii]; }
  f32x16 o[4]; o[0] = f32x16{}; o[1] = f32x16{}; o[2] = f32x16{}; o[3] = f32x16{};
  { const bf16* cp = CBAR + (size_t)uid * 32768 + (size_t)(dh * 4 * 8 * 64 + lane) * 8;
#pragma unroll
    for (int j = 0; j < 4; ++j) {
#pragma unroll
      for (int dh0 = 0; dh0 < 8; dh0 += 4) {
        bf16x8 cf[4];
#pragma unroll
        for (int d0 = 0; d0 < 4; ++d0) cf[d0] = *(const bf16x8*)(cp + (size_t)((j * 8 + dh0 + d0) * 64) * 8);
#pragma unroll
        for (int d0 = 0; d0 < 4; ++d0) o[j] = __builtin_amdgcn_mfma_f32_32x32x16_bf16(qr[dh0 + d0], cf[d0], o[j], 0, 0, 0); } } }
#pragma unroll
  for (int ii = 0; ii < 8; ++ii) { const int l = (tid >> 5) + 16 * ii, cc = (tid & 31) * 8; *(LAS v4u*)(Vl + ((l >> 6) * 2 + (cc >> 7)) * 16384 + v_st<128>(l & 63, cc & 127)) = vq[ii]; }
  __syncthreads();
  float qn = 0.f;
#pragma unroll
  for (int d0 = 0; d0 < 8; ++d0)
#pragma unroll
    for (int e = 0; e < 8; ++e) qn += bf2f((unsigned short)qr[d0][e]) * nS[d0 * 16 + hi * 8 + e];
  qn += bperm(qn, lane ^ 32);
#pragma unroll
  for (int r = 0; r < 16; ++r) { const float wi = wiS[32 * rblk + crow(r, hi)]; o[0][r] *= wi; o[1][r] *= wi; o[2][r] *= wi; o[3][r] *= wi; }
  float den = 0.f; const float Mq = MS_[lq];
  const int vb0 = lds_addr(Vl) + dh * 16384 + v_rd_base(lane);
#pragma nounroll
  for (int kt = 0; kt < 2; ++kt) {
    if (64 * kt <= 32 * rblk + 31) {
      f32x16 p0, p1; qkt<128>(p0, p1, Kl + kt * 16384, qr, r32, hi);
      const LAS float* up = uS + 64 * kt + 4 * hi; const int dql = lq - 64 * kt - 4 * hi;
#pragma unroll
      for (int r = 0; r < 16; ++r) { const int cr = (r & 3) + 8 * (r >> 2);
        const float u0 = up[cr], u1 = up[cr + 32];
        const float a0 = (cr <= dql) ? (u0 - Mq) * LOG2E : -1e30f, a1 = (cr + 32 <= dql) ? (u1 - Mq) * LOG2E : -1e30f;
        p0[r] *= __builtin_amdgcn_exp2f(a0); p1[r] *= __builtin_amdgcn_exp2f(a1); }
      asm volatile("" : "+v"(p0), "+v"(p1));
      den += row_sum(p0, p1);
      bf16x8 pa0, pa1, pa2, pa3; pack_p(p0, p1, pa0, pa1, pa2, pa3); SBAR();
      const int vb = vb0 + kt * 32768;
      pv_one<128, 0>(o[0], vb, pa0, pa1, pa2, pa3); pv_one<128, 1>(o[1], vb, pa0, pa1, pa2, pa3); pv_one<128, 2>(o[2], vb, pa0, pa1, pa2, pa3); pv_one<128, 3>(o[3], vb, pa0, pa1, pa2, pa3);
    }
  }
  if (uid_next >= 0) ml3_load(F, uid_next, RAW, GATESb, MSC, NBAR, qr, kq, gt, nbv);
  const float dtot = den + wiS[lq] * qn;
  const float fac = SCQ / fmaxf(SCQ * fabsf(dtot), emS[lq]);
  if (hi == 0) wsf[r32] = fac; asm volatile("s_waitcnt lgkmcnt(0)" ::: "memory");
  int r32e = r32, hie = hi; asm volatile("" : "+v"(r32e), "+v"(hie));
#pragma unroll
  for (int r = 0; r < 16; ++r) { const int lo_ = 32 * rblk + crow(r, hie); const float fr_ = wsf[crow(r, hie)];
    bf16* op = HX + (size_t)(base + sgn * lo_) * 1024 + 256 * h + 128 * dh + r32e;
    op[0] = f2bf16(o[0][r] * fr_); op[32] = f2bf16(o[1][r] * fr_); op[64] = f2bf16(o[2][r] * fr_); op[96] = f2bf16(o[3][r] * fr_); }
  __syncthreads();
}
__device__ __forceinline__ void mln_phase(const Frame& F, bf16* HF, const bf16* HB, const bf16* RAW, const float* hnorm) {
  const int j = F.lane & 31, hh = F.lane >> 5;
  float hn[8];
#pragma unroll
  for (int e = 0; e < 8; ++e) hn[e] = hnorm[8 * j + e];
  for (int r = F.gw; r < ML; r += F.ngw) {
#pragma unroll
    for (int p = 0; p < 2; ++p) { const size_t off = (size_t)r * 1024 + 256 * (2 * p + hh) + 8 * j;
      float a[8], b[8], g[8]; unpack8(*(const v4u*)(HF + off), a); unpack8(*(const v4u*)(HB + off), b); unpack8(*(const v4u*)(RAW + (size_t)r * 3072 + 2048 + 256 * (2 * p + hh) + 8 * j), g);
      float ss = 0.f;
#pragma unroll
      for (int e = 0; e < 8; ++e) { a[e] += b[e]; ss += a[e] * a[e]; }
#pragma unroll
      for (int o = 1; o < 32; o <<= 1) ss += bperm(ss, F.lane ^ o);
      const float rs = __builtin_amdgcn_rsqf(ss * (1.f / 256.f) + EPS);
#pragma unroll
      for (int e = 0; e < 8; ++e) a[e] = sigmoidf_(g[e]) * a[e] * rs * hn[e];
      *(v4u*)(HF + off) = pack8(a); }
  }
}

struct Args { const float* in[27]; float* out; unsigned char* ws; };
enum { I_X = 0, I_C, I_CTX, I_CCTX, I_ADAW, I_ADAB, I_NMIX, I_NFFN, I_WUP, I_FCONV, I_WDOWN, I_WINQKV, I_WINQN, I_WINKN, I_WINSINK, I_WINWO,
       I_SCWIN, I_SCCONV, I_SCWOUT, I_AXQKV, I_AXQN, I_AXKN, I_AXWO, I_MLWIN, I_MLBG, I_MLHN, I_MLWOUT };
typedef const __attribute__((address_space(4))) Args* ArgsP;

typedef pg8::StaticOrder SOrd;
#define GEMM_BF16(Aptr, Bptr, Mrows, Ncols, Kdim, Optr, ldc_) do { pg8::Gemm g_{(const pg8::bf16_t*)(Aptr), (const pg8::bf16_t*)(Bptr), (Mrows), (Ncols), (Kdim)}; SOrd S_; S_.init((Mrows), (Ncols), F.G, bid); \
    pg8::EpiStoreBf16 E_{(pg8::bf16_t*)(Optr), (ldc_)}; pg8::gemm_phase<pg8::EpiStoreBf16, SOrd, true, true>(F.lds, g_, S_, E_, F.tid); } while (0)
#define GEMM_RESID(Aptr, Bptr, Mrows, Kdim, blat, bctx, olat, octx, gatep, tile0_, bin_, bout_) do { pg8::Gemm g_{(const pg8::bf16_t*)(Aptr), (const pg8::bf16_t*)(Bptr), (Mrows), 1024, (Kdim)}; pg8::CtxSplitOrder S_; S_.init((Kdim), (Mrows) > ML, F.G, bid); \
    pg8::EpiResid E_{(blat), (bctx), (olat), (octx), (gatep), (tile0_), (bin_), (bout_)}; pg8::gemm_phase<pg8::EpiResid, pg8::CtxSplitOrder, true, true>(F.lds, g_, S_, E_, F.tid); } while (0)
#define PHASE() do { asm volatile("" : "+s"(F.wave)); F.tid = (F.wave << 6) | xb_lane(); asm volatile("" : "+v"(F.tid)); F.lane = F.tid & 63; asm volatile("" : "+s"(bid), "+s"(F.G)); \
    F.gw = bid * NWAVES + F.wave; F.ngw = F.G * NWAVES; asm volatile("" : "+s"(ap)); ws = ap->ws; asm volatile("" : "+s"(F.lds)); ldsc = (LAS char*)F.lds; asm volatile("" : "+s"(bar.bar), "+s"(bar.x), "+s"(bar.st)); } while (0)
#define AIN(k) (ap->in[k])
__device__ __forceinline__ int ml1_uid(int u) { const int sid = u / 66; int c = u - sid * 66; if (sid & 1) { const int cf = c + 2 >= 66 ? c + 2 - 66 : c + 2; c = cf >= 2 ? 67 - cf : 1 - cf; } return sid * 66 + c; }
__device__ __forceinline__ int ml3_uid(int u) { const int sid = u >> 6; int cc = u & 63; if (sid & 1) cc = 63 - cc; return sid * 66 + cc + 2; }

__global__ void __launch_bounds__(NWAVES * 64, 2) hybrid_fwd(Args args_unused) {
    extern __shared__ __attribute__((aligned(16))) unsigned char lds_raw[];
    ArgsP ap = (ArgsP)__builtin_amdgcn_kernarg_segment_ptr();
    Frame F;
    F.lds = (LAS unsigned char*)lds_raw;
    F.tid = threadIdx.x; F.lane = F.tid & 63; F.wave = __builtin_amdgcn_readfirstlane(F.tid >> 6);
    int bid = blockIdx.x;
    F.G = gridDim.x; F.gw = bid * NWAVES + F.wave; F.ngw = F.G * NWAVES;
    unsigned char* ws = ap->ws;
    for (int u = F.tid; u < (LDS_BYTES - LDSCTL_OFF) / 4; u += NWAVES * 64) ((LAS unsigned*)(F.lds + LDSCTL_OFF))[u] = 0u;
    __syncthreads();
    XcdBarrier bar = xcd_barrier_post((unsigned*)((gu32*)(ws + WS_CTL) + CW_BAR), (volatile LAS unsigned*)(F.lds + MISC_OFF) + 8, F.wave);
#define GRID_BAR() xcd_barrier(bar, F.wave)
    LAS char* ldsc = (LAS char*)F.lds;

    {
        __syncthreads();
        PHASE();
        mod_phase(F, AIN(I_C), AIN(I_CCTX), AIN(I_ADAW), AIN(I_ADAB), (float*)(ws + WS_MOD));
        rope_tables(F, (float*)(ws + WS_ROPE64), (float*)(ws + WS_ROPE128));
        for (int i = bid * 512 + F.tid; i < MC * DM / 4; i += F.G * 512) ((f32x4*)(ws + WS_HC))[i] = ((const f32x4*)AIN(I_CTX))[i];
        int rot = 0;
#pragma nounroll
        for (int l = 0; l < 4; ++l) {
            const size_t lb = l == 0 ? WT_L0 : l == 1 ? WT_L1 : l == 2 ? WT_L2 : WT_L3;
            const size_t szin = (l == 0 || l == 2) ? SZ_W1536 : SZ_W3072;
            const float* win = l == 0 ? AIN(I_WINQKV) : l == 1 ? AIN(I_SCWIN) : l == 2 ? AIN(I_AXQKV) : AIN(I_MLWIN);
            const float* wout = l == 0 ? AIN(I_WINWO) : l == 1 ? AIN(I_SCWOUT) : l == 2 ? AIN(I_AXWO) : AIN(I_MLWOUT);
            const int nin = (l == 0 || l == 2) ? 1536 : 3072, pin = l == 3 ? 3088 : nin;
            transpose_matrix(F, win, 1024, pin, nin, (bf16*)(ws + lb), rot);
            transpose_matrix(F, wout, 1024, 1024, 1024, (bf16*)(ws + lb + szin), rot);
            transpose_matrix(F, AIN(I_WUP) + (size_t)l * 1024 * NUP, 1024, NUP, NUP, (bf16*)(ws + lb + szin + SZ_W1024), rot, true);
            transpose_matrix(F, AIN(I_WDOWN) + (size_t)l * DFF * 1024, DFF, 1024, 1024, (bf16*)(ws + lb + szin + SZ_W1024 + SZ_UP), rot);
        }
    }
    GRID_BAR();

#pragma nounroll
    for (int layer = 0; layer < 4; ++layer) {
        asm volatile("" : "+s"(layer));
#define LB() (layer == 0 ? WT_L0 : layer == 1 ? WT_L1 : layer == 2 ? WT_L2 : WT_L3)
#define SZIN() ((layer == 0 || layer == 2) ? SZ_W1536 : SZ_W3072)
#define MODP() ((const float*)(ws + WS_MOD) + (size_t)layer * 5 * 6144)
#define HB_A() ((void*)ap->out)
#define HB_B() ((void*)((bf16*)ap->out + (size_t)ML * 1024))
#define HLAT() (layer == 0 ? (const void*)AIN(I_X) : (const void*)HB_B())
#define HMID() (layer == 3 ? (void*)(ws + WS_WT) : HB_A())
#define HCTX() ((const float*)(ws + WS_HC))
#define ROWS_OUT() (layer == 3 ? ML : MT)

        PHASE();
        if (layer == 3) norm_phase<true>(F, HLAT(), layer != 0, (float*)(ws + WS_HC), (const float*)(ws + BG_SLAB), layer == 0 ? 0 : 11, MT, AIN(I_NMIX) + layer * 1024, MODP(), 0, 1024, (bf16*)(ws + WS_XN), AIN(I_MLWIN), AIN(I_MLBG), (float*)(ws + WS_GATES));
        else norm_phase<false>(F, HLAT(), layer != 0, (float*)(ws + WS_HC), (const float*)(ws + BG_SLAB), layer == 0 ? 0 : 11, MT, AIN(I_NMIX) + layer * 1024, MODP(), 0, 1024, (bf16*)(ws + WS_XN), nullptr, nullptr, nullptr);
        GRID_BAR();
        PHASE();
        { const int nin = (layer == 0 || layer == 2) ? 1536 : 3072;
          GEMM_BF16(ws + WS_XN, ws + LB(), MT, nin, 1024, ws + BG_RAW, nin); }
        GRID_BAR();
        if (layer == 0) {
            PHASE();
            bool fast_w;
            { const float* gq_ = AIN(I_WINQN); const float* gk_ = AIN(I_WINKN);
              const float gqm = wave_max(fabsf(gq_[F.lane]), F.lane), gkm = wave_max(fabsf(gk_[F.lane]), F.lane);
              fast_w = __builtin_amdgcn_readfirstlane((11.55f * gqm * gkm <= 80.f) ? 1 : 0) != 0; }
            if (fast_w) knorm_rope64(F, (const bf16*)(ws + BG_RAW), AIN(I_WINKN), (const float*)(ws + WS_ROPE64), (bf16*)(ws + BG_K));
            else qknorm_rope64(F, (const bf16*)(ws + BG_RAW), AIN(I_WINQN), AIN(I_WINKN), (const float*)(ws + WS_ROPE64), (bf16*)(ws + BG_Q), (bf16*)(ws + BG_K));
            GRID_BAR();
            PHASE();
            for (int i_ = 0; i_ < 9; ++i_) {
                int u;
                if (F.G == 256) { if (i_ < 8) { const int x = bid & 7, li = 32 * i_ + (bid >> 3), pg = 2 * x + (li >> 7); u = (pg >> 2) * 512 + ((pg & 3) * 4 + ((li >> 5) & 3)) * 32 + (li & 31); }
                                  else { if (bid >= 64) break; u = 2048 + bid; } }
                else { u = bid + i_ * F.G; if (u >= 2048 + 64) break; }
                const bf16* Qp = (const bf16*)(ws + BG_Q); const bf16* Kp = (const bf16*)(ws + BG_K); const bf16* RAW = (const bf16*)(ws + BG_RAW); bf16* Ob = (bf16*)(ws + BG_O);
                const bool cq = u >= 2048; const int v = cq ? u - 2048 : u, qb = cq ? 0 : (v & 31), h = cq ? (v & 15) : ((v >> 5) & 15), b = cq ? (v >> 4) : (v >> 9);
                if (fast_w) win_attn_unit<true>(F, cq, b, h, qb, RAW, Kp, RAW, Ob, AIN(I_WINSINK)[h], ldsc, AIN(I_WINQN), (const float*)(ws + WS_ROPE64));
                else win_attn_unit<false>(F, cq, b, h, qb, Qp, Kp, RAW, Ob, AIN(I_WINSINK)[h], ldsc, AIN(I_WINQN), (const float*)(ws + WS_ROPE64));
            }
        } else if (layer == 1) {
            PHASE();
            sconv_phase(F, (const bf16*)(ws + BG_RAW), AIN(I_SCCONV), (bf16*)(ws + BG_O));
        } else if (layer == 2) {
            PHASE();
            bool fast_sm;
            { const float* gq_ = AIN(I_AXQN); const float* gk_ = AIN(I_AXKN);
              const float gqm = wave_max(fmaxf(fabsf(gq_[F.lane]), fabsf(gq_[F.lane + 64])), F.lane), gkm = wave_max(fmaxf(fabsf(gk_[F.lane]), fabsf(gk_[F.lane + 64])), F.lane);
              fast_sm = __builtin_amdgcn_readfirstlane((16.33f * gqm * gkm <= 80.f) ? 1 : 0) != 0; }
            if (fast_sm) knorm_rope128(F, (const bf16*)(ws + BG_RAW), AIN(I_AXKN), (const float*)(ws + WS_ROPE128), (bf16*)(ws + BG_K), (bf16*)(ws + BG_V));
            else qknorm_rope128(F, (const bf16*)(ws + BG_RAW), AIN(I_AXQN), AIN(I_AXKN), (const float*)(ws + WS_ROPE128), (bf16*)(ws + BG_Q), (bf16*)(ws + BG_K), (bf16*)(ws + BG_V));
            GRID_BAR();
            PHASE();
            for (int i_ = 0; i_ < 5; ++i_) {
                int u;
                if (F.G == 256) { if (i_ < 4) { const int x = bid & 7, j_ = (bid >> 3) + 32 * i_; u = ((x >> 1) * 8 + (x & 1) * 4 + (j_ >> 5)) * 32 + (j_ & 31); } else { if (bid >= 32) break; u = 1024 + bid; } }
                else { u = bid + i_ * F.G; if (u >= 1024 + 32) break; }
                const unsigned short* Qp = (const unsigned short*)(ws + BG_Q); const unsigned short* K2 = (const unsigned short*)(ws + BG_K); const unsigned short* V2 = (const unsigned short*)(ws + BG_V); unsigned short* Ob = (unsigned short*)(ws + BG_O);
                unsigned qoff, kvo, qraw; int seq_, t0_;
                if (u < 1024) { const int qb = u & 31, h = (u >> 5) & 7, b = u >> 8; qoff = (unsigned)(b * SEQ + qb * 256) * 1024u + h * 128; qraw = (unsigned)(b * SEQ + qb * 256) * 1536u + h * 128; t0_ = qb * 256;
                                kvo = (unsigned)b * (8448u * 256u) + (h >> 2) * 128; seq_ = 8448; }
                else { const int v = u - 1024, h = v & 7, b = v >> 3; qoff = (unsigned)(ML + b * CTXL) * 1024u + h * 128; qraw = (unsigned)(ML + b * CTXL) * 1536u + h * 128; t0_ = 0;
                       kvo = ((unsigned)b * 8448u + 8192u) * 256u + (h >> 2) * 128; seq_ = 256; }
                qoff = __builtin_amdgcn_readfirstlane(qoff); kvo = __builtin_amdgcn_readfirstlane(kvo); seq_ = __builtin_amdgcn_readfirstlane(seq_); qraw = __builtin_amdgcn_readfirstlane(qraw); t0_ = __builtin_amdgcn_readfirstlane(t0_);
                const int tid_ = (F.wave << 6) | xb_lane();
                if (fast_sm) exf::attn_dense_body<exf::bf16>((const unsigned short*)(ws + BG_RAW) + qraw, K2 + kvo, V2 + kvo, Ob + qoff, seq_, (char*)F.lds, tid_, AIN(I_AXQN), (const float*)(ws + WS_ROPE128), t0_, u < 1024);
                else exd::attn_dense_body<exd::bf16>(Qp + qoff, K2 + kvo, V2 + kvo, Ob + qoff, seq_, (char*)F.lds, tid_);
                __syncthreads();
            }
        } else {
            PHASE();
            { v4u kq_[4], vq_[8]; float gt_[4] = {0.f, 0.f, 0.f, 0.f}; int u = bid;
#pragma unroll
              for (int i_ = 0; i_ < 4; ++i_) kq_[i_] = (v4u){0u, 0u, 0u, 0u};
#pragma unroll
              for (int i_ = 0; i_ < 8; ++i_) vq_[i_] = (v4u){0u, 0u, 0u, 0u};
              if (u < ML_NUID) ml1_load(F, ml1_uid(u), (const bf16*)(ws + BG_RAW), (const float*)(ws + WS_GATES), kq_, vq_, gt_);
              for (; u < ML_NUID; u += F.G) ml1_unit(F, ml1_uid(u), u + F.G < ML_NUID ? ml1_uid(u + F.G) : ML_NUID, (const bf16*)(ws + BG_RAW), (const float*)(ws + WS_GATES), (bf16*)(ws + BG_CBAR), (float*)(ws + BG_NBAR), (float*)(ws + BG_MSC), ldsc, kq_, vq_, gt_); }
            GRID_BAR();
            PHASE();
            for (int s = bid; s < 256; s += F.G) ml2_scan(F, s, (bf16*)(ws + BG_CBAR), (float*)(ws + BG_NBAR), (float*)(ws + BG_MSC), ldsc);
            GRID_BAR();
            PHASE();
            { bf16x8 qr_[8]; v4u kq_[4]; float gt_[5] = {0.f, 0.f, 0.f, 0.f, 0.f}, nbv_ = 0.f;
#pragma unroll
              for (int i_ = 0; i_ < 8; ++i_) qr_[i_] = bf16x8{};
#pragma unroll
              for (int i_ = 0; i_ < 4; ++i_) kq_[i_] = (v4u){0u, 0u, 0u, 0u};
              int u = bid;
              if (u < 2048) ml3_load(F, ml3_uid(u), (const bf16*)(ws + BG_RAW), (const float*)(ws + WS_GATES), (const float*)(ws + BG_MSC), (const float*)(ws + BG_NBAR), qr_, kq_, gt_, nbv_);
              for (; u < 2048; u += F.G) { const int sid = u >> 6, un = u + F.G;
                ml3_unit(F, ml3_uid(u), un < 2048 ? ml3_uid(un) : -1, (const bf16*)(ws + BG_RAW), (const float*)(ws + WS_GATES), (const bf16*)(ws + BG_CBAR), (const float*)(ws + BG_NBAR),
                         (const float*)(ws + BG_MSC), (sid & 1) ? (bf16*)(ws + WS_HB) : (bf16*)(ws + WS_HF), ldsc, qr_, kq_, gt_, nbv_); } }
            GRID_BAR();
            PHASE();
            mln_phase(F, (bf16*)(ws + WS_HF), (const bf16*)(ws + WS_HB), (const bf16*)(ws + BG_RAW), AIN(I_MLHN));
        }
        GRID_BAR();
        PHASE();
        GEMM_RESID(layer == 3 ? ws + WS_HF : ws + BG_O, ws + LB() + SZIN(), ROWS_OUT(), 1024, HLAT(), HCTX(), HMID(), (float*)(ws + BG_SLAB), MODP() + 2048, 0, layer != 0, true);
        GRID_BAR();
        PHASE();
        norm_phase<false>(F, HMID(), true, (float*)(ws + WS_HC), (const float*)(ws + BG_SLAB), layer == 3 ? 0 : 4, ROWS_OUT(), AIN(I_NFFN) + layer * 1024, MODP(), 3072, 4096, (bf16*)(ws + WS_XN), nullptr, nullptr, nullptr);
        GRID_BAR();
        PHASE();
        { pg8::Gemm g_{(const pg8::bf16_t*)(ws + WS_XN), (const pg8::bf16_t*)(ws + LB() + SZIN() + SZ_W1024), ROWS_OUT(), NUP, 1024}; SOrd S_; S_.init(ROWS_OUT(), NUP, F.G, bid);
          pg8::EpiConvAct E_{(pg8::bf16_t*)(ws + BG_ACT), (float*)(ws + BG_HALO), AIN(I_FCONV) + (size_t)layer * 3 * NUP, (LAS float*)(F.lds + XB_OFF)};
          pg8::gemm_phase<pg8::EpiConvAct, SOrd, true, true>(F.lds, g_, S_, E_, F.tid); }
        GRID_BAR();
        PHASE();
        { SOrd S_; S_.init(ML, 1024, F.G, bid); pg8::Unit u_;
          for (int i_ = 0; S_.next(i_, u_); ++i_) ffn_fixup(F, u_.pm, (const float*)(ws + BG_HALO), AIN(I_FCONV) + (size_t)layer * 3 * NUP, (bf16*)(ws + BG_ACT));
          asm volatile("s_waitcnt vmcnt(0)" ::: "memory"); __syncthreads(); }
        GEMM_RESID(ws + BG_ACT, ws + LB() + SZIN() + SZ_W1024 + SZ_UP, ROWS_OUT(), DFF, HMID(), (const float*)(ws + WS_HC), layer == 3 ? (void*)ap->out : HB_B(), (float*)(ws + BG_SLAB), MODP() + 5120, 0, true, layer != 3);
        GRID_BAR();
    }
}

extern "C" void kernel_launch(void* const* d_in, const int* in_sizes, int n_in, void* d_out, int out_size, void* d_ws, size_t ws_size, hipStream_t stream) {
    static int grid = 0;
    if (grid == 0) {
        if (n_in != 27 || out_size != ML * DM || ws_size < WS_END) { fprintf(stderr, "kernel_launch: unexpected shapes: n_in %d out %d ws %zu (need %zu)\n", n_in, out_size, ws_size, (size_t)WS_END); grid = -1; return; }
        int dev = 0, cus = 0;
        if (hipGetDevice(&dev) != hipSuccess || hipDeviceGetAttribute(&cus, hipDeviceAttributeMultiprocessorCount, dev) != hipSuccess) { grid = -1; return; }
        if (hipFuncSetAttribute((const void*)hybrid_fwd, hipFuncAttributeMaxDynamicSharedMemorySize, LDS_BYTES) != hipSuccess) { fprintf(stderr, "kernel_launch: hipFuncSetAttribute failed\n"); grid = -1; return; }
        int per_cu = 0;
        if (hipOccupancyMaxActiveBlocksPerMultiprocessor(&per_cu, (const void*)hybrid_fwd, NWAVES * 64, LDS_BYTES) != hipSuccess || per_cu < 1) { fprintf(stderr, "kernel_launch: occupancy query reports %d\n", per_cu); }
        (void)hipGetLastError();
        grid = cus;
    }
    if (grid < 0) return;
    if (hipMemsetAsync((char*)d_ws + WS_CTL, 0, CTL_ZERO_BYTES, stream) != hipSuccess) return;
    Args a{};
    for (int i = 0; i < 27; ++i) a.in[i] = (const float*)d_in[i];
    a.out = (float*)d_out; a.ws = (unsigned char*)d_ws;
    hipLaunchKernelGGL(hybrid_fwd, dim3(grid), dim3(NWAVES * 64), LDS_BYTES, stream, a);
}
```

```cpp
#include <hip/hip_runtime.h>
#include <cstdio>
#include <cstdint>
namespace pg8 {
#define PG8_LAS __attribute__((address_space(3)))
typedef unsigned short bf16_t;
typedef short bf16x8 __attribute__((ext_vector_type(8)));
typedef float f32x4 __attribute__((ext_vector_type(4)));
typedef unsigned u32x4 __attribute__((ext_vector_type(4)));
constexpr int BM = 256, BK = 64, HALF = 128, HTB = HALF * BK * 2  , STAGE_BYTES = 8 * HTB, NXCD = 8, WGM = 8;

__host__ __device__ __forceinline__ int lds_byte(int r, int c) { const int st = (r >> 4) * 2 + (c >> 5), rr = r & 15, cc = c & 31, ob = rr * 64 + cc * 2; return st * 1024 + (ob ^ (((ob >> 9) & 1) << 5)); }
__host__ __device__ __forceinline__ void stage_rc(int b, int& R, int& C) { const int st = b / 1024, sb = b % 1024, swz = sb ^ (((sb >> 9) & 1) << 5); R = (st >> 1) * 16 + swz / 64; C = (st & 1) * 32 + (swz % 64) / 2; }
__host__ __device__ __forceinline__ int perm32(int rho) { const int n = rho >> 4, i = rho & 15; return 8 * (i >> 2) + 4 * n + (i & 3); }

struct Unit { int pm, pn, ko, nt; };
struct Gemm { const bf16_t* A; const bf16_t* Bt; int M, N, K; };

struct StaticOrder {
    int nM, nN, nwg, G, c;
    __host__ __device__ __forceinline__ void init(int M, int N, int G_, int c_) { nM = M / BM; nN = N / BM; nwg = nM * nN; G = G_; c = c_; }
    __host__ __device__ __forceinline__ bool next(int i, Unit& u) const {
        const long L = (long)i * G + c; if (L >= nwg) return false;
        int wgid = (int)L; { const int q = nwg / NXCD, r = nwg % NXCD, xcd = wgid % NXCD, off = wgid / NXCD; wgid = (xcd < r ? xcd * (q + 1) : r * (q + 1) + (xcd - r) * q) + off; }
        const int nig = WGM * nN, gid = wgid / nig, fm = gid * WGM, gsz = (nM - fm) < WGM ? (nM - fm) : WGM;
        u.pm = fm + ((wgid % nig) % gsz); u.pn = (wgid % nig) / gsz; u.ko = 0; u.nt = 0; return true;
    }
    __device__ __forceinline__ void a_ready(const Unit&) const {}
    __device__ __forceinline__ void done(const Unit&) const {}
};

__device__ __forceinline__ unsigned cvt_pk_bf16(float lo, float hi) { typedef float f32x2cv_ __attribute__((ext_vector_type(2))); typedef __bf16 bf16x2cv_ __attribute__((ext_vector_type(2))); const f32x2cv_ v_ = {lo, hi}; const bf16x2cv_ b_ = __builtin_convertvector(v_, bf16x2cv_); return __builtin_bit_cast(unsigned, b_); }
typedef float f32x2 __attribute__((ext_vector_type(2)));
struct EpiStoreBf16 {
    static constexpr bool PERM = true, AFTER_DRAIN = false, PERMA = false;
    bf16_t* O; int ldc;
    __device__ __forceinline__ void operator()(const f32x4 (&acc)[2][2][4][2], const Unit& u, int wr, int wc, int fr, int fq) const {
        const int row0 = u.pm * BM + wr * 64 + fr, col0 = u.pn * BM + wc * 32 + 8 * fq;
#pragma unroll
        for (int ai = 0; ai < 2; ++ai)
#pragma unroll
            for (int m = 0; m < 4; ++m) { bf16_t* rowp = O + (size_t)(row0 + ai * HALF + m * 16) * ldc + col0;
#pragma unroll
                for (int bj = 0; bj < 2; ++bj) { const f32x4 v0 = acc[ai][bj][m][0], v1 = acc[ai][bj][m][1];
                    u32x4 w; w.x = cvt_pk_bf16(v0[0], v0[1]); w.y = cvt_pk_bf16(v0[2], v0[3]); w.z = cvt_pk_bf16(v1[0], v1[1]); w.w = cvt_pk_bf16(v1[2], v1[3]);
                    *(u32x4*)(rowp + bj * HALF) = w; } }
    }
};
struct CtxSplitOrder {
    StaticOrder lat; int nlat, nsub, G, c;
    __device__ __forceinline__ void init(int K, bool with_ctx, int G_, int c_) { lat.init(128 * BM, 1024, G_, c_); nlat = 128 * 4; nsub = with_ctx ? 16 * (K / 256) : 0; G = G_; c = c_; }
    __device__ __forceinline__ bool next(int i, Unit& u) const {
        const int L = i * G + c;
        if (L < nlat) return lat.next(i, u);
        const int s = L - nlat; if (s >= nsub) return false;
        u.pm = 128 + (s & 3); u.pn = (s >> 2) & 3; u.ko = (s >> 4) * 256; u.nt = 4; return true;
    }
    __device__ __forceinline__ void a_ready(const Unit&) const {}
    __device__ __forceinline__ void done(const Unit&) const {}
};
struct EpiResid {
    static constexpr bool PERM = true, AFTER_DRAIN = false, PERMA = false;
    const void* base_lat; const float* base_ctx; void* out_lat; float* out_ctx; const float* gate; int tile0; bool bin, bout;
    template <bool BIN, bool BOUT>
    __device__ __forceinline__ void body(const f32x4 (&acc)[2][2][4][2], const void* bp_, void* op_, const float* gp, int wr, int fr) const {
        f32x4 g[2][2];
#pragma unroll
        for (int bj = 0; bj < 2; ++bj)
#pragma unroll
            for (int n = 0; n < 2; ++n) g[bj][n] = *(const f32x4*)(gp + bj * HALF + n * 4);
        if constexpr (BIN) {
            u32x4 rb[8][2];
#define RB_LOAD(it_) do { _Pragma("unroll") for (int bj = 0; bj < 2; ++bj) rb[it_][bj] = *(const u32x4*)((const bf16_t*)bp_ + (size_t)(((it_) >> 2) * HALF + wr * 64 + ((it_) & 3) * 16 + fr) * 1024 + bj * HALF); } while (0)
            RB_LOAD(0); RB_LOAD(1); RB_LOAD(2); RB_LOAD(3); RB_LOAD(4);
#pragma unroll
            for (int it = 0; it < 8; ++it) { const int ai = it >> 2, m = it & 3; const size_t off = (size_t)(ai * HALF + wr * 64 + m * 16 + fr) * 1024;
#pragma unroll
                for (int bj = 0; bj < 2; ++bj) { const size_t o = off + bj * HALF; const u32x4 w = rb[it][bj];
                    const f32x4 b0 = (f32x4){__uint_as_float(w.x << 16), __uint_as_float(w.x & 0xffff0000u), __uint_as_float(w.y << 16), __uint_as_float(w.y & 0xffff0000u)};
                    const f32x4 b1 = (f32x4){__uint_as_float(w.z << 16), __uint_as_float(w.z & 0xffff0000u), __uint_as_float(w.w << 16), __uint_as_float(w.w & 0xffff0000u)};
                    const f32x4 r0 = b0 + g[bj][0] * acc[ai][bj][m][0], r1 = b1 + g[bj][1] * acc[ai][bj][m][1];
                    if (BOUT) { u32x4 w2; w2.x = cvt_pk_bf16(r0[0], r0[1]); w2.y = cvt_pk_bf16(r0[2], r0[3]); w2.z = cvt_pk_bf16(r1[0], r1[1]); w2.w = cvt_pk_bf16(r1[2], r1[3]); *(u32x4*)((bf16_t*)op_ + o) = w2; }
                    else { *(f32x4*)((float*)op_ + o) = r0; *(f32x4*)((float*)op_ + o + 4) = r1; } }
                if (it + 5 < 8) RB_LOAD(it + 5);
                __builtin_amdgcn_sched_barrier(0); }
#undef RB_LOAD
        } else {
#pragma unroll
            for (int ai = 0; ai < 2; ++ai)
#pragma unroll
                for (int m = 0; m < 4; ++m) { const size_t off = (size_t)(ai * HALF + wr * 64 + m * 16 + fr) * 1024;
#pragma unroll
                    for (int bj = 0; bj < 2; ++bj) { const size_t o = off + bj * HALF;
                        const f32x4 b0 = *(const f32x4*)((const float*)bp_ + o), b1 = *(const f32x4*)((const float*)bp_ + o + 4);
                        const f32x4 r0 = b0 + g[bj][0] * acc[ai][bj][m][0], r1 = b1 + g[bj][1] * acc[ai][bj][m][1];
                        if (BOUT) { u32x4 w2; w2.x = cvt_pk_bf16(r0[0], r0[1]); w2.y = cvt_pk_bf16(r0[2], r0[3]); w2.z = cvt_pk_bf16(r1[0], r1[1]); w2.w = cvt_pk_bf16(r1[2], r1[3]); *(u32x4*)((bf16_t*)op_ + o) = w2; }
                        else { *(f32x4*)((float*)op_ + o) = r0; *(f32x4*)((float*)op_ + o + 4) = r1; } }
                    asm volatile("" ::: "memory"); }
        }
    }
    __device__ __forceinline__ void operator()(const f32x4 (&acc)[2][2][4][2], const Unit& u, int wr, int wc, int fr, int fq) const {
        asm volatile("" : "+v"(fr), "+v"(fq));
        const int tile = tile0 + u.pm; const bool lat = tile < 128; const int mb = lat ? (tile >> 5) : 4;
        const int col0 = u.pn * BM + wc * 32 + 8 * fq;
        const size_t toff = (lat ? (size_t)tile : (size_t)(tile - 128)) * (256 * 1024) + col0;
        const float* gp = gate + mb * 6144 + col0;
        if (!lat) {
            f32x4 g[2][2];
#pragma unroll
            for (int bj = 0; bj < 2; ++bj)
#pragma unroll
                for (int n = 0; n < 2; ++n) g[bj][n] = *(const f32x4*)(gp + bj * HALF + n * 4);
            float* op = out_ctx + (size_t)(u.ko >> 8) * (1024 * 1024) + toff;
#pragma unroll
            for (int ai = 0; ai < 2; ++ai)
#pragma unroll
                for (int m = 0; m < 4; ++m) { const size_t off = (size_t)(ai * HALF + wr * 64 + m * 16 + fr) * 1024;
#pragma unroll
                    for (int bj = 0; bj < 2; ++bj)
#pragma unroll
                        for (int n = 0; n < 2; ++n) *(f32x4*)(op + off + bj * HALF + n * 4) = g[bj][n] * acc[ai][bj][m][n]; }
        }
        else if (bin && bout) body<true, true>(acc, (const bf16_t*)base_lat + toff, (bf16_t*)out_lat + toff, gp, wr, fr);
        else if (bout) body<false, true>(acc, (const float*)base_lat + toff, (bf16_t*)out_lat + toff, gp, wr, fr);
        else body<true, false>(acc, (const bf16_t*)base_lat + toff, (float*)out_lat + toff, gp, wr, fr);
    }
};
struct EpiConvAct {
    static constexpr bool PERM = true, AFTER_DRAIN = false, PERMA = true;
    bf16_t* ACT; float* HALO; const float* cw; PG8_LAS float* XB;
    __device__ __forceinline__ void operator()(const f32x4 (&acc)[2][2][4][2], const Unit& u, int wr, int wc, int fr, int fq) const {
        { int l_; asm volatile("v_mbcnt_lo_u32_b32 %0, -1, 0\n\tv_mbcnt_hi_u32_b32 %0, -1, %0" : "=v"(l_)); fr = l_ & 15; fq = l_ >> 4; }
        const int lane = fq * 16 + fr, cloc = wc * 32 + 8 * fq;
        const int chan = u.pn * 128 + cloc;
        f32x4 w[2][3][2];
#pragma unroll
        for (int n = 0; n < 2; ++n)
#pragma unroll
            for (int t = 0; t < 3; ++t)
#pragma unroll
                for (int bj = 0; bj < 2; ++bj) w[n][t][bj] = *(const f32x4*)(cw + t * 5632 + bj * 2816 + chan + 4 * n) * (bj == 0 ? -1.4426950408889634f : -0.6931471805599453f);
#pragma unroll
        for (int ai = 0; ai < 2; ++ai) { const int k = 2 * ai + wr;
            if (fr == 0 || fr == 15) { const int slot = 2 * k + (fr == 15 ? 1 : 0), m = fr == 15 ? 3 : 0;
#pragma unroll
                for (int bj = 0; bj < 2; ++bj)
#pragma unroll
                    for (int n = 0; n < 2; ++n) *(PG8_LAS f32x4*)(XB + slot * 256 + bj * 128 + cloc + 4 * n) = (m == 0) ? acc[ai][bj][0][n] : acc[ai][bj][3][n]; } }
        if ((wr == 0 && fr == 0) || (wr == 1 && fr == 15)) { float* hp = HALO + ((size_t)u.pm * 4 + (wr == 0 ? 0 : 2)) * 5632 + chan;
#pragma unroll
            for (int bj = 0; bj < 2; ++bj)
#pragma unroll
                for (int n = 0; n < 2; ++n) { *(f32x4*)(hp + bj * 2816 + 4 * n) = (wr == 0) ? acc[0][bj][0][n] : acc[1][bj][2][n]; *(f32x4*)(hp + 5632 + bj * 2816 + 4 * n) = (wr == 0) ? acc[0][bj][1][n] : acc[1][bj][3][n]; } }
        asm volatile("s_waitcnt lgkmcnt(0)" ::: "memory"); __builtin_amdgcn_s_barrier(); asm volatile("" ::: "memory");
        const int ldn = ((lane & 48) | ((fr + 15) & 15)) << 2, lup = ((lane & 48) | ((fr + 1) & 15)) << 2;
#pragma unroll
        for (int ai = 0; ai < 2; ++ai) { const int k = 2 * ai + wr;
#pragma unroll
            for (int m = 0; m < 4; ++m) {
                u32x4 o;
#pragma unroll
                for (int n = 0; n < 2; ++n) {
                    f32x4 y[2];
#pragma unroll
                    for (int bj = 0; bj < 2; ++bj) {
                        const f32x4 x = acc[ai][bj][m][n];
                        f32x4 prev, next;
                        if (m > 0) prev = acc[ai][bj][m > 0 ? m - 1 : 0][n];
                        else { const f32x4 t3 = acc[ai][bj][3][n];
#pragma unroll
                            for (int e = 0; e < 4; ++e) prev[e] = __int_as_float(__builtin_amdgcn_ds_bpermute(ldn, __float_as_int(t3[e])));
                            f32x4 xb = (f32x4){0.f, 0.f, 0.f, 0.f}; if (k > 0) xb = *(const PG8_LAS f32x4*)(XB + (2 * k - 1) * 256 + bj * 128 + cloc + 4 * n); if (fr == 0) prev = xb; }
                        if (m < 3) next = acc[ai][bj][m < 3 ? m + 1 : 3][n];
                        else { const f32x4 t0 = acc[ai][bj][0][n];
#pragma unroll
                            for (int e = 0; e < 4; ++e) next[e] = __int_as_float(__builtin_amdgcn_ds_bpermute(lup, __float_as_int(t0[e])));
                            f32x4 xb = (f32x4){0.f, 0.f, 0.f, 0.f}; if (k < 3) xb = *(const PG8_LAS f32x4*)(XB + (2 * k + 2) * 256 + bj * 128 + cloc + 4 * n); if (fr == 15) next = xb; }
                        y[bj] = w[n][0][bj] * prev + w[n][1][bj] * x + w[n][2][bj] * next;
                    }
                    float a[4];
#pragma unroll
                    for (int e = 0; e < 4; ++e) a[e] = y[0][e] * __builtin_amdgcn_rcpf(1.f + __builtin_amdgcn_exp2f(y[0][e])) * y[1][e];
                    if (n == 0) { o.x = cvt_pk_bf16(a[0], a[1]); o.y = cvt_pk_bf16(a[2], a[3]); } else { o.z = cvt_pk_bf16(a[0], a[1]); o.w = cvt_pk_bf16(a[2], a[3]); }
                }
                *(u32x4*)(ACT + (size_t)(u.pm * BM + ai * HALF + wr * 64 + fr * 4 + m) * 2816 + chan) = o;
                __builtin_amdgcn_sched_barrier(0);
            }
        }
    }
};
template <class Epi, class Sched, bool ALIGN_EPI = false, bool SP2 = false>
__device__ __forceinline__ void gemm_phase(PG8_LAS unsigned char* lds, const Gemm g, const Sched& S, const Epi& E, const int tid) {
    const int wid = __builtin_amdgcn_readfirstlane(tid >> 6), lane = tid & 63, wr = wid >> 2, wc = wid & 3, fr = lane & 15, fq = lane >> 4;
    const int K = g.K;
    unsigned voffA[2], voffB[2];
#pragma unroll
    for (int i = 0; i < 2; ++i) { int R, C; stage_rc(tid * 16 + i * 8192, R, C); const int Rb = Epi::PERM ? ((R & ~31) + perm32(R & 31)) : R;
        const int Ra = Epi::PERMA ? ((R & ~63) + ((R & 15) << 2) + ((R >> 4) & 3)) : R;
        voffA[i] = (unsigned)(Ra * K + C) * 2u; voffB[i] = (unsigned)(Rb * K + C) * 2u; }
    const size_t kstep = (size_t)(BK * 2);
    const size_t hstep = (size_t)HALF * K * 2;
    const size_t tstep = 2 * hstep;
    const unsigned ldsw = (unsigned)wid * 1024u;
    const int aoff = lds_byte(wr * 64 + fr, fq * 8), boff = lds_byte(wc * 32 + fr, fq * 8);
#define PG8_SA(b, h) (((b) * 2 + (h)) * HTB)
#define PG8_SB(b, h) ((4 + (b) * 2 + (h)) * HTB)
#define PG8_STAGE(bufoff, gbase, voff) do { _Pragma("unroll") for (int _i = 0; _i < 2; ++_i) \
        __builtin_amdgcn_global_load_lds((const unsigned*)((const char*)(gbase) + (voff)[_i]), (PG8_LAS unsigned*)(lds + (bufoff) + ldsw + _i * 8192), 16, 0, 0); } while (0)
#define PG8_LDA(dst, b, h) do { _Pragma("unroll") for (int m = 0; m < 4; ++m) _Pragma("unroll") for (int k = 0; k < 2; ++k) dst[m][k] = *(const PG8_LAS bf16x8*)(lds + PG8_SA(b, h) + aoff + m * 2048 + k * 1024); } while (0)
#define PG8_LDB(dst, b, h) do { _Pragma("unroll") for (int n = 0; n < 2; ++n) _Pragma("unroll") for (int k = 0; k < 2; ++k) dst[n][k] = *(const PG8_LAS bf16x8*)(lds + PG8_SB(b, h) + boff + n * 2048 + k * 1024); } while (0)
#define PG8_MMA(ai, bj, At, Bt) do { __builtin_amdgcn_s_setprio(1); _Pragma("unroll") for (int m = 0; m < 4; ++m) _Pragma("unroll") for (int n = 0; n < 2; ++n) _Pragma("unroll") for (int k = 0; k < 2; ++k) \
        acc[ai][bj][m][n] = __builtin_amdgcn_mfma_f32_16x16x32_bf16(Bt[n][k], At[m][k], acc[ai][bj][m][n], 0, 0, 0); __builtin_amdgcn_s_setprio(0); } while (0)
#define PG8_WAIT_V(n) asm volatile("s_waitcnt vmcnt(" #n ")" ::: "memory")
#define PG8_WAIT_L(n) asm volatile("s_waitcnt lgkmcnt(" #n ")" ::: "memory")
#define PG8_BAR __builtin_amdgcn_s_barrier()
#define PG8_SCHED __builtin_amdgcn_sched_barrier(0)
    Unit cur, nxt; int ui = 0;
    if (!S.next(0, cur)) return;
    f32x4 acc[2][2][4][2];
#pragma unroll
    for (int a = 0; a < 2; ++a)
#pragma unroll
        for (int b = 0; b < 2; ++b)
#pragma unroll
            for (int m = 0; m < 4; ++m)
#pragma unroll
                for (int n = 0; n < 2; ++n) acc[a][b][m][n] = (f32x4){0.f, 0.f, 0.f, 0.f};
    bf16x8 At[4][2], B0[2][2], B1[2][2];
    const char* cA = (const char*)g.A + (size_t)cur.pm * tstep + (size_t)cur.ko * 2; const char* cB = (const char*)g.Bt + (size_t)cur.pn * tstep + (size_t)cur.ko * 2;
    S.a_ready(cur);
    if constexpr (SP2) {
        PG8_STAGE(PG8_SB(0, 0), cB, voffB); PG8_STAGE(PG8_SB(0, 1), cB + hstep, voffB); PG8_STAGE(PG8_SA(0, 0), cA, voffA); PG8_STAGE(PG8_SA(0, 1), cA + hstep, voffA);
        if (wr == 1) PG8_BAR;
        PG8_WAIT_V(2); PG8_BAR;
        PG8_STAGE(PG8_SB(1, 0), cB + kstep, voffB); PG8_STAGE(PG8_SA(1, 0), cA + kstep, voffA); PG8_STAGE(PG8_SB(1, 1), cB + hstep + kstep, voffB);
        PG8_WAIT_V(6); PG8_BAR;
    } else {
        PG8_STAGE(PG8_SB(0, 0), cB, voffB); PG8_STAGE(PG8_SA(0, 0), cA, voffA); PG8_STAGE(PG8_SB(0, 1), cB + hstep, voffB); PG8_STAGE(PG8_SA(0, 1), cA + hstep, voffA);
        if (wr == 1) PG8_BAR;
        PG8_WAIT_V(4); PG8_BAR;
        PG8_STAGE(PG8_SB(1, 0), cB + kstep, voffB); PG8_STAGE(PG8_SA(1, 0), cA + kstep, voffA); PG8_STAGE(PG8_SB(1, 1), cB + hstep + kstep, voffB);
        PG8_WAIT_V(6); PG8_BAR;
    }
    for (;;) {
        const bool has_next = S.next(ui + 1, nxt);
        const char* nA = has_next ? (const char*)g.A + (size_t)nxt.pm * tstep + (size_t)nxt.ko * 2 : cA; const char* nB = has_next ? (const char*)g.Bt + (size_t)nxt.pn * tstep + (size_t)nxt.ko * 2 : cB;
        const int nt = cur.nt ? cur.nt : K / BK;
        for (int t = 0; t < nt; t += 2) {
            const bool last = (t == nt - 2);
            const char* a1 = cA + (size_t)(t + 1) * kstep;
            const char* a2 = last ? nA : cA + (size_t)(t + 2) * kstep; const char* b2 = last ? nB : cB + (size_t)(t + 2) * kstep;
            const char* a3 = a2 + kstep; const char* b3 = b2 + kstep;
            if (last && has_next) S.a_ready(nxt);
            if constexpr (SP2) {
            PG8_LDB(B0, 0, 0); PG8_LDB(B1, 0, 1); PG8_SCHED; PG8_LDA(At, 0, 0); PG8_STAGE(PG8_SA(1, 1), a1 + hstep, voffA);
            PG8_WAIT_V(8); PG8_WAIT_L(0); PG8_BAR; PG8_MMA(0, 0, At, B0); PG8_MMA(0, 1, At, B1); PG8_BAR; PG8_SCHED;
            PG8_LDA(At, 0, 1); PG8_STAGE(PG8_SB(0, 0), b2, voffB); PG8_STAGE(PG8_SB(0, 1), b2 + hstep, voffB); PG8_STAGE(PG8_SA(0, 0), a2, voffA);
            PG8_WAIT_V(8); PG8_WAIT_L(0); PG8_BAR; PG8_MMA(1, 0, At, B0); PG8_MMA(1, 1, At, B1); PG8_BAR; PG8_SCHED;
            PG8_LDB(B0, 1, 0); PG8_LDB(B1, 1, 1); PG8_SCHED; PG8_LDA(At, 1, 0); PG8_STAGE(PG8_SA(0, 1), a2 + hstep, voffA);
            PG8_WAIT_V(8); PG8_WAIT_L(0); PG8_BAR; PG8_MMA(0, 0, At, B0); PG8_MMA(0, 1, At, B1); PG8_BAR; PG8_SCHED;
            PG8_LDA(At, 1, 1); PG8_STAGE(PG8_SB(1, 0), b3, voffB); PG8_STAGE(PG8_SB(1, 1), b3 + hstep, voffB); PG8_STAGE(PG8_SA(1, 0), a3, voffA);
            PG8_WAIT_V(8); PG8_WAIT_L(0); PG8_BAR; PG8_MMA(1, 0, At, B0); PG8_MMA(1, 1, At, B1); PG8_BAR; PG8_SCHED;
            } else {
            PG8_LDB(B0, 0, 0); PG8_SCHED; PG8_LDA(At, 0, 0); PG8_STAGE(PG8_SA(1, 1), a1 + hstep, voffA);
            PG8_WAIT_L(8); PG8_BAR; PG8_WAIT_L(0); PG8_MMA(0, 0, At, B0); PG8_BAR; PG8_SCHED;
            PG8_LDB(B1, 0, 1); PG8_STAGE(PG8_SB(0, 0), b2, voffB);
            PG8_BAR; PG8_WAIT_L(0); PG8_MMA(0, 1, At, B1); PG8_BAR;
            PG8_LDA(At, 0, 1); PG8_STAGE(PG8_SA(0, 0), a2, voffA);
            PG8_BAR; PG8_WAIT_L(0); PG8_MMA(1, 0, At, B0); PG8_BAR; PG8_SCHED;
            PG8_STAGE(PG8_SB(0, 1), b2 + hstep, voffB);
            PG8_WAIT_V(6); PG8_BAR; PG8_MMA(1, 1, At, B1); PG8_BAR;
            PG8_LDB(B0, 1, 0); PG8_SCHED; PG8_LDA(At, 1, 0); PG8_STAGE(PG8_SA(0, 1), a2 + hstep, voffA);
            PG8_WAIT_L(8); PG8_BAR; PG8_WAIT_L(0); PG8_MMA(0, 0, At, B0); PG8_BAR; PG8_SCHED;
            PG8_LDB(B1, 1, 1); PG8_STAGE(PG8_SB(1, 0), b3, voffB);
            PG8_BAR; PG8_WAIT_L(0); PG8_MMA(0, 1, At, B1); PG8_BAR;
            PG8_LDA(At, 1, 1); PG8_STAGE(PG8_SA(1, 0), a3, voffA);
            PG8_BAR; PG8_WAIT_L(0); PG8_MMA(1, 0, At, B0); PG8_BAR; PG8_SCHED;
            PG8_STAGE(PG8_SB(1, 1), b3 + hstep, voffB);
            PG8_WAIT_V(6); PG8_BAR; PG8_MMA(1, 1, At, B1); PG8_BAR;
            }
        }
        if constexpr (ALIGN_EPI) { if (wr == 0) PG8_BAR; }
        if constexpr (!Epi::AFTER_DRAIN) { E(acc, cur, wr, wc, fr, fq); S.done(cur); }
        if (!has_next) break;
#pragma unroll
        for (int a = 0; a < 2; ++a)
#pragma unroll
            for (int b = 0; b < 2; ++b)
#pragma unroll
                for (int m = 0; m < 4; ++m)
#pragma unroll
                    for (int n = 0; n < 2; ++n) acc[a][b][m][n] = (f32x4){0.f, 0.f, 0.f, 0.f};
        cur = nxt; cA = nA; cB = nB; ++ui;
        if constexpr (ALIGN_EPI) { if (wr == 1) PG8_BAR; }
    }
    PG8_WAIT_V(0);
    if constexpr (!ALIGN_EPI) { if (wr == 0) PG8_BAR; }
    PG8_BAR;
    if constexpr (Epi::AFTER_DRAIN) { E.fused(acc, cur, wr, wc, fr, fq, lds, wid, lane); S.done(cur); }
#undef PG8_SA
#undef PG8_SB
#undef PG8_STAGE
#undef PG8_LDA
#undef PG8_LDB
#undef PG8_MMA
#undef PG8_WAIT_V
#undef PG8_WAIT_L
#undef PG8_BAR
#undef PG8_SCHED
}
}

constexpr int DM = 1024, NB = 4, SEQ = 8192, CTXL = 256, ML = NB * SEQ, MC = NB * CTXL, MT = ML + MC;
constexpr int DFF = 2816, NUP = 2 * DFF;
constexpr float EPS = 1e-6f;
constexpr int NWAVES = 8;
constexpr float LOG2E = 1.4426950408889634f;

constexpr size_t MiB = 1u << 20;
constexpr size_t WS_CTL = 0, CTL_ZERO_BYTES = 64 * 1024;
constexpr int CW_BAR = 1024;
constexpr size_t WS_MOD = 1 * MiB;
constexpr size_t WS_ROPE64 = 1 * MiB + 512 * 1024;
constexpr size_t WS_ROPE128 = WS_ROPE64 + 16384;
constexpr size_t WS_HC = 2 * MiB;
constexpr size_t WS_WT = 6 * MiB;
constexpr size_t SZ_UP = (size_t)NUP * DM * 2, SZ_DOWN = (size_t)DM * DFF * 2, SZ_W1536 = 1536u * 1024 * 2, SZ_W1024 = 1024u * 1024 * 2, SZ_W3072 = 3072u * 1024 * 2;
constexpr size_t SZ_LA = SZ_W1536 + SZ_W1024 + SZ_UP + SZ_DOWN, SZ_LB = SZ_W3072 + SZ_W1024 + SZ_UP + SZ_DOWN;
constexpr size_t WT_L0 = WS_WT, WT_L1 = WT_L0 + SZ_LA, WT_L2 = WT_L1 + SZ_LB, WT_L3 = WT_L2 + SZ_LA, WT_END = WT_L3 + SZ_LB;
static_assert(WT_END <= 98 * MiB, "weights");
constexpr size_t WS_XN = 98 * MiB;
constexpr size_t WS_GATES = 164 * MiB;
constexpr size_t WS_BIG = 168 * MiB;
constexpr size_t WS_END = 512 * MiB;
constexpr size_t BG_RAW = WS_BIG, BG_Q = WS_BIG + 100 * MiB, BG_K = WS_BIG + 166 * MiB, BG_V = WS_BIG + 183 * MiB, BG_O = WS_BIG + 200 * MiB;
constexpr size_t BG_CBAR = WS_BIG + 200 * MiB, BG_NBAR = WS_BIG + 332 * MiB, BG_MSC = WS_BIG + 334 * MiB;
constexpr size_t WS_HF = WS_XN, WS_HB = WS_WT;
static_assert((size_t)ML * 1024 * 2 <= WT_L3 - WS_WT, "HB fits below layer 3's weights");
constexpr size_t BG_ACT = WS_BIG, BG_HALO = WS_BIG + 184 * MiB;
constexpr size_t BG_SLAB = WS_BIG + 270 * MiB;
constexpr int XB_OFF = 135168;
constexpr int ML_NUID = 32 * 66;

constexpr int RING_BYTES = 131072, LDSCTL_OFF = RING_BYTES, MISC_OFF = LDSCTL_OFF + 320, LDS_BYTES = 147456;
#define GAS __attribute__((address_space(1)))
#define LAS __attribute__((address_space(3)))
typedef unsigned short bf16;
typedef unsigned v4u __attribute__((ext_vector_type(4)));
typedef float f32x4 __attribute__((ext_vector_type(4)));
typedef short bf16x8 __attribute__((ext_vector_type(8)));
typedef GAS unsigned gu32;
typedef GAS unsigned long long gu64;
#define RLX_AGENT __ATOMIC_RELAXED, __HIP_MEMORY_SCOPE_AGENT
#define LDS_WAIT() asm volatile("s_waitcnt lgkmcnt(0)" ::: "memory")
#define VM_WAIT() asm volatile("s_waitcnt vmcnt(0)" ::: "memory")
__device__ __forceinline__ unsigned long long rt() { return __builtin_amdgcn_s_memrealtime(); }
__device__ __forceinline__ unsigned f2bf(float f) { unsigned u = __builtin_bit_cast(unsigned, f); return (u + 0x7fffu + ((u >> 16) & 1u)) >> 16; }
__device__ __forceinline__ unsigned pk2(float lo, float hi) { return f2bf(lo) | (f2bf(hi) << 16); }

#define XB_TMO      128
#define XB_XCNT(j)  (256  + 64 * (j))
#define XB_XSUB(j)  (1280 + 64 * (j))
#define XB_XGEN(j)  (2304 + 64 * (j))
#define XB_TOP      3328
#define XB_TOPGEN   3392
#define XCD_BAR_WORDS 3456
#define XB_SPIN_CAP (1u << 18)

__device__ __forceinline__ unsigned xb_ld(unsigned* p)              { return __hip_atomic_load(p, __ATOMIC_RELAXED, __HIP_MEMORY_SCOPE_AGENT); }
__device__ __forceinline__ unsigned xb_add(unsigned* p, unsigned v) { return __hip_atomic_fetch_add(p, v, __ATOMIC_RELAXED, __HIP_MEMORY_SCOPE_AGENT); }
__device__ __forceinline__ unsigned xb_xcc_id() { return (unsigned)__builtin_amdgcn_s_getreg((3 << 11) | 20) & 0xFu; }
#define XB_SPIN(cond, bar) do { unsigned _sp = 0; while (cond) { __builtin_amdgcn_s_sleep(1); \
    if ((++_sp & 255u) == 0u) { if (xb_ld(&(bar)[XB_TMO])) break; if (_sp > XB_SPIN_CAP) { atomicAdd(&(bar)[XB_TMO], 1u); break; } } } } while (0)

struct XcdBarrier {
    unsigned* bar; unsigned x;
    volatile LAS unsigned* st;
};

__device__ __forceinline__ int xb_lane() { int l_; asm volatile("v_mbcnt_lo_u32_b32 %0, -1, 0\n\tv_mbcnt_hi_u32_b32 %0, -1, %0" : "=v"(l_)); return l_; }
__device__ __forceinline__ XcdBarrier xcd_barrier_post(unsigned* bar, volatile LAS unsigned* st, int wave) {
    XcdBarrier b; b.bar = bar; b.x = xb_xcc_id(); b.st = st;
    if (wave == 0 && xb_lane() == 0) (void)xb_add(&bar[XB_XCNT(b.x)], 1u);
    return b;
}
__device__ __forceinline__ void xcd_barrier_complete(unsigned* bar, unsigned x, unsigned& nloc, unsigned& nx) {
    const unsigned G = gridDim.x * gridDim.y * gridDim.z;
    unsigned sum, cnt, mine, sp = 0u;
    for (;;) {
        sum = 0u; cnt = 0u; mine = 0u;
#pragma nounroll
        for (unsigned j = 0; j < 16; ++j) { const unsigned c = xb_ld(&bar[XB_XCNT(j)]); sum += c; cnt += (c > 0u) ? 1u : 0u; mine = (j == x) ? c : mine; }
        if (sum == G) break;
        __builtin_amdgcn_s_sleep(1);
        if ((++sp & 255u) == 0u) { if (xb_ld(&bar[XB_TMO])) break; if (sp > XB_SPIN_CAP) { atomicAdd(&bar[XB_TMO], 1u); break; } }
    }
    nloc = mine > 0u ? mine : 1u; nx = cnt > 0u ? cnt : 1u;
}

__device__ __forceinline__ void xcd_barrier(const XcdBarrier& b, int wave  ) {
    asm volatile("s_waitcnt vmcnt(0)" ::: "memory");
    __syncthreads();
    if (wave == 0 && xb_lane() == 0) {
        unsigned* bar = b.bar;
        __builtin_amdgcn_s_waitcnt(0);
        unsigned nloc = b.st[0], nx = b.st[1];
        if (nloc == 0u) { xcd_barrier_complete(bar, b.x, nloc, nx); b.st[0] = nloc; b.st[1] = nx; }
        const unsigned old = xb_add(&bar[XB_XSUB(b.x)], 1u);
        const unsigned gen = old / nloc;
        if (old + 1u == (gen + 1u) * nloc) {
            __builtin_amdgcn_fence(__ATOMIC_RELEASE, "agent");
            asm volatile("s_waitcnt vmcnt(0)" ::: "memory");
            const unsigned og = xb_add(&bar[XB_TOP], 1u);
            const unsigned tg = og / nx;
            if (og + 1u == (tg + 1u) * nx) xb_add(&bar[XB_TOPGEN], 1u);
            else XB_SPIN(xb_ld(&bar[XB_TOPGEN]) == tg, bar);
            __builtin_amdgcn_fence(__ATOMIC_ACQUIRE, "agent");
            xb_add(&bar[XB_XGEN(b.x)], 1u);
            asm volatile("s_waitcnt vmcnt(0)" ::: "memory");
        } else {
            XB_SPIN(xb_ld(&bar[XB_XGEN(b.x)]) == gen, bar);
            __builtin_amdgcn_fence(__ATOMIC_ACQUIRE, "agent");
            asm volatile("s_waitcnt vmcnt(0)" ::: "memory");
        }
    }
    __syncthreads();
}

typedef unsigned u32x2 __attribute__((ext_vector_type(2)));
struct Frame { LAS unsigned char* lds; int tid, lane, wave, G, gw, ngw; };

__device__ __forceinline__ float bperm(float v, int srclane) { return __int_as_float(__builtin_amdgcn_ds_bpermute(srclane << 2, __float_as_int(v))); }
#define DPP_ADD(v, ctrl) ((v) + __int_as_float(__builtin_amdgcn_update_dpp(0, __float_as_int(v), (ctrl), 0xf, 0xf, true)))
__device__ __forceinline__ float row_sum16(float v) {
    v = DPP_ADD(v, 0xB1); v = DPP_ADD(v, 0x4E); v = DPP_ADD(v, 0x141); v = DPP_ADD(v, 0x140); return v;
}
__device__ __forceinline__ float wave_sum(float v, int lane) {
    v = row_sum16(v);
    const float a = __int_as_float(__builtin_amdgcn_readlane(__float_as_int(v), 0)), b = __int_as_float(__builtin_amdgcn_readlane(__float_as_int(v), 16));
    const float c = __int_as_float(__builtin_amdgcn_readlane(__float_as_int(v), 32)), d = __int_as_float(__builtin_amdgcn_readlane(__float_as_int(v), 48));
    return (a + b) + (c + d);
}
__device__ __forceinline__ float wave_max(float v, int lane) {
#pragma unroll
    for (int o = 1; o < 64; o <<= 1) v = fmaxf(v, bperm(v, lane ^ o));
    return v;
}
__device__ __forceinline__ float bf2f(unsigned short x) { return __uint_as_float((unsigned)x << 16); }
__device__ __forceinline__ float bflo(unsigned w) { return __uint_as_float(w << 16); }
__device__ __forceinline__ float bfhi(unsigned w) { return __uint_as_float(w & 0xffff0000u); }
__device__ __forceinline__ unsigned cvtpk2(float lo, float hi) { unsigned r; asm volatile("v_cvt_pk_bf16_f32 %0, %1, %2" : "=v"(r) : "v"(lo), "v"(hi)); return r; }
__device__ __forceinline__ unsigned short f2bf16_mfma(float f) { const __bf16 b = (__bf16)f; return __builtin_bit_cast(unsigned short, b); }
__device__ __forceinline__ unsigned short f2bf16(float f) { return (unsigned short)(cvtpk2(f, 0.f) & 0xffffu); }
__device__ __forceinline__ void unpack8(const v4u w, float (&f)[8]) { f[0] = bflo(w.x); f[1] = bfhi(w.x); f[2] = bflo(w.y); f[3] = bfhi(w.y); f[4] = bflo(w.z); f[5] = bfhi(w.z); f[6] = bflo(w.w); f[7] = bfhi(w.w); }
__device__ __forceinline__ v4u pack8(const float (&f)[8]) { v4u w; w.x = cvtpk2(f[0], f[1]); w.y = cvtpk2(f[2], f[3]); w.z = cvtpk2(f[4], f[5]); w.w = cvtpk2(f[6], f[7]); return w; }
__device__ __forceinline__ float sigmoidf_(float x) { return __builtin_amdgcn_rcpf(1.f + __builtin_amdgcn_exp2f(-1.4426950408889634f * x)); }

__device__ __forceinline__ void p0_transpose_item(const float* W, int K, int pitch, int nblk, bf16* WT, LAS float* scr, int item, int lane, bool upperm) {
    const int kb = item / nblk, nb = item % nblk, k0 = 64 * kb, n0 = 32 * nb;
    int d0 = n0; if (upperm) { const int c = n0 < DFF ? n0 : n0 - DFF; d0 = 256 * (c >> 7) + (c & 127) + (n0 < DFF ? 0 : 128); }
    float wv[32];
#pragma unroll
    for (int i = 0; i < 32; ++i) { const int kk = 2 * i + (lane >> 5); wv[i] = W[(size_t)(k0 + kk) * pitch + n0 + (lane & 31)]; }
#pragma unroll
    for (int i = 0; i < 32; ++i) { const int kk = 2 * i + (lane >> 5); scr[kk * 33 + (lane & 31)] = wv[i]; }
    LDS_WAIT(); asm volatile("" ::: "memory");
    const int c = lane & 7;
#pragma unroll
    for (int j = 0; j < 4; ++j) { const int n = (lane >> 3) + 8 * j; const LAS float* s = scr + (8 * c) * 33 + n;
        v4u o; o.x = pk2(s[0 * 33], s[1 * 33]); o.y = pk2(s[2 * 33], s[3 * 33]); o.z = pk2(s[4 * 33], s[5 * 33]); o.w = pk2(s[6 * 33], s[7 * 33]);
        *(v4u*)(WT + (size_t)(d0 + n) * K + k0 + 8 * c) = o; }
    LDS_WAIT(); asm volatile("" ::: "memory");
}
__device__ __forceinline__ void transpose_matrix(const Frame& F, const float* W, int K, int pitch, int Nused, bf16* WT, int& rot, bool upperm = false) {
    const int nblk = Nused / 32, nitems = (K / 64) * nblk;
    LAS float* scr = (LAS float*)(F.lds + F.wave * 16384);
    int first = (F.gw - rot) % F.ngw; if (first < 0) first += F.ngw;
    for (int it = first; it < nitems; it += F.ngw) p0_transpose_item(W, K, pitch, nblk, WT, scr, it, F.lane, upperm);
    rot = (rot + nitems) % F.ngw;
}
__device__ __forceinline__ void mod_phase(const Frame& F, const float* c, const float* cctx, const float* ada_w, const float* ada_b, float* MOD) {
    LAS float* sc = (LAS float*)F.lds;
    LAS float* red = (LAS float*)(F.lds + 20480);
    { float cv[10];
#pragma unroll
      for (int i2 = 0; i2 < 10; ++i2) { const int i = F.tid + 512 * i2; cv[i2] = i < 4096 ? c[i] : cctx[i - 4096]; }
#pragma unroll
      for (int i2 = 0; i2 < 10; ++i2) sc[F.tid + 512 * i2] = cv[i2] / (1.f + expf(-cv[i2])); }
    __syncthreads();
    const int ks = F.tid >> 5, cn = F.tid & 31;
    for (int item = blockIdx.x; item < 768; item += F.G) {
        const int layer = item / 192, n0 = (item % 192) * 32;
        const float* wp = ada_w + (size_t)layer * 1024 * 6144 + (size_t)(ks * 64) * 6144 + n0 + cn;
        float a0 = 0.f, a1 = 0.f, a2 = 0.f, a3 = 0.f, a4 = 0.f;
#pragma unroll 32
        for (int k = 0; k < 64; ++k) { const float w = wp[(size_t)k * 6144]; const int kk = ks * 64 + k;
            a0 += w * sc[kk]; a1 += w * sc[1024 + kk]; a2 += w * sc[2048 + kk]; a3 += w * sc[3072 + kk]; a4 += w * sc[4096 + kk]; }
        LAS float* rp = red + (ks * 32 + cn) * 5; rp[0] = a0; rp[1] = a1; rp[2] = a2; rp[3] = a3; rp[4] = a4;
        __syncthreads();
        if (F.tid < 160) { const int cn2 = F.tid & 31, b = F.tid >> 5; float s = 0.f;
#pragma unroll
            for (int k2 = 0; k2 < 16; ++k2) s += red[(k2 * 32 + cn2) * 5 + b];
            MOD[(size_t)(layer * 5 + b) * 6144 + n0 + cn2] = s + ada_b[layer * 6144 + n0 + cn2]; }
        __syncthreads();
    }
}
__device__ __forceinline__ void rope_tables(const Frame& F, float* R64, float* R128) {
    for (int i = blockIdx.x * 512 + F.tid; i < 6144; i += F.G * 512) {
        int pos, f, nf; float* dst;
        if (i < 2048) { pos = i >> 4; f = i & 15; nf = 16; dst = R64 + 2 * i; } else { const int j = i - 2048; pos = j >> 5; f = j & 31; nf = 32; dst = R128 + 2 * j; }
        const float inv = powf(10000.f, -(float)f / (float)nf);
        const float ang = (float)pos * inv;
        dst[0] = cosf(ang); dst[1] = sinf(ang);
    }
}

#define NCOL(j) (8 * F.lane + 512 * ((j) >> 1) + 4 * ((j) & 1))
template <bool GATES, int RG>
__device__ __forceinline__ void norm_rows(const Frame& F, f32x4 (&v)[RG][4], int rbase, const f32x4 (&A)[4], const f32x4 (&Bv)[4], bf16* XN, const LAS float* WgT, const float* bgate, float* GATESb) {
#pragma unroll
    for (int q = 0; q < RG; ++q) {
        const int r = rbase + q; float ss = 0.f;
#pragma unroll
        for (int j = 0; j < 4; ++j) ss += (v[q][j].x * v[q][j].x + v[q][j].y * v[q][j].y) + (v[q][j].z * v[q][j].z + v[q][j].w * v[q][j].w);
        ss = wave_sum(ss, F.lane); const float rs = __builtin_amdgcn_rsqf(ss * (1.f / 1024.f) + EPS);
#pragma unroll
        for (int j = 0; j < 4; ++j) v[q][j] = v[q][j] * rs * A[j] + Bv[j];
#pragma unroll
        for (int i2 = 0; i2 < 2; ++i2) { v4u w; w.x = cvtpk2(v[q][2 * i2].x, v[q][2 * i2].y); w.y = cvtpk2(v[q][2 * i2].z, v[q][2 * i2].w); w.z = cvtpk2(v[q][2 * i2 + 1].x, v[q][2 * i2 + 1].y); w.w = cvtpk2(v[q][2 * i2 + 1].z, v[q][2 * i2 + 1].w);
            *(v4u*)(XN + (size_t)r * 1024 + 8 * F.lane + 512 * i2) = w; }
    }
    if (GATES) {
        float val[RG];
#pragma unroll
        for (int q = 0; q < RG; ++q) val[q] = 0.f;
#pragma unroll
        for (int jg = 0; jg < 16; ++jg) { f32x4 w[4];
#pragma unroll
            for (int j = 0; j < 4; ++j) w[j] = *(const LAS f32x4*)(WgT + jg * 1024 + NCOL(j));
#pragma unroll
            for (int q = 0; q < RG; ++q) { float s = 0.f;
#pragma unroll
                for (int j = 0; j < 4; ++j) s += (v[q][j].x * w[j].x + v[q][j].y * w[j].y) + (v[q][j].z * w[j].z + v[q][j].w * w[j].w);
                s = wave_sum(s, F.lane); val[q] = (F.lane == jg) ? s : val[q]; } }
        if (F.lane < 16) { const float bg = bgate[F.lane]; const int kind = F.lane >> 2;
#pragma unroll
            for (int q = 0; q < RG; ++q) { float x = val[q] + bg;
                if (kind & 1) x = fminf(x, 0.f) - 0.6931471805599453f * __builtin_amdgcn_logf(1.f + __builtin_amdgcn_exp2f(-1.4426950408889634f * fabsf(x)));
                GATESb[(size_t)(rbase + q) * 16 + F.lane] = x; } }
    }
}
template <bool GATES>
__device__ __forceinline__ void norm_phase(const Frame& F, const void* hlat, bool lat_bf16, float* hctx, const float* slab, int nslab, int nrows, const float* gain, const float* mod, int sh_off, int sc_off, bf16* XN,
                                           const float* wg_src, const float* bgate, float* GATESb) {
    LAS float* WgT = (LAS float*)F.lds;
    if (GATES) { float wv[32];
#pragma unroll
        for (int i2 = 0; i2 < 32; ++i2) wv[i2] = wg_src[(size_t)((F.tid >> 4) + 32 * i2) * 3088 + 3072 + (F.tid & 15)];
#pragma unroll
        for (int i2 = 0; i2 < 32; ++i2) WgT[(F.tid & 15) * 1024 + (F.tid >> 4) + 32 * i2] = wv[i2];
        __syncthreads(); }
    constexpr int RG = 4;
    const int nlat = ML / 16, nitems = nlat + (nrows > ML ? MC : 0);
    for (int it = F.gw; it < nitems; it += F.ngw) {
        const int r0 = it < nlat ? it * 16 : ML + (it - nlat), mb = r0 < ML ? (r0 >> 13) : 4;
        const bool pipe = r0 < ML && lat_bf16;
        const bf16* src = (const bf16*)hlat + (size_t)(pipe ? r0 : 0) * 1024 + 8 * F.lane;
        v4u raw[RG][2];
        if (pipe) {
#pragma unroll
            for (int q = 0; q < RG; ++q) { raw[q][0] = *(const v4u*)(src + q * 1024); raw[q][1] = *(const v4u*)(src + q * 1024 + 512); } }
        f32x4 A[4], Bv[4];
        { f32x4 g[4], s[4];
#pragma unroll
          for (int j = 0; j < 4; ++j) { const int col = NCOL(j); g[j] = *(const f32x4*)(gain + col); s[j] = *(const f32x4*)(mod + mb * 6144 + sc_off + col); Bv[j] = *(const f32x4*)(mod + mb * 6144 + sh_off + col); }
#pragma unroll
          for (int j = 0; j < 4; ++j) A[j] = g[j] * (1.f + s[j]); }
        if (pipe) {
#pragma nounroll
            for (int rr = 0; rr < 16; rr += RG) {
                f32x4 v[RG][4];
#pragma unroll
                for (int q = 0; q < RG; ++q)
#pragma unroll
                    for (int i2 = 0; i2 < 2; ++i2) { const v4u w = raw[q][i2];
                        v[q][2 * i2] = (f32x4){bflo(w.x), bfhi(w.x), bflo(w.y), bfhi(w.y)}; v[q][2 * i2 + 1] = (f32x4){bflo(w.z), bfhi(w.z), bflo(w.w), bfhi(w.w)}; }
                { const int rn = rr + RG < 16 ? rr + RG : rr;
#pragma unroll
                  for (int q = 0; q < RG; ++q) { raw[q][0] = *(const v4u*)(src + (size_t)(rn + q) * 1024); raw[q][1] = *(const v4u*)(src + (size_t)(rn + q) * 1024 + 512); } }
                norm_rows<GATES, RG>(F, v, r0 + rr, A, Bv, XN, WgT, bgate, GATESb);
            }
            continue;
        }
        if (r0 < ML) {
            for (int rr = 0; rr < 16; rr += RG) {
                f32x4 v[RG][4];
#pragma unroll
                for (int q = 0; q < RG; ++q) { const float* src = (const float*)hlat + (size_t)(r0 + rr + q) * 1024;
#pragma unroll
                    for (int j = 0; j < 4; ++j) v[q][j] = *(const f32x4*)(src + NCOL(j)); }
                norm_rows<GATES, RG>(F, v, r0 + rr, A, Bv, XN, WgT, bgate, GATESb);
            }
            continue;
        }
        { f32x4 v[1][4]; float* src = hctx + (size_t)(r0 - ML) * 1024;
#pragma unroll
          for (int j = 0; j < 4; ++j) v[0][j] = *(const f32x4*)(src + NCOL(j));
          if (nslab > 0) {
#pragma nounroll
              for (int s0 = 0; s0 < nslab; s0 += 4) { f32x4 sv[4][4];
#pragma unroll
                  for (int qq = 0; qq < 4; ++qq) { const int s = s0 + qq < nslab ? s0 + qq : nslab - 1; const float* sp = slab + ((size_t)s * 1024 + (r0 - ML)) * 1024;
#pragma unroll
                      for (int j = 0; j < 4; ++j) sv[qq][j] = *(const f32x4*)(sp + NCOL(j)); }
#pragma unroll
                  for (int qq = 0; qq < 4; ++qq) if (s0 + qq < nslab) {
#pragma unroll
                      for (int j = 0; j < 4; ++j) v[0][j] += sv[qq][j]; } }
#pragma unroll
              for (int j = 0; j < 4; ++j) *(f32x4*)(src + NCOL(j)) = v[0][j]; }
          norm_rows<GATES, 1>(F, v, r0, A, Bv, XN, WgT, bgate, GATESb); }
    }
}
#undef NCOL
template <int HD>
__device__ __forceinline__ void qk_head8(const v4u raw, const float (&g)[8], float qs, bool rope, const float (&cs)[8], const float (&sn)[8], int lane, v4u& out) {
    constexpr int LPH = HD / 8;
    float x[8]; unpack8(raw, x);
    float ss = 0.f;
#pragma unroll
    for (int e = 0; e < 8; ++e) ss += x[e] * x[e];
#pragma unroll
    for (int o = 1; o < LPH; o <<= 1) ss += bperm(ss, lane ^ o);
    const float rs = qs * __builtin_amdgcn_rsqf(ss * (1.f / HD) + EPS);
    float y[8], yp[8];
#pragma unroll
    for (int e = 0; e < 8; ++e) y[e] = x[e] * rs * g[e];
#pragma unroll
    for (int e = 0; e < 8; ++e) yp[e] = bperm(y[e], lane ^ (LPH / 2));
    const bool upper = (lane & (LPH / 2)) != 0;
    float o[8];
#pragma unroll
    for (int e = 0; e < 8; ++e) o[e] = rope ? (upper ? y[e] * cs[e] + yp[e] * sn[e] : y[e] * cs[e] - yp[e] * sn[e]) : y[e];
    out = pack8(o);
}
__device__ __forceinline__ void qknorm_rope64(const Frame& F, const bf16* RAW, const float* qn, const float* kn, const float* R64, bf16* Qp, bf16* Kp) {
    const int j = F.lane & 7, hq = F.lane >> 3;
    float gq[8], gk[8];
#pragma unroll
    for (int e = 0; e < 8; ++e) { gq[e] = qn[8 * j + e]; gk[e] = kn[8 * j + e]; }
    v4u rw[3]; f32x4 tw[4];
#define QK64_LOAD(r_) do { const bf16* s_ = RAW + (size_t)(r_) * 1536; _Pragma("unroll") for (int p = 0; p < 3; ++p) { const int hh = 8 * p + hq; if (hh < 20) rw[p] = *(const v4u*)(s_ + hh * 64 + 8 * j); } \
        const int t_ = (r_) & (SEQ - 1), pos_ = (j & 3) < 2 ? (t_ >> 6) : (t_ & 63); const float* tp_ = R64 + ((size_t)pos_ * 16 + 8 * (j & 1)) * 2; \
        _Pragma("unroll") for (int e2 = 0; e2 < 4; ++e2) tw[e2] = *(const f32x4*)(tp_ + 4 * e2); } while (0)
    int r = F.gw;
    if (r < MT) QK64_LOAD(r);
    for (; r < MT; r += F.ngw) {
        const bool rope = r < ML; float cs[8], sn[8];
        v4u cr[3];
#pragma unroll
        for (int p = 0; p < 3; ++p) cr[p] = rw[p];
#pragma unroll
        for (int e2 = 0; e2 < 4; ++e2) { const f32x4 w = rope ? tw[e2] : (f32x4){1.f, 0.f, 1.f, 0.f}; cs[2 * e2] = w.x; sn[2 * e2] = w.y; cs[2 * e2 + 1] = w.z; sn[2 * e2 + 1] = w.w; }
        { const int rn = r + F.ngw < MT ? r + F.ngw : r; QK64_LOAD(rn); }
#pragma unroll
        for (int p = 0; p < 3; ++p) { const int hh = 8 * p + hq;
            if (hh < 20) { const bool isq = hh < 16; v4u o; float g[8];
#pragma unroll
                for (int e = 0; e < 8; ++e) g[e] = isq ? gq[e] : gk[e];
                qk_head8<64>(cr[p], g, isq ? 0.18033688f : 1.f, rope, cs, sn, F.lane, o);
                *(v4u*)((isq ? Qp + (size_t)r * 1024 + hh * 64 : Kp + (size_t)r * 256 + (hh - 16) * 64) + 8 * j) = o; } }
    }
#undef QK64_LOAD
}
__device__ __forceinline__ void knorm_rope64(const Frame& F, const bf16* RAW, const float* kn, const float* R64, bf16* Kp) {
    float one = 1.f; asm volatile("" : "+v"(one));
    const int j = F.lane & 7, hk = (F.lane >> 3) & 3, half = F.lane >> 5;
    float gk[8];
#pragma unroll
    for (int e = 0; e < 8; ++e) gk[e] = kn[8 * j + e];
    v4u rw; f32x4 tw[4];
#define K64_LOAD(r_) do { rw = *(const v4u*)(RAW + (size_t)(r_) * 1536 + 1024 + hk * 64 + 8 * j); \
        const int t_ = (r_) & (SEQ - 1), pos_ = (j & 3) < 2 ? (t_ >> 6) : (t_ & 63); const float* tp_ = R64 + ((size_t)pos_ * 16 + 8 * (j & 1)) * 2; \
        _Pragma("unroll") for (int e2 = 0; e2 < 4; ++e2) tw[e2] = *(const f32x4*)(tp_ + 4 * e2); } while (0)
    int r = 2 * F.gw + half;
    if (r < MT) K64_LOAD(r);
    for (; r < MT; r += 2 * F.ngw) {
        const bool rope = r < ML; float cs[8], sn[8];
        const v4u cr = rw;
#pragma unroll
        for (int e2 = 0; e2 < 4; ++e2) { const f32x4 w = rope ? tw[e2] : (f32x4){one, 0.f, one, 0.f}; cs[2 * e2] = w.x; sn[2 * e2] = w.y; cs[2 * e2 + 1] = w.z; sn[2 * e2 + 1] = w.w; }
        { const int rn = r + 2 * F.ngw < MT ? r + 2 * F.ngw : r; K64_LOAD(rn); }
        v4u o; qk_head8<64>(cr, gk, 1.f, rope, cs, sn, F.lane, o);
        *(v4u*)(Kp + (size_t)r * 256 + hk * 64 + 8 * j) = o;
    }
#undef K64_LOAD
}
template <int HD, typename FR>
__device__ __forceinline__ void qnorm_rope_frag(FR (&qr)[HD / 16], const float* gq, const float* Rt, int t, bool rope, float qs, int lane) {
    constexpr int NB = HD / 16;
    const int hi = lane >> 5;
    float ss = 0.f;
#pragma unroll
    for (int d0 = 0; d0 < NB; ++d0) { float x[8]; unpack8(__builtin_bit_cast(v4u, qr[d0]), x);
#pragma unroll
        for (int e = 0; e < 8; ++e) ss += x[e] * x[e]; }
    ss += bperm(ss, lane ^ 32);
    const float rs = qs * __builtin_amdgcn_rsqf(ss * (1.f / HD) + EPS);
#pragma unroll
    for (int d0 = 0; d0 < NB / 2; ++d0) {
        float lo[8], up[8]; unpack8(__builtin_bit_cast(v4u, qr[d0]), lo); unpack8(__builtin_bit_cast(v4u, qr[d0 + NB / 2]), up);
        const float* gl = gq + d0 * 16 + hi * 8; const float* gu = gl + HD / 2;
        const f32x4 g0 = *(const f32x4*)gl, g1 = *(const f32x4*)(gl + 4), g2 = *(const f32x4*)gu, g3 = *(const f32x4*)(gu + 4);
#pragma unroll
        for (int e = 0; e < 8; ++e) { lo[e] = lo[e] * rs * (e < 4 ? g0[e & 3] : g1[e & 3]); up[e] = up[e] * rs * (e < 4 ? g2[e & 3] : g3[e & 3]); }
        if (rope) {
            const int a0 = d0 * 16 + hi * 8, pos = a0 < HD / 4 ? (t >> 6) : (t & 63), f0 = a0 < HD / 4 ? a0 : a0 - HD / 4;
            const float* tp = Rt + ((size_t)pos * (HD / 4) + f0) * 2;
#pragma unroll
            for (int e2 = 0; e2 < 4; ++e2) { const f32x4 w = *(const f32x4*)(tp + 4 * e2);
                const float l0 = lo[2 * e2], u0 = up[2 * e2], l1 = lo[2 * e2 + 1], u1 = up[2 * e2 + 1];
                lo[2 * e2] = l0 * w.x - u0 * w.y; up[2 * e2] = u0 * w.x + l0 * w.y; lo[2 * e2 + 1] = l1 * w.z - u1 * w.w; up[2 * e2 + 1] = u1 * w.z + l1 * w.w; } }
        qr[d0] = __builtin_bit_cast(FR, pack8(lo)); qr[d0 + NB / 2] = __builtin_bit_cast(FR, pack8(up));
    }
}
__device__ __forceinline__ void qknorm_rope128(const Frame& F, const bf16* RAW, const float* qn, const float* kn, const float* R128, bf16* Qp, bf16* K2, bf16* V2) {
    const int j = F.lane & 15, hq = F.lane >> 4;
    float gq[8], gk[8];
#pragma unroll
    for (int e = 0; e < 8; ++e) { gq[e] = qn[8 * j + e]; gk[e] = kn[8 * j + e]; }
    v4u rw[4]; f32x4 tw[4];
#define QK128_LOAD(r_) do { const bf16* s_ = RAW + (size_t)(r_) * 1536; _Pragma("unroll") for (int p = 0; p < 3; ++p) { const int hh = 4 * p + hq; if (hh < 10) rw[p] = *(const v4u*)(s_ + hh * 128 + 8 * j); } \
        rw[3] = *(const v4u*)(s_ + 1280 + 8 * (F.lane & 31)); \
        const int t_ = (r_) & (SEQ - 1), pos_ = (j & 7) < 4 ? (t_ >> 6) : (t_ & 63); const float* tp_ = R128 + ((size_t)pos_ * 32 + 8 * (j & 3)) * 2; \
        _Pragma("unroll") for (int e2 = 0; e2 < 4; ++e2) tw[e2] = *(const f32x4*)(tp_ + 4 * e2); } while (0)
    int r = F.gw;
    if (r < MT) QK128_LOAD(r);
    for (; r < MT; r += F.ngw) {
        const bool rope = r < ML; float cs[8], sn[8]; size_t kvrow;
        const int t = r & (SEQ - 1);
        if (rope) kvrow = (size_t)(r >> 13) * 8448 + t; else { const int rc = r - ML; kvrow = (size_t)(rc >> 8) * 8448 + 8192 + (rc & 255); }
        v4u cr[4];
#pragma unroll
        for (int p = 0; p < 4; ++p) cr[p] = rw[p];
#pragma unroll
        for (int e2 = 0; e2 < 4; ++e2) { const f32x4 w = rope ? tw[e2] : (f32x4){1.f, 0.f, 1.f, 0.f}; cs[2 * e2] = w.x; sn[2 * e2] = w.y; cs[2 * e2 + 1] = w.z; sn[2 * e2 + 1] = w.w; }
        { const int rn = r + F.ngw < MT ? r + F.ngw : r; QK128_LOAD(rn); }
#pragma unroll
        for (int p = 0; p < 3; ++p) { const int hh = 4 * p + hq;
            if (hh < 10) { const bool isq = hh < 8; v4u o; float g[8];
#pragma unroll
                for (int e = 0; e < 8; ++e) g[e] = isq ? gq[e] : gk[e];
                qk_head8<128>(cr[p], g, isq ? 0.12751743f : 1.f, rope, cs, sn, F.lane, o);
                *(v4u*)((isq ? Qp + (size_t)r * 1024 + hh * 128 : K2 + kvrow * 256 + (hh - 8) * 128) + 8 * j) = o; } }
        if (F.lane < 32) *(v4u*)(V2 + kvrow * 256 + 8 * F.lane) = cr[3];
    }
#undef QK128_LOAD
}
__device__ __forceinline__ void knorm_rope128(const Frame& F, const bf16* RAW, const float* kn, const float* R128, bf16* K2, bf16* V2) {
    float one = 1.f; asm volatile("" : "+v"(one));
    const int j = F.lane & 15, hk = (F.lane >> 4) & 1; const bool isv = F.lane >= 32;
    const int coff = isv ? 1280 + 8 * (F.lane & 31) : 1024 + hk * 128 + 8 * j;
    float gk[8];
#pragma unroll
    for (int e = 0; e < 8; ++e) gk[e] = kn[8 * j + e];
    v4u rw[2]; f32x4 tw[2][4];
#define K128_LOAD(it_) do { _Pragma("unroll") for (int q_ = 0; q_ < 2; ++q_) { const int r_ = 2 * (it_) + q_; rw[q_] = *(const v4u*)(RAW + (size_t)r_ * 1536 + coff); \
        const int t_ = r_ & (SEQ - 1), pos_ = (j & 7) < 4 ? (t_ >> 6) : (t_ & 63); const float* tp_ = R128 + ((size_t)pos_ * 32 + 8 * (j & 3)) * 2; \
        _Pragma("unroll") for (int e2 = 0; e2 < 4; ++e2) tw[q_][e2] = *(const f32x4*)(tp_ + 4 * e2); } } while (0)
    int it = F.gw;
    if (it < MT / 2) K128_LOAD(it);
    for (; it < MT / 2; it += F.ngw) {
        v4u cr[2]; f32x4 ct[2][4];
#pragma unroll
        for (int q = 0; q < 2; ++q) { cr[q] = rw[q];
#pragma unroll
            for (int e2 = 0; e2 < 4; ++e2) ct[q][e2] = tw[q][e2]; }
        { const int itn = it + F.ngw < MT / 2 ? it + F.ngw : it; K128_LOAD(itn); }
#pragma unroll
        for (int q = 0; q < 2; ++q) { const int r = 2 * it + q; const bool rope = r < ML; size_t kvrow;
            if (rope) kvrow = (size_t)(r >> 13) * 8448 + (r & (SEQ - 1)); else { const int rc = r - ML; kvrow = (size_t)(rc >> 8) * 8448 + 8192 + (rc & 255); }
            float cs[8], sn[8];
#pragma unroll
            for (int e2 = 0; e2 < 4; ++e2) { const f32x4 w = rope ? ct[q][e2] : (f32x4){one, 0.f, one, 0.f}; cs[2 * e2] = w.x; sn[2 * e2] = w.y; cs[2 * e2 + 1] = w.z; sn[2 * e2 + 1] = w.w; }
            v4u o; qk_head8<128>(cr[q], gk, 1.f, rope, cs, sn, F.lane, o);
            if (isv) *(v4u*)(V2 + kvrow * 256 + 8 * (F.lane & 31)) = cr[q]; else *(v4u*)(K2 + kvrow * 256 + hk * 128 + 8 * j) = o; }
    }
#undef K128_LOAD
}
__device__ __forceinline__ void sconv_phase(const Frame& F, const bf16* RAW, const float* cw  , bf16* O) {
    const int c0 = (F.tid & 127) * 8, qd = F.tid >> 7;
    f32x4 w[3][2];
#pragma unroll
    for (int j = 0; j < 3; ++j) { w[j][0] = *(const f32x4*)(cw + j * 1024 + c0); w[j][1] = *(const f32x4*)(cw + j * 1024 + c0 + 4); }
    for (int blk = F.gw >> 3; blk < MT / 132; blk += F.G) {
        const int rs = blk * 132 + qd * 33;
        float pm[8], pc[8];
        { const bf16* rp = RAW + (size_t)(rs > 0 ? rs - 1 : 0) * 3072 + c0; float a[8], b[8];
          const v4u x0 = *(const v4u*)(rp + 1024), x1 = *(const v4u*)(rp + 2048); const bf16* rq = RAW + (size_t)rs * 3072 + c0; const v4u y0 = *(const v4u*)(rq + 1024), y1 = *(const v4u*)(rq + 2048);
          unpack8(x0, a); unpack8(x1, b);
#pragma unroll
          for (int e2 = 0; e2 < 8; ++e2) pm[e2] = a[e2] * b[e2];
          unpack8(y0, a); unpack8(y1, b);
#pragma unroll
          for (int e2 = 0; e2 < 8; ++e2) pc[e2] = a[e2] * b[e2]; }
        v4u ngc, nu, ngb;
        { const int rn = rs + 1 < MT ? rs + 1 : rs; const bf16* rp = RAW + (size_t)rn * 3072 + c0; ngc = *(const v4u*)(rp + 1024); nu = *(const v4u*)(rp + 2048); ngb = *(const v4u*)(RAW + (size_t)rs * 3072 + c0); }
#pragma nounroll
        for (int k = 0; k < 33; ++k) {
            const int r = rs + k;
            const v4u cgc = ngc, cu = nu, cgb = ngb;
            { const int r2 = r + 2 < MT ? r + 2 : MT - 1, r1 = r + 1 < MT ? r + 1 : MT - 1;
              const bf16* rp = RAW + (size_t)r2 * 3072 + c0; ngc = *(const v4u*)(rp + 1024); nu = *(const v4u*)(rp + 2048); ngb = *(const v4u*)(RAW + (size_t)r1 * 3072 + c0); }
            const int tl = r < ML ? (r & (SEQ - 1)) : ((r - ML) & (CTXL - 1)), len = r < ML ? SEQ : CTXL;
            const float mp = tl > 0 ? 1.f : 0.f, mn = tl < len - 1 ? 1.f : 0.f;
            float a[8], b[8], pn[8], gb[8], z[8];
            unpack8(cgc, a); unpack8(cu, b); unpack8(cgb, gb);
#pragma unroll
            for (int e2 = 0; e2 < 8; ++e2) pn[e2] = a[e2] * b[e2];
#pragma unroll
            for (int e2 = 0; e2 < 8; ++e2) { const float w0 = w[0][e2 >> 2][e2 & 3] * mp, w1 = w[1][e2 >> 2][e2 & 3], w2 = w[2][e2 >> 2][e2 & 3] * mn;
                z[e2] = gb[e2] * (w0 * pm[e2] + w1 * pc[e2] + w2 * pn[e2]); pm[e2] = pc[e2]; pc[e2] = pn[e2]; }
            *(v4u*)(O + (size_t)r * 1024 + c0) = pack8(z);
        }
    }
}
__device__ __forceinline__ void ffn_fixup(const Frame& F, int tile, const float* HALO, const float* cw  , bf16* ACT) {
    const bool has_prev = tile < 128 && (tile & 31) != 0, has_next = tile < 128 && (tile & 31) != 31;
    for (int i = F.tid; i < 2 * (DFF / 4); i += 512) {
        const int which = i >= DFF / 4 ? 1 : 0, c = 4 * (i - which * (DFF / 4));
        const float* hm = HALO + ((size_t)tile * 4 + (which ? 2 : -1)) * NUP;
        const float* h0 = HALO + ((size_t)tile * 4 + (which ? 3 : 0)) * NUP;
        const float* hp = HALO + ((size_t)tile * 4 + (which ? 4 : 1)) * NUP;
        const bool vm = which ? true : has_prev, vp = which ? has_next : true;
        const f32x4 z4 = {0.f, 0.f, 0.f, 0.f};
        const f32x4 gm = vm ? *(const f32x4*)(hm + c) : z4, um = vm ? *(const f32x4*)(hm + DFF + c) : z4, gp = vp ? *(const f32x4*)(hp + c) : z4, up = vp ? *(const f32x4*)(hp + DFF + c) : z4;
        const f32x4 g0 = *(const f32x4*)(h0 + c), u0 = *(const f32x4*)(h0 + DFF + c);
        const f32x4 wg0 = *(const f32x4*)(cw + c), wg1 = *(const f32x4*)(cw + NUP + c), wg2 = *(const f32x4*)(cw + 2 * NUP + c);
        const f32x4 wu0 = *(const f32x4*)(cw + DFF + c), wu1 = *(const f32x4*)(cw + NUP + DFF + c), wu2 = *(const f32x4*)(cw + 2 * NUP + DFF + c);
        float a[4];
#pragma unroll
        for (int e2 = 0; e2 < 4; ++e2) { const float g = wg0[e2] * gm[e2] + wg1[e2] * g0[e2] + wg2[e2] * gp[e2], u = wu0[e2] * um[e2] + wu1[e2] * u0[e2] + wu2[e2] * up[e2];
            a[e2] = g / (1.f + expf(-g)) * u; }
        uint2 o; o.x = cvtpk2(a[0], a[1]); o.y = cvtpk2(a[2], a[3]);
        *(uint2*)(ACT + ((size_t)tile * 256 + (which ? 255 : 0)) * DFF + c) = o;
    }
}

namespace exd {
typedef unsigned short bf16;
constexpr int   D = 128, NW = 8, QBLK = 32, KVBLK = 64;
constexpr float SCALE = 0.6931471805599453f;
constexpr float THR = 8.f;
constexpr int SDEPTH = 1;
constexpr int LDQ = 1024, LDK = 256, LDO = 1024;
constexpr size_t SHM_V = KVBLK * D * 2, SHM_K = KVBLK * D * 2, SHM_ATTN = 2 * SHM_V + 2 * SHM_K + NW * 64 * 4;
using bf16x8 = __attribute__((ext_vector_type(8))) short;
using s16x4  = __attribute__((ext_vector_type(4))) short;
using f32x16 = __attribute__((ext_vector_type(16))) float;
using f32x8  = __attribute__((ext_vector_type(8))) float;
using u32x4  = __attribute__((ext_vector_type(4))) unsigned;
#define KSWZ(row, colB) ((row) * 256 + ((colB) ^ (((row) & 7) << 4)))
#define SBAR() __builtin_amdgcn_sched_barrier(0)
__device__ __forceinline__ int crow(int r, int hi) { return (r & 3) + 8 * (r >> 2) + 4 * hi; }
__device__ __forceinline__ unsigned cvtpk(float lo, float hi) {
  unsigned r; asm volatile("v_cvt_pk_bf16_f32 %0, %1, %2" : "=v"(r) : "v"(lo), "v"(hi)); return r;
}
template <typename TIn> struct Stage;
template <> struct Stage<bf16>  { using T = bf16x8;
  __device__ static __forceinline__ T ld8(const bf16* p) { return *reinterpret_cast<const bf16x8*>(p); }
  __device__ static __forceinline__ bf16x8 tobf(T x) { return x; } };
template <> struct Stage<float> { using T = f32x8;
  __device__ static __forceinline__ T ld8(const float* p) { return *reinterpret_cast<const f32x8*>(p); }
  __device__ static __forceinline__ bf16x8 tobf(T x) {
    u32x4 w = {cvtpk(x[0], x[1]), cvtpk(x[2], x[3]), cvtpk(x[4], x[5]), cvtpk(x[6], x[7])}; return *reinterpret_cast<bf16x8*>(&w); } };

__device__ __forceinline__ void partialSM(f32x16& p0, f32x16& p1, float& m_reg, float& mn, float& alpha) {
  constexpr float C = SCALE * 1.4426950408889634f;
  float pmax = p0[0]; for (int r = 1; r < 16; ++r) pmax = fmaxf(pmax, p0[r]); for (int r = 0; r < 16; ++r) pmax = fmaxf(pmax, p1[r]);
  { auto rr = __builtin_amdgcn_permlane32_swap(__float_as_uint(pmax), __float_as_uint(pmax), false, false);
    pmax = fmaxf(__uint_as_float(rr[0]), __uint_as_float(rr[1])); }
  if (__builtin_expect(__all(pmax - m_reg <= THR / SCALE), 1)) { mn = m_reg; alpha = 1.f; }
  else { mn = fmaxf(m_reg, pmax); alpha = __builtin_amdgcn_exp2f((m_reg - mn) * C); m_reg = mn; }
  float mnC = -mn * C;
  for (int r = 0; r < 16; ++r) p0[r] = fmaf(p0[r], C, mnC); for (int r = 0; r < 16; ++r) p1[r] = fmaf(p1[r], C, mnC);
  for (int r = 0; r < 16; ++r) p0[r] = __builtin_amdgcn_exp2f(p0[r]);
}
__device__ __forceinline__ void finishSM(f32x16& p0, f32x16& p1, float alpha, float& l_reg, bf16x8& pa0, bf16x8& pa1, bf16x8& pa2, bf16x8& pa3) {
  for (int r = 0; r < 16; ++r) p1[r] = __builtin_amdgcn_exp2f(p1[r]);
  float ps = 0; for (int r = 0; r < 16; ++r) ps += p0[r]; for (int r = 0; r < 16; ++r) ps += p1[r];
  { auto rr = __builtin_amdgcn_permlane32_swap(__float_as_uint(ps), __float_as_uint(ps), false, false);
    ps = __uint_as_float(rr[0]) + __uint_as_float(rr[1]); }
  l_reg = l_reg * alpha + ps;
#define PK4(P, BASE, OUT) do { unsigned a0 = cvtpk(P[BASE + 0], P[BASE + 1]), a1 = cvtpk(P[BASE + 2], P[BASE + 3]);   \
    unsigned b0 = cvtpk(P[BASE + 4], P[BASE + 5]), b1 = cvtpk(P[BASE + 6], P[BASE + 7]);                              \
    auto r0 = __builtin_amdgcn_permlane32_swap(a0, b0, false, false); auto r1 = __builtin_amdgcn_permlane32_swap(a1, b1, false, false); \
    u32x4 w = {r0[0], r1[0], r0[1], r1[1]}; OUT = *reinterpret_cast<bf16x8*>(&w); } while (0)
  PK4(p0, 0, pa0); PK4(p0, 8, pa1); PK4(p1, 0, pa2); PK4(p1, 8, pa3);
#undef PK4
}
__device__ __forceinline__ void qkt(f32x16& p0, f32x16& p1, const bf16* Ks, const bf16x8* qr, int r32, int hi) {
  p0 = f32x16{}; p1 = f32x16{};
  for (int d0 = 0; d0 < 8; ++d0) { int cb = (d0 * 16 + hi * 8) * 2;
    bf16x8 b0 = *reinterpret_cast<const bf16x8*>((const char*)Ks + KSWZ(r32, cb));
    bf16x8 b1 = *reinterpret_cast<const bf16x8*>((const char*)Ks + KSWZ(32 + r32, cb));
    p0 = __builtin_amdgcn_mfma_f32_32x32x16_bf16(b0, qr[d0], p0, 0, 0, 0);
    p1 = __builtin_amdgcn_mfma_f32_32x32x16_bf16(b1, qr[d0], p1, 0, 0, 0); }
}
__device__ __forceinline__ int v_st(int k, int c) { const int kk = (k & ~0xC) | ((k & 4) << 1) | ((k & 8) >> 1); return ((kk >> 3) * 4 + (c >> 5)) * 512 + ((kk & 7) * 32 + (c & 31)) * 2; }
__device__ __forceinline__ int v_rd_base(int lane) { return ((lane & 3) << 3) | (((lane >> 2) & 3) << 6) | (((lane >> 4) & 1) << 5) | (((lane >> 5) & 1) << 8); }
constexpr int v_rd_off(int d0, int ks, int half) { return d0 * 512 + ks * 4096 + half * 2048; }
template <int OFF> __device__ __forceinline__ s16x4 tr_read(int vb) {
  s16x4 r; asm volatile("ds_read_b64_tr_b16 %0, %1 offset:%2" : "=&v"(r) : "v"(vb), "i"(OFF) : "memory"); return r;
}
template <int D0> __device__ __forceinline__ void pv_one(f32x16& od, int vb, bf16x8 pa0, bf16x8 pa1, bf16x8 pa2, bf16x8 pa3) {
  const s16x4 l0 = tr_read<v_rd_off(D0, 0, 0)>(vb), h0 = tr_read<v_rd_off(D0, 0, 1)>(vb), l1 = tr_read<v_rd_off(D0, 1, 0)>(vb), h1 = tr_read<v_rd_off(D0, 1, 1)>(vb);
  const s16x4 l2 = tr_read<v_rd_off(D0, 2, 0)>(vb), h2 = tr_read<v_rd_off(D0, 2, 1)>(vb), l3 = tr_read<v_rd_off(D0, 3, 0)>(vb), h3 = tr_read<v_rd_off(D0, 3, 1)>(vb);
  asm volatile("s_waitcnt lgkmcnt(0)" ::: "memory"); SBAR();
#define PK(L, H) (bf16x8){L[0], L[1], L[2], L[3], H[0], H[1], H[2], H[3]}
  od = __builtin_amdgcn_mfma_f32_32x32x16_bf16(pa0, PK(l0, h0), od, 0, 0, 0);
  od = __builtin_amdgcn_mfma_f32_32x32x16_bf16(pa1, PK(l1, h1), od, 0, 0, 0);
  od = __builtin_amdgcn_mfma_f32_32x32x16_bf16(pa2, PK(l2, h2), od, 0, 0, 0);
  od = __builtin_amdgcn_mfma_f32_32x32x16_bf16(pa3, PK(l3, h3), od, 0, 0, 0);
#undef PK
}
__device__ __forceinline__ void pv_d0(f32x16* o, int vb, bf16x8 pa0, bf16x8 pa1, bf16x8 pa2, bf16x8 pa3) {
  pv_one<0>(o[0], vb, pa0, pa1, pa2, pa3); pv_one<1>(o[1], vb, pa0, pa1, pa2, pa3); pv_one<2>(o[2], vb, pa0, pa1, pa2, pa3); pv_one<3>(o[3], vb, pa0, pa1, pa2, pa3);
}

template <typename TQ>
__device__ __forceinline__ void attn_dense_body(const TQ* __restrict__ Qb, const bf16* __restrict__ Kh, const bf16* __restrict__ Vh,
                                                bf16* __restrict__ Ob, int seq, char* lds, const int tid) {
  using St = Stage<bf16>; using SQ = Stage<TQ>;
  const int wid = tid >> 6, lane = tid & 63, r32 = lane & 31, hi = lane >> 5;
  bf16* V_lds = (bf16*)lds; bf16* K_lds = (bf16*)(lds + 2 * SHM_V);
  float* ws = (float*)(lds + 2 * SHM_V + 2 * SHM_K) + wid * 64; float* li_l = ws; float* al_l = ws + 32;
  float m_reg = -1e30f, l_reg = 0; f32x16 o[4] = {}; bf16x8 qr[8];
  const TQ* Qw = Qb + (long)(wid * QBLK + r32) * LDQ + hi * 8;
#pragma unroll
  for (int d0 = 0; d0 < 8; ++d0) qr[d0] = SQ::tobf(SQ::ld8(Qw + d0 * 16));
  const int sr = tid >> 4, sc = (tid & 15) * 8, vst0 = v_st(sr, sc), vst1 = v_st(32 + sr, sc);
  const int vb0 = (int)(uintptr_t)V_lds + v_rd_base(lane);
  struct { typename St::T vs0, vs1, ks0, ks1; } sr_[SDEPTH];
  const unsigned lo0 = (unsigned)(sr * LDK + sc) * 2u, lo1 = lo0 + 32u * LDK * 2u;
#define SLOAD(i, k0) do { const char* vt_ = (const char*)Vh + (size_t)(k0) * (LDK * 2); const char* kt_ = (const char*)Kh + (size_t)(k0) * (LDK * 2); \
    sr_[i].vs0 = *reinterpret_cast<const bf16x8*>(vt_ + lo0); sr_[i].vs1 = *reinterpret_cast<const bf16x8*>(vt_ + lo1); \
    sr_[i].ks0 = *reinterpret_cast<const bf16x8*>(kt_ + lo0); sr_[i].ks1 = *reinterpret_cast<const bf16x8*>(kt_ + lo1); } while (0)
#define SWRITE(b, i) do { *(bf16x8*)((char*)V_lds + (b) * SHM_V + vst0) = St::tobf(sr_[i].vs0);          \
    *(bf16x8*)((char*)V_lds + (b) * SHM_V + vst1) = St::tobf(sr_[i].vs1); int kc = sc * 2;               \
    *(bf16x8*)((char*)K_lds + (b) * SHM_K + KSWZ(sr, kc)) = St::tobf(sr_[i].ks0);                       \
    *(bf16x8*)((char*)K_lds + (b) * SHM_K + KSWZ(32 + sr, kc)) = St::tobf(sr_[i].ks1); } while (0)
#define SWAIT() do { if constexpr (SDEPTH == 2) asm volatile("s_waitcnt vmcnt(4)" ::: "memory"); else asm volatile("s_waitcnt vmcnt(0)" ::: "memory"); } while (0)
#define RESC(a) do { if (__any((a) < 1.f)) { if (hi == 0) al_l[r32] = (a); asm volatile("s_waitcnt lgkmcnt(0)" ::: "memory"); \
    for (int d = 0; d < 4; ++d) for (int r = 0; r < 16; ++r) o[d][r] *= al_l[crow(r, hi)]; } } while (0)
  f32x16 pA0, pA1, pB0, pB1; float mnA, mnB, alA, alB; bf16x8 pa0, pa1, pa2, pa3; const int NT = seq / KVBLK;
  constexpr int SE = 0, SO = SDEPTH - 1;
  SLOAD(SE, 0); asm volatile("s_waitcnt vmcnt(0)" ::: "memory"); SWRITE(0, SE); __syncthreads();
  qkt(pA0, pA1, K_lds, qr, r32, hi); partialSM(pA0, pA1, m_reg, mnA, alA);
  SLOAD(SO, KVBLK); if constexpr (SDEPTH == 2) { if (2 < NT) SLOAD(SE, 2 * KVBLK); }
  SWAIT(); SWRITE(1, SO); __syncthreads();
  for (int j = 1; j + 1 < NT; j += 2) {
    SBAR(); qkt(pB0, pB1, (bf16*)((char*)K_lds + SHM_K), qr, r32, hi);
    finishSM(pA0, pA1, alA, l_reg, pa0, pa1, pa2, pa3); SBAR();
    SLOAD(SO, (j + SDEPTH) * KVBLK); SBAR();
    pv_d0(o, vb0, pa0, pa1, pa2, pa3); partialSM(pB0, pB1, m_reg, mnB, alB);
    __syncthreads(); SWAIT(); SWRITE(0, SE);
    RESC(alB); __syncthreads();
    SBAR(); qkt(pA0, pA1, K_lds, qr, r32, hi);
    finishSM(pB0, pB1, alB, l_reg, pa0, pa1, pa2, pa3); SBAR();
    if (SDEPTH == 1 || j + 3 < NT) SLOAD(SE, (j + 1 + SDEPTH) * KVBLK); SBAR();
    pv_d0(o, vb0 + (int)SHM_V, pa0, pa1, pa2, pa3); partialSM(pA0, pA1, m_reg, mnA, alA);
    __syncthreads(); SWAIT(); SWRITE(1, SO);
    RESC(alA); __syncthreads();
  }
  SBAR(); qkt(pB0, pB1, (bf16*)((char*)K_lds + SHM_K), qr, r32, hi);
  finishSM(pA0, pA1, alA, l_reg, pa0, pa1, pa2, pa3); SBAR();
  pv_d0(o, vb0, pa0, pa1, pa2, pa3); partialSM(pB0, pB1, m_reg, mnB, alB);
  __syncthreads(); RESC(alB);
  finishSM(pB0, pB1, alB, l_reg, pa0, pa1, pa2, pa3); SBAR();
  pv_d0(o, vb0 + (int)SHM_V, pa0, pa1, pa2, pa3);
  if (hi == 0) li_l[r32] = l_reg; asm volatile("s_waitcnt lgkmcnt(0)" ::: "memory");
  float rli[16];
#pragma unroll
  for (int r = 0; r < 16; ++r) rli[r] = __builtin_amdgcn_rcpf(li_l[crow(r, hi)]);
  bf16* Ow = Ob + (long)(wid * QBLK) * LDO;
#pragma unroll
  for (int r = 0; r < 16; ++r) { int orow = crow(r, hi);
    for (int d0 = 0; d0 < 4; ++d0) Ow[(long)orow * LDO + d0 * 32 + r32] = (bf16)(cvtpk(o[d0][r] * rli[r], 0.f) & 0xffffu); }
#undef SLOAD
#undef SWRITE
#undef SWAIT
#undef RESC
}
#undef KSWZ
#undef SBAR
}

namespace exf {
typedef unsigned short bf16;
constexpr int   D = 128, NW = 8, QBLK = 32, KVBLK = 64;
constexpr float SCALE = 0.6931471805599453f;
constexpr float THR = 8.f;
constexpr int SDEPTH = 1;
constexpr int LDQ = 1536, LDK = 256, LDO = 1024;
constexpr size_t SHM_V = KVBLK * D * 2, SHM_K = KVBLK * D * 2, SHM_ATTN = 2 * SHM_V + 2 * SHM_K + NW * 64 * 4;
using bf16x8 = __attribute__((ext_vector_type(8))) short;
using s16x4  = __attribute__((ext_vector_type(4))) short;
using f32x16 = __attribute__((ext_vector_type(16))) float;
using f32x8  = __attribute__((ext_vector_type(8))) float;
using u32x4  = __attribute__((ext_vector_type(4))) unsigned;
#define KSWZ(row, colB) ((row) * 256 + ((colB) ^ (((row) & 7) << 4)))
#define SBAR() __builtin_amdgcn_sched_barrier(0)
__device__ __forceinline__ int crow(int r, int hi) { return (r & 3) + 8 * (r >> 2) + 4 * hi; }
__device__ __forceinline__ unsigned cvtpk(float lo, float hi) {
  unsigned r; asm volatile("v_cvt_pk_bf16_f32 %0, %1, %2" : "=v"(r) : "v"(lo), "v"(hi)); return r;
}
template <typename TIn> struct Stage;
template <> struct Stage<bf16>  { using T = bf16x8;
  __device__ static __forceinline__ T ld8(const bf16* p) { return *reinterpret_cast<const bf16x8*>(p); }
  __device__ static __forceinline__ bf16x8 tobf(T x) { return x; } };
template <> struct Stage<float> { using T = f32x8;
  __device__ static __forceinline__ T ld8(const float* p) { return *reinterpret_cast<const f32x8*>(p); }
  __device__ static __forceinline__ bf16x8 tobf(T x) {
    u32x4 w = {cvtpk(x[0], x[1]), cvtpk(x[2], x[3]), cvtpk(x[4], x[5]), cvtpk(x[6], x[7])}; return *reinterpret_cast<bf16x8*>(&w); } };

__device__ __forceinline__ void partialSM(f32x16& p0, f32x16& p1, float& m_reg, float& mn, float& alpha) {
  mn = 0.f; alpha = 1.f;
  for (int r = 0; r < 16; ++r) p0[r] = __builtin_amdgcn_exp2f(p0[r]);
}
__device__ __forceinline__ void finishSM(f32x16& p0, f32x16& p1, float alpha, float& l_reg, bf16x8& pa0, bf16x8& pa1, bf16x8& pa2, bf16x8& pa3) {
  for (int r = 0; r < 16; ++r) p1[r] = __builtin_amdgcn_exp2f(p1[r]);
  float ps = 0; for (int r = 0; r < 16; ++r) ps += p0[r]; for (int r = 0; r < 16; ++r) ps += p1[r];
  { auto rr = __builtin_amdgcn_permlane32_swap(__float_as_uint(ps), __float_as_uint(ps), false, false);
    ps = __uint_as_float(rr[0]) + __uint_as_float(rr[1]); }
  l_reg = l_reg * alpha + ps;
#define PK4(P, BASE, OUT) do { unsigned a0 = cvtpk(P[BASE + 0], P[BASE + 1]), a1 = cvtpk(P[BASE + 2], P[BASE + 3]);   \
    unsigned b0 = cvtpk(P[BASE + 4], P[BASE + 5]), b1 = cvtpk(P[BASE + 6], P[BASE + 7]);                              \
    auto r0 = __builtin_amdgcn_permlane32_swap(a0, b0, false, false); auto r1 = __builtin_amdgcn_permlane32_swap(a1, b1, false, false); \
    u32x4 w = {r0[0], r1[0], r0[1], r1[1]}; OUT = *reinterpret_cast<bf16x8*>(&w); } while (0)
  PK4(p0, 0, pa0); PK4(p0, 8, pa1); PK4(p1, 0, pa2); PK4(p1, 8, pa3);
#undef PK4
}
__device__ __forceinline__ void qkt(f32x16& p0, f32x16& p1, const bf16* Ks, const bf16x8* qr, int r32, int hi) {
  p0 = f32x16{}; p1 = f32x16{};
  for (int d0 = 0; d0 < 8; ++d0) { int cb = (d0 * 16 + hi * 8) * 2;
    bf16x8 b0 = *reinterpret_cast<const bf16x8*>((const char*)Ks + KSWZ(r32, cb));
    bf16x8 b1 = *reinterpret_cast<const bf16x8*>((const char*)Ks + KSWZ(32 + r32, cb));
    p0 = __builtin_amdgcn_mfma_f32_32x32x16_bf16(b0, qr[d0], p0, 0, 0, 0);
    p1 = __builtin_amdgcn_mfma_f32_32x32x16_bf16(b1, qr[d0], p1, 0, 0, 0); }
}
__device__ __forceinline__ int v_st(int k, int c) { const int kk = (k & ~0xC) | ((k & 4) << 1) | ((k & 8) >> 1); return ((kk >> 3) * 4 + (c >> 5)) * 512 + ((kk & 7) * 32 + (c & 31)) * 2; }
__device__ __forceinline__ int v_rd_base(int lane) { return ((lane & 3) << 3) | (((lane >> 2) & 3) << 6) | (((lane >> 4) & 1) << 5) | (((lane >> 5) & 1) << 8); }
constexpr int v_rd_off(int d0, int ks, int half) { return d0 * 512 + ks * 4096 + half * 2048; }
template <int OFF> __device__ __forceinline__ s16x4 tr_read(int vb) {
  s16x4 r; asm volatile("ds_read_b64_tr_b16 %0, %1 offset:%2" : "=&v"(r) : "v"(vb), "i"(OFF) : "memory"); return r;
}
template <int D0> __device__ __forceinline__ void pv_one(f32x16& od, int vb, bf16x8 pa0, bf16x8 pa1, bf16x8 pa2, bf16x8 pa3) {
  const s16x4 l0 = tr_read<v_rd_off(D0, 0, 0)>(vb), h0 = tr_read<v_rd_off(D0, 0, 1)>(vb), l1 = tr_read<v_rd_off(D0, 1, 0)>(vb), h1 = tr_read<v_rd_off(D0, 1, 1)>(vb);
  const s16x4 l2 = tr_read<v_rd_off(D0, 2, 0)>(vb), h2 = tr_read<v_rd_off(D0, 2, 1)>(vb), l3 = tr_read<v_rd_off(D0, 3, 0)>(vb), h3 = tr_read<v_rd_off(D0, 3, 1)>(vb);
  asm volatile("s_waitcnt lgkmcnt(0)" ::: "memory"); SBAR();
#define PK(L, H) (bf16x8){L[0], L[1], L[2], L[3], H[0], H[1], H[2], H[3]}
  od = __builtin_amdgcn_mfma_f32_32x32x16_bf16(pa0, PK(l0, h0), od, 0, 0, 0);
  od = __builtin_amdgcn_mfma_f32_32x32x16_bf16(pa1, PK(l1, h1), od, 0, 0, 0);
  od = __builtin_amdgcn_mfma_f32_32x32x16_bf16(pa2, PK(l2, h2), od, 0, 0, 0);
  od = __builtin_amdgcn_mfma_f32_32x32x16_bf16(pa3, PK(l3, h3), od, 0, 0, 0);
#undef PK
}
__device__ __forceinline__ void pv_d0(f32x16* o, int vb, bf16x8 pa0, bf16x8 pa1, bf16x8 pa2, bf16x8 pa3) {
  pv_one<0>(o[0], vb, pa0, pa1, pa2, pa3); pv_one<1>(o[1], vb, pa0, pa1, pa2, pa3); pv_one<2>(o[2], vb, pa0, pa1, pa2, pa3); pv_one<3>(o[3], vb, pa0, pa1, pa2, pa3);
}

template <typename TQ>
__device__ __forceinline__ void attn_dense_body(const TQ* __restrict__ Qb, const bf16* __restrict__ Kh, const bf16* __restrict__ Vh,
                                                bf16* __restrict__ Ob, int seq, char* lds, const int tid, const float* gq, const float* R128, int t0, bool rope) {
  using St = Stage<bf16>; using SQ = Stage<TQ>;
  const int wid = tid >> 6, lane = tid & 63, r32 = lane & 31, hi = lane >> 5;
  bf16* V_lds = (bf16*)lds; bf16* K_lds = (bf16*)(lds + 2 * SHM_V);
  float* ws = (float*)(lds + 2 * SHM_V + 2 * SHM_K) + wid * 64; float* li_l = ws; float* al_l = ws + 32;
  float m_reg = -1e30f, l_reg = 0; f32x16 o[4] = {}; bf16x8 qr[8];
  const TQ* Qw = Qb + (long)(wid * QBLK + r32) * LDQ + hi * 8;
#pragma unroll
  for (int d0 = 0; d0 < 8; ++d0) qr[d0] = SQ::tobf(SQ::ld8(Qw + d0 * 16));
  qnorm_rope_frag<128>(qr, gq, R128, t0 + wid * QBLK + r32, rope, 0.12751743f, lane);
  const int sr = tid >> 4, sc = (tid & 15) * 8, vst0 = v_st(sr, sc), vst1 = v_st(32 + sr, sc);
  const int vb0 = (int)(uintptr_t)V_lds + v_rd_base(lane);
  struct { typename St::T vs0, vs1, ks0, ks1; } sr_[SDEPTH];
  const unsigned lo0 = (unsigned)(sr * LDK + sc) * 2u, lo1 = lo0 + 32u * LDK * 2u;
#define SLOAD(i, k0) do { const char* vt_ = (const char*)Vh + (size_t)(k0) * (LDK * 2); const char* kt_ = (const char*)Kh + (size_t)(k0) * (LDK * 2); \
    sr_[i].vs0 = *reinterpret_cast<const bf16x8*>(vt_ + lo0); sr_[i].vs1 = *reinterpret_cast<const bf16x8*>(vt_ + lo1); \
    sr_[i].ks0 = *reinterpret_cast<const bf16x8*>(kt_ + lo0); sr_[i].ks1 = *reinterpret_cast<const bf16x8*>(kt_ + lo1); } while (0)
#define SWRITE(b, i) do { *(bf16x8*)((char*)V_lds + (b) * SHM_V + vst0) = St::tobf(sr_[i].vs0);          \
    *(bf16x8*)((char*)V_lds + (b) * SHM_V + vst1) = St::tobf(sr_[i].vs1); int kc = sc * 2;               \
    *(bf16x8*)((char*)K_lds + (b) * SHM_K + KSWZ(sr, kc)) = St::tobf(sr_[i].ks0);                       \
    *(bf16x8*)((char*)K_lds + (b) * SHM_K + KSWZ(32 + sr, kc)) = St::tobf(sr_[i].ks1); } while (0)
#define SWAIT() do { if constexpr (SDEPTH == 2) asm volatile("s_waitcnt vmcnt(4)" ::: "memory"); else asm volatile("s_waitcnt vmcnt(0)" ::: "memory"); } while (0)
#define RESC(a) do { } while (0)
  f32x16 pA0, pA1, pB0, pB1; float mnA, mnB, alA, alB; bf16x8 pa0, pa1, pa2, pa3; const int NT = seq / KVBLK;
  constexpr int SE = 0, SO = SDEPTH - 1;
  SLOAD(SE, 0); asm volatile("s_waitcnt vmcnt(0)" ::: "memory"); SWRITE(0, SE); __syncthreads();
  qkt(pA0, pA1, K_lds, qr, r32, hi); partialSM(pA0, pA1, m_reg, mnA, alA);
  SLOAD(SO, KVBLK); if constexpr (SDEPTH == 2) { if (2 < NT) SLOAD(SE, 2 * KVBLK); }
  SWAIT(); SWRITE(1, SO); __syncthreads();
  for (int j = 1; j + 1 < NT; j += 2) {
    SBAR(); qkt(pB0, pB1, (bf16*)((char*)K_lds + SHM_K), qr, r32, hi);
    finishSM(pA0, pA1, alA, l_reg, pa0, pa1, pa2, pa3); SBAR();
    SLOAD(SO, (j + SDEPTH) * KVBLK); SBAR();
    pv_d0(o, vb0, pa0, pa1, pa2, pa3); partialSM(pB0, pB1, m_reg, mnB, alB);
    __syncthreads(); SWAIT(); SWRITE(0, SE);
    RESC(alB); __syncthreads();
    SBAR(); qkt(pA0, pA1, K_lds, qr, r32, hi);
    finishSM(pB0, pB1, alB, l_reg, pa0, pa1, pa2, pa3); SBAR();
    if (SDEPTH == 1 || j + 3 < NT) SLOAD(SE, (j + 1 + SDEPTH) * KVBLK); SBAR();
    pv_d0(o, vb0 + (int)SHM_V, pa0, pa1, pa2, pa3); partialSM(pA0, pA1, m_reg, mnA, alA);
    __syncthreads(); SWAIT(); SWRITE(1, SO);
    RESC(alA); __syncthreads();
  }
  SBAR(); qkt(pB0, pB1, (bf16*)((char*)K_lds + SHM_K), qr, r32, hi);
  finishSM(pA0, pA1, alA, l_reg, pa0, pa1, pa2, pa3); SBAR();
  pv_d0(o, vb0, pa0, pa1, pa2, pa3); partialSM(pB0, pB1, m_reg, mnB, alB);
  __syncthreads(); RESC(alB);
  finishSM(pB0, pB1, alB, l_reg, pa0, pa1, pa2, pa3); SBAR();
  pv_d0(o, vb0 + (int)SHM_V, pa0, pa1, pa2, pa3);
  if (hi == 0) li_l[r32] = l_reg; asm volatile("s_waitcnt lgkmcnt(0)" ::: "memory");
  float rli[16];
#pragma unroll
  for (int r = 0; r < 16; ++r) rli[r] = __builtin_amdgcn_rcpf(li_l[crow(r, hi)]);
  bf16* Ow = Ob + (long)(wid * QBLK) * LDO;
#pragma unroll
  for (int r = 0; r < 16; ++r) { int orow = crow(r, hi);
    for (int d0 = 0; d0 < 4; ++d0) Ow[(long)orow * LDO + d0 * 32 + r32] = (bf16)(cvtpk(o[d0][r] * rli[r], 0.f) & 0xffffu); }
#undef SLOAD
#undef SWRITE
#undef SWAIT
#undef RESC
}
#undef KSWZ
#undef SBAR
#undef KSWZ
#undef SBAR
}


namespace att {
typedef short bf16x8 __attribute__((ext_vector_type(8)));
typedef short s16x4 __attribute__((ext_vector_type(4)));
typedef float f32x16 __attribute__((ext_vector_type(16)));
typedef unsigned u32x4 __attribute__((ext_vector_type(4)));
#define SBAR() __builtin_amdgcn_sched_barrier(0)
__device__ __forceinline__ int crow(int r, int hi) { return (r & 3) + 8 * (r >> 2) + 4 * hi; }
__device__ __forceinline__ unsigned cvtpk(float lo, float hi) { unsigned r; asm volatile("v_cvt_pk_bf16_f32 %0, %1, %2" : "=v"(r) : "v"(lo), "v"(hi)); return r; }
__device__ __forceinline__ int lds_addr(const LAS void* p) { return (int)(unsigned)(unsigned long long)p; }
template <int D> __device__ __forceinline__ int kswz(int row, int colB) { return row * (2 * D) + (colB ^ ((row & 7) << 4)); }
__device__ __forceinline__ void partialSM(f32x16& p0, f32x16& p1, float& m_reg, float& mn, float& alpha, const float C, const float THRS) {
  float pmax = p0[0];
#pragma unroll
  for (int r = 1; r < 16; ++r) pmax = fmaxf(pmax, p0[r]);
#pragma unroll
  for (int r = 0; r < 16; ++r) pmax = fmaxf(pmax, p1[r]);
  { auto rr = __builtin_amdgcn_permlane32_swap(__float_as_uint(pmax), __float_as_uint(pmax), false, false);
    pmax = fmaxf(__uint_as_float(rr[0]), __uint_as_float(rr[1])); }
  if (__builtin_expect(__all(pmax - m_reg <= THRS), 1)) { mn = m_reg; alpha = 1.f; }
  else { mn = fmaxf(m_reg, pmax); alpha = __builtin_amdgcn_exp2f((m_reg - mn) * C); m_reg = mn; }
  const float mnC = -mn * C;
#pragma unroll
  for (int r = 0; r < 16; ++r) p0[r] = fmaf(p0[r], C, mnC);
#pragma unroll
  for (int r = 0; r < 16; ++r) p1[r] = fmaf(p1[r], C, mnC);
#pragma unroll
  for (int r = 0; r < 16; ++r) p0[r] = __builtin_amdgcn_exp2f(p0[r]);
}
__device__ __forceinline__ void pack_p(const f32x16& p0, const f32x16& p1, bf16x8& pa0, bf16x8& pa1, bf16x8& pa2, bf16x8& pa3) {
#define PK4(P, BASE, OUT) do { unsigned a0 = cvtpk(P[BASE + 0], P[BASE + 1]), a1 = cvtpk(P[BASE + 2], P[BASE + 3]);   \
    unsigned b0 = cvtpk(P[BASE + 4], P[BASE + 5]), b1 = cvtpk(P[BASE + 6], P[BASE + 7]);                              \
    auto r0 = __builtin_amdgcn_permlane32_swap(a0, b0, false, false); auto r1 = __builtin_amdgcn_permlane32_swap(a1, b1, false, false); \
    u32x4 w = {r0[0], r1[0], r0[1], r1[1]}; OUT = *reinterpret_cast<bf16x8*>(&w); } while (0)
  PK4(p0, 0, pa0); PK4(p0, 8, pa1); PK4(p1, 0, pa2); PK4(p1, 8, pa3);
#undef PK4
}
__device__ __forceinline__ float row_sum(const f32x16& p0, const f32x16& p1) {
  float ps = 0.f;
#pragma unroll
  for (int r = 0; r < 16; ++r) ps += p0[r];
#pragma unroll
  for (int r = 0; r < 16; ++r) ps += p1[r];
  auto rr = __builtin_amdgcn_permlane32_swap(__float_as_uint(ps), __float_as_uint(ps), false, false);
  return __uint_as_float(rr[0]) + __uint_as_float(rr[1]);
}
__device__ __forceinline__ void finishSM(f32x16& p0, f32x16& p1, float alpha, float& l_reg, bf16x8& pa0, bf16x8& pa1, bf16x8& pa2, bf16x8& pa3) {
#pragma unroll
  for (int r = 0; r < 16; ++r) p1[r] = __builtin_amdgcn_exp2f(p1[r]);
  const float ps = row_sum(p0, p1);
  l_reg = l_reg * alpha + ps;
  pack_p(p0, p1, pa0, pa1, pa2, pa3);
}
template <int D> __device__ __forceinline__ void qkt(f32x16& p0, f32x16& p1, const LAS char* Ks, const bf16x8* qr, int r32, int hi) {
  p0 = f32x16{}; p1 = f32x16{};
#pragma unroll
  for (int d0 = 0; d0 < D / 16; ++d0) { const int cb = (d0 * 16 + hi * 8) * 2;
    const bf16x8 b0 = *(const LAS bf16x8*)(Ks + kswz<D>(r32, cb));
    const bf16x8 b1 = *(const LAS bf16x8*)(Ks + kswz<D>(32 + r32, cb));
    p0 = __builtin_amdgcn_mfma_f32_32x32x16_bf16(b0, qr[d0], p0, 0, 0, 0);
    p1 = __builtin_amdgcn_mfma_f32_32x32x16_bf16(b1, qr[d0], p1, 0, 0, 0); }
}
template <int D> __device__ __forceinline__ int v_st(int k, int c) { const int kk = (k & ~0xC) | ((k & 4) << 1) | ((k & 8) >> 1); return ((kk >> 3) * (D / 32) + (c >> 5)) * 512 + ((kk & 7) * 32 + (c & 31)) * 2; }
__device__ __forceinline__ int v_rd_base(int lane) { return ((lane & 3) << 3) | (((lane >> 2) & 3) << 6) | (((lane >> 4) & 1) << 5) | (((lane >> 5) & 1) << 8); }
template <int D> constexpr int v_rd_off(int d0, int ks, int half) { return d0 * 512 + ks * (D / 32) * 1024 + half * (D / 32) * 512; }
template <int OFF> __device__ __forceinline__ s16x4 tr_read(int vb) {
  s16x4 r; asm volatile("ds_read_b64_tr_b16 %0, %1 offset:%2" : "=&v"(r) : "v"(vb), "i"(OFF) : "memory"); return r;
}
template <int D, int D0> __device__ __forceinline__ void pv_one(f32x16& od, int vb, bf16x8 pa0, bf16x8 pa1, bf16x8 pa2, bf16x8 pa3) {
  const s16x4 l0 = tr_read<v_rd_off<D>(D0, 0, 0)>(vb), h0 = tr_read<v_rd_off<D>(D0, 0, 1)>(vb), l1 = tr_read<v_rd_off<D>(D0, 1, 0)>(vb), h1 = tr_read<v_rd_off<D>(D0, 1, 1)>(vb);
  const s16x4 l2 = tr_read<v_rd_off<D>(D0, 2, 0)>(vb), h2 = tr_read<v_rd_off<D>(D0, 2, 1)>(vb), l3 = tr_read<v_rd_off<D>(D0, 3, 0)>(vb), h3 = tr_read<v_rd_off<D>(D0, 3, 1)>(vb);
  asm volatile("s_waitcnt lgkmcnt(0)" ::: "memory"); SBAR();
#define PK(L, H) (bf16x8){L[0], L[1], L[2], L[3], H[0], H[1], H[2], H[3]}
  od = __builtin_amdgcn_mfma_f32_32x32x16_bf16(pa0, PK(l0, h0), od, 0, 0, 0);
  od = __builtin_amdgcn_mfma_f32_32x32x16_bf16(pa1, PK(l1, h1), od, 0, 0, 0);
  od = __builtin_amdgcn_mfma_f32_32x32x16_bf16(pa2, PK(l2, h2), od, 0, 0, 0);
  od = __builtin_amdgcn_mfma_f32_32x32x16_bf16(pa3, PK(l3, h3), od, 0, 0, 0);
#undef PK
}
}

template <bool FAST>
__device__ __forceinline__ void win_attn_unit(const Frame& F, bool ctxq, int b, int h, int qb, const bf16* Qp, const bf16* Kp, const bf16* RAW, bf16* O, float sink, LAS char* lds, const float* qn, const float* R64) {
  using namespace att;
  constexpr float C = 1.f, THRS = 8.f * LOG2E;
  const int tid = F.tid, wid = F.wave, lane = F.lane, r32 = lane & 31, hi = lane >> 5;
  LAS char* Kl = lds; LAS char* Vl = lds + 16384; LAS float* li_l = (LAS float*)(lds + 32768) + wid * 64; LAS float* al_l = li_l + 32;
  const int g = h >> 2;
  const int q0 = ctxq ? 0 : qb * 256;
  const long qrow_w = (ctxq ? (long)ML + b * CTXL : (long)b * SEQ + q0) + wid * 32;
  bf16x8 qr[4];
  if constexpr (FAST) {
#pragma unroll
    for (int d0 = 0; d0 < 4; ++d0) qr[d0] = *(const bf16x8*)(Qp + (qrow_w + r32) * 1536 + h * 64 + d0 * 16 + hi * 8);
    qnorm_rope_frag<64>(qr, qn, R64, q0 + wid * 32 + r32, !ctxq, 0.18033688f, lane);
  } else {
#pragma unroll
    for (int d0 = 0; d0 < 4; ++d0) qr[d0] = *(const bf16x8*)(Qp + (qrow_w + r32) * 1024 + h * 64 + d0 * 16 + hi * 8);
  }
  int jlo = 0, jhi = 0;
  if (!ctxq) { jlo = (q0 == 0) ? 2 : 0; jhi = (SEQ - (q0 - 128)) / 64; if (jhi > 8) jhi = 8; }
  const int NT = 4 + (jhi - jlo);
  const int srow = tid >> 3, sch = tid & 7;
  const int vb0 = lds_addr(Vl) + v_rd_base(lane);
  float m_reg = -1e30f, l_reg = 0.f; f32x16 o[2]; o[0] = f32x16{}; o[1] = f32x16{};
  v4u kreg, vreg;
#define TROW(i) ((i) < 4 ? (long)ML + b * CTXL + 64 * (i) : (long)b * SEQ + q0 - 128 + 64 * (jlo + (i) - 4))
#define WLOAD(i) do { const long tr_ = TROW(i) + srow; kreg = *(const v4u*)(Kp + tr_ * 256 + g * 64 + sch * 8); vreg = *(const v4u*)(RAW + tr_ * 1536 + 1280 + g * 64 + sch * 8); } while (0)
  WLOAD(0);
  for (int i = 0; i < NT; ++i) {
    const int buf = i & 1;
    *(LAS v4u*)(Kl + buf * 8192 + kswz<64>(srow, sch * 16)) = kreg;
    *(LAS v4u*)(Vl + buf * 8192 + v_st<64>(srow, sch * 8)) = vreg;
    __syncthreads();
    if (i + 1 < NT) WLOAD(i + 1);
    bool need = true; int T = 0;
    if (i >= 4) { T = q0 - 128 + 64 * (jlo + i - 4); const int qw0 = q0 + wid * 32; need = (T + 63 >= qw0 - 128) && (T <= qw0 + 31 + 128); }
    if (need) {
      f32x16 p0, p1; qkt<64>(p0, p1, Kl + buf * 8192, qr, r32, hi);
      if (i >= 4) { const int dq = q0 + wid * 32 + r32 - T;
#pragma unroll
        for (int r = 0; r < 16; ++r) { const int d0_ = dq - crow(r, hi), d1_ = d0_ - 32;
          if (d0_ > 128 || d0_ < -128) p0[r] = -1e30f;
          if (d1_ > 128 || d1_ < -128) p1[r] = -1e30f; } }
      bf16x8 pa0, pa1, pa2, pa3;
      if constexpr (FAST) {
#pragma unroll
        for (int r = 0; r < 16; ++r) { p0[r] = __builtin_amdgcn_exp2f(p0[r]); p1[r] = __builtin_amdgcn_exp2f(p1[r]); }
        l_reg += row_sum(p0, p1); pack_p(p0, p1, pa0, pa1, pa2, pa3); SBAR();
      } else {
      float mn, alpha; partialSM(p0, p1, m_reg, mn, alpha, C, THRS);
      if (__any(alpha < 1.f)) { if (hi == 0) al_l[r32] = alpha; asm volatile("s_waitcnt lgkmcnt(0)" ::: "memory");
#pragma unroll
        for (int d = 0; d < 2; ++d)
#pragma unroll
          for (int r = 0; r < 16; ++r) o[d][r] *= al_l[crow(r, hi)]; }
      finishSM(p0, p1, alpha, l_reg, pa0, pa1, pa2, pa3); SBAR();
      }
      pv_one<64, 0>(o[0], vb0 + buf * 8192, pa0, pa1, pa2, pa3); pv_one<64, 1>(o[1], vb0 + buf * 8192, pa0, pa1, pa2, pa3);
    }
  }
#undef TROW
#undef WLOAD
  l_reg += __builtin_amdgcn_exp2f(sink * LOG2E - (FAST ? 0.f : m_reg * C));
  if (hi == 0) li_l[r32] = l_reg; asm volatile("s_waitcnt lgkmcnt(0)" ::: "memory");
  float rli[16];
#pragma unroll
  for (int r = 0; r < 16; ++r) rli[r] = __builtin_amdgcn_rcpf(li_l[crow(r, hi)]);
  bf16* Ow = O + qrow_w * 1024 + h * 64;
#pragma unroll
  for (int r = 0; r < 16; ++r) { const int orow = crow(r, hi);
#pragma unroll
    for (int d0 = 0; d0 < 2; ++d0) Ow[(long)orow * 1024 + d0 * 32 + r32] = f2bf16(o[d0][r] * rli[r]); }
  __syncthreads();
}


__device__ __forceinline__ void ml_decode(int uid, int& b, int& h, int& dir, int& c, long& base, int& sgn) {
  c = uid % 66; const int sid = uid / 66; dir = sid & 1; h = (sid >> 1) & 3; b = sid >> 3;
  if (dir == 0) { base = c < 2 ? (long)ML + b * CTXL + 128 * c : (long)b * SEQ + 128 * (c - 2); sgn = 1; }
  else { base = c < 2 ? (long)ML + b * CTXL + 255 - 128 * c : (long)b * SEQ + 8191 - 128 * (c - 2); sgn = -1; }
}
__device__ __forceinline__ float wave_incl_scan_add(float v, int lane) {
#pragma unroll
  for (int o = 1; o < 64; o <<= 1) { const float t = bperm(v, lane - o); if (lane >= o) v += t; }
  return v;
}
__device__ __forceinline__ float wave_incl_scan_max(float v, int lane) {
#pragma unroll
  for (int o = 1; o < 64; o <<= 1) { const float t = bperm(v, lane - o); if (lane >= o) v = fmaxf(v, t); }
  return v;
}
__device__ __forceinline__ void ml1_load(const Frame& F, int uid, const bf16* RAW, const float* GATESb, v4u (&kq)[4], v4u (&vq)[8], float (&gt)[4]) {
  int b, h, dir, c, sgn; long base; ml_decode(uid, b, h, dir, c, base, sgn);
  const int wid = F.wave, ln = xb_lane(), tid = (wid << 6) | ln;
  if (wid == 0) { const long ra = base + sgn * ln, rb = base + sgn * (ln + 64);
    gt[0] = GATESb[ra * 16 + dir * 8 + h]; gt[1] = GATESb[ra * 16 + dir * 8 + 4 + h]; gt[2] = GATESb[rb * 16 + dir * 8 + h]; gt[3] = GATESb[rb * 16 + dir * 8 + 4 + h]; }
#pragma unroll
  for (int ii = 0; ii < 4; ++ii) { const int l = (tid >> 4) + 32 * ii; kq[ii] = *(const v4u*)(RAW + (size_t)(base + sgn * l) * 3072 + 512 + 128 * h + (tid & 15) * 8); }
#pragma unroll
  for (int ii = 0; ii < 8; ++ii) { const int l = (tid >> 5) + 16 * ii; vq[ii] = *(const v4u*)(RAW + (size_t)(base + sgn * l) * 3072 + 1024 + 256 * h + (tid & 31) * 8); }
}
__device__ __forceinline__ void ml1_unit(const Frame& F, int uid, int uid_next, const bf16* RAW, const float* GATESb, bf16* CBAR, float* NBAR, float* MSC, LAS char* lds, v4u (&kq)[4], v4u (&vq)[8], float (&gt)[4]) {
  using namespace att;
  LAS char* Kt = lds; LAS char* Vt = lds + 32768; LAS float* wS = (LAS float*)(lds + 98304); LAS float* nP = wS + 128;
  const int tid = F.tid, wid = F.wave, lane = F.lane, r32 = lane & 31, hi = lane >> 5;
  const float lia = gt[0], lfa = gt[1], lib = gt[2], lfb = gt[3];
  if (wid == 0) {
    const int lane = xb_lane();
    const float ca = wave_incl_scan_add(lfa, lane); const float tot = __int_as_float(__builtin_amdgcn_readlane(__float_as_int(ca), 63));
    const float cb = wave_incl_scan_add(lfb, lane) + tot; const float g = __int_as_float(__builtin_amdgcn_readlane(__float_as_int(cb), 63));
    const float ua = lia - ca, ub = lib - cb; const float um = wave_max(fmaxf(ua, ub), lane);
    wS[lane] = __builtin_amdgcn_exp2f((ua - um) * LOG2E); wS[lane + 64] = __builtin_amdgcn_exp2f((ub - um) * LOG2E);
    if (lane == 0) { MSC[(size_t)uid * 4 + 0] = g; MSC[(size_t)uid * 4 + 1] = g + um; }
  }
  __syncthreads();
  float kacc[8];
#pragma unroll
  for (int e = 0; e < 8; ++e) kacc[e] = 0.f;
#pragma unroll
  for (int ii = 0; ii < 4; ++ii) { const int l = (tid >> 4) + 32 * ii, cc = (tid & 15) * 8;
    *(LAS v4u*)(Kt + (l >> 6) * 16384 + v_st<128>(l & 63, cc)) = kq[ii];
    float f[8]; unpack8(kq[ii], f); const float wl = wS[l];
#pragma unroll
    for (int e = 0; e < 8; ++e) kacc[e] += wl * f[e]; }
#pragma unroll
  for (int ii = 0; ii < 8; ++ii) { const int l = (tid >> 5) + 16 * ii, cc = (tid & 31) * 8;
    float f[8]; unpack8(vq[ii], f); const float wl = wS[l];
#pragma unroll
    for (int e = 0; e < 8; ++e) f[e] *= wl;
    *(LAS v4u*)(Vt + ((l >> 6) * 2 + (cc >> 7)) * 16384 + v_st<128>(l & 63, cc & 127)) = pack8(f); }
#pragma unroll
  for (int e = 0; e < 8; ++e) { kacc[e] += bperm(kacc[e], lane ^ 16); kacc[e] += bperm(kacc[e], lane ^ 32); }
  if (lane < 16) {
#pragma unroll
    for (int e = 0; e < 8; ++e) nP[wid * 128 + lane * 8 + e] = kacc[e]; }
  __syncthreads();
  if (uid_next < ML_NUID) ml1_load(F, uid_next, RAW, GATESb, kq, vq, gt);
  if (wid < 2) { float s = 0.f; const int t2 = (wid << 6) + xb_lane();
#pragma unroll
    for (int w8 = 0; w8 < 8; ++w8) s += nP[w8 * 128 + t2];
    NBAR[(size_t)uid * 128 + t2] = s; }
  f32x16 acc[4]; acc[0] = f32x16{}; acc[1] = f32x16{}; acc[2] = f32x16{}; acc[3] = f32x16{};
  const int vbA = lds_addr(Vt) + (wid >> 2) * 16384 + (wid & 3) * 512 + v_rd_base(lane);
  const int vbB = lds_addr(Kt) + v_rd_base(lane);
#define ML1_STEP(KT, KS) do { \
    const s16x4 al = tr_read<(KT) * 32768 + (KS) * 4096>(vbA), ah = tr_read<(KT) * 32768 + (KS) * 4096 + 2048>(vbA); \
    const s16x4 b0l = tr_read<(KT) * 16384 + 0 * 512 + (KS) * 4096>(vbB), b0h = tr_read<(KT) * 16384 + 0 * 512 + (KS) * 4096 + 2048>(vbB); \
    const s16x4 b1l = tr_read<(KT) * 16384 + 1 * 512 + (KS) * 4096>(vbB), b1h = tr_read<(KT) * 16384 + 1 * 512 + (KS) * 4096 + 2048>(vbB); \
    const s16x4 b2l = tr_read<(KT) * 16384 + 2 * 512 + (KS) * 4096>(vbB), b2h = tr_read<(KT) * 16384 + 2 * 512 + (KS) * 4096 + 2048>(vbB); \
    const s16x4 b3l = tr_read<(KT) * 16384 + 3 * 512 + (KS) * 4096>(vbB), b3h = tr_read<(KT) * 16384 + 3 * 512 + (KS) * 4096 + 2048>(vbB); \
    asm volatile("s_waitcnt lgkmcnt(0)" ::: "memory"); SBAR(); \
    const bf16x8 a_ = (bf16x8){al[0], al[1], al[2], al[3], ah[0], ah[1], ah[2], ah[3]}; \
    acc[0] = __builtin_amdgcn_mfma_f32_32x32x16_bf16((bf16x8){b0l[0], b0l[1], b0l[2], b0l[3], b0h[0], b0h[1], b0h[2], b0h[3]}, a_, acc[0], 0, 0, 0); \
    acc[1] = __builtin_amdgcn_mfma_f32_32x32x16_bf16((bf16x8){b1l[0], b1l[1], b1l[2], b1l[3], b1h[0], b1h[1], b1h[2], b1h[3]}, a_, acc[1], 0, 0, 0); \
    acc[2] = __builtin_amdgcn_mfma_f32_32x32x16_bf16((bf16x8){b2l[0], b2l[1], b2l[2], b2l[3], b2h[0], b2h[1], b2h[2], b2h[3]}, a_, acc[2], 0, 0, 0); \
    acc[3] = __builtin_amdgcn_mfma_f32_32x32x16_bf16((bf16x8){b3l[0], b3l[1], b3l[2], b3l[3], b3h[0], b3h[1], b3h[2], b3h[3]}, a_, acc[3], 0, 0, 0); \
    SBAR(); } while (0)
  ML1_STEP(0, 0); ML1_STEP(0, 1); ML1_STEP(0, 2); ML1_STEP(0, 3); ML1_STEP(1, 0); ML1_STEP(1, 1); ML1_STEP(1, 2); ML1_STEP(1, 3);
#undef ML1_STEP
  bf16* cbp = CBAR + (size_t)uid * 32768;
#pragma unroll
  for (int nb = 0; nb < 4; ++nb)
#pragma unroll
    for (int g = 0; g < 4; ++g) { uint2 w; w.x = pg8::cvt_pk_bf16(acc[nb][4 * g], acc[nb][4 * g + 1]); w.y = pg8::cvt_pk_bf16(acc[nb][4 * g + 2], acc[nb][4 * g + 3]);
      *(uint2*)(cbp + ((wid * 8 + 2 * nb + (g >> 1)) * 64 + (g & 1) * 32 + r32) * 8 + 4 * hi) = w; }
  __syncthreads();
}
__device__ __forceinline__ void ml2_scan(const Frame& F, int s, bf16* CBAR, float* NBAR, float* MSC, LAS char* lds) {
  const int sid = s >> 3, slice = s & 7, uid0 = sid * 66;
  LAS float* gS = (LAS float*)lds; LAS float* mbS = gS + 66;
  __syncthreads();
  if (F.tid < 66) { gS[F.tid] = MSC[(size_t)(uid0 + F.tid) * 4 + 0]; mbS[F.tid] = MSC[(size_t)(uid0 + F.tid) * 4 + 1]; }
  __syncthreads();
  const size_t e0 = (size_t)(slice * 32 + (F.tid >> 4)) * 128 + (F.tid & 15) * 8;
  const bool nthr = (slice == 0) && (F.tid < 128);
  float Cs[8]; float m = -1e30f, nst = 0.f;
#pragma unroll
  for (int e = 0; e < 8; ++e) Cs[e] = 0.f;
  for (int grp = 0; grp < 3; ++grp) {
    v4u cb[22]; float nbv[22];
#pragma unroll
    for (int i = 0; i < 22; ++i) { cb[i] = *(const v4u*)(CBAR + (size_t)(uid0 + grp * 22 + i) * 32768 + e0); nbv[i] = nthr ? NBAR[(size_t)(uid0 + grp * 22 + i) * 128 + F.tid] : 0.f; }
#pragma unroll
    for (int i = 0; i < 22; ++i) {
      const int c = grp * 22 + i, uid = uid0 + c;
      const float g = gS[c], mb = mbS[c];
      *(v4u*)(CBAR + (size_t)uid * 32768 + e0) = pack8(Cs);
      if (slice == 0 && F.tid == 0) MSC[(size_t)uid * 4 + 2] = m;
      if (nthr) NBAR[(size_t)uid * 128 + F.tid] = nst;
      const float m_new = fmaxf(g + m, mb), decay = __expf(g + m - m_new), inj = __expf(mb - m_new);
      float f[8]; unpack8(cb[i], f);
#pragma unroll
      for (int e = 0; e < 8; ++e) Cs[e] = decay * Cs[e] + inj * f[e];
      nst = decay * nst + inj * nbv[i]; m = m_new;
    }
  }
}
__device__ __forceinline__ void ml3_load(const Frame& F, int uid, const bf16* RAW, const float* GATESb, const float* MSC, const float* NBAR, bf16x8 (&qr)[8], v4u (&kq)[4], float (&gt)[5], float& nbv) {
  int b, h, dir, c, sgn; long base; ml_decode(uid, b, h, dir, c, base, sgn);
  const int wid = F.wave, ln = xb_lane(), tid = (wid << 6) | ln, r32 = ln & 31, hi = ln >> 5, lq = 32 * (wid & 3) + r32;
  if (wid == 0) { const long ra = base + sgn * ln, rb = base + sgn * (ln + 64);
    gt[0] = GATESb[ra * 16 + dir * 8 + h]; gt[1] = GATESb[ra * 16 + dir * 8 + 4 + h]; gt[2] = GATESb[rb * 16 + dir * 8 + h]; gt[3] = GATESb[rb * 16 + dir * 8 + 4 + h]; gt[4] = MSC[(size_t)uid * 4 + 2]; }
  else if (wid == 2 || wid == 3) nbv = NBAR[(size_t)uid * 128 + tid - 128];
  { const bf16* qp = RAW + (size_t)(base + sgn * lq) * 3072 + 128 * h + hi * 8;
#pragma unroll
    for (int d0 = 0; d0 < 8; ++d0) qr[d0] = *(const bf16x8*)(qp + d0 * 16); }
#pragma unroll
  for (int ii = 0; ii < 4; ++ii) { const int l = (tid >> 4) + 32 * ii; kq[ii] = *(const v4u*)(RAW + (size_t)(base + sgn * l) * 3072 + 512 + 128 * h + (tid & 15) * 8); }
}
__device__ __forceinline__ void ml3_unit(const Frame& F, int uid, int uid_next, const bf16* RAW, const float* GATESb, const bf16* CBAR, const float* NBAR, const float* MSC, bf16* HX, LAS char* lds,
                                         bf16x8 (&qr)[8], v4u (&kq)[4], float (&gt)[5], float& nbv) {
  using namespace att;
  constexpr float SCQ = 0.08838834764831845f;
  LAS char* Kl = lds; LAS char* Vl = lds + 32768;
  LAS float* uS = (LAS float*)(lds + 98304); LAS float* MS_ = uS + 128; LAS float* wiS = uS + 256; LAS float* emS = uS + 384; LAS float* nS = uS + 512;
  int b, h, dir, c, sgn; long base; ml_decode(uid, b, h, dir, c, base, sgn);
  const int tid = F.tid, wid = F.wave, lane = F.lane, r32 = lane & 31, hi = lane >> 5;
  LAS float* wsf = (LAS float*)(lds + 98304 + 2560) + wid * 64;
  const int rblk = wid & 3, dh = wid >> 2, lq = 32 * rblk + r32;
  const float lia = gt[0], lfa = gt[1], lib = gt[2], lfb = gt[3], ms = gt[4];
  v4u vq[8];
#pragma unroll
  for (int ii = 0; ii < 8; ++ii) { const int l = (tid >> 5) + 16 * ii; vq[ii] = *(const v4u*)(RAW + (size_t)(base + sgn * l) * 3072 + 1024 + 256 * h + (tid & 31) * 8); }
  if (wid == 0) {
    const int lane = xb_lane();
    const float ca = wave_incl_scan_add(lfa, lane); const float tot = __int_as_float(__builtin_amdgcn_readlane(__float_as_int(ca), 63));
    const float cb = wave_incl_scan_add(lfb, lane) + tot;
    const float ua = lia - ca, ub = lib - cb;
    const float pa = wave_incl_scan_max(ua, lane); const float pma = __int_as_float(__builtin_amdgcn_readlane(__float_as_int(pa), 63));
    const float pb = fmaxf(wave_incl_scan_max(ub, lane), pma);
    const float Ma = fmaxf(ms, pa), Mb = fmaxf(ms, pb);
    uS[lane] = ua; uS[lane + 64] = ub; MS_[lane] = Ma; MS_[lane + 64] = Mb;
    wiS[lane] = __builtin_amdgcn_exp2f((ms - Ma) * LOG2E); wiS[lane + 64] = __builtin_amdgcn_exp2f((ms - Mb) * LOG2E);
    emS[lane] = __builtin_amdgcn_exp2f(-(ca + Ma) * LOG2E); emS[lane + 64] = __builtin_amdgcn_exp2f(-(cb + Mb) * LOG2E);
  } else if (wid == 2 || wid == 3) { const int t2 = (wid << 6) + xb_lane() - 128; nS[t2] = nbv; }
#pragma unroll
  for (int ii = 0; ii < 4; ++ii) { const int l = (tid >> 4) + 32 * ii; *(LAS v4u*)(Kl + kswz<128>(l, (tid & 15) * 16)) = kq[ii]; }
  f32x16 o[4]; o[0] = f32x16{}; o[1] = f32x16{}; o[2] = f32x16{}; o[3] = f32x16{};
  { const bf16* cp = CBAR + (size_t)uid * 32768 + (size_t)(dh * 4 * 8 * 64 + lane) * 8;
#pragma unroll
    for (int j = 0; j < 4; ++j) {
#pragma unroll
      for (int dh0 = 0; dh0 < 8; dh0 += 4) {
        bf16x8 cf[4];
#pragma unroll
        for (int d0 = 0; d0 < 4; ++d0) cf[d0] = *(const bf16x8*)(cp + (size_t)((j * 8 + dh0 + d0) * 64) * 8);
#pragma unroll
        for (int d0 = 0; d0 < 4; ++d0) o[j] = __builtin_amdgcn_mfma_f32_32x32x16_bf16(qr[dh0 + d0], cf[d0], o[j], 0, 0, 0); } } }
#pragma unroll
  for (int ii = 0; ii < 8; ++ii) { const int l = (tid >> 5) + 16 * ii, cc = (tid & 31) * 8; *(LAS v4u*)(Vl + ((l >> 6) * 2 + (cc >> 7)) * 16384 + v_st<128>(l & 63, cc & 127)) = vq[ii]; }
  __syncthreads();
  float qn = 0.f;
#pragma unroll
  for (int d0 = 0; d0 < 8; ++d0)
#pragma unroll
    for (int e = 0; e < 8; ++e) qn += bf2f((unsigned short)qr[d0][e]) * nS[d0 * 16 + hi * 8 + e];
  qn += bperm(qn, lane ^ 32);
#pragma unroll
  for (int r = 0; r < 16; ++r) { const float wi = wiS[32 * rblk + crow(r, hi)]; o[0][r] *= wi; o[1][r] *= wi; o[2][r] *= wi; o[3][r] *= wi; }
  float den = 0.f; const float Mq = MS_[lq];
  const int vb0 = lds_addr(Vl) + dh * 16384 + v_rd_base(lane);
#pragma nounroll
  for (int kt = 0; kt < 2; ++kt) {
    if (64 * kt <= 32 * rblk + 31) {
      f32x16 p0, p1; qkt<128>(p0, p1, Kl + kt * 16384, qr, r32, hi);
      const LAS float* up = uS + 64 * kt + 4 * hi; const int dql = lq - 64 * kt - 4 * hi;
#pragma unroll
      for (int r = 0; r < 16; ++r) { const int cr = (r & 3) + 8 * (r >> 2);
        const float u0 = up[cr], u1 = up[cr + 32];
        const float a0 = (cr <= dql) ? (u0 - Mq) * LOG2E : -1e30f, a1 = (cr + 32 <= dql) ? (u1 - Mq) * LOG2E : -1e30f;
        p0[r] *= __builtin_amdgcn_exp2f(a0); p1[r] *= __builtin_amdgcn_exp2f(a1); }
      asm volatile("" : "+v"(p0), "+v"(p1));
      den += row_sum(p0, p1);
      bf16x8 pa0, pa1, pa2, pa3; pack_p(p0, p1, pa0, pa1, pa2, pa3); SBAR();
      const int vb = vb0 + kt * 32768;
      pv_one<128, 0>(o[0], vb, pa0, pa1, pa2, pa3); pv_one<128, 1>(o[1], vb, pa0, pa1, pa2, pa3); pv_one<128, 2>(o[2], vb, pa0, pa1, pa2, pa3); pv_one<128, 3>(o[3], vb, pa0, pa1, pa2, pa3);
    }
  }
  if (uid_next >= 0) ml3_load(F, uid_next, RAW, GATESb, MSC, NBAR, qr, kq, gt, nbv);
  const float dtot = den + wiS[lq] * qn;
  const float fac = SCQ / fmaxf(SCQ * fabsf(dtot), emS[lq]);
  if (hi == 0) wsf[r32] = fac; asm volatile("s_waitcnt lgkmcnt(0)" ::: "memory");
  int r32e = r32, hie = hi; asm volatile("" : "+v"(r32e), "+v"(hie));
#pragma unroll
  for (int r = 0; r < 16; ++r) { const int lo_ = 32 * rblk + crow(r, hie); const float fr_ = wsf[crow(r, hie)];
    bf16* op = HX + (size_t)(base + sgn * lo_) * 1024 + 256 * h + 128 * dh + r32e;
    op[0] = f2bf16(o[0][r] * fr_); op[32] = f2bf16(o[1][r] * fr_); op[64] = f2bf16(o[2][r] * fr_); op[96] = f2bf16(o[3][r] * fr_); }
  __syncthreads();
}
__device__ __forceinline__ void mln_phase(const Frame& F, bf16* HF, const bf16* HB, const bf16* RAW, const float* hnorm) {
  const int j = F.lane & 31, hh = F.lane >> 5;
  float hn[8];
#pragma unroll
  for (int e = 0; e < 8; ++e) hn[e] = hnorm[8 * j + e];
  for (int r = F.gw; r < ML; r += F.ngw) {
#pragma unroll
    for (int p = 0; p < 2; ++p) { const size_t off = (size_t)r * 1024 + 256 * (2 * p + hh) + 8 * j;
      float a[8], b[8], g[8]; unpack8(*(const v4u*)(HF + off), a); unpack8(*(const v4u*)(HB + off), b); unpack8(*(const v4u*)(RAW + (size_t)r * 3072 + 2048 + 256 * (2 * p + hh) + 8 * j), g);
      float ss = 0.f;
#pragma unroll
      for (int e = 0; e < 8; ++e) { a[e] += b[e]; ss += a[e] * a[e]; }
#pragma unroll
      for (int o = 1; o < 32; o <<= 1) ss += bperm(ss, F.lane ^ o);
      const float rs = __builtin_amdgcn_rsqf(ss * (1.f / 256.f) + EPS);
#pragma unroll
      for (int e = 0; e < 8; ++e) a[e] = sigmoidf_(g[e]) * a[e] * rs * hn[e];
      *(v4u*)(HF + off) = pack8(a); }
  }
}

struct Args { const float* in[27]; float* out; unsigned char* ws; };
enum { I_X = 0, I_C, I_CTX, I_CCTX, I_ADAW, I_ADAB, I_NMIX, I_NFFN, I_WUP, I_FCONV, I_WDOWN, I_WINQKV, I_WINQN, I_WINKN, I_WINSINK, I_WINWO,
       I_SCWIN, I_SCCONV, I_SCWOUT, I_AXQKV, I_AXQN, I_AXKN, I_AXWO, I_MLWIN, I_MLBG, I_MLHN, I_MLWOUT };
typedef const __attribute__((address_space(4))) Args* ArgsP;

typedef pg8::StaticOrder SOrd;
#define GEMM_BF16(Aptr, Bptr, Mrows, Ncols, Kdim, Optr, ldc_) do { pg8::Gemm g_{(const pg8::bf16_t*)(Aptr), (const pg8::bf16_t*)(Bptr), (Mrows), (Ncols), (Kdim)}; SOrd S_; S_.init((Mrows), (Ncols), F.G, bid); \
    pg8::EpiStoreBf16 E_{(pg8::bf16_t*)(Optr), (ldc_)}; pg8::gemm_phase<pg8::EpiStoreBf16, SOrd, true, true>(F.lds, g_, S_, E_, F.tid); } while (0)
#define GEMM_RESID(Aptr, Bptr, Mrows, Kdim, blat, bctx, olat, octx, gatep, tile0_, bin_, bout_) do { pg8::Gemm g_{(const pg8::bf16_t*)(Aptr), (const pg8::bf16_t*)(Bptr), (Mrows), 1024, (Kdim)}; pg8::CtxSplitOrder S_; S_.init((Kdim), (Mrows) > ML, F.G, bid); \
    pg8::EpiResid E_{(blat), (bctx), (olat), (octx), (gatep), (tile0_), (bin_), (bout_)}; pg8::gemm_phase<pg8::EpiResid, pg8::CtxSplitOrder, true, true>(F.lds, g_, S_, E_, F.tid); } while (0)
#define PHASE() do { asm volatile("" : "+s"(F.wave)); F.tid = (F.wave << 6) | xb_lane(); asm volatile("" : "+v"(F.tid)); F.lane = F.tid & 63; asm volatile("" : "+s"(bid), "+s"(F.G)); \
    F.gw = bid * NWAVES + F.wave; F.ngw = F.G * NWAVES; asm volatile("" : "+s"(ap)); ws = ap->ws; asm volatile("" : "+s"(F.lds)); ldsc = (LAS char*)F.lds; asm volatile("" : "+s"(bar.bar), "+s"(bar.x), "+s"(bar.st)); } while (0)
#define AIN(k) (ap->in[k])
__device__ __forceinline__ int ml1_uid(int u) { const int sid = u / 66; int c = u - sid * 66; if (sid & 1) { const int cf = c + 2 >= 66 ? c + 2 - 66 : c + 2; c = cf >= 2 ? 67 - cf : 1 - cf; } return sid * 66 + c; }
__device__ __forceinline__ int ml3_uid(int u) { const int sid = u >> 6; int cc = u & 63; if (sid & 1) cc = 63 - cc; return sid * 66 + cc + 2; }

__global__ void __launch_bounds__(NWAVES * 64, 2) hybrid_fwd(Args args_unused) {
    extern __shared__ __attribute__((aligned(16))) unsigned char lds_raw[];
    ArgsP ap = (ArgsP)__builtin_amdgcn_kernarg_segment_ptr();
    Frame F;
    F.lds = (LAS unsigned char*)lds_raw;
    F.tid = threadIdx.x; F.lane = F.tid & 63; F.wave = __builtin_amdgcn_readfirstlane(F.tid >> 6);
    int bid = blockIdx.x;
    F.G = gridDim.x; F.gw = bid * NWAVES + F.wave; F.ngw = F.G * NWAVES;
    unsigned char* ws = ap->ws;
    for (int u = F.tid; u < (LDS_BYTES - LDSCTL_OFF) / 4; u += NWAVES * 64) ((LAS unsigned*)(F.lds + LDSCTL_OFF))[u] = 0u;
    __syncthreads();
    XcdBarrier bar = xcd_barrier_post((unsigned*)((gu32*)(ws + WS_CTL) + CW_BAR), (volatile LAS unsigned*)(F.lds + MISC_OFF) + 8, F.wave);
#define GRID_BAR() xcd_barrier(bar, F.wave)
    LAS char* ldsc = (LAS char*)F.lds;

    {
        __syncthreads();
        PHASE();
        mod_phase(F, AIN(I_C), AIN(I_CCTX), AIN(I_ADAW), AIN(I_ADAB), (float*)(ws + WS_MOD));
        rope_tables(F, (float*)(ws + WS_ROPE64), (float*)(ws + WS_ROPE128));
        for (int i = bid * 512 + F.tid; i < MC * DM / 4; i += F.G * 512) ((f32x4*)(ws + WS_HC))[i] = ((const f32x4*)AIN(I_CTX))[i];
        int rot = 0;
#pragma nounroll
        for (int l = 0; l < 4; ++l) {
            const size_t lb = l == 0 ? WT_L0 : l == 1 ? WT_L1 : l == 2 ? WT_L2 : WT_L3;
            const size_t szin = (l == 0 || l == 2) ? SZ_W1536 : SZ_W3072;
            const float* win = l == 0 ? AIN(I_WINQKV) : l == 1 ? AIN(I_SCWIN) : l == 2 ? AIN(I_AXQKV) : AIN(I_MLWIN);
            const float* wout = l == 0 ? AIN(I_WINWO) : l == 1 ? AIN(I_SCWOUT) : l == 2 ? AIN(I_AXWO) : AIN(I_MLWOUT);
            const int nin = (l == 0 || l == 2) ? 1536 : 3072, pin = l == 3 ? 3088 : nin;
            transpose_matrix(F, win, 1024, pin, nin, (bf16*)(ws + lb), rot);
            transpose_matrix(F, wout, 1024, 1024, 1024, (bf16*)(ws + lb + szin), rot);
            transpose_matrix(F, AIN(I_WUP) + (size_t)l * 1024 * NUP, 1024, NUP, NUP, (bf16*)(ws + lb + szin + SZ_W1024), rot, true);
            transpose_matrix(F, AIN(I_WDOWN) + (size_t)l * DFF * 1024, DFF, 1024, 1024, (bf16*)(ws + lb + szin + SZ_W1024 + SZ_UP), rot);
        }
    }
    GRID_BAR();

#pragma nounroll
    for (int layer = 0; layer < 4; ++layer) {
        asm volatile("" : "+s"(layer));
#define LB() (layer == 0 ? WT_L0 : layer == 1 ? WT_L1 : layer == 2 ? WT_L2 : WT_L3)
#define SZIN() ((layer == 0 || layer == 2) ? SZ_W1536 : SZ_W3072)
#define MODP() ((const float*)(ws + WS_MOD) + (size_t)layer * 5 * 6144)
#define HB_A() ((void*)ap->out)
#define HB_B() ((void*)((bf16*)ap->out + (size_t)ML * 1024))
#define HLAT() (layer == 0 ? (const void*)AIN(I_X) : (const void*)HB_B())
#define HMID() (layer == 3 ? (void*)(ws + WS_WT) : HB_A())
#define HCTX() ((const float*)(ws + WS_HC))
#define ROWS_OUT() (layer == 3 ? ML : MT)

        PHASE();
        if (layer == 3) norm_phase<true>(F, HLAT(), layer != 0, (float*)(ws + WS_HC), (const float*)(ws + BG_SLAB), layer == 0 ? 0 : 11, MT, AIN(I_NMIX) + layer * 1024, MODP(), 0, 1024, (bf16*)(ws + WS_XN), AIN(I_MLWIN), AIN(I_MLBG), (float*)(ws + WS_GATES));
        else norm_phase<false>(F, HLAT(), layer != 0, (float*)(ws + WS_HC), (const float*)(ws + BG_SLAB), layer == 0 ? 0 : 11, MT, AIN(I_NMIX) + layer * 1024, MODP(), 0, 1024, (bf16*)(ws + WS_XN), nullptr, nullptr, nullptr);
        GRID_BAR();
        PHASE();
        { const int nin = (layer == 0 || layer == 2) ? 1536 : 3072;
          GEMM_BF16(ws + WS_XN, ws + LB(), MT, nin, 1024, ws + BG_RAW, nin); }
        GRID_BAR();
        if (layer == 0) {
            PHASE();
            bool fast_w;
            { const float* gq_ = AIN(I_WINQN); const float* gk_ = AIN(I_WINKN);
              const float gqm = wave_max(fabsf(gq_[F.lane]), F.lane), gkm = wave_max(fabsf(gk_[F.lane]), F.lane);
              fast_w = __builtin_amdgcn_readfirstlane((11.55f * gqm * gkm <= 80.f) ? 1 : 0) != 0; }
            if (fast_w) knorm_rope64(F, (const bf16*)(ws + BG_RAW), AIN(I_WINKN), (const float*)(ws + WS_ROPE64), (bf16*)(ws + BG_K));
            else qknorm_rope64(F, (const bf16*)(ws + BG_RAW), AIN(I_WINQN), AIN(I_WINKN), (const float*)(ws + WS_ROPE64), (bf16*)(ws + BG_Q), (bf16*)(ws + BG_K));
            GRID_BAR();
            PHASE();
            for (int i_ = 0; i_ < 9; ++i_) {
                int u;
                if (F.G == 256) { if (i_ < 8) { const int x = bid & 7, li = 32 * i_ + (bid >> 3), pg = 2 * x + (li >> 7); u = (pg >> 2) * 512 + ((pg & 3) * 4 + ((li >> 5) & 3)) * 32 + (li & 31); }
                                  else { if (bid >= 64) break; u = 2048 + bid; } }
                else { u = bid + i_ * F.G; if (u >= 2048 + 64) break; }
                const bf16* Qp = (const bf16*)(ws + BG_Q); const bf16* Kp = (const bf16*)(ws + BG_K); const bf16* RAW = (const bf16*)(ws + BG_RAW); bf16* Ob = (bf16*)(ws + BG_O);
                const bool cq = u >= 2048; const int v = cq ? u - 2048 : u, qb = cq ? 0 : (v & 31), h = cq ? (v & 15) : ((v >> 5) & 15), b = cq ? (v >> 4) : (v >> 9);
                if (fast_w) win_attn_unit<true>(F, cq, b, h, qb, RAW, Kp, RAW, Ob, AIN(I_WINSINK)[h], ldsc, AIN(I_WINQN), (const float*)(ws + WS_ROPE64));
                else win_attn_unit<false>(F, cq, b, h, qb, Qp, Kp, RAW, Ob, AIN(I_WINSINK)[h], ldsc, AIN(I_WINQN), (const float*)(ws + WS_ROPE64));
            }
        } else if (layer == 1) {
            PHASE();
            sconv_phase(F, (const bf16*)(ws + BG_RAW), AIN(I_SCCONV), (bf16*)(ws + BG_O));
        } else if (layer == 2) {
            PHASE();
            bool fast_sm;
            { const float* gq_ = AIN(I_AXQN); const float* gk_ = AIN(I_AXKN);
              const float gqm = wave_max(fmaxf(fabsf(gq_[F.lane]), fabsf(gq_[F.lane + 64])), F.lane), gkm = wave_max(fmaxf(fabsf(gk_[F.lane]), fabsf(gk_[F.lane + 64])), F.lane);
              fast_sm = __builtin_amdgcn_readfirstlane((16.33f * gqm * gkm <= 80.f) ? 1 : 0) != 0; }
            if (fast_sm) knorm_rope128(F, (const bf16*)(ws + BG_RAW), AIN(I_AXKN), (const float*)(ws + WS_ROPE128), (bf16*)(ws + BG_K), (bf16*)(ws + BG_V));
            else qknorm_rope128(F, (const bf16*)(ws + BG_RAW), AIN(I_AXQN), AIN(I_AXKN), (const float*)(ws + WS_ROPE128), (bf16*)(ws + BG_Q), (bf16*)(ws + BG_K), (bf16*)(ws + BG_V));
            GRID_BAR();
            PHASE();
            for (int i_ = 0; i_ < 5; ++i_) {
                int u;
                if (F.G == 256) { if (i_ < 4) { const int x = bid & 7, j_ = (bid >> 3) + 32 * i_; u = ((x >> 1) * 8 + (x & 1) * 4 + (j_ >> 5)) * 32 + (j_ & 31); } else { if (bid >= 32) break; u = 1024 + bid; } }
                else { u = bid + i_ * F.G; if (u >= 1024 + 32) break; }
                const unsigned short* Qp = (const unsigned short*)(ws + BG_Q); const unsigned short* K2 = (const unsigned short*)(ws + BG_K); const unsigned short* V2 = (const unsigned short*)(ws + BG_V); unsigned short* Ob = (unsigned short*)(ws + BG_O);
                unsigned qoff, kvo, qraw; int seq_, t0_;
                if (u < 1024) { const int qb = u & 31, h = (u >> 5) & 7, b = u >> 8; qoff = (unsigned)(b * SEQ + qb * 256) * 1024u + h * 128; qraw = (unsigned)(b * SEQ + qb * 256) * 1536u + h * 128; t0_ = qb * 256;
                                kvo = (unsigned)b * (8448u * 256u) + (h >> 2) * 128; seq_ = 8448; }
                else { const int v = u - 1024, h = v & 7, b = v >> 3; qoff = (unsigned)(ML + b * CTXL) * 1024u + h * 128; qraw = (unsigned)(ML + b * CTXL) * 1536u + h * 128; t0_ = 0;
                       kvo = ((unsigned)b * 8448u + 8192u) * 256u + (h >> 2) * 128; seq_ = 256; }
                qoff = __builtin_amdgcn_readfirstlane(qoff); kvo = __builtin_amdgcn_readfirstlane(kvo); seq_ = __builtin_amdgcn_readfirstlane(seq_); qraw = __builtin_amdgcn_readfirstlane(qraw); t0_ = __builtin_amdgcn_readfirstlane(t0_);
                const int tid_ = (F.wave << 6) | xb_lane();
                if (fast_sm) exf::attn_dense_body<exf::bf16>((const unsigned short*)(ws + BG_RAW) + qraw, K2 + kvo, V2 + kvo, Ob + qoff, seq_, (char*)F.lds, tid_, AIN(I_AXQN), (const float*)(ws + WS_ROPE128), t0_, u < 1024);
                else exd::attn_dense_body<exd::bf16>(Qp + qoff, K2 + kvo, V2 + kvo, Ob + qoff, seq_, (char*)F.lds, tid_);
                __syncthreads();
            }
        } else {
            PHASE();
            { v4u kq_[4], vq_[8]; float gt_[4] = {0.f, 0.f, 0.f, 0.f}; int u = bid;
#pragma unroll
              for (int i_ = 0; i_ < 4; ++i_) kq_[i_] = (v4u){0u, 0u, 0u, 0u};
#pragma unroll
              for (int i_ = 0; i_ < 8; ++i_) vq_[i_] = (v4u){0u, 0u, 0u, 0u};
              if (u < ML_NUID) ml1_load(F, ml1_uid(u), (const bf16*)(ws + BG_RAW), (const float*)(ws + WS_GATES), kq_, vq_, gt_);
              for (; u < ML_NUID; u += F.G) ml1_unit(F, ml1_uid(u), u + F.G < ML_NUID ? ml1_uid(u + F.G) : ML_NUID, (const bf16*)(ws + BG_RAW), (const float*)(ws + WS_GATES), (bf16*)(ws + BG_CBAR), (float*)(ws + BG_NBAR), (float*)(ws + BG_MSC), ldsc, kq_, vq_, gt_); }
            GRID_BAR();
            PHASE();
            for (int s = bid; s < 256; s += F.G) ml2_scan(F, s, (bf16*)(ws + BG_CBAR), (float*)(ws + BG_NBAR), (float*)(ws + BG_MSC), ldsc);
            GRID_BAR();
            PHASE();
            { bf16x8 qr_[8]; v4u kq_[4]; float gt_[5] = {0.f, 0.f, 0.f, 0.f, 0.f}, nbv_ = 0.f;
#pragma unroll
              for (int i_ = 0; i_ < 8; ++i_) qr_[i_] = bf16x8{};
#pragma unroll
              for (int i_ = 0; i_ < 4; ++i_) kq_[i_] = (v4u){0u, 0u, 0u, 0u};
              int u = bid;
              if (u < 2048) ml3_load(F, ml3_uid(u), (const bf16*)(ws + BG_RAW), (const float*)(ws + WS_GATES), (const float*)(ws + BG_MSC), (const float*)(ws + BG_NBAR), qr_, kq_, gt_, nbv_);
              for (; u < 2048; u += F.G) { const int sid = u >> 6, un = u + F.G;
                ml3_unit(F, ml3_uid(u), un < 2048 ? ml3_uid(un) : -1, (const bf16*)(ws + BG_RAW), (const float*)(ws + WS_GATES), (const bf16*)(ws + BG_CBAR), (const float*)(ws + BG_NBAR),
                         (const float*)(ws + BG_MSC), (sid & 1) ? (bf16*)(ws + WS_HB) : (bf16*)(ws + WS_HF), ldsc, qr_, kq_, gt_, nbv_); } }
            GRID_BAR();
            PHASE();
            mln_phase(F, (bf16*)(ws + WS_HF), (const bf16*)(ws + WS_HB), (const bf16*)(ws + BG_RAW), AIN(I_MLHN));
        }
        GRID_BAR();
        PHASE();
        GEMM_RESID(layer == 3 ? ws + WS_HF : ws + BG_O, ws + LB() + SZIN(), ROWS_OUT(), 1024, HLAT(), HCTX(), HMID(), (float*)(ws + BG_SLAB), MODP() + 2048, 0, layer != 0, true);
        GRID_BAR();
        PHASE();
        norm_phase<false>(F, HMID(), true, (float*)(ws + WS_HC), (const float*)(ws + BG_SLAB), layer == 3 ? 0 : 4, ROWS_OUT(), AIN(I_NFFN) + layer * 1024, MODP(), 3072, 4096, (bf16*)(ws + WS_XN), nullptr, nullptr, nullptr);
        GRID_BAR();
        PHASE();
        { pg8::Gemm g_{(const pg8::bf16_t*)(ws + WS_XN), (const pg8::bf16_t*)(ws + LB() + SZIN() + SZ_W1024), ROWS_OUT(), NUP, 1024}; SOrd S_; S_.init(ROWS_OUT(), NUP, F.G, bid);
          pg8::EpiConvAct E_{(pg8::bf16_t*)(ws + BG_ACT), (float*)(ws + BG_HALO), AIN(I_FCONV) + (size_t)layer * 3 * NUP, (LAS float*)(F.lds + XB_OFF)};
          pg8::gemm_phase<pg8::EpiConvAct, SOrd, true, true>(F.lds, g_, S_, E_, F.tid); }
        GRID_BAR();
        PHASE();
        { SOrd S_; S_.init(ML, 1024, F.G, bid); pg8::Unit u_;
          for (int i_ = 0; S_.next(i_, u_); ++i_) ffn_fixup(F, u_.pm, (const float*)(ws + BG_HALO), AIN(I_FCONV) + (size_t)layer * 3 * NUP, (bf16*)(ws + BG_ACT));
          asm volatile("s_waitcnt vmcnt(0)" ::: "memory"); __syncthreads(); }
        GEMM_RESID(ws + BG_ACT, ws + LB() + SZIN() + SZ_W1024 + SZ_UP, ROWS_OUT(), DFF, HMID(), (const float*)(ws + WS_HC), layer == 3 ? (void*)ap->out : HB_B(), (float*)(ws + BG_SLAB), MODP() + 5120, 0, true, layer != 3);
        GRID_BAR();
    }
}

extern "C" void kernel_launch(void* const* d_in, const int* in_sizes, int n_in, void* d_out, int out_size, void* d_ws, size_t ws_size, hipStream_t stream) {
    static int grid = 0;
    if (grid == 0) {
        if (n_in != 27 || out_size != ML * DM || ws_size < WS_END) { fprintf(stderr, "kernel_launch: unexpected shapes: n_in %d out %d ws %zu (need %zu)\n", n_in, out_size, ws_size, (size_t)WS_END); grid = -1; return; }
        int dev = 0, cus = 0;
        if (hipGetDevice(&dev) != hipSuccess || hipDeviceGetAttribute(&cus, hipDeviceAttributeMultiprocessorCount, dev) != hipSuccess) { grid = -1; return; }
        if (hipFuncSetAttribute((const void*)hybrid_fwd, hipFuncAttributeMaxDynamicSharedMemorySize, LDS_BYTES) != hipSuccess) { fprintf(stderr, "kernel_launch: hipFuncSetAttribute failed\n"); grid = -1; return; }
        int per_cu = 0;
        if (hipOccupancyMaxActiveBlocksPerMultiprocessor(&per_cu, (const void*)hybrid_fwd, NWAVES * 64, LDS_BYTES) != hipSuccess || per_cu < 1) { fprintf(stderr, "kernel_launch: occupancy query reports %d\n", per_cu); }
        (void)hipGetLastError();
        grid = cus;
    }
    if (grid < 0) return;
    if (hipMemsetAsync((char*)d_ws + WS_CTL, 0, CTL_ZERO_BYTES, stream) != hipSuccess) return;
    Args a{};
    for (int i = 0; i < 27; ++i) a.in[i] = (const float*)d_in[i];
    a.out = (float*)d_out; a.ws = (unsigned char*)d_ws;
    hipLaunchKernelGGL(hybrid_fwd, dim3(grid), dim3(NWAVES * 64), LDS_BYTES, stream, a);
}
```
